# Optimizing an MI355X kernel written in HIP

```python
import math
import jax, jax.numpy as jnp
from jax import lax
import numpy as np

D_MODEL = 1024
BATCH = 4
SEQ = 4096
DEPTH = 2

D_MIX = D_MODEL
A_HEADS = 4
A_HEAD_DIM = 128
A_WIDTH = A_HEADS * A_HEAD_DIM
CONV_K = 4
CHUNK = 64
B_Q_HEADS = 8
B_KV_HEADS = 2
B_HEAD_DIM = 64
B_GROUP = B_Q_HEADS // B_KV_HEADS
B_WIDTH = B_Q_HEADS * B_HEAD_DIM
B_KV_WIDTH = B_KV_HEADS * B_HEAD_DIM
WINDOW = 128
BLOCK = 128
IN_SIZES = (A_WIDTH, A_WIDTH, A_WIDTH, A_WIDTH, A_HEADS, A_HEADS,
            B_WIDTH, B_KV_WIDTH, B_KV_WIDTH, B_WIDTH)
IN_COLS = sum(IN_SIZES)
DEEPNORM_ALPHA = (2 * DEPTH) ** 0.25
DEEPNORM_BETA = (8 * DEPTH) ** -0.25
LN_EPS = 1e-5
RMS_EPS = 1e-6
L2_EPS = 1e-6

kernel_name = "hybrid_deltanet_swa_sink_alibi_deepnorm"


def _alibi_slopes(n_heads):
    return jnp.asarray([2.0 ** (-8.0 * (h + 1) / n_heads) for h in range(n_heads)], dtype=jnp.float32)


def _layernorm(x, g, b):
    xf = x.astype(jnp.float32)
    mu = jnp.mean(xf, axis=-1, keepdims=True)
    var = jnp.mean(jnp.square(xf - mu), axis=-1, keepdims=True)
    y = (xf - mu) * lax.rsqrt(var + LN_EPS) * g.astype(jnp.float32) + b.astype(jnp.float32)
    return y.astype(x.dtype)


def _l2norm(t):
    return t * lax.rsqrt(jnp.sum(jnp.square(t), axis=-1, keepdims=True) + L2_EPS)


def _short_conv(x, w):
    c = x.shape[-1]
    return lax.conv_general_dilated(
        x, w[:, None, :].astype(x.dtype), window_strides=(1,), padding=[(CONV_K - 1, 0)],
        dimension_numbers=('NWC', 'WIO', 'NWC'), feature_group_count=c)


def _gated_delta_rule(q, k, v, g, beta):
    bsz, t_len, h, dk = q.shape
    dv = v.shape[-1]
    n = t_len // CHUNK

    def chunks(t):
        t = t.reshape((bsz, n, CHUNK, h) + t.shape[3:])
        return jnp.moveaxis(t, 3, 1)

    q, k, v, g, beta = chunks(q), chunks(k), chunks(v), chunks(g), chunks(beta)
    g = jnp.cumsum(g, axis=-1)
    causal = jnp.tril(jnp.ones((CHUNK, CHUNK), dtype=bool))
    strict = jnp.tril(jnp.ones((CHUNK, CHUNK), dtype=bool), -1)
    decay = jnp.exp(jnp.where(causal, g[..., :, None] - g[..., None, :], -jnp.inf))
    k_beta = k * beta[..., None]
    a_mat = jnp.where(strict, jnp.einsum('bhncd,bhnsd->bhncs', k_beta, k) * decay, 0.0)
    eye = jnp.eye(CHUNK, dtype=a_mat.dtype)
    t_mat = lax.linalg.triangular_solve(eye + a_mat, jnp.broadcast_to(eye, a_mat.shape),
                                        left_side=True, lower=True)
    u = jnp.einsum('bhncs,bhnse->bhnce', t_mat, v * beta[..., None])
    w = jnp.einsum('bhncs,bhnsd->bhncd', t_mat, k_beta * jnp.exp(g)[..., None])
    qk = jnp.where(causal, jnp.einsum('bhncd,bhnsd->bhncs', q, k) * decay, 0.0)
    q_dec = q * jnp.exp(g)[..., None]
    k_dec = k * jnp.exp(g[..., -1:] - g)[..., None]
    g_tot = jnp.exp(g[..., -1])
    xs = tuple(jnp.moveaxis(t, 2, 0) for t in (q_dec, k_dec, u, w, qk, g_tot))

    def step(s, inp):
        q_c, k_c, u_c, w_c, qk_c, gt = inp
        v_new = u_c - jnp.einsum('bhcd,bhde->bhce', w_c, s)
        o = jnp.einsum('bhcd,bhde->bhce', q_c, s) + jnp.einsum('bhcs,bhse->bhce', qk_c, v_new)
        s = s * gt[..., None, None] + jnp.einsum('bhcd,bhce->bhde', k_c, v_new)
        return s, o

    s0 = jnp.zeros((bsz, h, dk, dv), jnp.float32)
    _, o = lax.scan(step, s0, xs)
    o = jnp.moveaxis(o, 0, 2)
    return jnp.moveaxis(o, 1, 3).reshape(bsz, t_len, h, dv)


def _deltanet_group(q, k, v, z, b, a, conv_w, a_log, dt_bias, norm_w):
    bsz, t_len, _ = q.shape
    qkv = jax.nn.silu(_short_conv(jnp.concatenate([q, k, v], axis=-1), conv_w))
    q, k, v = jnp.split(qkv, 3, axis=-1)
    heads = lambda t: t.reshape(bsz, t_len, A_HEADS, A_HEAD_DIM).astype(jnp.float32)
    q = _l2norm(heads(q)) * (A_HEAD_DIM ** -0.5)
    k = _l2norm(heads(k))
    v = heads(v)
    beta = jax.nn.sigmoid(b.astype(jnp.float32))
    g = -jnp.exp(a_log.astype(jnp.float32)) * jax.nn.softplus(
        a.astype(jnp.float32) + dt_bias.astype(jnp.float32))
    o = _gated_delta_rule(q, k, v, g, beta)
    o = o * lax.rsqrt(jnp.mean(jnp.square(o), axis=-1, keepdims=True) + RMS_EPS) * norm_w.astype(jnp.float32)
    return o.reshape(bsz, t_len, A_WIDTH).astype(z.dtype) * jax.nn.silu(z)


def _swa_group(q, k, v, z, sinks):
    bsz, t_len, _ = q.shape
    n = t_len // BLOCK
    q = q.reshape(bsz, n, BLOCK, B_KV_HEADS, B_GROUP, B_HEAD_DIM)
    k = k.reshape(bsz, t_len, B_KV_HEADS, B_HEAD_DIM)
    v = v.reshape(bsz, t_len, B_KV_HEADS, B_HEAD_DIM)

    def band(t):
        prev = jnp.pad(t, ((0, 0), (BLOCK, 0), (0, 0), (0, 0)))[:, :t_len]
        shp = (bsz, n, BLOCK, B_KV_HEADS, B_HEAD_DIM)
        return jnp.concatenate([prev.reshape(shp), t.reshape(shp)], axis=2)

    kb, vb = band(k), band(v)
    s = jnp.einsum('bnqhgd,bnshd->bhgnqs', q, kb).astype(jnp.float32) * (B_HEAD_DIM ** -0.5)
    q_idx = jnp.arange(BLOCK)[:, None]
    s_idx = jnp.arange(2 * BLOCK)[None, :]
    dist = q_idx + BLOCK - s_idx
    key_pos = jnp.arange(n)[:, None] * BLOCK - BLOCK + jnp.arange(2 * BLOCK)[None, :]
    mask = ((dist >= 0) & (dist < WINDOW))[None] & (key_pos >= 0)[:, None, :]
    slopes = _alibi_slopes(B_Q_HEADS).reshape(B_KV_HEADS, B_GROUP)
    s = s - slopes[:, :, None, None, None] * dist.astype(jnp.float32)
    s = jnp.where(mask, s, -jnp.inf)
    sink = sinks.astype(jnp.float32).reshape(B_KV_HEADS, B_GROUP)[:, :, None, None]
    m = jnp.maximum(jnp.max(s, axis=-1), sink)
    p = jnp.exp(s - m[..., None])
    p = p / (jnp.sum(p, axis=-1, keepdims=True) + jnp.exp(sink - m)[..., None])
    o = jnp.einsum('bhgnqs,bnshd->bnqhgd', p.astype(vb.dtype), vb)
    return o.reshape(bsz, t_len, B_WIDTH) * jax.nn.silu(z)


def _layer(x, w_in, conv_w, a_log, dt_bias, norm_w, sinks, w_out, ln_g, ln_b):
    h = jnp.einsum('btd,dc->btc', x, w_in)
    offsets = [sum(IN_SIZES[:i]) for i in range(1, len(IN_SIZES))]
    qa, ka, va, za, ba, aa, qb, kb, vb, zb = jnp.split(h, offsets, axis=-1)
    ya = _deltanet_group(qa, ka, va, za, ba, aa, conv_w, a_log, dt_bias, norm_w)
    yb = _swa_group(qb, kb, vb, zb, sinks)
    y = jnp.einsum('btc,cd->btd', jnp.concatenate([ya, yb], axis=-1), w_out)
    return _layernorm(DEEPNORM_ALPHA * x + y, ln_g, ln_b)


def setup_inputs(seed: int = 0) -> dict:
    key = jax.random.key(seed)
    ks = jax.random.split(key, 10)
    x = jax.random.normal(ks[0], (BATCH, SEQ, D_MODEL), jnp.float32)
    col_scale = np.concatenate([
        np.ones(2 * A_WIDTH), np.full(A_WIDTH, DEEPNORM_BETA), np.ones(A_WIDTH + 2 * A_HEADS),
        np.ones(B_WIDTH + B_KV_WIDTH), np.full(B_KV_WIDTH, DEEPNORM_BETA), np.ones(B_WIDTH)]).astype(np.float32)
    w_in = jax.random.normal(ks[1], (DEPTH, D_MODEL, IN_COLS), jnp.float32) * (D_MODEL ** -0.5) * jnp.asarray(col_scale)
    conv_w = jax.random.normal(ks[2], (DEPTH, CONV_K, 3 * A_WIDTH), jnp.float32) * (CONV_K ** -0.5)
    a_log = jnp.log(jax.random.uniform(ks[3], (DEPTH, A_HEADS), jnp.float32, 1.0, 16.0))
    dt = jnp.exp(jax.random.uniform(ks[4], (DEPTH, A_HEADS), jnp.float32, math.log(1e-3), math.log(1e-1)))
    dt_bias = dt + jnp.log(-jnp.expm1(-dt))
    norm_w = 1.0 + 0.02 * jax.random.normal(ks[5], (DEPTH, A_HEAD_DIM), jnp.float32)
    sinks = 0.5 * jax.random.normal(ks[6], (DEPTH, B_Q_HEADS), jnp.float32)
    w_out = jax.random.normal(ks[7], (DEPTH, D_MIX, D_MODEL), jnp.float32) * (D_MIX ** -0.5) * DEEPNORM_BETA
    ln_g = 1.0 + 0.02 * jax.random.normal(ks[8], (DEPTH, D_MODEL), jnp.float32)
    ln_b = 0.02 * jax.random.normal(ks[9], (DEPTH, D_MODEL), jnp.float32)
    return {"x": x, "w_in": w_in, "conv_w": conv_w, "a_log": a_log, "dt_bias": dt_bias,
            "norm_w": norm_w, "sinks": sinks, "w_out": w_out, "ln_g": ln_g, "ln_b": ln_b}


def reference(x, w_in, conv_w, a_log, dt_bias, norm_w, sinks, w_out, ln_g, ln_b):
    for l in range(DEPTH):
        x = _layer(x, w_in[l], conv_w[l], a_log[l], dt_bias[l], norm_w[l], sinks[l],
                   w_out[l], ln_g[l], ln_b[l])
    return x
```

```cpp
#include <hip/hip_runtime.h>
#include <cstdio>
#include <cstdint>

#define USE_CG 1
#define PHM 255
#define LAS __attribute__((address_space(3)))
__device__ __forceinline__ int opaque_lane() { int lane; asm volatile("v_mbcnt_lo_u32_b32 %0, -1, 0\n\tv_mbcnt_hi_u32_b32 %0, -1, %0" : "=v"(lane)); return lane; }
typedef unsigned short bf16_t;
typedef short bf16x8 __attribute__((ext_vector_type(8)));
typedef float f32x4 __attribute__((ext_vector_type(4)));

constexpr int NTOK = 16384, SEQ = 4096, DM = 1024, INC = 3336, NIN = 3328;
constexpr int HA_LD = 1536, HB_LD = 1792;
constexpr int HB_ZA = 0, HB_QB = 512, HB_KB = 1024, HB_VB = 1152, HB_ZB = 1280;
constexpr float DN_ALPHA = 1.41421356237f;

constexpr size_t OFF_BAR = 0;
constexpr size_t OFF_XB = 16384;
constexpr size_t OFF_WIN = OFF_XB + (size_t)NTOK * DM * 2;
constexpr size_t OFF_WOUT = OFF_WIN + (size_t)2 * NIN * DM * 2;
constexpr size_t OFF_HA = OFF_WOUT + (size_t)2 * DM * DM * 2;
constexpr size_t OFF_HB = OFF_HA + (size_t)NTOK * HA_LD * 2;
constexpr size_t OFF_UT = OFF_HB + (size_t)NTOK * HB_LD * 2;
constexpr size_t OFF_W = OFF_UT + (size_t)NTOK * 512 * 2;
constexpr size_t OFF_QD = OFF_W + (size_t)NTOK * 512 * 2;
constexpr size_t OFF_KDT = OFF_QD + (size_t)NTOK * 512 * 2;
constexpr size_t OFF_QK = OFF_KDT + (size_t)NTOK * 512 * 2;
constexpr size_t OFF_BA = OFF_QK + (size_t)NTOK * 256 * 2;
constexpr size_t OFF_GT = OFF_BA + (size_t)NTOK * 8 * 4;
constexpr size_t WS_NEED = OFF_GT + 4096;

constexpr int LDS_BYTES = 147456;
extern __shared__ __attribute__((aligned(16))) unsigned char dyn_lds[];

struct Params {
    const float* x; const float* w_in; const float* conv_w; const float* a_log; const float* dt_bias;
    const float* norm_w; const float* sinks; const float* w_out; const float* ln_g; const float* ln_b;
    float* out; unsigned char* ws;
};

typedef float f32x2_t __attribute__((ext_vector_type(2)));
typedef __bf16 bf16x2_t __attribute__((ext_vector_type(2)));
__device__ __forceinline__ unsigned cvt_pk_bf16(float lo, float hi) {
    const f32x2_t v = {lo, hi};
    const bf16x2_t r = __builtin_convertvector(v, bf16x2_t);
    return __builtin_bit_cast(unsigned, r);
}
__device__ __forceinline__ float bf_lo(unsigned u) { return __uint_as_float(u << 16); }
__device__ __forceinline__ float bf_hi(unsigned u) { return __uint_as_float(u & 0xffff0000u); }
__device__ __forceinline__ float silu_f(float x) { return x / (1.0f + __expf(-x)); }
__device__ __forceinline__ f32x4 mfma16(bf16x8 a, bf16x8 b, f32x4 c) { return __builtin_amdgcn_mfma_f32_16x16x32_bf16(a, b, c, 0, 0, 0); }
__device__ __forceinline__ bf16x8 ldg8(const bf16_t* p) { return *reinterpret_cast<const bf16x8*>(p); }
__device__ __forceinline__ bf16x8 lds8(const unsigned char* p) { return *reinterpret_cast<const bf16x8*>(p); }

__device__ __forceinline__ int opaque_tid_(int g_wave) {
    int lane; asm volatile("v_mbcnt_lo_u32_b32 %0, -1, 0\n\tv_mbcnt_hi_u32_b32 %0, -1, %0" : "=v"(lane));
    return g_wave * 64 + lane; }
#define opaque_tid() opaque_tid_(g_wave)
__device__ __forceinline__ unsigned char* opaque_ws(unsigned char* w) { asm volatile("" : "+s"(w)); return w; }
__device__ __forceinline__ const bf16_t* uniform_ptr(const bf16_t* p) {
    const unsigned long long v = (unsigned long long)p;
    const unsigned lo = __builtin_amdgcn_readfirstlane((unsigned)v), hi = __builtin_amdgcn_readfirstlane((unsigned)(v >> 32));
    return (const bf16_t*)(((unsigned long long)hi << 32) | lo);
}

__device__ __forceinline__ float shx(float v, int m, int lane) { return __int_as_float(__builtin_amdgcn_ds_bpermute((lane ^ m) << 2, __float_as_int(v))); }

#define XB_TMO      128
#define XB_XCNT(j)  (256  + 64 * (j))
#define XB_XSUB(j)  (1280 + 64 * (j))
#define XB_XGEN(j)  (2304 + 64 * (j))
#define XB_TOP      3328
#define XB_TOPGEN   3392
#define XCD_BAR_WORDS 3456
#define XB_SPIN_CAP (1u << 20)
__device__ __forceinline__ unsigned xb_ld(unsigned* p)              { return __hip_atomic_load(p, __ATOMIC_RELAXED, __HIP_MEMORY_SCOPE_AGENT); }
__device__ __forceinline__ unsigned xb_add(unsigned* p, unsigned v) { return __hip_atomic_fetch_add(p, v, __ATOMIC_RELAXED, __HIP_MEMORY_SCOPE_AGENT); }
__device__ __forceinline__ unsigned xb_xcc_id() { return (unsigned)__builtin_amdgcn_s_getreg((3 << 11) | 20) & 0xFu; }
#define XB_SPIN(cond, bar) do { unsigned _sp = 0; while (cond) { __builtin_amdgcn_s_sleep(1); \
    if ((++_sp & 255u) == 0u) { if (xb_ld(&(bar)[XB_TMO])) break; if (_sp > XB_SPIN_CAP) { atomicAdd(&(bar)[XB_TMO], 1u); break; } } } } while (0)
struct XcdBarrier { unsigned* bar; unsigned x; volatile LAS unsigned* st; int gw; };
__device__ __forceinline__ bool xb_t0(int gw) { return gw == 0 && opaque_lane() == 0; }
__device__ __forceinline__ XcdBarrier xcd_barrier_post(unsigned* bar, volatile LAS unsigned* st, int gw) {
    XcdBarrier b; b.bar = bar; b.x = xb_xcc_id(); b.st = st; b.gw = gw;
    if (xb_t0(gw)) (void)xb_add(&bar[XB_XCNT(b.x)], 1u);
    return b;
}
__device__ __forceinline__ void xcd_barrier_complete(unsigned* bar, unsigned x, unsigned& nloc, unsigned& nx) {
    const unsigned G = gridDim.x * gridDim.y * gridDim.z;
    unsigned sum, cnt, mine, sp = 0u;
    for (;;) {
        sum = 0u; cnt = 0u; mine = 0u;
#pragma unroll
        for (unsigned j = 0; j < 16; ++j) { const unsigned c = xb_ld(&bar[XB_XCNT(j)]); sum += c; cnt += (c > 0u) ? 1u : 0u; mine = (j == x) ? c : mine; }
        if (sum == G) break;
        __builtin_amdgcn_s_sleep(1);
        if ((++sp & 255u) == 0u) { if (xb_ld(&bar[XB_TMO])) break; if (sp > XB_SPIN_CAP) { atomicAdd(&bar[XB_TMO], 1u); break; } }
    }
    nloc = mine > 0u ? mine : 1u; nx = cnt > 0u ? cnt : 1u;
}
#ifdef USE_CG
__device__ __forceinline__ void xcd_barrier(XcdBarrier& b) {
    asm volatile("s_waitcnt vmcnt(0)" ::: "memory");
    __syncthreads();
    b.x = __builtin_amdgcn_readfirstlane(b.x + gridDim.x);
    if (xb_t0(b.gw)) {
        __threadfence();
        unsigned* c = b.bar + 4000;
        xb_add(c, 1u);
        unsigned sp = 0;
        while (xb_ld(c) < b.x) { __builtin_amdgcn_s_sleep(2); if (++sp > (1u << 24)) break; }
        __threadfence();
    }
    __syncthreads();
}
#else
__device__ __forceinline__ void xcd_barrier(const XcdBarrier& b_) {
    asm volatile("s_waitcnt vmcnt(0)" ::: "memory");
    __syncthreads();
    if (xb_t0(b_.gw)) {
        XcdBarrier b = b_; b.x = xb_xcc_id();
        asm volatile("" : "+s"(b.x));
        unsigned* bar = b.bar;
        __builtin_amdgcn_s_waitcnt(0);
        unsigned nloc = b.st[0], nx = b.st[1];
        if (nloc == 0u) { xcd_barrier_complete(bar, b.x, nloc, nx); b.st[0] = nloc; b.st[1] = nx; }
        const unsigned old = xb_add(&bar[XB_XSUB(b.x)], 1u);
        const unsigned gen = old / nloc;
        if (old + 1u == (gen + 1u) * nloc) {
            __builtin_amdgcn_fence(__ATOMIC_RELEASE, "agent");
            asm volatile("s_waitcnt vmcnt(0)" ::: "memory");
            const unsigned og = xb_add(&bar[XB_TOP], 1u);
            const unsigned tg = og / nx;
            if (og + 1u == (tg + 1u) * nx) xb_add(&bar[XB_TOPGEN], 1u);
            else XB_SPIN(xb_ld(&bar[XB_TOPGEN]) == tg, bar);
            __builtin_amdgcn_fence(__ATOMIC_ACQUIRE, "agent");
            xb_add(&bar[XB_XGEN(b.x)], 1u);
            asm volatile("s_waitcnt vmcnt(0)" ::: "memory");
        } else {
            XB_SPIN(xb_ld(&bar[XB_XGEN(b.x)]) == gen, bar);
            __builtin_amdgcn_fence(__ATOMIC_ACQUIRE, "agent");
            asm volatile("s_waitcnt vmcnt(0)" ::: "memory");
        }
    }
    __syncthreads();
}

#endif

constexpr int BM = 256, BK = 64, HALF = 128, NXCD = 8, WGM = 8, HT = HALF * BK;
__device__ __forceinline__ int lds_byte(int r, int c) {
    int st = (r >> 4) * 2 + (c >> 5), rr = r & 15, cc = c & 31, ob = rr * 64 + cc * 2;
    return st * 1024 + (ob ^ (((ob >> 9) & 1) << 5));
}
__device__ __forceinline__ void stage_rc(int b, int& R, int& C) {
    int st = b / 1024, sb = b % 1024, swz = sb ^ (((sb >> 9) & 1) << 5);
    R = (st >> 1) * 16 + swz / 64; C = (st & 1) * 32 + (swz % 64) / 2;
}

struct EpiH {
    bf16_t* ha; bf16_t* hb;
    __device__ __forceinline__ void operator()(const f32x4 (&acc)[2][2][4][2], int brow, int bcol, int wr, int wc, int fr, int fq) const {
        bf16_t* base; int ld, c0;
        if (bcol < HA_LD) { base = ha; ld = HA_LD; c0 = bcol; } else { base = hb; ld = HB_LD; c0 = bcol - HA_LD; }
#pragma unroll
        for (int ai = 0; ai < 2; ++ai)
#pragma unroll
            for (int m = 0; m < 4; ++m) {
                const int row = brow + ai * HALF + wr * 64 + m * 16 + fr;
                bf16_t* rp = base + (size_t)row * ld + c0 + wc * 32 + fq * 4;
#pragma unroll
                for (int bj = 0; bj < 2; ++bj)
#pragma unroll
                    for (int n = 0; n < 2; ++n) {
                        const f32x4 v = acc[ai][bj][m][n];
                        uint2 w; w.x = cvt_pk_bf16(v[0], v[1]); w.y = cvt_pk_bf16(v[2], v[3]);
                        *reinterpret_cast<uint2*>(rp + bj * HALF + n * 16) = w;
                    }
            }
    }
};
struct EpiZ {
    const float* xres; float* out;
    __device__ __forceinline__ void operator()(const f32x4 (&acc)[2][2][4][2], int brow, int bcol, int wr, int wc, int fr, int fq) const {
#pragma unroll
        for (int ai = 0; ai < 2; ++ai)
#pragma unroll
            for (int m = 0; m < 4; ++m) {
                const int row = brow + ai * HALF + wr * 64 + m * 16 + fr;
                const size_t ro = (size_t)row * DM + bcol + wc * 32 + fq * 4;
#pragma unroll
                for (int bj = 0; bj < 2; ++bj)
#pragma unroll
                    for (int n = 0; n < 2; ++n) {
                        const size_t o = ro + bj * HALF + n * 16;
                        const f32x4 r = *reinterpret_cast<const f32x4*>(xres + o);
                        *reinterpret_cast<f32x4*>(out + o) = r * DN_ALPHA + acc[ai][bj][m][n];
                    }
            }
    }
};

template <class Epi>
__device__ __forceinline__ void gemm_phase(const bf16_t* __restrict__ A, const bf16_t* __restrict__ Bt, int M, int N, int K, const Epi& epi, int g_wave) {
    bf16_t* shm = reinterpret_cast<bf16_t*>(dyn_lds);
#define SA(b,h) (shm+((b)*2+(h))*HT)
#define SB(b,h) (shm+(4+(b)*2+(h))*HT)
#define STAGE(P,BASE,br,kt) do{const bf16_t* _bp=uniform_ptr((BASE)+((long)(br)*K+(long)(kt)*BK)); \
    __builtin_amdgcn_global_load_lds((const unsigned*)((const char*)_bp+soff0),(unsigned*)((char*)(P)+tidx*16),16,0,0); \
    __builtin_amdgcn_global_load_lds((const unsigned*)((const char*)_bp+soff1),(unsigned*)((char*)(P)+tidx*16+8192),16,0,0);}while(0)
#define LDA(dst,b,h) for(int m=0;m<4;++m)for(int k=0;k<2;++k) \
    dst[m][k]=*reinterpret_cast<const bf16x8*>((char*)SA(b,h)+lds_byte(wr*64+m*16+fr,k*32+fq*8))
#define LDB(dst,b,h) for(int n=0;n<2;++n)for(int k=0;k<2;++k) \
    dst[n][k]=*reinterpret_cast<const bf16x8*>((char*)SB(b,h)+lds_byte(wc*32+n*16+fr,k*32+fq*8))
#define MMA(ai,bj,At,Bt_) do{__builtin_amdgcn_s_setprio(1); \
    for(int m=0;m<4;++m)for(int n=0;n<2;++n)for(int k=0;k<2;++k) \
      acc[ai][bj][m][n]=__builtin_amdgcn_mfma_f32_16x16x32_bf16(Bt_[n][k],At[m][k],acc[ai][bj][m][n],0,0,0); \
    __builtin_amdgcn_s_setprio(0);}while(0)
#define WAIT_V(n) asm volatile("s_waitcnt vmcnt(" #n ")":::"memory")
#define WAIT_L(n) asm volatile("s_waitcnt lgkmcnt(" #n ")":::"memory")
#define BAR __builtin_amdgcn_s_barrier()
#define SCHED __builtin_amdgcn_sched_barrier(0)
    const int nM = M / BM, nN = N / BM, nwg = nM * nN;
    const int tidx = opaque_tid();
    const int wid = tidx >> 6, lane = tidx & 63, wr = wid >> 2, wc = wid & 3, fr = lane & 15, fq = lane >> 4;
    const int nt = K / BK;
    unsigned soff0, soff1;
    { int r_, c_; stage_rc(tidx * 16, r_, c_); soff0 = (unsigned)(r_ * K + c_) * 2u; stage_rc(tidx * 16 + 8192, r_, c_); soff1 = (unsigned)(r_ * K + c_) * 2u; }
    for (int L = blockIdx.x; L < nwg; L += gridDim.x) {
        int wgid = L;
        { int q = nwg / NXCD, r = nwg % NXCD, xcd = wgid % NXCD, off = wgid / NXCD; wgid = (xcd < r ? xcd * (q + 1) : r * (q + 1) + (xcd - r) * q) + off; }
        const int nig = WGM * nN, gid = wgid / nig, fm = gid * WGM, gsz = min(nM - fm, WGM);
        const int pm = fm + ((wgid % nig) % gsz), pn = (wgid % nig) / gsz, brow = pm * BM, bcol = pn * BM;
        f32x4 acc[2][2][4][2] = {};
        bf16x8 At[4][2], B0[2][2], B1[2][2];
        STAGE(SB(0,0),Bt,bcol,0); STAGE(SA(0,0),A,brow,0);
        STAGE(SB(0,1),Bt,bcol+HALF,0); STAGE(SA(0,1),A,brow+HALF,0);
        if(wr==1)BAR;
        WAIT_V(4); BAR;
        STAGE(SB(1,0),Bt,bcol,1); STAGE(SA(1,0),A,brow,1); STAGE(SB(1,1),Bt,bcol+HALF,1);
        WAIT_V(6); BAR;
        for(int t=0;t<nt-2;t+=2){
            LDB(B0,0,0); SCHED; LDA(At,0,0); STAGE(SA(1,1),A,brow+HALF,t+1);
            WAIT_L(8); BAR; WAIT_L(0); MMA(0,0,At,B0); BAR; SCHED;
            LDB(B1,0,1); STAGE(SB(0,0),Bt,bcol,t+2);
            BAR; WAIT_L(0); MMA(0,1,At,B1); BAR;
            LDA(At,0,1); STAGE(SA(0,0),A,brow,t+2);
            BAR; WAIT_L(0); MMA(1,0,At,B0); BAR; SCHED;
            STAGE(SB(0,1),Bt,bcol+HALF,t+2);
            WAIT_V(6); BAR; MMA(1,1,At,B1); BAR;
            LDB(B0,1,0); SCHED; LDA(At,1,0); STAGE(SA(0,1),A,brow+HALF,t+2);
            WAIT_L(8); BAR; WAIT_L(0); MMA(0,0,At,B0); BAR; SCHED;
            LDB(B1,1,1); STAGE(SB(1,0),Bt,bcol,t+3);
            BAR; WAIT_L(0); MMA(0,1,At,B1); BAR;
            LDA(At,1,1); STAGE(SA(1,0),A,brow,t+3);
            BAR; WAIT_L(0); MMA(1,0,At,B0); BAR; SCHED;
            STAGE(SB(1,1),Bt,bcol+HALF,t+3);
            WAIT_V(6); BAR; MMA(1,1,At,B1); BAR;
        }
        { LDB(B0,0,0); LDA(At,0,0); STAGE(SA(1,1),A,brow+HALF,nt-1);
          BAR; WAIT_L(0); MMA(0,0,At,B0); BAR;
          LDB(B1,0,1); BAR; WAIT_L(0); MMA(0,1,At,B1); BAR;
          LDA(At,0,1); WAIT_V(4); BAR; WAIT_L(0); MMA(1,0,At,B0); MMA(1,1,At,B1); BAR; }
        { LDB(B0,1,0); LDA(At,1,0); WAIT_V(2); BAR; WAIT_L(0); MMA(0,0,At,B0); BAR;
          LDB(B1,1,1); WAIT_V(0); BAR; WAIT_L(0); MMA(0,1,At,B1); BAR;
          LDA(At,1,1); BAR; WAIT_L(0); MMA(1,0,At,B0); MMA(1,1,At,B1); BAR; }
        if(wr==0)BAR;
        epi(acc, brow, bcol, wr, wc, fr, fq);
        __syncthreads();
    }
#undef SA
#undef SB
#undef STAGE
#undef LDA
#undef LDB
#undef MMA
}

__device__ __forceinline__ void prep_weights(const Params& p, int g_wave) {
    bf16_t* win = reinterpret_cast<bf16_t*>(p.ws + OFF_WIN);
    bf16_t* wout = reinterpret_cast<bf16_t*>(p.ws + OFF_WOUT);
    const int gtid = blockIdx.x * 512 + opaque_tid(), gsz = gridDim.x * 512;
    const int n_in = 2 * 128 * NIN;
    for (int i = gtid; i < n_in; i += gsz) {
        const int n = i % NIN, kg = (i / NIN) % 128, l = i / (NIN * 128);
        const int sc = n < 2048 ? n : n + 8;
        const float* s = p.w_in + (size_t)l * DM * INC + (size_t)(kg * 8) * INC + sc;
        uint4 w;
        w.x = cvt_pk_bf16(s[0], s[INC]); w.y = cvt_pk_bf16(s[2 * INC], s[3 * INC]);
        w.z = cvt_pk_bf16(s[4 * INC], s[5 * INC]); w.w = cvt_pk_bf16(s[6 * INC], s[7 * INC]);
        *reinterpret_cast<uint4*>(win + ((size_t)l * NIN + n) * DM + kg * 8) = w;
    }
    const int n_out = 2 * 128 * DM;
    for (int i = gtid; i < n_out; i += gsz) {
        const int n = i % DM, kg = (i / DM) % 128, l = i / (DM * 128);
        const float* s = p.w_out + (size_t)l * DM * DM + (size_t)(kg * 8) * DM + n;
        uint4 w;
        w.x = cvt_pk_bf16(s[0], s[DM]); w.y = cvt_pk_bf16(s[2 * DM], s[3 * DM]);
        w.z = cvt_pk_bf16(s[4 * DM], s[5 * DM]); w.w = cvt_pk_bf16(s[6 * DM], s[7 * DM]);
        *reinterpret_cast<uint4*>(wout + ((size_t)l * DM + n) * DM + kg * 8) = w;
    }
}

__device__ __forceinline__ void row_pass(const float* src, bool ln, const float* g, const float* bta, float* dstf, bf16_t* xb, const float* wg  , float* BA, int g_wave) {
    const int tidx = opaque_tid();
    const int lane = tidx & 63;
    const int gw = blockIdx.x * 8 + (tidx >> 6), nw = gridDim.x * 8;
    for (int row = gw; row < NTOK; row += nw) {
        f32x4 v[4];
#pragma unroll
        for (int i = 0; i < 4; ++i) v[i] = *reinterpret_cast<const f32x4*>(src + (size_t)row * DM + i * 256 + lane * 4);
        if (ln) {
            float s = 0.f;
#pragma unroll
            for (int i = 0; i < 4; ++i) s += (v[i][0] + v[i][1]) + (v[i][2] + v[i][3]);
#pragma unroll
            for (int o = 32; o > 0; o >>= 1) s += shx(s, o, lane);
            const float mu = s * (1.0f / DM);
            float q = 0.f;
#pragma unroll
            for (int i = 0; i < 4; ++i) { v[i] = v[i] - mu; q += (v[i][0] * v[i][0] + v[i][1] * v[i][1]) + (v[i][2] * v[i][2] + v[i][3] * v[i][3]); }
#pragma unroll
            for (int o = 32; o > 0; o >>= 1) q += shx(q, o, lane);
            const float rstd = rsqrtf(q * (1.0f / DM) + 1e-5f);
#pragma unroll
            for (int i = 0; i < 4; ++i) {
                const f32x4 gg = *reinterpret_cast<const f32x4*>(g + i * 256 + lane * 4), bb = *reinterpret_cast<const f32x4*>(bta + i * 256 + lane * 4);
                v[i] = v[i] * rstd * gg + bb;
            }
        }
#ifdef SANITIZE
#pragma unroll
        for (int i = 0; i < 4; ++i)
#pragma unroll
            for (int e = 0; e < 4; ++e) if (!(fabsf(v[i][e]) < 1e30f)) v[i][e] = 0.f;
#endif
        if (dstf) {
#pragma unroll
            for (int i = 0; i < 4; ++i) *reinterpret_cast<f32x4*>(dstf + (size_t)row * DM + i * 256 + lane * 4) = v[i];
        }
        if (xb) {
#pragma unroll
            for (int i = 0; i < 4; ++i) { uint2 w; w.x = cvt_pk_bf16(v[i][0], v[i][1]); w.y = cvt_pk_bf16(v[i][2], v[i][3]);
                *reinterpret_cast<uint2*>(xb + (size_t)row * DM + i * 256 + lane * 4) = w; }
        }
        if (wg) {
            float d[8] = {0.f, 0.f, 0.f, 0.f, 0.f, 0.f, 0.f, 0.f};
#pragma unroll
            for (int i = 0; i < 4; ++i)
#pragma unroll
                for (int e = 0; e < 4; ++e) {
                    const float* wp = wg + (size_t)(i * 256 + lane * 4 + e) * INC;
                    const f32x4 w0 = *reinterpret_cast<const f32x4*>(wp), w1 = *reinterpret_cast<const f32x4*>(wp + 4);
                    const float xv = v[i][e];
                    d[0] += xv * w0[0]; d[1] += xv * w0[1]; d[2] += xv * w0[2]; d[3] += xv * w0[3];
                    d[4] += xv * w1[0]; d[5] += xv * w1[1]; d[6] += xv * w1[2]; d[7] += xv * w1[3];
                }
#pragma unroll
            for (int j = 0; j < 8; ++j) {
#pragma unroll
                for (int o = 32; o > 0; o >>= 1) d[j] += shx(d[j], o, lane);
            }
            if (lane == 0) {
                *reinterpret_cast<f32x4*>(BA + (size_t)row * 8) = (f32x4){d[0], d[1], d[2], d[3]};
                *reinterpret_cast<f32x4*>(BA + (size_t)row * 8 + 4) = (f32x4){d[4], d[5], d[6], d[7]};
            }
        }
    }
}

constexpr int GRP_LDS = 73728;
constexpr int L_KRM = 0, L_QRM = 17408, L_KBGT = 34816, L_VBT = 53248, L_GC = 71680, L_BETA = 71936;
__device__ __forceinline__ void chunk_prep(const Params& p_, int l, int g_wave) {
    Params p = p_; p.ws = opaque_ws(p.ws);
    const bf16_t* HA = reinterpret_cast<const bf16_t*>(p.ws + OFF_HA);
    const float* BA = reinterpret_cast<const float*>(p.ws + OFF_BA);
    bf16_t* UT = reinterpret_cast<bf16_t*>(p.ws + OFF_UT);
    bf16_t* W = reinterpret_cast<bf16_t*>(p.ws + OFF_W);
    bf16_t* QD = reinterpret_cast<bf16_t*>(p.ws + OFF_QD);
    bf16_t* KDT = reinterpret_cast<bf16_t*>(p.ws + OFF_KDT);
    bf16_t* QK = reinterpret_cast<bf16_t*>(p.ws + OFF_QK);
    float* GT = reinterpret_cast<float*>(p.ws + OFF_GT);
    const float* cw = p.conv_w + (size_t)l * 4 * 1536;
#define CP_LANEVARS const int tid = opaque_tid(), grp = tid >> 8, gt = tid & 255, lane = tid & 63, wv = gt >> 6, fr = lane & 15, fq = lane >> 4; \
    unsigned char* lds = dyn_lds + grp * GRP_LDS; float* gc_s = reinterpret_cast<float*>(lds + L_GC); float* beta_s = reinterpret_cast<float*>(lds + L_BETA); \
    const int tg = gt >> 4, sg = gt & 15, t0 = tg * 4, c0 = sg * 8; (void)fr; (void)fq; (void)wv; (void)t0; (void)c0; (void)gc_s; (void)beta_s; (void)lane;
    for (int pi = blockIdx.x; pi < 512; pi += gridDim.x) {
        const int grp0 = opaque_tid() >> 8;
        const int hp = pi & 1, n = (pi >> 1) & 63, b = pi >> 7, h = hp * 2 + grp0;
        const int item = (b * 4 + h) * 64 + n, tok0 = b * SEQ + n * 64;
        { CP_LANEVARS
        if (wv == 0) {
            const float bv = BA[(size_t)(tok0 + lane) * 8 + h], av = BA[(size_t)(tok0 + lane) * 8 + 4 + h];
            const float beta = 1.0f / (1.0f + __expf(-bv));
            const float xx = av + p.dt_bias[l * 4 + h];
            const float sp = fmaxf(xx, 0.f) + log1pf(__expf(-fabsf(xx)));
            float gv = -__expf(p.a_log[l * 4 + h]) * sp;
#pragma unroll
            for (int o = 1; o < 64; o <<= 1) { const float t = __int_as_float(__builtin_amdgcn_ds_bpermute((lane - o) << 2, __float_as_int(gv))); if (lane >= o) gv += t; }
            gc_s[lane] = gv; beta_s[lane] = beta;
            if (lane == 63) GT[item] = __expf(gv);
        } }
        __syncthreads();
        {
            CP_LANEVARS
            const float glast = gc_s[63];
            float eg[4], ek[4], be[4];
#pragma unroll
            for (int i = 0; i < 4; ++i) { const float gci = gc_s[t0 + i]; eg[i] = __expf(gci); ek[i] = __expf(glast - gci); be[i] = beta_s[t0 + i]; }
#pragma unroll
            for (int ten = 0; ten < 3; ++ten) {
                __builtin_amdgcn_sched_barrier(0);
                float raw[7][8];
#pragma unroll
                for (int r = 0; r < 7; ++r) {
                    const int tt = n * 64 + t0 - 3 + r;
                    uint4 u = make_uint4(0u, 0u, 0u, 0u);
                    if (tt >= 0) u = *reinterpret_cast<const uint4*>(HA + (size_t)(b * SEQ + tt) * HA_LD + ten * 512 + h * 128 + c0);
                    raw[r][0] = bf_lo(u.x); raw[r][1] = bf_hi(u.x); raw[r][2] = bf_lo(u.y); raw[r][3] = bf_hi(u.y);
                    raw[r][4] = bf_lo(u.z); raw[r][5] = bf_hi(u.z); raw[r][6] = bf_lo(u.w); raw[r][7] = bf_hi(u.w);
                }
                float o[4][8];
#pragma unroll
                for (int i = 0; i < 4; ++i)
#pragma unroll
                    for (int c = 0; c < 8; ++c) o[i][c] = 0.f;
#pragma unroll
                for (int j = 0; j < 4; ++j) {
                    const float* wp = cw + (size_t)j * 1536 + ten * 512 + h * 128 + c0;
                    const f32x4 a = *reinterpret_cast<const f32x4*>(wp), c4 = *reinterpret_cast<const f32x4*>(wp + 4);
                    const float wj[8] = {a[0], a[1], a[2], a[3], c4[0], c4[1], c4[2], c4[3]};
#pragma unroll
                    for (int i = 0; i < 4; ++i)
#pragma unroll
                        for (int c = 0; c < 8; ++c) o[i][c] += wj[c] * raw[i + j][c];
                }
#pragma unroll
                for (int i = 0; i < 4; ++i)
#pragma unroll
                    for (int c = 0; c < 8; ++c) o[i][c] = silu_f(o[i][c]);
                if (ten < 2) {
#pragma unroll
                    for (int i = 0; i < 4; ++i) {
                        float sq = 0.f;
#pragma unroll
                        for (int c = 0; c < 8; ++c) sq += o[i][c] * o[i][c];
#pragma unroll
                        for (int off = 1; off < 16; off <<= 1) sq += shx(sq, off, lane);
                        const float rq = rsqrtf(sq + 1e-6f) * (ten == 0 ? 0.08838834764831845f : 1.0f);
#pragma unroll
                        for (int c = 0; c < 8; ++c) o[i][c] *= rq;
                    }
                }
                if (ten == 0) {
#pragma unroll
                    for (int i = 0; i < 4; ++i) {
                        uint4 w;
                        w.x = cvt_pk_bf16(o[i][0] * eg[i], o[i][1] * eg[i]); w.y = cvt_pk_bf16(o[i][2] * eg[i], o[i][3] * eg[i]);
                        w.z = cvt_pk_bf16(o[i][4] * eg[i], o[i][5] * eg[i]); w.w = cvt_pk_bf16(o[i][6] * eg[i], o[i][7] * eg[i]);
                        *reinterpret_cast<uint4*>(QD + (size_t)(tok0 + t0 + i) * 512 + h * 128 + c0) = w;
                        w.x = cvt_pk_bf16(o[i][0], o[i][1]); w.y = cvt_pk_bf16(o[i][2], o[i][3]); w.z = cvt_pk_bf16(o[i][4], o[i][5]); w.w = cvt_pk_bf16(o[i][6], o[i][7]);
                        *reinterpret_cast<uint4*>(lds + L_QRM + ((t0 + i) * 136 + c0) * 2) = w;
                    }
                } else if (ten == 1) {
#pragma unroll
                    for (int i = 0; i < 4; ++i) {
                        uint4 w;
                        w.x = cvt_pk_bf16(o[i][0], o[i][1]); w.y = cvt_pk_bf16(o[i][2], o[i][3]); w.z = cvt_pk_bf16(o[i][4], o[i][5]); w.w = cvt_pk_bf16(o[i][6], o[i][7]);
                        *reinterpret_cast<uint4*>(lds + L_KRM + ((t0 + i) * 136 + c0) * 2) = w;
                    }
#pragma unroll
                    for (int c = 0; c < 8; ++c) {
                        uint2 w;
                        w.x = cvt_pk_bf16(o[0][c] * ek[0], o[1][c] * ek[1]); w.y = cvt_pk_bf16(o[2][c] * ek[2], o[3][c] * ek[3]);
                        *reinterpret_cast<uint2*>(KDT + (size_t)item * 8192 + (c0 + c) * 64 + t0) = w;
                        w.x = cvt_pk_bf16(o[0][c] * be[0] * eg[0], o[1][c] * be[1] * eg[1]); w.y = cvt_pk_bf16(o[2][c] * be[2] * eg[2], o[3][c] * be[3] * eg[3]);
                        *reinterpret_cast<uint2*>(lds + L_KBGT + ((c0 + c) * 72 + t0) * 2) = w;
                    }
                } else {
#pragma unroll
                    for (int c = 0; c < 8; ++c) {
                        uint2 w;
                        w.x = cvt_pk_bf16(o[0][c] * be[0], o[1][c] * be[1]); w.y = cvt_pk_bf16(o[2][c] * be[2], o[3][c] * be[3]);
                        *reinterpret_cast<uint2*>(lds + L_VBT + ((c0 + c) * 72 + t0) * 2) = w;
                    }
                }
            }
        }
        __syncthreads();
        {
            CP_LANEVARS
            const int ib = wv;
            f32x4 kk[4], qk[4];
#pragma unroll
            for (int jb = 0; jb < 4; ++jb) { kk[jb] = (f32x4){0.f, 0.f, 0.f, 0.f}; qk[jb] = (f32x4){0.f, 0.f, 0.f, 0.f}; }
            bf16x8 ki[4], qi[4];
#pragma unroll
            for (int ks = 0; ks < 4; ++ks) {
                ki[ks] = lds8(lds + L_KRM + ((ib * 16 + fr) * 136 + ks * 32 + fq * 8) * 2);
                qi[ks] = lds8(lds + L_QRM + ((ib * 16 + fr) * 136 + ks * 32 + fq * 8) * 2);
            }
#pragma unroll
            for (int jb = 0; jb < 4; ++jb) {
                if (jb <= ib) {
#pragma unroll
                    for (int ks = 0; ks < 4; ++ks) {
                        const bf16x8 kj = lds8(lds + L_KRM + ((jb * 16 + fr) * 136 + ks * 32 + fq * 8) * 2);
                        kk[jb] = mfma16(ki[ks], kj, kk[jb]);
                        qk[jb] = mfma16(kj, qi[ks], qk[jb]);
                    }
                }
            }
            __syncthreads();
            float* AP = reinterpret_cast<float*>(lds + L_KRM);
#pragma unroll
            for (int jb = 0; jb < 4; ++jb) {
                if (jb <= ib) {
                    const int j = jb * 16 + fr, i0 = ib * 16 + fq * 4;
                    const float gj = gc_s[j];
#pragma unroll
                    for (int r = 0; r < 4; ++r) {
                        const int i = i0 + r;
                        const float dec = __expf(fminf(gc_s[i] - gj, 0.f));
                        float av_ = (i > j) ? kk[jb][r] * beta_s[i] * dec : 0.f;
#ifdef DIAG3
                        atomicMax(reinterpret_cast<unsigned*>(p.ws + OFF_BAR) + 4011, __float_as_uint(fabsf(kk[jb][r])));
                        atomicMax(reinterpret_cast<unsigned*>(p.ws + OFF_BAR) + 4012, __float_as_uint(fabsf(av_)));
#endif
#ifdef CLAMP_A
                        if (!(fabsf(av_) <= 0.02f)) av_ = 0.f;
#endif
                        AP[j * 64 + r * 16 + ib * 4 + fq] = av_;
                    }
                }
                {
                    const int i = ib * 16 + fr, j0 = jb * 16 + fq * 4;
                    const float gi = gc_s[i];
                    float o[4];
#pragma unroll
                    for (int r = 0; r < 4; ++r) {
                        const int j = j0 + r;
                        const float dec = __expf(fminf(gi - gc_s[j], 0.f));
                        o[r] = (i >= j) ? qk[jb][r] * dec : 0.f;
                    }
                    uint2 w; w.x = cvt_pk_bf16(o[0], o[1]); w.y = cvt_pk_bf16(o[2], o[3]);
                    *reinterpret_cast<uint2*>(QK + (size_t)(tok0 + i) * 256 + h * 64 + j0) = w;
                }
            }
        }
        __syncthreads();
        {
            CP_LANEVARS
            const float* AP = reinterpret_cast<const float*>(lds + L_KRM);
            const int cl = lane >> 2, pp = lane & 3, ccol = wv * 16 + cl;
            float a[16];
#pragma unroll
            for (int k = 0; k < 16; ++k) a[k] = (4 * k + pp == ccol) ? 1.f : 0.f;
#define INV_STEP(SS) { const int j = jq * 4 + SS; \
                    const float tj = __int_as_float(__builtin_amdgcn_ds_bpermute(((lane & ~3) + SS) << 2, __float_as_int(a[jq]))); \
                    const float* ap = AP + j * 64 + pp * 16; \
                    _Pragma("unroll") for (int k = jq; k < 16; ++k) a[k] -= ap[k] * tj; }
#pragma unroll
            for (int jq = 0; jq < 16; ++jq) {
                __builtin_amdgcn_sched_barrier(0);
#ifdef NO_INV
                if (false) {
#else
                if (jq >= wv * 4) {
#endif
                    INV_STEP(0) INV_STEP(1) INV_STEP(2)
                    if (jq < 15) INV_STEP(3)
                }
            }
#undef INV_STEP
#ifdef DIAG3
            { float mx = 0.f;
              for (int k = 0; k < 16; ++k) { const float av = fabsf(a[k]); mx = (av > mx || !(av == av)) ? av : mx; }
              atomicMax(reinterpret_cast<unsigned*>(p.ws + OFF_BAR) + 4010, __float_as_uint(mx)); }
#endif
            bf16_t* TR = reinterpret_cast<bf16_t*>(lds + L_QRM);
#pragma unroll
            for (int k = 0; k < 16; ++k) TR[(4 * k + pp) * 72 + ccol] = (bf16_t)(cvt_pk_bf16(a[k], 0.f) & 0xffffu);
        }
        __syncthreads();
        {
            CP_LANEVARS
            bf16x8 tf[2];
#pragma unroll
            for (int ks = 0; ks < 2; ++ks) tf[ks] = lds8(lds + L_QRM + ((wv * 16 + fr) * 72 + ks * 32 + fq * 8) * 2);
#pragma unroll
            for (int db = 0; db < 8; ++db) {
                f32x4 au = (f32x4){0.f, 0.f, 0.f, 0.f}, aw = (f32x4){0.f, 0.f, 0.f, 0.f};
#pragma unroll
                for (int ks = 0; ks < 2; ++ks) {
                    const bf16x8 vb = lds8(lds + L_VBT + ((db * 16 + fr) * 72 + ks * 32 + fq * 8) * 2);
                    const bf16x8 kb = lds8(lds + L_KBGT + ((db * 16 + fr) * 72 + ks * 32 + fq * 8) * 2);
                    au = mfma16(tf[ks], vb, au);
                    aw = mfma16(kb, tf[ks], aw);
                }
                uint2 w; w.x = cvt_pk_bf16(au[0], au[1]); w.y = cvt_pk_bf16(au[2], au[3]);
                *reinterpret_cast<uint2*>(UT + (size_t)item * 8192 + (db * 16 + fr) * 64 + wv * 16 + fq * 4) = w;
                w.x = cvt_pk_bf16(aw[0], aw[1]); w.y = cvt_pk_bf16(aw[2], aw[3]);
                *reinterpret_cast<uint2*>(W + (size_t)(tok0 + wv * 16 + fr) * 512 + h * 128 + db * 16 + fq * 4) = w;
            }
        }
        __syncthreads();
    }
}

__device__ __forceinline__ void delta_scan(const Params& p_, int blk, int g_wave) {
    Params p = p_; p.ws = opaque_ws(p.ws);
    const int tid = opaque_tid(), lane = tid & 63, w = tid >> 6, fr = lane & 15, fq = lane >> 4;
    const int bh = blk >> 2, sl = blk & 3, b = bh >> 2, h = bh & 3, dv0 = sl * 32;
    bf16_t* ST = reinterpret_cast<bf16_t*>(p.ws + OFF_HA);
    bf16_t* UT = reinterpret_cast<bf16_t*>(p.ws + OFF_UT);
    const bf16_t* W = reinterpret_cast<const bf16_t*>(p.ws + OFF_W);
    const bf16_t* KDT = reinterpret_cast<const bf16_t*>(p.ws + OFF_KDT);
    const float* GT = reinterpret_cast<const float*>(p.ws + OFF_GT);
    unsigned char* STL = dyn_lds;
    unsigned char* VTL = dyn_lds + 8704;
    const int tb = w >> 1, db1 = w & 1;
    f32x4 S[2] = {(f32x4){0.f, 0.f, 0.f, 0.f}, (f32x4){0.f, 0.f, 0.f, 0.f}};
#pragma unroll
    for (int db = 0; db < 2; ++db) {
        const uint2 z = make_uint2(0u, 0u);
        *reinterpret_cast<uint2*>(STL + ((db * 16 + fr) * 136 + w * 16 + fq * 4) * 2) = z;
        *reinterpret_cast<uint2*>(ST + (size_t)(bh * 64) * 16384 + (dv0 + db * 16 + fr) * 128 + w * 16 + fq * 4) = z;
    }
    __syncthreads();
    for (int n = 0; n < 64; ++n) {
        const int item = bh * 64 + n, tok0 = b * SEQ + n * 64;
        bf16x8 wf[4], kf[2];
#pragma unroll
        for (int ks = 0; ks < 4; ++ks) wf[ks] = ldg8(W + (size_t)(tok0 + tb * 16 + fr) * 512 + h * 128 + ks * 32 + fq * 8);
#pragma unroll
        for (int ks = 0; ks < 2; ++ks) kf[ks] = ldg8(KDT + (size_t)item * 8192 + (w * 16 + fr) * 64 + ks * 32 + fq * 8);
        bf16_t* up = UT + (size_t)item * 8192 + (dv0 + db1 * 16 + fr) * 64 + tb * 16 + fq * 4;
        const uint2 ub = *reinterpret_cast<const uint2*>(up);
        const float gt = GT[item];
        f32x4 a1 = (f32x4){0.f, 0.f, 0.f, 0.f};
#pragma unroll
        for (int ks = 0; ks < 4; ++ks) a1 = mfma16(wf[ks], lds8(STL + ((db1 * 16 + fr) * 136 + ks * 32 + fq * 8) * 2), a1);
        {
            uint2 vw;
            vw.x = cvt_pk_bf16(bf_lo(ub.x) - a1[0], bf_hi(ub.x) - a1[1]); vw.y = cvt_pk_bf16(bf_lo(ub.y) - a1[2], bf_hi(ub.y) - a1[3]);
            *reinterpret_cast<uint2*>(VTL + ((db1 * 16 + fr) * 72 + tb * 16 + fq * 4) * 2) = vw;
            *reinterpret_cast<uint2*>(up) = vw;
#ifdef DIAG4
            { float mx = 0.f; for (int r = 0; r < 4; ++r) { const float av = fabsf(a1[r]); mx = (av > mx || !(av == av)) ? av : mx; }
              atomicMax(reinterpret_cast<unsigned*>(p.ws + OFF_BAR) + 4014, __float_as_uint(mx)); }
#endif
        }
        __syncthreads();
#pragma unroll
        for (int db = 0; db < 2; ++db) {
            f32x4 a2 = S[db] * gt;
#pragma unroll
            for (int ks = 0; ks < 2; ++ks) a2 = mfma16(kf[ks], lds8(VTL + ((db * 16 + fr) * 72 + ks * 32 + fq * 8) * 2), a2);
            S[db] = a2;
#ifdef DIAG4
            { float mx = 0.f; for (int r = 0; r < 4; ++r) { const float av = fabsf(a2[r]); mx = (av > mx || !(av == av)) ? av : mx; }
              atomicMax(reinterpret_cast<unsigned*>(p.ws + OFF_BAR) + 4013, __float_as_uint(mx)); }
#endif
            if (n < 63) {
                uint2 sw; sw.x = cvt_pk_bf16(a2[0], a2[1]); sw.y = cvt_pk_bf16(a2[2], a2[3]);
                *reinterpret_cast<uint2*>(STL + ((db * 16 + fr) * 136 + w * 16 + fq * 4) * 2) = sw;
                *reinterpret_cast<uint2*>(ST + (size_t)(item + 1) * 16384 + (dv0 + db * 16 + fr) * 128 + w * 16 + fq * 4) = sw;
            }
        }
        __syncthreads();
    }
}

__device__ __forceinline__ void swa_phase(const Params& p_, int l, int sblk, int nsb, int g_wave) {
    Params p = p_; p.ws = opaque_ws(p.ws);
    const int tid = opaque_tid(), lane = tid & 63, w = tid >> 6, fr = lane & 15, fq = lane >> 4;
    const bf16_t* HB = reinterpret_cast<const bf16_t*>(p.ws + OFF_HB);
    bf16_t* YM = reinterpret_cast<bf16_t*>(p.ws + OFF_XB);
    unsigned char* VTS = dyn_lds;
    for (int it = sblk; it < 1024; it += nsb) {
        const int b = it >> 8, kvh = (it >> 7) & 1, qt = it & 127, q0 = qt * 32, kbase = q0 - 128;
        for (int idx = tid; idx < 1280; idx += 512) {
            const int key = idx >> 3, ds = idx & 7, kp = kbase + key;
            uint4 u = make_uint4(0u, 0u, 0u, 0u);
            if (kp >= 0) u = *reinterpret_cast<const uint4*>(HB + (size_t)(b * SEQ + kp) * HB_LD + HB_VB + kvh * 64 + ds * 8);
            bf16_t* d = reinterpret_cast<bf16_t*>(VTS) + (ds * 8) * 168 + key;
            d[0 * 168] = (bf16_t)(u.x & 0xffffu); d[1 * 168] = (bf16_t)(u.x >> 16);
            d[2 * 168] = (bf16_t)(u.y & 0xffffu); d[3 * 168] = (bf16_t)(u.y >> 16);
            d[4 * 168] = (bf16_t)(u.z & 0xffffu); d[5 * 168] = (bf16_t)(u.z >> 16);
            d[6 * 168] = (bf16_t)(u.w & 0xffffu); d[7 * 168] = (bf16_t)(u.w >> 16);
        }
        const int g = w >> 1, sub = w & 1, qs = q0 + sub * 16, hq = kvh * 4 + g;
        const float slope = exp2f(-(float)(hq + 1)), sink = p.sinks[l * 8 + hq];
        bf16x8 qf[2];
#pragma unroll
        for (int ks = 0; ks < 2; ++ks) qf[ks] = ldg8(HB + (size_t)(b * SEQ + qs + fr) * HB_LD + HB_QB + hq * 64 + ks * 32 + fq * 8);
        f32x4 sc[10];
#pragma unroll
        for (int kt = 0; kt < 10; ++kt) {
            int kp = kbase + kt * 16 + fr; kp = kp < 0 ? 0 : kp;
            const bf16_t* kr = HB + (size_t)(b * SEQ + kp) * HB_LD + HB_KB + kvh * 64 + fq * 8;
            f32x4 a = (f32x4){0.f, 0.f, 0.f, 0.f};
            a = mfma16(ldg8(kr), qf[0], a);
            a = mfma16(ldg8(kr + 32), qf[1], a);
            sc[kt] = a;
        }
        const int qpos = qs + fr;
        float m = -1e30f;
#pragma unroll
        for (int kt = 0; kt < 10; ++kt)
#pragma unroll
            for (int r = 0; r < 4; ++r) {
                const int kpos = kbase + kt * 16 + fq * 4 + r, dist = qpos - kpos;
                const bool valid = (dist >= 0) && (dist < 128) && (kpos >= 0);
                const float s = valid ? sc[kt][r] * 0.125f - slope * (float)dist : -1e30f;
                sc[kt][r] = s; m = fmaxf(m, s);
            }
        m = fmaxf(m, shx(m, 16, lane)); m = fmaxf(m, shx(m, 32, lane));
        m = fmaxf(m, sink);
        float lsum = 0.f;
#pragma unroll
        for (int kt = 0; kt < 10; ++kt)
#pragma unroll
            for (int r = 0; r < 4; ++r) { const float e = __expf(sc[kt][r] - m); sc[kt][r] = e; lsum += e; }
        lsum += shx(lsum, 16, lane); lsum += shx(lsum, 32, lane);
        lsum += __expf(sink - m);
        const float inv = 1.0f / lsum;
        __syncthreads();
        f32x4 o[4];
#pragma unroll
        for (int db = 0; db < 4; ++db) o[db] = (f32x4){0.f, 0.f, 0.f, 0.f};
#pragma unroll
        for (int j = 0; j < 5; ++j) {
            union { bf16x8 v; unsigned u[4]; } pf;
            pf.u[0] = cvt_pk_bf16(sc[2 * j][0], sc[2 * j][1]); pf.u[1] = cvt_pk_bf16(sc[2 * j][2], sc[2 * j][3]);
            pf.u[2] = cvt_pk_bf16(sc[2 * j + 1][0], sc[2 * j + 1][1]); pf.u[3] = cvt_pk_bf16(sc[2 * j + 1][2], sc[2 * j + 1][3]);
#pragma unroll
            for (int db = 0; db < 4; ++db) {
                union { bf16x8 v; uint2 h[2]; } vf;
                const unsigned char* vr = VTS + ((db * 16 + fr) * 168 + (2 * j) * 16 + fq * 4) * 2;
                vf.h[0] = *reinterpret_cast<const uint2*>(vr);
                vf.h[1] = *reinterpret_cast<const uint2*>(vr + 32);
                o[db] = mfma16(vf.v, pf.v, o[db]);
            }
        }
        {
            const size_t tok = (size_t)(b * SEQ + qs + fr);
#pragma unroll
            for (int db = 0; db < 4; ++db) {
                const int col = hq * 64 + db * 16 + fq * 4;
                const uint2 z = *reinterpret_cast<const uint2*>(HB + tok * HB_LD + HB_ZB + col);
                uint2 y;
                y.x = cvt_pk_bf16(o[db][0] * inv * silu_f(bf_lo(z.x)), o[db][1] * inv * silu_f(bf_hi(z.x)));
                y.y = cvt_pk_bf16(o[db][2] * inv * silu_f(bf_lo(z.y)), o[db][3] * inv * silu_f(bf_hi(z.y)));
                *reinterpret_cast<uint2*>(YM + tok * DM + 512 + col) = y;
            }
        }
        __syncthreads();
    }
}

__device__ __forceinline__ void delta_out(const Params& p_, int l, int g_wave) {
    Params p = p_; p.ws = opaque_ws(p.ws);
    const int tid = opaque_tid(), grp = tid >> 8, lane = tid & 63, wv = (tid & 255) >> 6, fr = lane & 15, fq = lane >> 4;
    const bf16_t* ST = reinterpret_cast<const bf16_t*>(p.ws + OFF_HA);
    const bf16_t* VT = reinterpret_cast<const bf16_t*>(p.ws + OFF_UT);
    const bf16_t* QD = reinterpret_cast<const bf16_t*>(p.ws + OFF_QD);
    const bf16_t* QK = reinterpret_cast<const bf16_t*>(p.ws + OFF_QK);
    const bf16_t* HB = reinterpret_cast<const bf16_t*>(p.ws + OFF_HB);
    bf16_t* YM = reinterpret_cast<bf16_t*>(p.ws + OFF_XB);
    const float* nw = p.norm_w + l * 128;
    for (int pi = blockIdx.x; pi < 512; pi += gridDim.x) {
        const int item = pi * 2 + grp, bh = item >> 6, n = item & 63, b = bh >> 2, h = bh & 3;
        const int tok = b * SEQ + n * 64 + wv * 16 + fr;
        bf16x8 qd[4], qk[2];
#pragma unroll
        for (int ks = 0; ks < 4; ++ks) qd[ks] = ldg8(QD + (size_t)tok * 512 + h * 128 + ks * 32 + fq * 8);
#pragma unroll
        for (int ks = 0; ks < 2; ++ks) qk[ks] = ldg8(QK + (size_t)tok * 256 + h * 64 + ks * 32 + fq * 8);
        f32x4 o[8];
        float ss = 0.f;
#pragma unroll
        for (int db = 0; db < 8; ++db) {
            if ((db & 1) == 0) __builtin_amdgcn_sched_barrier(0);
            f32x4 a = (f32x4){0.f, 0.f, 0.f, 0.f};
            const bf16_t* sp = ST + (size_t)item * 16384 + (db * 16 + fr) * 128 + fq * 8;
#pragma unroll
            for (int ks = 0; ks < 4; ++ks) a = mfma16(ldg8(sp + ks * 32), qd[ks], a);
            const bf16_t* vp = VT + (size_t)item * 8192 + (db * 16 + fr) * 64 + fq * 8;
#pragma unroll
            for (int ks = 0; ks < 2; ++ks) a = mfma16(ldg8(vp + ks * 32), qk[ks], a);
            o[db] = a;
            ss += (a[0] * a[0] + a[1] * a[1]) + (a[2] * a[2] + a[3] * a[3]);
        }
        ss += shx(ss, 16, lane); ss += shx(ss, 32, lane);
        const float rs = rsqrtf(ss * (1.0f / 128.0f) + 1e-6f);
#pragma unroll
        for (int db = 0; db < 8; ++db) {
            const int dv = db * 16 + fq * 4;
            const f32x4 nv = *reinterpret_cast<const f32x4*>(nw + dv);
            const uint2 z = *reinterpret_cast<const uint2*>(HB + (size_t)tok * HB_LD + HB_ZA + h * 128 + dv);
            uint2 y;
            y.x = cvt_pk_bf16(o[db][0] * rs * nv[0] * silu_f(bf_lo(z.x)), o[db][1] * rs * nv[1] * silu_f(bf_hi(z.x)));
            y.y = cvt_pk_bf16(o[db][2] * rs * nv[2] * silu_f(bf_lo(z.y)), o[db][3] * rs * nv[3] * silu_f(bf_hi(z.y)));
            *reinterpret_cast<uint2*>(YM + (size_t)tok * DM + h * 128 + dv) = y;
        }
    }
}


__device__ __forceinline__ void diag_rows(const bf16_t* YM, float* out, int g_wave) {
    const int tidx = opaque_tid();
    const int lane = tidx & 63;
    const int gw = blockIdx.x * 8 + (tidx >> 6), nw = gridDim.x * 8;
    for (int row = gw; row < NTOK; row += nw) {
        float ca = 0.f, cb = 0.f;
        for (int i = 0; i < 16; ++i) {
            const int col = i * 64 + lane;
            const float v = bf_lo((unsigned)YM[(size_t)row * DM + col]);
            const bool bad = !(fabsf(v) < 1e30f);
            if (bad) { if (col < 512) ca += 1.f; else cb += 1.f; }
        }
        for (int o = 32; o > 0; o >>= 1) { ca += shx(ca, o, lane); cb += shx(cb, o, lane); }
        for (int i = 0; i < 16; ++i) out[(size_t)row * DM + i * 64 + lane] = 0.f;
        if (lane == 0) out[(size_t)row * DM] = (ca > 0.f ? 1e6f : 0.f) + (cb > 0.f ? 1e5f : 0.f);
    }
}


__device__ __forceinline__ void diag_prep(unsigned char* ws, float* out, int g_wave) {
    const int tidx = opaque_tid();
    const int lane = tidx & 63;
    const int gw = blockIdx.x * 8 + (tidx >> 6), nw = gridDim.x * 8;
    const bf16_t* UT = reinterpret_cast<const bf16_t*>(ws + OFF_UT);
    const bf16_t* W = reinterpret_cast<const bf16_t*>(ws + OFF_W);
    const bf16_t* QD = reinterpret_cast<const bf16_t*>(ws + OFF_QD);
    const bf16_t* KDT = reinterpret_cast<const bf16_t*>(ws + OFF_KDT);
    const bf16_t* QK = reinterpret_cast<const bf16_t*>(ws + OFF_QK);
    const float* GT = reinterpret_cast<const float*>(ws + OFF_GT);
    const float* BA = reinterpret_cast<const float*>(ws + OFF_BA);
    for (int row = gw; row < NTOK; row += nw) {
        float c[6] = {0.f, 0.f, 0.f, 0.f, 0.f, 0.f};
        for (int i = 0; i < 8; ++i) {
            const size_t o = (size_t)row * 512 + i * 64 + lane;
            if (!(fabsf(bf_lo((unsigned)UT[o])) < 1e30f)) c[0] += 1.f;
            if (!(fabsf(bf_lo((unsigned)W[o])) < 1e30f)) c[1] += 1.f;
            if (!(fabsf(bf_lo((unsigned)QD[o])) < 1e30f)) c[2] += 1.f;
            if (!(fabsf(bf_lo((unsigned)KDT[o])) < 1e30f)) c[3] += 1.f;
        }
        for (int i = 0; i < 4; ++i) if (!(fabsf(bf_lo((unsigned)QK[(size_t)row * 256 + i * 64 + lane])) < 1e30f)) c[4] += 1.f;
        if (row < 1024 && lane == 0 && !(fabsf(GT[row]) < 1e30f)) c[5] += 1.f;
        if (lane < 8 && !(fabsf(BA[(size_t)row * 8 + lane]) < 1e30f)) c[5] += 1.f;
        for (int j = 0; j < 6; ++j) for (int o = 32; o > 0; o >>= 1) c[j] += shx(c[j], o, lane);
        unsigned bits = 0;
        for (int j = 0; j < 6; ++j) if (c[j] > 0.f) bits |= (1u << j);
        if (lane == 0 && bits) atomicOr(reinterpret_cast<unsigned*>(ws + OFF_BAR) + 4020, bits);
        for (int i = 0; i < 16; ++i) out[(size_t)row * DM + i * 64 + lane] = 0.f;
    }
}

__global__ void __launch_bounds__(512) fwd_megakernel(Params p) {
    __shared__ uint4 xb_words;
    const int g_wave = __builtin_amdgcn_readfirstlane((int)(threadIdx.x >> 6));
    if (xb_t0(g_wave)) xb_words = make_uint4(0u, 0u, 0u, 0u);
    __syncthreads();
    XcdBarrier gb = xcd_barrier_post(reinterpret_cast<unsigned*>(p.ws + OFF_BAR), (volatile LAS unsigned*)&xb_words, g_wave);
#ifdef USE_CG
    gb.x = 0;
#endif

#ifndef PHM
#define PHM 255
#endif
    if (PHM & 1) prep_weights(p, g_wave);
    if (PHM & 2) row_pass(p.x, false, nullptr, nullptr, nullptr, reinterpret_cast<bf16_t*>(p.ws + OFF_XB), p.w_in + 2048, reinterpret_cast<float*>(p.ws + OFF_BA), g_wave);
    xcd_barrier(gb);
    for (int l = 0; l < 2; ++l) {
        unsigned char* wsl = opaque_ws(p.ws);
        bf16_t* XB = reinterpret_cast<bf16_t*>(wsl + OFF_XB);
        float* BA = reinterpret_cast<float*>(wsl + OFF_BA);
        {
            EpiH e; e.ha = reinterpret_cast<bf16_t*>(p.ws + OFF_HA); e.hb = reinterpret_cast<bf16_t*>(p.ws + OFF_HB);
            if (PHM & 4) gemm_phase(XB, reinterpret_cast<const bf16_t*>(p.ws + OFF_WIN) + (size_t)l * NIN * DM, NTOK, NIN, DM, e, g_wave);
        }
        xcd_barrier(gb);
        if (PHM & 8) chunk_prep(p, l, g_wave);
        xcd_barrier(gb);
#ifdef DIAG2
        if (l == 0) { diag_prep(wsl, p.out, g_wave); xcd_barrier(gb);
            if (blockIdx.x == 0 && opaque_tid() == 0) p.out[0] = 1000.f * (float)reinterpret_cast<const unsigned*>(wsl + OFF_BAR)[4020];
            return; }
#endif
#ifdef DIAG3
        if (l == 0) {
            const int tidx = opaque_tid();
            const unsigned* dw = reinterpret_cast<const unsigned*>(wsl + OFF_BAR);
            for (size_t i = (size_t)blockIdx.x * 512 + tidx; i < (size_t)NTOK * DM; i += (size_t)gridDim.x * 512) {
                float v = 0.f;
                if (i == 0) v = fminf(__uint_as_float(dw[4010]), 1e37f) * DIAG3_S0;
                if (i == 1) v = fminf(__uint_as_float(dw[4011]), 1e37f) * DIAG3_S1;
                if (i == 2) v = fminf(__uint_as_float(dw[4012]), 1e37f) * DIAG3_S2;
                p.out[i] = v;
            }
            return;
        }
#endif
        if (blockIdx.x < 64) { if (PHM & 16) delta_scan(p, blockIdx.x, g_wave); }
        else if (PHM & 32) swa_phase(p, l, blockIdx.x - 64, gridDim.x - 64, g_wave);
        xcd_barrier(gb);
#ifdef DIAG4
        if (l == 0) {
            const int tidx = opaque_tid();
            const unsigned* dw = reinterpret_cast<const unsigned*>(wsl + OFF_BAR);
            for (size_t i = (size_t)blockIdx.x * 512 + tidx; i < (size_t)NTOK * DM; i += (size_t)gridDim.x * 512) {
                float v = 0.f;
                if (i == 0) v = fminf(__uint_as_float(dw[4013]), 1e37f) * DIAG4_S0;
                if (i == 1) v = fminf(__uint_as_float(dw[4014]), 1e37f) * DIAG4_S1;
                p.out[i] = v;
            }
            return;
        }
#endif
        if (PHM & 64) delta_out(p, l, g_wave);
        xcd_barrier(gb);
#ifdef DIAG1
        if (l == DIAG1 - 1) { diag_rows(XB, p.out, g_wave); return; }
#endif
        {
            EpiZ e; e.xres = (l == 0) ? p.x : p.out; e.out = p.out;
            if (PHM & 128) gemm_phase(XB, reinterpret_cast<const bf16_t*>(p.ws + OFF_WOUT) + (size_t)l * DM * DM, NTOK, DM, DM, e, g_wave);
        }
        xcd_barrier(gb);
        if (l == 0) row_pass(p.out, true, p.ln_g, p.ln_b, p.out, XB, p.w_in + (size_t)DM * INC + 2048, BA, g_wave);
        else        row_pass(p.out, true, p.ln_g + DM, p.ln_b + DM, p.out, nullptr, nullptr, nullptr, g_wave);
        if (l == 0) xcd_barrier(gb);
    }
}

extern "C" void kernel_launch(void* const* d_in, const int* in_sizes, int n_in, void* d_out, int out_size, void* d_ws, size_t ws_size, hipStream_t stream) {
    static int grid_blocks = 0;
    if (!grid_blocks) {
        int dev = 0, cus = 0, per_cu = 0;
        hipGetDevice(&dev);
        hipDeviceGetAttribute(&cus, hipDeviceAttributeMultiprocessorCount, dev);
        hipFuncSetAttribute((const void*)fwd_megakernel, hipFuncAttributeMaxDynamicSharedMemorySize, LDS_BYTES);
        hipOccupancyMaxActiveBlocksPerMultiprocessor(&per_cu, fwd_megakernel, 512, LDS_BYTES);
        grid_blocks = (per_cu >= 1) ? cus : 0;
        if (grid_blocks > 256) grid_blocks = 256;
        if (ws_size < WS_NEED) { fprintf(stderr, "workspace too small: %zu < %zu\n", ws_size, (size_t)WS_NEED); }
        if (!grid_blocks) { fprintf(stderr, "occupancy query returned 0\n"); grid_blocks = 256; }
    }
    Params p{};
    p.x = (const float*)d_in[0]; p.w_in = (const float*)d_in[1]; p.conv_w = (const float*)d_in[2]; p.a_log = (const float*)d_in[3];
    p.dt_bias = (const float*)d_in[4]; p.norm_w = (const float*)d_in[5]; p.sinks = (const float*)d_in[6]; p.w_out = (const float*)d_in[7];
    p.ln_g = (const float*)d_in[8]; p.ln_b = (const float*)d_in[9]; p.out = (float*)d_out; p.ws = (unsigned char*)d_ws;
    hipMemsetAsync(d_ws, 0, 16384, stream);
    void* args[] = {&p};
    hipError_t e = hipLaunchCooperativeKernel((const void*)fwd_megakernel, dim3(grid_blocks), dim3(512), args, LDS_BYTES, stream);
    if (e != hipSuccess) fprintf(stderr, "cooperative launch failed: %s (grid %d)\n", hipGetErrorString(e), grid_blocks);
}
```

```cpp
#include <hip/hip_runtime.h>
#include <cstdio>
#include <cstdint>

#define PHM 255
#define LAS __attribute__((address_space(3)))
__device__ __forceinline__ int opaque_lane() { int lane; asm volatile("v_mbcnt_lo_u32_b32 %0, -1, 0\n\tv_mbcnt_hi_u32_b32 %0, -1, %0" : "=v"(lane)); return lane; }
typedef unsigned short bf16_t;
typedef short bf16x8 __attribute__((ext_vector_type(8)));
typedef float f32x4 __attribute__((ext_vector_type(4)));

constexpr int NTOK = 16384, SEQ = 4096, DM = 1024, INC = 3336, NIN = 3328;
constexpr int HA_LD = 1536, HB_LD = 1792;
constexpr int HB_ZA = 0, HB_QB = 512, HB_KB = 1024, HB_VB = 1152, HB_ZB = 1280;
constexpr float DN_ALPHA = 1.41421356237f;

constexpr size_t OFF_BAR = 0;
constexpr size_t OFF_XB = 16384;
constexpr size_t OFF_WIN = OFF_XB + (size_t)NTOK * DM * 2;
constexpr size_t OFF_WOUT = OFF_WIN + (size_t)2 * NIN * DM * 2;
constexpr size_t OFF_HA = OFF_WOUT + (size_t)2 * DM * DM * 2;
constexpr size_t OFF_HB = OFF_HA + (size_t)NTOK * HA_LD * 2;
constexpr size_t OFF_UT = OFF_HB + (size_t)NTOK * HB_LD * 2;
constexpr size_t OFF_W = OFF_UT + (size_t)NTOK * 512 * 2;
constexpr size_t OFF_QD = OFF_W + (size_t)NTOK * 512 * 2;
constexpr size_t OFF_KDT = OFF_QD + (size_t)NTOK * 512 * 2;
constexpr size_t OFF_QK = OFF_KDT + (size_t)NTOK * 512 * 2;
constexpr size_t OFF_BA = OFF_QK + (size_t)NTOK * 256 * 2;
constexpr size_t OFF_GT = OFF_BA + (size_t)NTOK * 8 * 4;
constexpr size_t WS_NEED = OFF_GT + 4096;

constexpr int LDS_BYTES = 147456;
extern __shared__ __attribute__((aligned(16))) unsigned char dyn_lds[];

struct Params {
    const float* x; const float* w_in; const float* conv_w; const float* a_log; const float* dt_bias;
    const float* norm_w; const float* sinks; const float* w_out; const float* ln_g; const float* ln_b;
    float* out; unsigned char* ws;
};

typedef float f32x2_t __attribute__((ext_vector_type(2)));
typedef __bf16 bf16x2_t __attribute__((ext_vector_type(2)));
__device__ __forceinline__ unsigned cvt_pk_bf16(float lo, float hi) {
    const f32x2_t v = {lo, hi};
    const bf16x2_t r = __builtin_convertvector(v, bf16x2_t);
    return __builtin_bit_cast(unsigned, r);
}
__device__ __forceinline__ float bf_lo(unsigned u) { return __uint_as_float(u << 16); }
__device__ __forceinline__ float bf_hi(unsigned u) { return __uint_as_float(u & 0xffff0000u); }
__device__ __forceinline__ float silu_f(float x) { return x / (1.0f + __expf(-x)); }
__device__ __forceinline__ f32x4 mfma16(bf16x8 a, bf16x8 b, f32x4 c) { return __builtin_amdgcn_mfma_f32_16x16x32_bf16(a, b, c, 0, 0, 0); }
__device__ __forceinline__ bf16x8 ldg8(const bf16_t* p) { return *reinterpret_cast<const bf16x8*>(p); }
__device__ __forceinline__ bf16x8 lds8(const unsigned char* p) { return *reinterpret_cast<const bf16x8*>(p); }

__device__ __forceinline__ int opaque_tid_(int g_wave) {
    int lane; asm volatile("v_mbcnt_lo_u32_b32 %0, -1, 0\n\tv_mbcnt_hi_u32_b32 %0, -1, %0" : "=v"(lane));
    return g_wave * 64 + lane; }
#define opaque_tid() opaque_tid_(g_wave)
__device__ __forceinline__ unsigned char* opaque_ws(unsigned char* w) { asm volatile("" : "+s"(w)); return w; }
__device__ __forceinline__ const bf16_t* uniform_ptr(const bf16_t* p) {
    const unsigned long long v = (unsigned long long)p;
    const unsigned lo = __builtin_amdgcn_readfirstlane((unsigned)v), hi = __builtin_amdgcn_readfirstlane((unsigned)(v >> 32));
    return (const bf16_t*)(((unsigned long long)hi << 32) | lo);
}

__device__ __forceinline__ float shx(float v, int m, int lane) { return __int_as_float(__builtin_amdgcn_ds_bpermute((lane ^ m) << 2, __float_as_int(v))); }

#define XB_TMO      128
#define XB_XCNT(j)  (256  + 64 * (j))
#define XB_XSUB(j)  (1280 + 64 * (j))
#define XB_XGEN(j)  (2304 + 64 * (j))
#define XB_TOP      3328
#define XB_TOPGEN   3392
#define XCD_BAR_WORDS 3456
#define XB_SPIN_CAP (1u << 20)
__device__ __forceinline__ unsigned xb_ld(unsigned* p)              { return __hip_atomic_load(p, __ATOMIC_RELAXED, __HIP_MEMORY_SCOPE_AGENT); }
__device__ __forceinline__ unsigned xb_add(unsigned* p, unsigned v) { return __hip_atomic_fetch_add(p, v, __ATOMIC_RELAXED, __HIP_MEMORY_SCOPE_AGENT); }
__device__ __forceinline__ unsigned xb_xcc_id() { return (unsigned)__builtin_amdgcn_s_getreg((3 << 11) | 20) & 0xFu; }
#define XB_SPIN(cond, bar) do { unsigned _sp = 0; while (cond) { __builtin_amdgcn_s_sleep(1); \
    if ((++_sp & 255u) == 0u) { if (xb_ld(&(bar)[XB_TMO])) break; if (_sp > XB_SPIN_CAP) { atomicAdd(&(bar)[XB_TMO], 1u); break; } } } } while (0)
struct XcdBarrier { unsigned* bar; unsigned x; volatile LAS unsigned* st; int gw; };
__device__ __forceinline__ bool xb_t0(int gw) { return gw == 0 && opaque_lane() == 0; }
__device__ __forceinline__ XcdBarrier xcd_barrier_post(unsigned* bar, volatile LAS unsigned* st, int gw) {
    XcdBarrier b; b.bar = bar; b.x = xb_xcc_id(); b.st = st; b.gw = gw;
    if (xb_t0(gw)) (void)xb_add(&bar[XB_XCNT(b.x)], 1u);
    return b;
}
__device__ __forceinline__ void xcd_barrier_complete(unsigned* bar, unsigned x, unsigned& nloc, unsigned& nx) {
    const unsigned G = gridDim.x * gridDim.y * gridDim.z;
    unsigned sum, cnt, mine, sp = 0u;
    for (;;) {
        sum = 0u; cnt = 0u; mine = 0u;
#pragma unroll
        for (unsigned j = 0; j < 16; ++j) { const unsigned c = xb_ld(&bar[XB_XCNT(j)]); sum += c; cnt += (c > 0u) ? 1u : 0u; mine = (j == x) ? c : mine; }
        if (sum == G) break;
        __builtin_amdgcn_s_sleep(1);
        if ((++sp & 255u) == 0u) { if (xb_ld(&bar[XB_TMO])) break; if (sp > XB_SPIN_CAP) { atomicAdd(&bar[XB_TMO], 1u); break; } }
    }
    nloc = mine > 0u ? mine : 1u; nx = cnt > 0u ? cnt : 1u;
}
#ifdef USE_CG
__device__ __forceinline__ void xcd_barrier(XcdBarrier& b) {
    asm volatile("s_waitcnt vmcnt(0)" ::: "memory");
    __syncthreads();
    b.x = __builtin_amdgcn_readfirstlane(b.x + gridDim.x);
    if (xb_t0(b.gw)) {
        __threadfence();
        unsigned* c = b.bar + 4000;
        xb_add(c, 1u);
        unsigned sp = 0;
        while (xb_ld(c) < b.x) { __builtin_amdgcn_s_sleep(2); if (++sp > (1u << 24)) break; }
        __threadfence();
    }
    __syncthreads();
}
#else
__device__ __forceinline__ void xcd_barrier(const XcdBarrier& b_) {
    asm volatile("s_waitcnt vmcnt(0)" ::: "memory");
    __syncthreads();
    if (xb_t0(b_.gw)) {
        XcdBarrier b = b_; b.x = xb_xcc_id();
        asm volatile("" : "+s"(b.x));
        unsigned* bar = b.bar;
        __builtin_amdgcn_s_waitcnt(0);
        unsigned nloc = b.st[0], nx = b.st[1];
        if (nloc == 0u) { xcd_barrier_complete(bar, b.x, nloc, nx); b.st[0] = nloc; b.st[1] = nx; }
        const unsigned old = xb_add(&bar[XB_XSUB(b.x)], 1u);
        const unsigned gen = old / nloc;
        if (old + 1u == (gen + 1u) * nloc) {
            __builtin_amdgcn_fence(__ATOMIC_RELEASE, "agent");
            asm volatile("s_waitcnt vmcnt(0)" ::: "memory");
            const unsigned og = xb_add(&bar[XB_TOP], 1u);
            const unsigned tg = og / nx;
            if (og + 1u == (tg + 1u) * nx) xb_add(&bar[XB_TOPGEN], 1u);
            else XB_SPIN(xb_ld(&bar[XB_TOPGEN]) == tg, bar);
            __builtin_amdgcn_fence(__ATOMIC_ACQUIRE, "agent");
            xb_add(&bar[XB_XGEN(b.x)], 1u);
            asm volatile("s_waitcnt vmcnt(0)" ::: "memory");
        } else {
            XB_SPIN(xb_ld(&bar[XB_XGEN(b.x)]) == gen, bar);
            __builtin_amdgcn_fence(__ATOMIC_ACQUIRE, "agent");
            asm volatile("s_waitcnt vmcnt(0)" ::: "memory");
        }
    }
    __syncthreads();
}

#endif

constexpr int BM = 256, BK = 64, HALF = 128, NXCD = 8, WGM = 8, HT = HALF * BK;
__device__ __forceinline__ int lds_byte(int r, int c) {
    int st = (r >> 4) * 2 + (c >> 5), rr = r & 15, cc = c & 31, ob = rr * 64 + cc * 2;
    return st * 1024 + (ob ^ (((ob >> 9) & 1) << 5));
}
__device__ __forceinline__ void stage_rc(int b, int& R, int& C) {
    int st = b / 1024, sb = b % 1024, swz = sb ^ (((sb >> 9) & 1) << 5);
    R = (st >> 1) * 16 + swz / 64; C = (st & 1) * 32 + (swz % 64) / 2;
}

struct EpiH {
    bf16_t* ha; bf16_t* hb;
    __device__ __forceinline__ void operator()(const f32x4 (&acc)[2][2][4][2], int brow, int bcol, int wr, int wc, int fr, int fq) const {
        bf16_t* base; int ld, c0;
        if (bcol < HA_LD) { base = ha; ld = HA_LD; c0 = bcol; } else { base = hb; ld = HB_LD; c0 = bcol - HA_LD; }
#pragma unroll
        for (int ai = 0; ai < 2; ++ai)
#pragma unroll
            for (int m = 0; m < 4; ++m) {
                const int row = brow + ai * HALF + wr * 64 + m * 16 + fr;
                bf16_t* rp = base + (size_t)row * ld + c0 + wc * 32 + fq * 4;
#pragma unroll
                for (int bj = 0; bj < 2; ++bj)
#pragma unroll
                    for (int n = 0; n < 2; ++n) {
                        const f32x4 v = acc[ai][bj][m][n];
                        uint2 w; w.x = cvt_pk_bf16(v[0], v[1]); w.y = cvt_pk_bf16(v[2], v[3]);
                        *reinterpret_cast<uint2*>(rp + bj * HALF + n * 16) = w;
                    }
            }
    }
};
struct EpiZ {
    const float* xres; float* out;
    __device__ __forceinline__ void operator()(const f32x4 (&acc)[2][2][4][2], int brow, int bcol, int wr, int wc, int fr, int fq) const {
#pragma unroll
        for (int ai = 0; ai < 2; ++ai)
#pragma unroll
            for (int m = 0; m < 4; ++m) {
                const int row = brow + ai * HALF + wr * 64 + m * 16 + fr;
                const size_t ro = (size_t)row * DM + bcol + wc * 32 + fq * 4;
#pragma unroll
                for (int bj = 0; bj < 2; ++bj)
#pragma unroll
                    for (int n = 0; n < 2; ++n) {
                        const size_t o = ro + bj * HALF + n * 16;
                        const f32x4 r = *reinterpret_cast<const f32x4*>(xres + o);
                        *reinterpret_cast<f32x4*>(out + o) = r * DN_ALPHA + acc[ai][bj][m][n];
                    }
            }
    }
};

template <class Epi>
__device__ __forceinline__ void gemm_phase(const bf16_t* __restrict__ A, const bf16_t* __restrict__ Bt, int M, int N, int K, const Epi& epi, int g_wave) {
    bf16_t* shm = reinterpret_cast<bf16_t*>(dyn_lds);
#define SA(b,h) (shm+((b)*2+(h))*HT)
#define SB(b,h) (shm+(4+(b)*2+(h))*HT)
#define STAGE(P,BASE,br,kt) do{const bf16_t* _bp=uniform_ptr((BASE)+((long)(br)*K+(long)(kt)*BK)); \
    __builtin_amdgcn_global_load_lds((const unsigned*)((const char*)_bp+soff0),(unsigned*)((char*)(P)+tidx*16),16,0,0); \
    __builtin_amdgcn_global_load_lds((const unsigned*)((const char*)_bp+soff1),(unsigned*)((char*)(P)+tidx*16+8192),16,0,0);}while(0)
#define LDA(dst,b,h) for(int m=0;m<4;++m)for(int k=0;k<2;++k) \
    dst[m][k]=*reinterpret_cast<const bf16x8*>((char*)SA(b,h)+lds_byte(wr*64+m*16+fr,k*32+fq*8))
#define LDB(dst,b,h) for(int n=0;n<2;++n)for(int k=0;k<2;++k) \
    dst[n][k]=*reinterpret_cast<const bf16x8*>((char*)SB(b,h)+lds_byte(wc*32+n*16+fr,k*32+fq*8))
#define MMA(ai,bj,At,Bt_) do{__builtin_amdgcn_s_setprio(1); \
    for(int m=0;m<4;++m)for(int n=0;n<2;++n)for(int k=0;k<2;++k) \
      acc[ai][bj][m][n]=__builtin_amdgcn_mfma_f32_16x16x32_bf16(Bt_[n][k],At[m][k],acc[ai][bj][m][n],0,0,0); \
    __builtin_amdgcn_s_setprio(0);}while(0)
#define WAIT_V(n) asm volatile("s_waitcnt vmcnt(" #n ")":::"memory")
#define WAIT_L(n) asm volatile("s_waitcnt lgkmcnt(" #n ")":::"memory")
#define BAR __builtin_amdgcn_s_barrier()
#define SCHED __builtin_amdgcn_sched_barrier(0)
    const int nM = M / BM, nN = N / BM, nwg = nM * nN;
    const int tidx = opaque_tid();
    const int wid = tidx >> 6, lane = tidx & 63, wr = wid >> 2, wc = wid & 3, fr = lane & 15, fq = lane >> 4;
    const int nt = K / BK;
    unsigned soff0, soff1;
    { int r_, c_; stage_rc(tidx * 16, r_, c_); soff0 = (unsigned)(r_ * K + c_) * 2u; stage_rc(tidx * 16 + 8192, r_, c_); soff1 = (unsigned)(r_ * K + c_) * 2u; }
    for (int L = blockIdx.x; L < nwg; L += gridDim.x) {
        int wgid = L;
        { int q = nwg / NXCD, r = nwg % NXCD, xcd = wgid % NXCD, off = wgid / NXCD; wgid = (xcd < r ? xcd * (q + 1) : r * (q + 1) + (xcd - r) * q) + off; }
        const int nig = WGM * nN, gid = wgid / nig, fm = gid * WGM, gsz = min(nM - fm, WGM);
        const int pm = fm + ((wgid % nig) % gsz), pn = (wgid % nig) / gsz, brow = pm * BM, bcol = pn * BM;
        f32x4 acc[2][2][4][2] = {};
        bf16x8 At[4][2], B0[2][2], B1[2][2];
        STAGE(SB(0,0),Bt,bcol,0); STAGE(SA(0,0),A,brow,0);
        STAGE(SB(0,1),Bt,bcol+HALF,0); STAGE(SA(0,1),A,brow+HALF,0);
        if(wr==1)BAR;
        WAIT_V(4); BAR;
        STAGE(SB(1,0),Bt,bcol,1); STAGE(SA(1,0),A,brow,1); STAGE(SB(1,1),Bt,bcol+HALF,1);
        WAIT_V(6); BAR;
        for(int t=0;t<nt-2;t+=2){
            LDB(B0,0,0); SCHED; LDA(At,0,0); STAGE(SA(1,1),A,brow+HALF,t+1);
            WAIT_L(8); BAR; WAIT_L(0); MMA(0,0,At,B0); BAR; SCHED;
            LDB(B1,0,1); STAGE(SB(0,0),Bt,bcol,t+2);
            BAR; WAIT_L(0); MMA(0,1,At,B1); BAR;
            LDA(At,0,1); STAGE(SA(0,0),A,brow,t+2);
            BAR; WAIT_L(0); MMA(1,0,At,B0); BAR; SCHED;
            STAGE(SB(0,1),Bt,bcol+HALF,t+2);
            WAIT_V(6); BAR; MMA(1,1,At,B1); BAR;
            LDB(B0,1,0); SCHED; LDA(At,1,0); STAGE(SA(0,1),A,brow+HALF,t+2);
            WAIT_L(8); BAR; WAIT_L(0); MMA(0,0,At,B0); BAR; SCHED;
            LDB(B1,1,1); STAGE(SB(1,0),Bt,bcol,t+3);
            BAR; WAIT_L(0); MMA(0,1,At,B1); BAR;
            LDA(At,1,1); STAGE(SA(1,0),A,brow,t+3);
            BAR; WAIT_L(0); MMA(1,0,At,B0); BAR; SCHED;
            STAGE(SB(1,1),Bt,bcol+HALF,t+3);
            WAIT_V(6); BAR; MMA(1,1,At,B1); BAR;
        }
        { LDB(B0,0,0); LDA(At,0,0); STAGE(SA(1,1),A,brow+HALF,nt-1);
          BAR; WAIT_L(0); MMA(0,0,At,B0); BAR;
          LDB(B1,0,1); BAR; WAIT_L(0); MMA(0,1,At,B1); BAR;
          LDA(At,0,1); WAIT_V(4); BAR; WAIT_L(0); MMA(1,0,At,B0); MMA(1,1,At,B1); BAR; }
        { LDB(B0,1,0); LDA(At,1,0); WAIT_V(2); BAR; WAIT_L(0); MMA(0,0,At,B0); BAR;
          LDB(B1,1,1); WAIT_V(0); BAR; WAIT_L(0); MMA(0,1,At,B1); BAR;
          LDA(At,1,1); BAR; WAIT_L(0); MMA(1,0,At,B0); MMA(1,1,At,B1); BAR; }
        if(wr==0)BAR;
        epi(acc, brow, bcol, wr, wc, fr, fq);
        __syncthreads();
    }
#undef SA
#undef SB
#undef STAGE
#undef LDA
#undef LDB
#undef MMA
}

__device__ __forceinline__ void prep_weights(const Params& p, int g_wave) {
    bf16_t* win = reinterpret_cast<bf16_t*>(p.ws + OFF_WIN);
    bf16_t* wout = reinterpret_cast<bf16_t*>(p.ws + OFF_WOUT);
    const int gtid = blockIdx.x * 512 + opaque_tid(), gsz = gridDim.x * 512;
    const int n_in = 2 * 128 * NIN;
    for (int i = gtid; i < n_in; i += gsz) {
        const int n = i % NIN, kg = (i / NIN) % 128, l = i / (NIN * 128);
        const int sc = n < 2048 ? n : n + 8;
        const float* s = p.w_in + (size_t)l * DM * INC + (size_t)(kg * 8) * INC + sc;
        uint4 w;
        w.x = cvt_pk_bf16(s[0], s[INC]); w.y = cvt_pk_bf16(s[2 * INC], s[3 * INC]);
        w.z = cvt_pk_bf16(s[4 * INC], s[5 * INC]); w.w = cvt_pk_bf16(s[6 * INC], s[7 * INC]);
        *reinterpret_cast<uint4*>(win + ((size_t)l * NIN + n) * DM + kg * 8) = w;
    }
    const int n_out = 2 * 128 * DM;
    for (int i = gtid; i < n_out; i += gsz) {
        const int n = i % DM, kg = (i / DM) % 128, l = i / (DM * 128);
        const float* s = p.w_out + (size_t)l * DM * DM + (size_t)(kg * 8) * DM + n;
        uint4 w;
        w.x = cvt_pk_bf16(s[0], s[DM]); w.y = cvt_pk_bf16(s[2 * DM], s[3 * DM]);
        w.z = cvt_pk_bf16(s[4 * DM], s[5 * DM]); w.w = cvt_pk_bf16(s[6 * DM], s[7 * DM]);
        *reinterpret_cast<uint4*>(wout + ((size_t)l * DM + n) * DM + kg * 8) = w;
    }
}

__device__ __forceinline__ void row_pass(const float* src, bool ln, const float* g, const float* bta, float* dstf, bf16_t* xb, const float* wg  , float* BA, int g_wave) {
    const int tidx = opaque_tid();
    const int lane = tidx & 63;
    const int gw = blockIdx.x * 8 + (tidx >> 6), nw = gridDim.x * 8;
    for (int row = gw; row < NTOK; row += nw) {
        f32x4 v[4];
#pragma unroll
        for (int i = 0; i < 4; ++i) v[i] = *reinterpret_cast<const f32x4*>(src + (size_t)row * DM + i * 256 + lane * 4);
        if (ln) {
            float s = 0.f;
#pragma unroll
            for (int i = 0; i < 4; ++i) s += (v[i][0] + v[i][1]) + (v[i][2] + v[i][3]);
#pragma unroll
            for (int o = 32; o > 0; o >>= 1) s += shx(s, o, lane);
            const float mu = s * (1.0f / DM);
            float q = 0.f;
#pragma unroll
            for (int i = 0; i < 4; ++i) { v[i] = v[i] - mu; q += (v[i][0] * v[i][0] + v[i][1] * v[i][1]) + (v[i][2] * v[i][2] + v[i][3] * v[i][3]); }
#pragma unroll
            for (int o = 32; o > 0; o >>= 1) q += shx(q, o, lane);
            const float rstd = rsqrtf(q * (1.0f / DM) + 1e-5f);
#pragma unroll
            for (int i = 0; i < 4; ++i) {
                const f32x4 gg = *reinterpret_cast<const f32x4*>(g + i * 256 + lane * 4), bb = *reinterpret_cast<const f32x4*>(bta + i * 256 + lane * 4);
                v[i] = v[i] * rstd * gg + bb;
            }
        }
#ifdef SANITIZE
#pragma unroll
        for (int i = 0; i < 4; ++i)
#pragma unroll
            for (int e = 0; e < 4; ++e) if (!(fabsf(v[i][e]) < 1e30f)) v[i][e] = 0.f;
#endif
        if (dstf) {
#pragma unroll
            for (int i = 0; i < 4; ++i) *reinterpret_cast<f32x4*>(dstf + (size_t)row * DM + i * 256 + lane * 4) = v[i];
        }
        if (xb) {
#pragma unroll
            for (int i = 0; i < 4; ++i) { uint2 w; w.x = cvt_pk_bf16(v[i][0], v[i][1]); w.y = cvt_pk_bf16(v[i][2], v[i][3]);
                *reinterpret_cast<uint2*>(xb + (size_t)row * DM + i * 256 + lane * 4) = w; }
        }
        if (wg) {
            float d[8] = {0.f, 0.f, 0.f, 0.f, 0.f, 0.f, 0.f, 0.f};
#pragma unroll
            for (int i = 0; i < 4; ++i)
#pragma unroll
                for (int e = 0; e < 4; ++e) {
                    const float* wp = wg + (size_t)(i * 256 + lane * 4 + e) * INC;
                    const f32x4 w0 = *reinterpret_cast<const f32x4*>(wp), w1 = *reinterpret_cast<const f32x4*>(wp + 4);
                    const float xv = v[i][e];
                    d[0] += xv * w0[0]; d[1] += xv * w0[1]; d[2] += xv * w0[2]; d[3] += xv * w0[3];
                    d[4] += xv * w1[0]; d[5] += xv * w1[1]; d[6] += xv * w1[2]; d[7] += xv * w1[3];
                }
#pragma unroll
            for (int j = 0; j < 8; ++j) {
#pragma unroll
                for (int o = 32; o > 0; o >>= 1) d[j] += shx(d[j], o, lane);
            }
            if (lane == 0) {
                *reinterpret_cast<f32x4*>(BA + (size_t)row * 8) = (f32x4){d[0], d[1], d[2], d[3]};
                *reinterpret_cast<f32x4*>(BA + (size_t)row * 8 + 4) = (f32x4){d[4], d[5], d[6], d[7]};
            }
        }
    }
}

constexpr int GRP_LDS = 73728;
constexpr int L_KRM = 0, L_QRM = 17408, L_KBGT = 34816, L_VBT = 53248, L_GC = 71680, L_BETA = 71936;
__device__ __forceinline__ void chunk_prep(const Params& p_, int l, int g_wave) {
    Params p = p_; p.ws = opaque_ws(p.ws);
    const bf16_t* HA = reinterpret_cast<const bf16_t*>(p.ws + OFF_HA);
    const float* BA = reinterpret_cast<const float*>(p.ws + OFF_BA);
    bf16_t* UT = reinterpret_cast<bf16_t*>(p.ws + OFF_UT);
    bf16_t* W = reinterpret_cast<bf16_t*>(p.ws + OFF_W);
    bf16_t* QD = reinterpret_cast<bf16_t*>(p.ws + OFF_QD);
    bf16_t* KDT = reinterpret_cast<bf16_t*>(p.ws + OFF_KDT);
    bf16_t* QK = reinterpret_cast<bf16_t*>(p.ws + OFF_QK);
    float* GT = reinterpret_cast<float*>(p.ws + OFF_GT);
    const float* cw = p.conv_w + (size_t)l * 4 * 1536;
#define CP_LANEVARS const int tid = opaque_tid(), grp = tid >> 8, gt = tid & 255, lane = tid & 63, wv = gt >> 6, fr = lane & 15, fq = lane >> 4; \
    unsigned char* lds = dyn_lds + grp * GRP_LDS; float* gc_s = reinterpret_cast<float*>(lds + L_GC); float* beta_s = reinterpret_cast<float*>(lds + L_BETA); \
    const int tg = gt >> 4, sg = gt & 15, t0 = tg * 4, c0 = sg * 8; (void)fr; (void)fq; (void)wv; (void)t0; (void)c0; (void)gc_s; (void)beta_s; (void)lane;
    for (int pi = blockIdx.x; pi < 512; pi += gridDim.x) {
        const int grp0 = opaque_tid() >> 8;
        const int hp = pi & 1, n = (pi >> 1) & 63, b = pi >> 7, h = hp * 2 + grp0;
        const int item = (b * 4 + h) * 64 + n, tok0 = b * SEQ + n * 64;
        { CP_LANEVARS
        if (wv == 0) {
            const float bv = BA[(size_t)(tok0 + lane) * 8 + h], av = BA[(size_t)(tok0 + lane) * 8 + 4 + h];
            const float beta = 1.0f / (1.0f + __expf(-bv));
            const float xx = av + p.dt_bias[l * 4 + h];
            const float sp = fmaxf(xx, 0.f) + log1pf(__expf(-fabsf(xx)));
            float gv = -__expf(p.a_log[l * 4 + h]) * sp;
#pragma unroll
            for (int o = 1; o < 64; o <<= 1) { const float t = __int_as_float(__builtin_amdgcn_ds_bpermute((lane - o) << 2, __float_as_int(gv))); if (lane >= o) gv += t; }
            gc_s[lane] = gv; beta_s[lane] = beta;
            if (lane == 63) GT[item] = __expf(gv);
        } }
        __syncthreads();
        {
            CP_LANEVARS
            const float glast = gc_s[63];
            float eg[4], ek[4], be[4];
#pragma unroll
            for (int i = 0; i < 4; ++i) { const float gci = gc_s[t0 + i]; eg[i] = __expf(gci); ek[i] = __expf(glast - gci); be[i] = beta_s[t0 + i]; }
#pragma unroll
            for (int ten = 0; ten < 3; ++ten) {
                __builtin_amdgcn_sched_barrier(0);
                float raw[7][8];
#pragma unroll
                for (int r = 0; r < 7; ++r) {
                    const int tt = n * 64 + t0 - 3 + r;
                    uint4 u = make_uint4(0u, 0u, 0u, 0u);
                    if (tt >= 0) u = *reinterpret_cast<const uint4*>(HA + (size_t)(b * SEQ + tt) * HA_LD + ten * 512 + h * 128 + c0);
                    raw[r][0] = bf_lo(u.x); raw[r][1] = bf_hi(u.x); raw[r][2] = bf_lo(u.y); raw[r][3] = bf_hi(u.y);
                    raw[r][4] = bf_lo(u.z); raw[r][5] = bf_hi(u.z); raw[r][6] = bf_lo(u.w); raw[r][7] = bf_hi(u.w);
                }
                float o[4][8];
#pragma unroll
                for (int i = 0; i < 4; ++i)
#pragma unroll
                    for (int c = 0; c < 8; ++c) o[i][c] = 0.f;
#pragma unroll
                for (int j = 0; j < 4; ++j) {
                    const float* wp = cw + (size_t)j * 1536 + ten * 512 + h * 128 + c0;
                    const f32x4 a = *reinterpret_cast<const f32x4*>(wp), c4 = *reinterpret_cast<const f32x4*>(wp + 4);
                    const float wj[8] = {a[0], a[1], a[2], a[3], c4[0], c4[1], c4[2], c4[3]};
#pragma unroll
                    for (int i = 0; i < 4; ++i)
#pragma unroll
                        for (int c = 0; c < 8; ++c) o[i][c] += wj[c] * raw[i + j][c];
                }
#pragma unroll
                for (int i = 0; i < 4; ++i)
#pragma unroll
                    for (int c = 0; c < 8; ++c) o[i][c] = silu_f(o[i][c]);
                if (ten < 2) {
#pragma unroll
                    for (int i = 0; i < 4; ++i) {
                        float sq = 0.f;
#pragma unroll
                        for (int c = 0; c < 8; ++c) sq += o[i][c] * o[i][c];
#pragma unroll
                        for (int off = 1; off < 16; off <<= 1) sq += shx(sq, off, lane);
                        const float rq = rsqrtf(sq + 1e-6f) * (ten == 0 ? 0.08838834764831845f : 1.0f);
#pragma unroll
                        for (int c = 0; c < 8; ++c) o[i][c] *= rq;
                    }
                }
                if (ten == 0) {
#pragma unroll
                    for (int i = 0; i < 4; ++i) {
                        uint4 w;
                        w.x = cvt_pk_bf16(o[i][0] * eg[i], o[i][1] * eg[i]); w.y = cvt_pk_bf16(o[i][2] * eg[i], o[i][3] * eg[i]);
                        w.z = cvt_pk_bf16(o[i][4] * eg[i], o[i][5] * eg[i]); w.w = cvt_pk_bf16(o[i][6] * eg[i], o[i][7] * eg[i]);
                        *reinterpret_cast<uint4*>(QD + (size_t)(tok0 + t0 + i) * 512 + h * 128 + c0) = w;
                        w.x = cvt_pk_bf16(o[i][0], o[i][1]); w.y = cvt_pk_bf16(o[i][2], o[i][3]); w.z = cvt_pk_bf16(o[i][4], o[i][5]); w.w = cvt_pk_bf16(o[i][6], o[i][7]);
                        *reinterpret_cast<uint4*>(lds + L_QRM + ((t0 + i) * 136 + c0) * 2) = w;
                    }
                } else if (ten == 1) {
#pragma unroll
                    for (int i = 0; i < 4; ++i) {
                        uint4 w;
                        w.x = cvt_pk_bf16(o[i][0], o[i][1]); w.y = cvt_pk_bf16(o[i][2], o[i][3]); w.z = cvt_pk_bf16(o[i][4], o[i][5]); w.w = cvt_pk_bf16(o[i][6], o[i][7]);
                        *reinterpret_cast<uint4*>(lds + L_KRM + ((t0 + i) * 136 + c0) * 2) = w;
                    }
#pragma unroll
                    for (int c = 0; c < 8; ++c) {
                        uint2 w;
                        w.x = cvt_pk_bf16(o[0][c] * ek[0], o[1][c] * ek[1]); w.y = cvt_pk_bf16(o[2][c] * ek[2], o[3][c] * ek[3]);
                        *reinterpret_cast<uint2*>(KDT + (size_t)item * 8192 + (c0 + c) * 64 + t0) = w;
                        w.x = cvt_pk_bf16(o[0][c] * be[0] * eg[0], o[1][c] * be[1] * eg[1]); w.y = cvt_pk_bf16(o[2][c] * be[2] * eg[2], o[3][c] * be[3] * eg[3]);
                        *reinterpret_cast<uint2*>(lds + L_KBGT + ((c0 + c) * 72 + t0) * 2) = w;
                    }
                } else {
#pragma unroll
                    for (int c = 0; c < 8; ++c) {
                        uint2 w;
                        w.x = cvt_pk_bf16(o[0][c] * be[0], o[1][c] * be[1]); w.y = cvt_pk_bf16(o[2][c] * be[2], o[3][c] * be[3]);
                        *reinterpret_cast<uint2*>(lds + L_VBT + ((c0 + c) * 72 + t0) * 2) = w;
                    }
                }
            }
        }
        __syncthreads();
        {
            CP_LANEVARS
            const int ib = wv;
            f32x4 kk[4], qk[4];
#pragma unroll
            for (int jb = 0; jb < 4; ++jb) { kk[jb] = (f32x4){0.f, 0.f, 0.f, 0.f}; qk[jb] = (f32x4){0.f, 0.f, 0.f, 0.f}; }
            bf16x8 ki[4], qi[4];
#pragma unroll
            for (int ks = 0; ks < 4; ++ks) {
                ki[ks] = lds8(lds + L_KRM + ((ib * 16 + fr) * 136 + ks * 32 + fq * 8) * 2);
                qi[ks] = lds8(lds + L_QRM + ((ib * 16 + fr) * 136 + ks * 32 + fq * 8) * 2);
            }
#pragma unroll
            for (int jb = 0; jb < 4; ++jb) {
                if (jb <= ib) {
#pragma unroll
                    for (int ks = 0; ks < 4; ++ks) {
                        const bf16x8 kj = lds8(lds + L_KRM + ((jb * 16 + fr) * 136 + ks * 32 + fq * 8) * 2);
                        kk[jb] = mfma16(ki[ks], kj, kk[jb]);
                        qk[jb] = mfma16(kj, qi[ks], qk[jb]);
                    }
                }
            }
            __syncthreads();
            float* AP = reinterpret_cast<float*>(lds + L_KRM);
#pragma unroll
            for (int jb = 0; jb < 4; ++jb) {
                if (jb <= ib) {
                    const int j = jb * 16 + fr, i0 = ib * 16 + fq * 4;
                    const float gj = gc_s[j];
#pragma unroll
                    for (int r = 0; r < 4; ++r) {
                        const int i = i0 + r;
                        const float dec = __expf(fminf(gc_s[i] - gj, 0.f));
                        float av_ = (i > j) ? kk[jb][r] * beta_s[i] * dec : 0.f;
#ifdef DIAG3
                        atomicMax(reinterpret_cast<unsigned*>(p.ws + OFF_BAR) + 4011, __float_as_uint(fabsf(kk[jb][r])));
                        atomicMax(reinterpret_cast<unsigned*>(p.ws + OFF_BAR) + 4012, __float_as_uint(fabsf(av_)));
#endif
#ifdef CLAMP_A
                        if (!(fabsf(av_) <= 0.02f)) av_ = 0.f;
#endif
                        AP[j * 64 + r * 16 + ib * 4 + fq] = av_;
                    }
                }
                {
                    const int i = ib * 16 + fr, j0 = jb * 16 + fq * 4;
                    const float gi = gc_s[i];
                    float o[4];
#pragma unroll
                    for (int r = 0; r < 4; ++r) {
                        const int j = j0 + r;
                        const float dec = __expf(fminf(gi - gc_s[j], 0.f));
                        o[r] = (i >= j) ? qk[jb][r] * dec : 0.f;
                    }
                    uint2 w; w.x = cvt_pk_bf16(o[0], o[1]); w.y = cvt_pk_bf16(o[2], o[3]);
                    *reinterpret_cast<uint2*>(QK + (size_t)(tok0 + i) * 256 + h * 64 + j0) = w;
                }
            }
        }
        __syncthreads();
        {
            CP_LANEVARS
            const float* AP = reinterpret_cast<const float*>(lds + L_KRM);
            const int cl = lane >> 2, pp = lane & 3, ccol = wv * 16 + cl;
            float a[16];
#pragma unroll
            for (int k = 0; k < 16; ++k) a[k] = (4 * k + pp == ccol) ? 1.f : 0.f;
#define INV_STEP(SS) { const int j = jq * 4 + SS; \
                    const float tj = __int_as_float(__builtin_amdgcn_update_dpp(0, __float_as_int(a[jq]), SS * 0x55, 0xf, 0xf, false)); \
                    const float* ap = AP + j * 64 + pp * 16; \
                    _Pragma("unroll") for (int k = jq; k < 16; ++k) a[k] -= ap[k] * tj; }
#pragma unroll
            for (int jq = 0; jq < 16; ++jq) {
                __builtin_amdgcn_sched_barrier(0);
#ifdef NO_INV
                if (false) {
#else
                if (jq >= wv * 4) {
#endif
                    INV_STEP(0) INV_STEP(1) INV_STEP(2)
                    if (jq < 15) INV_STEP(3)
                }
            }
#undef INV_STEP
#ifdef DIAG3
            { float mx = 0.f;
              for (int k = 0; k < 16; ++k) { const float av = fabsf(a[k]); mx = (av > mx || !(av == av)) ? av : mx; }
              atomicMax(reinterpret_cast<unsigned*>(p.ws + OFF_BAR) + 4010, __float_as_uint(mx)); }
#endif
            bf16_t* TR = reinterpret_cast<bf16_t*>(lds + L_QRM);
#pragma unroll
            for (int k = 0; k < 16; ++k) TR[(4 * k + pp) * 72 + ccol] = (bf16_t)(cvt_pk_bf16(a[k], 0.f) & 0xffffu);
        }
        __syncthreads();
        {
            CP_LANEVARS
            bf16x8 tf[2];
#pragma unroll
            for (int ks = 0; ks < 2; ++ks) tf[ks] = lds8(lds + L_QRM + ((wv * 16 + fr) * 72 + ks * 32 + fq * 8) * 2);
#pragma unroll
            for (int db = 0; db < 8; ++db) {
                f32x4 au = (f32x4){0.f, 0.f, 0.f, 0.f}, aw = (f32x4){0.f, 0.f, 0.f, 0.f};
#pragma unroll
                for (int ks = 0; ks < 2; ++ks) {
                    const bf16x8 vb = lds8(lds + L_VBT + ((db * 16 + fr) * 72 + ks * 32 + fq * 8) * 2);
                    const bf16x8 kb = lds8(lds + L_KBGT + ((db * 16 + fr) * 72 + ks * 32 + fq * 8) * 2);
                    au = mfma16(tf[ks], vb, au);
                    aw = mfma16(kb, tf[ks], aw);
                }
                uint2 w; w.x = cvt_pk_bf16(au[0], au[1]); w.y = cvt_pk_bf16(au[2], au[3]);
                *reinterpret_cast<uint2*>(UT + (size_t)item * 8192 + (db * 16 + fr) * 64 + wv * 16 + fq * 4) = w;
                w.x = cvt_pk_bf16(aw[0], aw[1]); w.y = cvt_pk_bf16(aw[2], aw[3]);
                *reinterpret_cast<uint2*>(W + (size_t)(tok0 + wv * 16 + fr) * 512 + h * 128 + db * 16 + fq * 4) = w;
            }
        }
        __syncthreads();
    }
}

__device__ __forceinline__ void delta_scan(const Params& p_, int blk, int g_wave) {
    Params p = p_; p.ws = opaque_ws(p.ws);
    const int tid = opaque_tid(), lane = tid & 63, w = tid >> 6, fr = lane & 15, fq = lane >> 4;
    const int bh = blk >> 2, sl = blk & 3, b = bh >> 2, h = bh & 3, dv0 = sl * 32;
    bf16_t* ST = reinterpret_cast<bf16_t*>(p.ws + OFF_HA);
    bf16_t* UT = reinterpret_cast<bf16_t*>(p.ws + OFF_UT);
    const bf16_t* W = reinterpret_cast<const bf16_t*>(p.ws + OFF_W);
    const bf16_t* KDT = reinterpret_cast<const bf16_t*>(p.ws + OFF_KDT);
    const float* GT = reinterpret_cast<const float*>(p.ws + OFF_GT);
    unsigned char* STL = dyn_lds;
    unsigned char* VTL = dyn_lds + 8704;
    const int tb = w >> 1, db1 = w & 1;
    f32x4 S[2] = {(f32x4){0.f, 0.f, 0.f, 0.f}, (f32x4){0.f, 0.f, 0.f, 0.f}};
#pragma unroll
    for (int db = 0; db < 2; ++db) {
        const uint2 z = make_uint2(0u, 0u);
        *reinterpret_cast<uint2*>(STL + ((db * 16 + fr) * 136 + w * 16 + fq * 4) * 2) = z;
        *reinterpret_cast<uint2*>(ST + (size_t)(bh * 64) * 16384 + (dv0 + db * 16 + fr) * 128 + w * 16 + fq * 4) = z;
    }
    __syncthreads();
#define SCAN_LOAD(NN, WF, KF, UB, GTV) do { const int item_ = bh * 64 + (NN), tok_ = b * SEQ + (NN) * 64; \
        _Pragma("unroll") for (int ks = 0; ks < 4; ++ks) WF[ks] = ldg8(W + (size_t)(tok_ + tb * 16 + fr) * 512 + h * 128 + ks * 32 + fq * 8); \
        _Pragma("unroll") for (int ks = 0; ks < 2; ++ks) KF[ks] = ldg8(KDT + (size_t)item_ * 8192 + (w * 16 + fr) * 64 + ks * 32 + fq * 8); \
        UB = *reinterpret_cast<const uint2*>(UT + (size_t)item_ * 8192 + (dv0 + db1 * 16 + fr) * 64 + tb * 16 + fq * 4); \
        GTV = GT[item_]; } while (0)
#define LDS_BAR() do { asm volatile("s_waitcnt lgkmcnt(0)" ::: "memory"); __builtin_amdgcn_s_barrier(); asm volatile("" ::: "memory"); } while (0)
    bf16x8 wf[4], kf[2]; uint2 ub; float gt;
    SCAN_LOAD(0, wf, kf, ub, gt);
    for (int n = 0; n < 64; ++n) {
        const int item = bh * 64 + n;
        bf16x8 nwf[4], nkf[2]; uint2 nub; float ngt;
        { const int nn = n < 63 ? n + 1 : 63; SCAN_LOAD(nn, nwf, nkf, nub, ngt); }
        bf16_t* up = UT + (size_t)item * 8192 + (dv0 + db1 * 16 + fr) * 64 + tb * 16 + fq * 4;
        f32x4 a1 = (f32x4){0.f, 0.f, 0.f, 0.f};
#pragma unroll
        for (int ks = 0; ks < 4; ++ks) a1 = mfma16(wf[ks], lds8(STL + ((db1 * 16 + fr) * 136 + ks * 32 + fq * 8) * 2), a1);
        {
            uint2 vw;
            vw.x = cvt_pk_bf16(bf_lo(ub.x) - a1[0], bf_hi(ub.x) - a1[1]); vw.y = cvt_pk_bf16(bf_lo(ub.y) - a1[2], bf_hi(ub.y) - a1[3]);
            *reinterpret_cast<uint2*>(VTL + ((db1 * 16 + fr) * 72 + tb * 16 + fq * 4) * 2) = vw;
            *reinterpret_cast<uint2*>(up) = vw;
        }
        LDS_BAR();
#pragma unroll
        for (int db = 0; db < 2; ++db) {
            f32x4 a2 = S[db] * gt;
#pragma unroll
            for (int ks = 0; ks < 2; ++ks) a2 = mfma16(kf[ks], lds8(VTL + ((db * 16 + fr) * 72 + ks * 32 + fq * 8) * 2), a2);
            S[db] = a2;
            if (n < 63) {
                uint2 sw; sw.x = cvt_pk_bf16(a2[0], a2[1]); sw.y = cvt_pk_bf16(a2[2], a2[3]);
                *reinterpret_cast<uint2*>(STL + ((db * 16 + fr) * 136 + w * 16 + fq * 4) * 2) = sw;
                *reinterpret_cast<uint2*>(ST + (size_t)(item + 1) * 16384 + (dv0 + db * 16 + fr) * 128 + w * 16 + fq * 4) = sw;
            }
        }
        LDS_BAR();
#pragma unroll
        for (int ks = 0; ks < 4; ++ks) wf[ks] = nwf[ks];
        kf[0] = nkf[0]; kf[1] = nkf[1]; ub = nub; gt = ngt;
    }
#undef SCAN_LOAD
#undef LDS_BAR
}

__device__ __forceinline__ void swa_phase(const Params& p_, int l, int sblk, int nsb, int g_wave) {
    Params p = p_; p.ws = opaque_ws(p.ws);
    const int tid = opaque_tid(), lane = tid & 63, w = tid >> 6, fr = lane & 15, fq = lane >> 4;
    const bf16_t* HB = reinterpret_cast<const bf16_t*>(p.ws + OFF_HB);
    bf16_t* YM = reinterpret_cast<bf16_t*>(p.ws + OFF_XB);
    unsigned char* VTS = dyn_lds;
    for (int it = sblk; it < 1024; it += nsb) {
        const int b = it >> 8, kvh = (it >> 7) & 1, qt = it & 127, q0 = qt * 32, kbase = q0 - 128;
        for (int idx = tid; idx < 1280; idx += 512) {
            const int key = idx >> 3, ds = idx & 7, kp = kbase + key;
            uint4 u = make_uint4(0u, 0u, 0u, 0u);
            if (kp >= 0) u = *reinterpret_cast<const uint4*>(HB + (size_t)(b * SEQ + kp) * HB_LD + HB_VB + kvh * 64 + ds * 8);
            bf16_t* d = reinterpret_cast<bf16_t*>(VTS) + (ds * 8) * 168 + key;
            d[0 * 168] = (bf16_t)(u.x & 0xffffu); d[1 * 168] = (bf16_t)(u.x >> 16);
            d[2 * 168] = (bf16_t)(u.y & 0xffffu); d[3 * 168] = (bf16_t)(u.y >> 16);
            d[4 * 168] = (bf16_t)(u.z & 0xffffu); d[5 * 168] = (bf16_t)(u.z >> 16);
            d[6 * 168] = (bf16_t)(u.w & 0xffffu); d[7 * 168] = (bf16_t)(u.w >> 16);
        }
        const int g = w >> 1, sub = w & 1, qs = q0 + sub * 16, hq = kvh * 4 + g;
        const float slope = exp2f(-(float)(hq + 1)), sink = p.sinks[l * 8 + hq];
        bf16x8 qf[2];
#pragma unroll
        for (int ks = 0; ks < 2; ++ks) qf[ks] = ldg8(HB + (size_t)(b * SEQ + qs + fr) * HB_LD + HB_QB + hq * 64 + ks * 32 + fq * 8);
        f32x4 sc[10];
#pragma unroll
        for (int kt = 0; kt < 10; ++kt) {
            int kp = kbase + kt * 16 + fr; kp = kp < 0 ? 0 : kp;
            const bf16_t* kr = HB + (size_t)(b * SEQ + kp) * HB_LD + HB_KB + kvh * 64 + fq * 8;
            f32x4 a = (f32x4){0.f, 0.f, 0.f, 0.f};
            a = mfma16(ldg8(kr), qf[0], a);
            a = mfma16(ldg8(kr + 32), qf[1], a);
            sc[kt] = a;
        }
        const int qpos = qs + fr;
        float m = -1e30f;
#pragma unroll
        for (int kt = 0; kt < 10; ++kt)
#pragma unroll
            for (int r = 0; r < 4; ++r) {
                const int kpos = kbase + kt * 16 + fq * 4 + r, dist = qpos - kpos;
                const bool valid = (dist >= 0) && (dist < 128) && (kpos >= 0);
                const float s = valid ? sc[kt][r] * 0.125f - slope * (float)dist : -1e30f;
                sc[kt][r] = s; m = fmaxf(m, s);
            }
        m = fmaxf(m, shx(m, 16, lane)); m = fmaxf(m, shx(m, 32, lane));
        m = fmaxf(m, sink);
        float lsum = 0.f;
#pragma unroll
        for (int kt = 0; kt < 10; ++kt)
#pragma unroll
            for (int r = 0; r < 4; ++r) { const float e = __expf(sc[kt][r] - m); sc[kt][r] = e; lsum += e; }
        lsum += shx(lsum, 16, lane); lsum += shx(lsum, 32, lane);
        lsum += __expf(sink - m);
        const float inv = 1.0f / lsum;
        __syncthreads();
        f32x4 o[4];
#pragma unroll
        for (int db = 0; db < 4; ++db) o[db] = (f32x4){0.f, 0.f, 0.f, 0.f};
#pragma unroll
        for (int j = 0; j < 5; ++j) {
            union { bf16x8 v; unsigned u[4]; } pf;
            pf.u[0] = cvt_pk_bf16(sc[2 * j][0], sc[2 * j][1]); pf.u[1] = cvt_pk_bf16(sc[2 * j][2], sc[2 * j][3]);
            pf.u[2] = cvt_pk_bf16(sc[2 * j + 1][0], sc[2 * j + 1][1]); pf.u[3] = cvt_pk_bf16(sc[2 * j + 1][2], sc[2 * j + 1][3]);
#pragma unroll
            for (int db = 0; db < 4; ++db) {
                union { bf16x8 v; uint2 h[2]; } vf;
                const unsigned char* vr = VTS + ((db * 16 + fr) * 168 + (2 * j) * 16 + fq * 4) * 2;
                vf.h[0] = *reinterpret_cast<const uint2*>(vr);
                vf.h[1] = *reinterpret_cast<const uint2*>(vr + 32);
                o[db] = mfma16(vf.v, pf.v, o[db]);
            }
        }
        {
            const size_t tok = (size_t)(b * SEQ + qs + fr);
#pragma unroll
            for (int db = 0; db < 4; ++db) {
                const int col = hq * 64 + db * 16 + fq * 4;
                const uint2 z = *reinterpret_cast<const uint2*>(HB + tok * HB_LD + HB_ZB + col);
                uint2 y;
                y.x = cvt_pk_bf16(o[db][0] * inv * silu_f(bf_lo(z.x)), o[db][1] * inv * silu_f(bf_hi(z.x)));
                y.y = cvt_pk_bf16(o[db][2] * inv * silu_f(bf_lo(z.y)), o[db][3] * inv * silu_f(bf_hi(z.y)));
                *reinterpret_cast<uint2*>(YM + tok * DM + 512 + col) = y;
            }
        }
        __syncthreads();
    }
}

__device__ __forceinline__ void delta_out(const Params& p_, int l, int g_wave) {
    Params p = p_; p.ws = opaque_ws(p.ws);
    const int tid = opaque_tid(), grp = tid >> 8, lane = tid & 63, wv = (tid & 255) >> 6, fr = lane & 15, fq = lane >> 4;
    const bf16_t* ST = reinterpret_cast<const bf16_t*>(p.ws + OFF_HA);
    const bf16_t* VT = reinterpret_cast<const bf16_t*>(p.ws + OFF_UT);
    const bf16_t* QD = reinterpret_cast<const bf16_t*>(p.ws + OFF_QD);
    const bf16_t* QK = reinterpret_cast<const bf16_t*>(p.ws + OFF_QK);
    const bf16_t* HB = reinterpret_cast<const bf16_t*>(p.ws + OFF_HB);
    bf16_t* YM = reinterpret_cast<bf16_t*>(p.ws + OFF_XB);
    const float* nw = p.norm_w + l * 128;
    for (int pi = blockIdx.x; pi < 512; pi += gridDim.x) {
        const int item = pi * 2 + grp, bh = item >> 6, n = item & 63, b = bh >> 2, h = bh & 3;
        const int tok = b * SEQ + n * 64 + wv * 16 + fr;
        bf16x8 qd[4], qk[2];
#pragma unroll
        for (int ks = 0; ks < 4; ++ks) qd[ks] = ldg8(QD + (size_t)tok * 512 + h * 128 + ks * 32 + fq * 8);
#pragma unroll
        for (int ks = 0; ks < 2; ++ks) qk[ks] = ldg8(QK + (size_t)tok * 256 + h * 64 + ks * 32 + fq * 8);
        f32x4 o[8];
        float ss = 0.f;
#pragma unroll
        for (int db = 0; db < 8; ++db) {
            if ((db & 1) == 0) __builtin_amdgcn_sched_barrier(0);
            f32x4 a = (f32x4){0.f, 0.f, 0.f, 0.f};
            const bf16_t* sp = ST + (size_t)item * 16384 + (db * 16 + fr) * 128 + fq * 8;
#pragma unroll
            for (int ks = 0; ks < 4; ++ks) a = mfma16(ldg8(sp + ks * 32), qd[ks], a);
            const bf16_t* vp = VT + (size_t)item * 8192 + (db * 16 + fr) * 64 + fq * 8;
#pragma unroll
            for (int ks = 0; ks < 2; ++ks) a = mfma16(ldg8(vp + ks * 32), qk[ks], a);
            o[db] = a;
            ss += (a[0] * a[0] + a[1] * a[1]) + (a[2] * a[2] + a[3] * a[3]);
        }
        ss += shx(ss, 16, lane); ss += shx(ss, 32, lane);
        const float rs = rsqrtf(ss * (1.0f / 128.0f) + 1e-6f);
#pragma unroll
        for (int db = 0; db < 8; ++db) {
            const int dv = db * 16 + fq * 4;
            const f32x4 nv = *reinterpret_cast<const f32x4*>(nw + dv);
            const uint2 z = *reinterpret_cast<const uint2*>(HB + (size_t)tok * HB_LD + HB_ZA + h * 128 + dv);
            uint2 y;
            y.x = cvt_pk_bf16(o[db][0] * rs * nv[0] * silu_f(bf_lo(z.x)), o[db][1] * rs * nv[1] * silu_f(bf_hi(z.x)));
            y.y = cvt_pk_bf16(o[db][2] * rs * nv[2] * silu_f(bf_lo(z.y)), o[db][3] * rs * nv[3] * silu_f(bf_hi(z.y)));
            *reinterpret_cast<uint2*>(YM + (size_t)tok * DM + h * 128 + dv) = y;
        }
    }
}


__device__ __forceinline__ void diag_rows(const bf16_t* YM, float* out, int g_wave) {
    const int tidx = opaque_tid();
    const int lane = tidx & 63;
    const int gw = blockIdx.x * 8 + (tidx >> 6), nw = gridDim.x * 8;
    for (int row = gw; row < NTOK; row += nw) {
        float ca = 0.f, cb = 0.f;
        for (int i = 0; i < 16; ++i) {
            const int col = i * 64 + lane;
            const float v = bf_lo((unsigned)YM[(size_t)row * DM + col]);
            const bool bad = !(fabsf(v) < 1e30f);
            if (bad) { if (col < 512) ca += 1.f; else cb += 1.f; }
        }
        for (int o = 32; o > 0; o >>= 1) { ca += shx(ca, o, lane); cb += shx(cb, o, lane); }
        for (int i = 0; i < 16; ++i) out[(size_t)row * DM + i * 64 + lane] = 0.f;
        if (lane == 0) out[(size_t)row * DM] = (ca > 0.f ? 1e6f : 0.f) + (cb > 0.f ? 1e5f : 0.f);
    }
}


__device__ __forceinline__ void diag_prep(unsigned char* ws, float* out, int g_wave) {
    const int tidx = opaque_tid();
    const int lane = tidx & 63;
    const int gw = blockIdx.x * 8 + (tidx >> 6), nw = gridDim.x * 8;
    const bf16_t* UT = reinterpret_cast<const bf16_t*>(ws + OFF_UT);
    const bf16_t* W = reinterpret_cast<const bf16_t*>(ws + OFF_W);
    const bf16_t* QD = reinterpret_cast<const bf16_t*>(ws + OFF_QD);
    const bf16_t* KDT = reinterpret_cast<const bf16_t*>(ws + OFF_KDT);
    const bf16_t* QK = reinterpret_cast<const bf16_t*>(ws + OFF_QK);
    const float* GT = reinterpret_cast<const float*>(ws + OFF_GT);
    const float* BA = reinterpret_cast<const float*>(ws + OFF_BA);
    for (int row = gw; row < NTOK; row += nw) {
        float c[6] = {0.f, 0.f, 0.f, 0.f, 0.f, 0.f};
        for (int i = 0; i < 8; ++i) {
            const size_t o = (size_t)row * 512 + i * 64 + lane;
            if (!(fabsf(bf_lo((unsigned)UT[o])) < 1e30f)) c[0] += 1.f;
            if (!(fabsf(bf_lo((unsigned)W[o])) < 1e30f)) c[1] += 1.f;
            if (!(fabsf(bf_lo((unsigned)QD[o])) < 1e30f)) c[2] += 1.f;
            if (!(fabsf(bf_lo((unsigned)KDT[o])) < 1e30f)) c[3] += 1.f;
        }
        for (int i = 0; i < 4; ++i) if (!(fabsf(bf_lo((unsigned)QK[(size_t)row * 256 + i * 64 + lane])) < 1e30f)) c[4] += 1.f;
        if (row < 1024 && lane == 0 && !(fabsf(GT[row]) < 1e30f)) c[5] += 1.f;
        if (lane < 8 && !(fabsf(BA[(size_t)row * 8 + lane]) < 1e30f)) c[5] += 1.f;
        for (int j = 0; j < 6; ++j) for (int o = 32; o > 0; o >>= 1) c[j] += shx(c[j], o, lane);
        unsigned bits = 0;
        for (int j = 0; j < 6; ++j) if (c[j] > 0.f) bits |= (1u << j);
        if (lane == 0 && bits) atomicOr(reinterpret_cast<unsigned*>(ws + OFF_BAR) + 4020, bits);
        for (int i = 0; i < 16; ++i) out[(size_t)row * DM + i * 64 + lane] = 0.f;
    }
}

__global__ void __launch_bounds__(512) fwd_megakernel(Params p) {
    __shared__ uint4 xb_words;
    const int g_wave = __builtin_amdgcn_readfirstlane((int)(threadIdx.x >> 6));
    if (xb_t0(g_wave)) xb_words = make_uint4(0u, 0u, 0u, 0u);
    __syncthreads();
    XcdBarrier gb = xcd_barrier_post(reinterpret_cast<unsigned*>(p.ws + OFF_BAR), (volatile LAS unsigned*)&xb_words, g_wave);
#ifdef USE_CG
    gb.x = 0;
#endif

#ifndef PHM
#define PHM 255
#endif
    if (PHM & 1) prep_weights(p, g_wave);
    if (PHM & 2) row_pass(p.x, false, nullptr, nullptr, nullptr, reinterpret_cast<bf16_t*>(p.ws + OFF_XB), p.w_in + 2048, reinterpret_cast<float*>(p.ws + OFF_BA), g_wave);
    xcd_barrier(gb);
    for (int l = 0; l < 2; ++l) {
        unsigned char* wsl = opaque_ws(p.ws);
        bf16_t* XB = reinterpret_cast<bf16_t*>(wsl + OFF_XB);
        float* BA = reinterpret_cast<float*>(wsl + OFF_BA);
        {
            EpiH e; e.ha = reinterpret_cast<bf16_t*>(p.ws + OFF_HA); e.hb = reinterpret_cast<bf16_t*>(p.ws + OFF_HB);
            if (PHM & 4) gemm_phase(XB, reinterpret_cast<const bf16_t*>(p.ws + OFF_WIN) + (size_t)l * NIN * DM, NTOK, NIN, DM, e, g_wave);
        }
        xcd_barrier(gb);
        if (PHM & 8) chunk_prep(p, l, g_wave);
        xcd_barrier(gb);
#ifdef DIAG2
        if (l == 0) { diag_prep(wsl, p.out, g_wave); xcd_barrier(gb);
            if (blockIdx.x == 0 && opaque_tid() == 0) p.out[0] = 1000.f * (float)reinterpret_cast<const unsigned*>(wsl + OFF_BAR)[4020];
            return; }
#endif
#ifdef DIAG3
        if (l == 0) {
            const int tidx = opaque_tid();
            const unsigned* dw = reinterpret_cast<const unsigned*>(wsl + OFF_BAR);
            for (size_t i = (size_t)blockIdx.x * 512 + tidx; i < (size_t)NTOK * DM; i += (size_t)gridDim.x * 512) {
                float v = 0.f;
                if (i == 0) v = fminf(__uint_as_float(dw[4010]), 1e37f) * DIAG3_S0;
                if (i == 1) v = fminf(__uint_as_float(dw[4011]), 1e37f) * DIAG3_S1;
                if (i == 2) v = fminf(__uint_as_float(dw[4012]), 1e37f) * DIAG3_S2;
                p.out[i] = v;
            }
            return;
        }
#endif
        if (blockIdx.x < 64) { if (PHM & 16) delta_scan(p, blockIdx.x, g_wave); }
        else if (PHM & 32) swa_phase(p, l, blockIdx.x - 64, gridDim.x - 64, g_wave);
        xcd_barrier(gb);
#ifdef DIAG4
        if (l == 0) {
            const int tidx = opaque_tid();
            const unsigned* dw = reinterpret_cast<const unsigned*>(wsl + OFF_BAR);
            for (size_t i = (size_t)blockIdx.x * 512 + tidx; i < (size_t)NTOK * DM; i += (size_t)gridDim.x * 512) {
                float v = 0.f;
                if (i == 0) v = fminf(__uint_as_float(dw[4013]), 1e37f) * DIAG4_S0;
                if (i == 1) v = fminf(__uint_as_float(dw[4014]), 1e37f) * DIAG4_S1;
                p.out[i] = v;
            }
            return;
        }
#endif
        if (PHM & 64) delta_out(p, l, g_wave);
        xcd_barrier(gb);
#ifdef DIAG1
        if (l == DIAG1 - 1) { diag_rows(XB, p.out, g_wave); return; }
#endif
        {
            EpiZ e; e.xres = (l == 0) ? p.x : p.out; e.out = p.out;
            if (PHM & 128) gemm_phase(XB, reinterpret_cast<const bf16_t*>(p.ws + OFF_WOUT) + (size_t)l * DM * DM, NTOK, DM, DM, e, g_wave);
        }
        xcd_barrier(gb);
        if (l == 0) row_pass(p.out, true, p.ln_g, p.ln_b, p.out, XB, p.w_in + (size_t)DM * INC + 2048, BA, g_wave);
        else        row_pass(p.out, true, p.ln_g + DM, p.ln_b + DM, p.out, nullptr, nullptr, nullptr, g_wave);
        if (l == 0) xcd_barrier(gb);
    }
}

extern "C" void kernel_launch(void* const* d_in, const int* in_sizes, int n_in, void* d_out, int out_size, void* d_ws, size_t ws_size, hipStream_t stream) {
    static int grid_blocks = 0;
    if (!grid_blocks) {
        int dev = 0, cus = 0, per_cu = 0;
        hipGetDevice(&dev);
        hipDeviceGetAttribute(&cus, hipDeviceAttributeMultiprocessorCount, dev);
        hipFuncSetAttribute((const void*)fwd_megakernel, hipFuncAttributeMaxDynamicSharedMemorySize, LDS_BYTES);
        hipOccupancyMaxActiveBlocksPerMultiprocessor(&per_cu, fwd_megakernel, 512, LDS_BYTES);
        grid_blocks = (per_cu >= 1) ? cus : 0;
        if (grid_blocks > 256) grid_blocks = 256;
        if (ws_size < WS_NEED) { fprintf(stderr, "workspace too small: %zu < %zu\n", ws_size, (size_t)WS_NEED); }
        if (!grid_blocks) { fprintf(stderr, "occupancy query returned 0\n"); grid_blocks = 256; }
    }
    Params p{};
    p.x = (const float*)d_in[0]; p.w_in = (const float*)d_in[1]; p.conv_w = (const float*)d_in[2]; p.a_log = (const float*)d_in[3];
    p.dt_bias = (const float*)d_in[4]; p.norm_w = (const float*)d_in[5]; p.sinks = (const float*)d_in[6]; p.w_out = (const float*)d_in[7];
    p.ln_g = (const float*)d_in[8]; p.ln_b = (const float*)d_in[9]; p.out = (float*)d_out; p.ws = (unsigned char*)d_ws;
    hipMemsetAsync(d_ws, 0, 16384, stream);
    void* args[] = {&p};
    hipError_t e = hipLaunchCooperativeKernel((const void*)fwd_megakernel, dim3(grid_blocks), dim3(512), args, LDS_BYTES, stream);
    if (e != hipSuccess) fprintf(stderr, "cooperative launch failed: %s (grid %d)\n", hipGetErrorString(e), grid_blocks);
}
```

```cpp
#include <hip/hip_runtime.h>
#include <cstdio>
#include <cstdint>

#define PHM 255
#ifndef PROBE_REPS_GEMM
#define PROBE_REPS_GEMM 1
#endif
#ifndef PROBE_REPS_PREP
#define PROBE_REPS_PREP 1
#endif
#ifndef PROBE_REPS_DOUT
#define PROBE_REPS_DOUT 1
#endif
#ifndef PROBE_REPS_SWA
#define PROBE_REPS_SWA 1
#endif
#ifndef PROBE_REPS_W
#define PROBE_REPS_W 1
#endif
#define LAS __attribute__((address_space(3)))
__device__ __forceinline__ int opaque_lane() { int lane; asm volatile("v_mbcnt_lo_u32_b32 %0, -1, 0\n\tv_mbcnt_hi_u32_b32 %0, -1, %0" : "=v"(lane)); return lane; }
typedef unsigned short bf16_t;
typedef short bf16x8 __attribute__((ext_vector_type(8)));
typedef float f32x4 __attribute__((ext_vector_type(4)));
typedef unsigned u32x4 __attribute__((ext_vector_type(4)));
typedef unsigned u32x2 __attribute__((ext_vector_type(2)));
__device__ __forceinline__ u32x4 mk4(unsigned a, unsigned b, unsigned c, unsigned d) { return (u32x4){a, b, c, d}; }
__device__ __forceinline__ u32x2 mk2(unsigned a, unsigned b) { return (u32x2){a, b}; }

constexpr int NTOK = 16384, SEQ = 4096, DM = 1024, INC = 3336, NIN = 3328;
constexpr int HA_LD = 1536, HB_LD = 1792;
constexpr int HB_ZA = 0, HB_QB = 512, HB_KB = 1024, HB_VB = 1152, HB_ZB = 1280;
constexpr float DN_ALPHA = 1.41421356237f;

constexpr size_t OFF_BAR = 0;
constexpr size_t OFF_XB = 16384;
constexpr size_t OFF_WIN = OFF_XB + (size_t)NTOK * DM * 2;
constexpr size_t OFF_WOUT = OFF_WIN + (size_t)2 * NIN * DM * 2;
constexpr size_t OFF_HA = OFF_WOUT + (size_t)2 * DM * DM * 2;
constexpr size_t OFF_HB = OFF_HA + (size_t)NTOK * HA_LD * 2;
constexpr size_t OFF_UT = OFF_HB + (size_t)NTOK * HB_LD * 2;
constexpr size_t OFF_W = OFF_UT + (size_t)NTOK * 512 * 2;
constexpr size_t OFF_QD = OFF_W + (size_t)NTOK * 512 * 2;
constexpr size_t OFF_KDT = OFF_QD + (size_t)NTOK * 512 * 2;
constexpr size_t OFF_QK = OFF_KDT + (size_t)NTOK * 512 * 2;
constexpr size_t OFF_BA = OFF_QK + (size_t)NTOK * 256 * 2;
constexpr size_t OFF_GT = OFF_BA + (size_t)NTOK * 8 * 4;
constexpr size_t WS_NEED = OFF_GT + 4096;

constexpr int LDS_BYTES = 147456;
extern __shared__ __attribute__((aligned(16))) unsigned char dyn_lds[];

struct Params {
    const float* x; const float* w_in; const float* conv_w; const float* a_log; const float* dt_bias;
    const float* norm_w; const float* sinks; const float* w_out; const float* ln_g; const float* ln_b;
    float* out; unsigned char* ws;
};

typedef float f32x2_t __attribute__((ext_vector_type(2)));
typedef __bf16 bf16x2_t __attribute__((ext_vector_type(2)));
__device__ __forceinline__ unsigned cvt_pk_bf16(float lo, float hi) {
    const f32x2_t v = {lo, hi};
    const bf16x2_t r = __builtin_convertvector(v, bf16x2_t);
    return __builtin_bit_cast(unsigned, r);
}
__device__ __forceinline__ float bf_lo(unsigned u) { return __uint_as_float(u << 16); }
__device__ __forceinline__ float bf_hi(unsigned u) { return __uint_as_float(u & 0xffff0000u); }
__device__ __forceinline__ float silu_f(float x) { return x / (1.0f + __expf(-x)); }
__device__ __forceinline__ f32x4 mfma16(bf16x8 a, bf16x8 b, f32x4 c) { return __builtin_amdgcn_mfma_f32_16x16x32_bf16(a, b, c, 0, 0, 0); }
#define GPC(T) (const __attribute__((address_space(1))) T*)
#define GP(T) (__attribute__((address_space(1))) T*)
__device__ __forceinline__ bf16x8 ldg8(const bf16_t* p) { return *GPC(bf16x8)(p); }
__device__ __forceinline__ bf16x8 lds8(const unsigned char* p) { return *reinterpret_cast<const bf16x8*>(p); }

__device__ __forceinline__ int opaque_tid_(int g_wave) {
    int lane; asm volatile("v_mbcnt_lo_u32_b32 %0, -1, 0\n\tv_mbcnt_hi_u32_b32 %0, -1, %0" : "=v"(lane));
    return g_wave * 64 + lane; }
#define opaque_tid() opaque_tid_(g_wave)
__device__ __forceinline__ unsigned char* opaque_ws(unsigned char* w) { asm volatile("" : "+s"(w)); return w; }
__device__ __forceinline__ const bf16_t* uniform_ptr(const bf16_t* p) {
    const unsigned long long v = (unsigned long long)p;
    const unsigned lo = __builtin_amdgcn_readfirstlane((unsigned)v), hi = __builtin_amdgcn_readfirstlane((unsigned)(v >> 32));
    return (const bf16_t*)(((unsigned long long)hi << 32) | lo);
}

__device__ __forceinline__ float shx(float v, int m, int lane) { return __int_as_float(__builtin_amdgcn_ds_bpermute((lane ^ m) << 2, __float_as_int(v))); }

#define XB_TMO      128
#define XB_XCNT(j)  (256  + 64 * (j))
#define XB_XSUB(j)  (1280 + 64 * (j))
#define XB_XGEN(j)  (2304 + 64 * (j))
#define XB_TOP      3328
#define XB_TOPGEN   3392
#define XCD_BAR_WORDS 3456
#define XB_SPIN_CAP (1u << 20)
__device__ __forceinline__ unsigned xb_ld(unsigned* p)              { return __hip_atomic_load(p, __ATOMIC_RELAXED, __HIP_MEMORY_SCOPE_AGENT); }
__device__ __forceinline__ unsigned xb_add(unsigned* p, unsigned v) { return __hip_atomic_fetch_add(p, v, __ATOMIC_RELAXED, __HIP_MEMORY_SCOPE_AGENT); }
__device__ __forceinline__ unsigned xb_xcc_id() { return (unsigned)__builtin_amdgcn_s_getreg((3 << 11) | 20) & 0xFu; }
#define XB_SPIN(cond, bar) do { unsigned _sp = 0; while (cond) { __builtin_amdgcn_s_sleep(1); \
    if ((++_sp & 255u) == 0u) { if (xb_ld(&(bar)[XB_TMO])) break; if (_sp > XB_SPIN_CAP) { atomicAdd(&(bar)[XB_TMO], 1u); break; } } } } while (0)
struct XcdBarrier { unsigned* bar; unsigned x; volatile LAS unsigned* st; int gw; };
__device__ __forceinline__ bool xb_t0(int gw) { return gw == 0 && opaque_lane() == 0; }
__device__ __forceinline__ XcdBarrier xcd_barrier_post(unsigned* bar, volatile LAS unsigned* st, int gw) {
    XcdBarrier b; b.bar = bar; b.x = xb_xcc_id(); b.st = st; b.gw = gw;
    if (xb_t0(gw)) (void)xb_add(&bar[XB_XCNT(b.x)], 1u);
    return b;
}
__device__ __forceinline__ void xcd_barrier_complete(unsigned* bar, unsigned x, unsigned& nloc, unsigned& nx) {
    const unsigned G = gridDim.x * gridDim.y * gridDim.z;
    unsigned sum, cnt, mine, sp = 0u;
    for (;;) {
        sum = 0u; cnt = 0u; mine = 0u;
#pragma unroll
        for (unsigned j = 0; j < 16; ++j) { const unsigned c = xb_ld(&bar[XB_XCNT(j)]); sum += c; cnt += (c > 0u) ? 1u : 0u; mine = (j == x) ? c : mine; }
        if (sum == G) break;
        __builtin_amdgcn_s_sleep(1);
        if ((++sp & 255u) == 0u) { if (xb_ld(&bar[XB_TMO])) break; if (sp > XB_SPIN_CAP) { atomicAdd(&bar[XB_TMO], 1u); break; } }
    }
    nloc = mine > 0u ? mine : 1u; nx = cnt > 0u ? cnt : 1u;
}
#ifdef USE_CG
__device__ __forceinline__ void xcd_barrier(XcdBarrier& b) {
    asm volatile("s_waitcnt vmcnt(0)" ::: "memory");
    __syncthreads();
    b.x = __builtin_amdgcn_readfirstlane(b.x + gridDim.x);
    if (xb_t0(b.gw)) {
        __threadfence();
        unsigned* c = b.bar + 4000;
        xb_add(c, 1u);
        unsigned sp = 0;
        while (xb_ld(c) < b.x) { __builtin_amdgcn_s_sleep(2); if (++sp > (1u << 24)) break; }
        __threadfence();
    }
    __syncthreads();
}
#else
__device__ __forceinline__ void xcd_barrier(const XcdBarrier& b_) {
    asm volatile("s_waitcnt vmcnt(0)" ::: "memory");
    __syncthreads();
    if (xb_t0(b_.gw)) {
        XcdBarrier b = b_; b.x = xb_xcc_id();
        asm volatile("" : "+s"(b.x));
        unsigned* bar = b.bar;
        __builtin_amdgcn_s_waitcnt(0);
        unsigned nloc = b.st[0], nx = b.st[1];
        if (nloc == 0u) { xcd_barrier_complete(bar, b.x, nloc, nx); b.st[0] = nloc; b.st[1] = nx; }
        const unsigned old = xb_add(&bar[XB_XSUB(b.x)], 1u);
        const unsigned gen = old / nloc;
        if (old + 1u == (gen + 1u) * nloc) {
            __builtin_amdgcn_fence(__ATOMIC_RELEASE, "agent");
            asm volatile("s_waitcnt vmcnt(0)" ::: "memory");
            const unsigned og = xb_add(&bar[XB_TOP], 1u);
            const unsigned tg = og / nx;
            if (og + 1u == (tg + 1u) * nx) xb_add(&bar[XB_TOPGEN], 1u);
            else XB_SPIN(xb_ld(&bar[XB_TOPGEN]) == tg, bar);
            __builtin_amdgcn_fence(__ATOMIC_ACQUIRE, "agent");
            xb_add(&bar[XB_XGEN(b.x)], 1u);
            asm volatile("s_waitcnt vmcnt(0)" ::: "memory");
        } else {
            XB_SPIN(xb_ld(&bar[XB_XGEN(b.x)]) == gen, bar);
            __builtin_amdgcn_fence(__ATOMIC_ACQUIRE, "agent");
            asm volatile("s_waitcnt vmcnt(0)" ::: "memory");
        }
    }
    __syncthreads();
}

#endif

constexpr int BM = 256, BK = 64, HALF = 128, NXCD = 8, WGM = 8, HT = HALF * BK;
__device__ __forceinline__ int lds_byte(int r, int c) {
    int st = (r >> 4) * 2 + (c >> 5), rr = r & 15, cc = c & 31, ob = rr * 64 + cc * 2;
    return st * 1024 + (ob ^ (((ob >> 9) & 1) << 5));
}
__device__ __forceinline__ void stage_rc(int b, int& R, int& C) {
    int st = b / 1024, sb = b % 1024, swz = sb ^ (((sb >> 9) & 1) << 5);
    R = (st >> 1) * 16 + swz / 64; C = (st & 1) * 32 + (swz % 64) / 2;
}

struct EpiH {
    bf16_t* ha; bf16_t* hb;
    __device__ __forceinline__ void operator()(const f32x4 (&acc)[2][2][4][2], int brow, int bcol, int wr, int wc, int fr, int fq) const {
        bf16_t* base; int ld, c0;
        if (bcol < HA_LD) { base = ha; ld = HA_LD; c0 = bcol; } else { base = hb; ld = HB_LD; c0 = bcol - HA_LD; }
#pragma unroll
        for (int ai = 0; ai < 2; ++ai)
#pragma unroll
            for (int m = 0; m < 4; ++m) {
                const int row = brow + ai * HALF + wr * 64 + m * 16 + fr;
                bf16_t* rp = base + (size_t)row * ld + c0 + wc * 32 + fq * 4;
#pragma unroll
                for (int bj = 0; bj < 2; ++bj)
#pragma unroll
                    for (int n = 0; n < 2; ++n) {
                        const f32x4 v = acc[ai][bj][m][n];
                        u32x2 w; w.x = cvt_pk_bf16(v[0], v[1]); w.y = cvt_pk_bf16(v[2], v[3]);
                        *GP(u32x2)(rp + bj * HALF + n * 16) = w;
                    }
            }
    }
};
struct EpiZ {
    const float* xres; float* out;
    __device__ __forceinline__ void operator()(const f32x4 (&acc)[2][2][4][2], int brow, int bcol, int wr, int wc, int fr, int fq) const {
#pragma unroll
        for (int ai = 0; ai < 2; ++ai)
#pragma unroll
            for (int m = 0; m < 4; ++m) {
                const int row = brow + ai * HALF + wr * 64 + m * 16 + fr;
                const size_t ro = (size_t)row * DM + bcol + wc * 32 + fq * 4;
#pragma unroll
                for (int bj = 0; bj < 2; ++bj)
#pragma unroll
                    for (int n = 0; n < 2; ++n) {
                        const size_t o = ro + bj * HALF + n * 16;
                        const f32x4 r = *GPC(f32x4)(xres + o);
                        *GP(f32x4)(out + o) = r * DN_ALPHA + acc[ai][bj][m][n];
                    }
            }
    }
};

template <class Epi>
__device__ __forceinline__ void gemm_phase(const bf16_t* __restrict__ A, const bf16_t* __restrict__ Bt, int M, int N, int K, const Epi& epi, int g_wave) {
    bf16_t* shm = reinterpret_cast<bf16_t*>(dyn_lds);
#define SA(b,h) (shm+((b)*2+(h))*HT)
#define SB(b,h) (shm+(4+(b)*2+(h))*HT)
#define STAGE(P,BASE,br,kt) do{const bf16_t* _bp=uniform_ptr((BASE)+((long)(br)*K+(long)(kt)*BK)); \
    __builtin_amdgcn_global_load_lds((const unsigned*)((const char*)_bp+soff0),(unsigned*)((char*)(P)+tidx*16),16,0,0); \
    __builtin_amdgcn_global_load_lds((const unsigned*)((const char*)_bp+soff1),(unsigned*)((char*)(P)+tidx*16+8192),16,0,0);}while(0)
#define LDA(dst,b,h) for(int m=0;m<4;++m)for(int k=0;k<2;++k) \
    dst[m][k]=*reinterpret_cast<const bf16x8*>((char*)SA(b,h)+lds_byte(wr*64+m*16+fr,k*32+fq*8))
#define LDB(dst,b,h) for(int n=0;n<2;++n)for(int k=0;k<2;++k) \
    dst[n][k]=*reinterpret_cast<const bf16x8*>((char*)SB(b,h)+lds_byte(wc*32+n*16+fr,k*32+fq*8))
#define MMA(ai,bj,At,Bt_) do{__builtin_amdgcn_s_setprio(1); \
    for(int m=0;m<4;++m)for(int n=0;n<2;++n)for(int k=0;k<2;++k) \
      acc[ai][bj][m][n]=__builtin_amdgcn_mfma_f32_16x16x32_bf16(Bt_[n][k],At[m][k],acc[ai][bj][m][n],0,0,0); \
    __builtin_amdgcn_s_setprio(0);}while(0)
#define WAIT_V(n) asm volatile("s_waitcnt vmcnt(" #n ")":::"memory")
#define WAIT_L(n) asm volatile("s_waitcnt lgkmcnt(" #n ")":::"memory")
#define BAR __builtin_amdgcn_s_barrier()
#define SCHED __builtin_amdgcn_sched_barrier(0)
    const int nM = M / BM, nN = N / BM, nwg = nM * nN;
    const int tidx = opaque_tid();
    const int wid = tidx >> 6, lane = tidx & 63, wr = wid >> 2, wc = wid & 3, fr = lane & 15, fq = lane >> 4;
    const int nt = K / BK;
    unsigned soff0, soff1;
    { int r_, c_; stage_rc(tidx * 16, r_, c_); soff0 = (unsigned)(r_ * K + c_) * 2u; stage_rc(tidx * 16 + 8192, r_, c_); soff1 = (unsigned)(r_ * K + c_) * 2u; }
    for (int L = blockIdx.x; L < nwg; L += gridDim.x) {
        int wgid = L;
        { int q = nwg / NXCD, r = nwg % NXCD, xcd = wgid % NXCD, off = wgid / NXCD; wgid = (xcd < r ? xcd * (q + 1) : r * (q + 1) + (xcd - r) * q) + off; }
        const int nig = WGM * nN, gid = wgid / nig, fm = gid * WGM, gsz = min(nM - fm, WGM);
        const int pm = fm + ((wgid % nig) % gsz), pn = (wgid % nig) / gsz, brow = pm * BM, bcol = pn * BM;
        f32x4 acc[2][2][4][2] = {};
        bf16x8 At[4][2], B0[2][2], B1[2][2];
        STAGE(SB(0,0),Bt,bcol,0); STAGE(SA(0,0),A,brow,0);
        STAGE(SB(0,1),Bt,bcol+HALF,0); STAGE(SA(0,1),A,brow+HALF,0);
        if(wr==1)BAR;
        WAIT_V(4); BAR;
        STAGE(SB(1,0),Bt,bcol,1); STAGE(SA(1,0),A,brow,1); STAGE(SB(1,1),Bt,bcol+HALF,1);
        WAIT_V(6); BAR;
        for(int t=0;t<nt-2;t+=2){
            LDB(B0,0,0); SCHED; LDA(At,0,0); STAGE(SA(1,1),A,brow+HALF,t+1);
            WAIT_L(8); BAR; WAIT_L(0); MMA(0,0,At,B0); BAR; SCHED;
            LDB(B1,0,1); STAGE(SB(0,0),Bt,bcol,t+2);
            BAR; WAIT_L(0); MMA(0,1,At,B1); BAR;
            LDA(At,0,1); STAGE(SA(0,0),A,brow,t+2);
            BAR; WAIT_L(0); MMA(1,0,At,B0); BAR; SCHED;
            STAGE(SB(0,1),Bt,bcol+HALF,t+2);
            WAIT_V(6); BAR; MMA(1,1,At,B1); BAR;
            LDB(B0,1,0); SCHED; LDA(At,1,0); STAGE(SA(0,1),A,brow+HALF,t+2);
            WAIT_L(8); BAR; WAIT_L(0); MMA(0,0,At,B0); BAR; SCHED;
            LDB(B1,1,1); STAGE(SB(1,0),Bt,bcol,t+3);
            BAR; WAIT_L(0); MMA(0,1,At,B1); BAR;
            LDA(At,1,1); STAGE(SA(1,0),A,brow,t+3);
            BAR; WAIT_L(0); MMA(1,0,At,B0); BAR; SCHED;
            STAGE(SB(1,1),Bt,bcol+HALF,t+3);
            WAIT_V(6); BAR; MMA(1,1,At,B1); BAR;
        }
        { LDB(B0,0,0); LDA(At,0,0); STAGE(SA(1,1),A,brow+HALF,nt-1);
          BAR; WAIT_L(0); MMA(0,0,At,B0); BAR;
          LDB(B1,0,1); BAR; WAIT_L(0); MMA(0,1,At,B1); BAR;
          LDA(At,0,1); WAIT_V(4); BAR; WAIT_L(0); MMA(1,0,At,B0); MMA(1,1,At,B1); BAR; }
        { LDB(B0,1,0); LDA(At,1,0); WAIT_V(2); BAR; WAIT_L(0); MMA(0,0,At,B0); BAR;
          LDB(B1,1,1); WAIT_V(0); BAR; WAIT_L(0); MMA(0,1,At,B1); BAR;
          LDA(At,1,1); BAR; WAIT_L(0); MMA(1,0,At,B0); MMA(1,1,At,B1); BAR; }
        if(wr==0)BAR;
        epi(acc, brow, bcol, wr, wc, fr, fq);
        __syncthreads();
    }
#undef SA
#undef SB
#undef STAGE
#undef LDA
#undef LDB
#undef MMA
}

__device__ __forceinline__ void prep_weights(const Params& p, int g_wave) {
    bf16_t* win = reinterpret_cast<bf16_t*>(p.ws + OFF_WIN);
    bf16_t* wout = reinterpret_cast<bf16_t*>(p.ws + OFF_WOUT);
    const int gtid = blockIdx.x * 512 + opaque_tid(), gsz = gridDim.x * 512;
    const int n_in = 2 * 128 * NIN;
    for (int i = gtid; i < n_in; i += gsz) {
        const int n = i % NIN, kg = (i / NIN) % 128, l = i / (NIN * 128);
        const int sc = n < 2048 ? n : n + 8;
        const float* s = p.w_in + (size_t)l * DM * INC + (size_t)(kg * 8) * INC + sc;
        u32x4 w;
        w.x = cvt_pk_bf16(s[0], s[INC]); w.y = cvt_pk_bf16(s[2 * INC], s[3 * INC]);
        w.z = cvt_pk_bf16(s[4 * INC], s[5 * INC]); w.w = cvt_pk_bf16(s[6 * INC], s[7 * INC]);
        *GP(u32x4)(win + ((size_t)l * NIN + n) * DM + kg * 8) = w;
    }
    const int n_out = 2 * 128 * DM;
    for (int i = gtid; i < n_out; i += gsz) {
        const int n = i % DM, kg = (i / DM) % 128, l = i / (DM * 128);
        const float* s = p.w_out + (size_t)l * DM * DM + (size_t)(kg * 8) * DM + n;
        u32x4 w;
        w.x = cvt_pk_bf16(s[0], s[DM]); w.y = cvt_pk_bf16(s[2 * DM], s[3 * DM]);
        w.z = cvt_pk_bf16(s[4 * DM], s[5 * DM]); w.w = cvt_pk_bf16(s[6 * DM], s[7 * DM]);
        *GP(u32x4)(wout + ((size_t)l * DM + n) * DM + kg * 8) = w;
    }
}

__device__ __forceinline__ void row_pass(const float* src, bool ln, const float* g, const float* bta, float* dstf, bf16_t* xb, const float* wg  , float* BA, int g_wave) {
    const int tidx = opaque_tid();
    const int lane = tidx & 63;
    const int gw = blockIdx.x * 8 + (tidx >> 6), nw = gridDim.x * 8;
    float* wgs = reinterpret_cast<float*>(dyn_lds);
    if (wg) {
        for (int c = tidx; c < DM; c += 512) {
            const f32x4 w0 = *GPC(f32x4)(wg + (size_t)c * INC), w1 = *GPC(f32x4)(wg + (size_t)c * INC + 4);
            *reinterpret_cast<f32x4*>(wgs + c * 8) = w0; *reinterpret_cast<f32x4*>(wgs + c * 8 + 4) = w1;
        }
    }
    __syncthreads();
    f32x4 gg[4], bb[4];
#pragma unroll
    for (int i = 0; i < 4; ++i) { gg[i] = ln ? *GPC(f32x4)(g + i * 256 + lane * 4) : (f32x4){1.f, 1.f, 1.f, 1.f}; bb[i] = ln ? *GPC(f32x4)(bta + i * 256 + lane * 4) : (f32x4){0.f, 0.f, 0.f, 0.f}; }
    f32x4 nv[4];
    if (gw < NTOK) {
#pragma unroll
        for (int i = 0; i < 4; ++i) nv[i] = *GPC(f32x4)(src + (size_t)gw * DM + i * 256 + lane * 4);
    }
    for (int row = gw; row < NTOK; row += nw) {
        f32x4 v[4];
#pragma unroll
        for (int i = 0; i < 4; ++i) v[i] = nv[i];
        if (row + nw < NTOK) {
#pragma unroll
            for (int i = 0; i < 4; ++i) nv[i] = *GPC(f32x4)(src + (size_t)(row + nw) * DM + i * 256 + lane * 4);
        }
        if (ln) {
            float s = 0.f;
#pragma unroll
            for (int i = 0; i < 4; ++i) s += (v[i][0] + v[i][1]) + (v[i][2] + v[i][3]);
#pragma unroll
            for (int o = 32; o > 0; o >>= 1) s += shx(s, o, lane);
            const float mu = s * (1.0f / DM);
            float q = 0.f;
#pragma unroll
            for (int i = 0; i < 4; ++i) { v[i] = v[i] - mu; q += (v[i][0] * v[i][0] + v[i][1] * v[i][1]) + (v[i][2] * v[i][2] + v[i][3] * v[i][3]); }
#pragma unroll
            for (int o = 32; o > 0; o >>= 1) q += shx(q, o, lane);
            const float rstd = rsqrtf(q * (1.0f / DM) + 1e-5f);
#pragma unroll
            for (int i = 0; i < 4; ++i) v[i] = v[i] * rstd * gg[i] + bb[i];
        }
        if (dstf) {
#pragma unroll
            for (int i = 0; i < 4; ++i) *GP(f32x4)(dstf + (size_t)row * DM + i * 256 + lane * 4) = v[i];
        }
        if (xb) {
#pragma unroll
            for (int i = 0; i < 4; ++i) { u32x2 w; w.x = cvt_pk_bf16(v[i][0], v[i][1]); w.y = cvt_pk_bf16(v[i][2], v[i][3]);
                *GP(u32x2)(xb + (size_t)row * DM + i * 256 + lane * 4) = w; }
        }
        if (wg) {
            float d[8] = {0.f, 0.f, 0.f, 0.f, 0.f, 0.f, 0.f, 0.f};
#pragma unroll
            for (int i = 0; i < 4; ++i)
#pragma unroll
                for (int e = 0; e < 4; ++e) {
                    const float* wp = wgs + (i * 256 + lane * 4 + e) * 8;
                    const f32x4 w0 = *reinterpret_cast<const f32x4*>(wp), w1 = *reinterpret_cast<const f32x4*>(wp + 4);
                    const float xv = v[i][e];
                    d[0] += xv * w0[0]; d[1] += xv * w0[1]; d[2] += xv * w0[2]; d[3] += xv * w0[3];
                    d[4] += xv * w1[0]; d[5] += xv * w1[1]; d[6] += xv * w1[2]; d[7] += xv * w1[3];
                }
#pragma unroll
            for (int j = 0; j < 8; ++j) {
#pragma unroll
                for (int o = 32; o > 0; o >>= 1) d[j] += shx(d[j], o, lane);
            }
            if (lane == 0) {
                *GP(f32x4)(BA + (size_t)row * 8) = (f32x4){d[0], d[1], d[2], d[3]};
                *GP(f32x4)(BA + (size_t)row * 8 + 4) = (f32x4){d[4], d[5], d[6], d[7]};
            }
        }
    }
    __syncthreads();
}

constexpr int GRP_LDS = 73728;
constexpr int L_KRM = 0, L_QRM = 17408, L_KBGT = 34816, L_VBT = 53248, L_GC = 71680, L_BETA = 71936;
__device__ __forceinline__ void chunk_prep(const Params& p_, int l, int g_wave) {
    Params p = p_; p.ws = opaque_ws(p.ws);
    const bf16_t* HA = reinterpret_cast<const bf16_t*>(p.ws + OFF_HA);
    const float* BA = reinterpret_cast<const float*>(p.ws + OFF_BA);
    bf16_t* UT = reinterpret_cast<bf16_t*>(p.ws + OFF_UT);
    bf16_t* W = reinterpret_cast<bf16_t*>(p.ws + OFF_W);
    bf16_t* QD = reinterpret_cast<bf16_t*>(p.ws + OFF_QD);
    bf16_t* KDT = reinterpret_cast<bf16_t*>(p.ws + OFF_KDT);
    bf16_t* QK = reinterpret_cast<bf16_t*>(p.ws + OFF_QK);
    float* GT = reinterpret_cast<float*>(p.ws + OFF_GT);
    const float* cw = p.conv_w + (size_t)l * 4 * 1536;
#define CP_LANEVARS const int tid = opaque_tid(), grp = tid >> 8, gt = tid & 255, lane = tid & 63, wv = gt >> 6, fr = lane & 15, fq = lane >> 4; \
    unsigned char* lds = dyn_lds + grp * GRP_LDS; float* gc_s = reinterpret_cast<float*>(lds + L_GC); float* beta_s = reinterpret_cast<float*>(lds + L_BETA); \
    const int tg = gt >> 4, sg = gt & 15, t0 = tg * 4, c0 = sg * 8; (void)fr; (void)fq; (void)wv; (void)t0; (void)c0; (void)gc_s; (void)beta_s; (void)lane;
    for (int pi = blockIdx.x; pi < 512; pi += gridDim.x) {
        const int grp0 = opaque_tid() >> 8;
        const int hp = pi & 1, n = (pi >> 1) & 63, b = pi >> 7, h = hp * 2 + grp0;
        const int item = (b * 4 + h) * 64 + n, tok0 = b * SEQ + n * 64;
        { CP_LANEVARS
        if (wv == 0) {
            const float bv = *GPC(float)(BA + (size_t)(tok0 + lane) * 8 + h), av = *GPC(float)(BA + (size_t)(tok0 + lane) * 8 + 4 + h);
            const float beta = 1.0f / (1.0f + __expf(-bv));
            const float xx = av + p.dt_bias[l * 4 + h];
            const float sp = fmaxf(xx, 0.f) + log1pf(__expf(-fabsf(xx)));
            float gv = -__expf(p.a_log[l * 4 + h]) * sp;
#pragma unroll
            for (int o = 1; o < 64; o <<= 1) { const float t = __int_as_float(__builtin_amdgcn_ds_bpermute((lane - o) << 2, __float_as_int(gv))); if (lane >= o) gv += t; }
            gc_s[lane] = gv; beta_s[lane] = beta;
            if (lane == 63) *GP(float)(GT + item) = __expf(gv);
        } }
        __syncthreads();
        {
            CP_LANEVARS
            const float glast = gc_s[63];
            float eg[4], ek[4], be[4];
#pragma unroll
            for (int i = 0; i < 4; ++i) { const float gci = gc_s[t0 + i]; eg[i] = __expf(gci); ek[i] = __expf(glast - gci); be[i] = beta_s[t0 + i]; }
#pragma unroll
            for (int ten = 0; ten < 3; ++ten) {
                __builtin_amdgcn_sched_barrier(0);
                float raw[7][8];
#pragma unroll
                for (int r = 0; r < 7; ++r) {
                    const int tt = n * 64 + t0 - 3 + r;
                    u32x4 u = mk4(0u, 0u, 0u, 0u);
                    if (tt >= 0) u = *GPC(u32x4)(HA + (size_t)(b * SEQ + tt) * HA_LD + ten * 512 + h * 128 + c0);
                    raw[r][0] = bf_lo(u.x); raw[r][1] = bf_hi(u.x); raw[r][2] = bf_lo(u.y); raw[r][3] = bf_hi(u.y);
                    raw[r][4] = bf_lo(u.z); raw[r][5] = bf_hi(u.z); raw[r][6] = bf_lo(u.w); raw[r][7] = bf_hi(u.w);
                }
                float o[4][8];
#pragma unroll
                for (int i = 0; i < 4; ++i)
#pragma unroll
                    for (int c = 0; c < 8; ++c) o[i][c] = 0.f;
#pragma unroll
                for (int j = 0; j < 4; ++j) {
                    const float* wp = cw + (size_t)j * 1536 + ten * 512 + h * 128 + c0;
                    const f32x4 a = *GPC(f32x4)(wp), c4 = *GPC(f32x4)(wp + 4);
                    const float wj[8] = {a[0], a[1], a[2], a[3], c4[0], c4[1], c4[2], c4[3]};
#pragma unroll
                    for (int i = 0; i < 4; ++i)
#pragma unroll
                        for (int c = 0; c < 8; ++c) o[i][c] += wj[c] * raw[i + j][c];
                }
#pragma unroll
                for (int i = 0; i < 4; ++i)
#pragma unroll
                    for (int c = 0; c < 8; ++c) o[i][c] = silu_f(o[i][c]);
                if (ten < 2) {
#pragma unroll
                    for (int i = 0; i < 4; ++i) {
                        float sq = 0.f;
#pragma unroll
                        for (int c = 0; c < 8; ++c) sq += o[i][c] * o[i][c];
#pragma unroll
                        for (int off = 1; off < 16; off <<= 1) sq += shx(sq, off, lane);
                        const float rq = rsqrtf(sq + 1e-6f) * (ten == 0 ? 0.08838834764831845f : 1.0f);
#pragma unroll
                        for (int c = 0; c < 8; ++c) o[i][c] *= rq;
                    }
                }
                if (ten == 0) {
#pragma unroll
                    for (int i = 0; i < 4; ++i) {
                        u32x4 w;
                        w.x = cvt_pk_bf16(o[i][0] * eg[i], o[i][1] * eg[i]); w.y = cvt_pk_bf16(o[i][2] * eg[i], o[i][3] * eg[i]);
                        w.z = cvt_pk_bf16(o[i][4] * eg[i], o[i][5] * eg[i]); w.w = cvt_pk_bf16(o[i][6] * eg[i], o[i][7] * eg[i]);
                        *GP(u32x4)(QD + (size_t)(tok0 + t0 + i) * 512 + h * 128 + c0) = w;
                        w.x = cvt_pk_bf16(o[i][0], o[i][1]); w.y = cvt_pk_bf16(o[i][2], o[i][3]); w.z = cvt_pk_bf16(o[i][4], o[i][5]); w.w = cvt_pk_bf16(o[i][6], o[i][7]);
                        *reinterpret_cast<u32x4*>(lds + L_QRM + ((t0 + i) * 136 + c0) * 2) = w;
                    }
                } else if (ten == 1) {
#pragma unroll
                    for (int i = 0; i < 4; ++i) {
                        u32x4 w;
                        w.x = cvt_pk_bf16(o[i][0], o[i][1]); w.y = cvt_pk_bf16(o[i][2], o[i][3]); w.z = cvt_pk_bf16(o[i][4], o[i][5]); w.w = cvt_pk_bf16(o[i][6], o[i][7]);
                        *reinterpret_cast<u32x4*>(lds + L_KRM + ((t0 + i) * 136 + c0) * 2) = w;
                    }
#pragma unroll
                    for (int c = 0; c < 8; ++c) {
                        u32x2 w;
                        w.x = cvt_pk_bf16(o[0][c] * ek[0], o[1][c] * ek[1]); w.y = cvt_pk_bf16(o[2][c] * ek[2], o[3][c] * ek[3]);
                        *GP(u32x2)(KDT + (size_t)item * 8192 + (c0 + c) * 64 + t0) = w;
                        w.x = cvt_pk_bf16(o[0][c] * be[0] * eg[0], o[1][c] * be[1] * eg[1]); w.y = cvt_pk_bf16(o[2][c] * be[2] * eg[2], o[3][c] * be[3] * eg[3]);
                        *reinterpret_cast<u32x2*>(lds + L_KBGT + ((c0 + c) * 72 + t0) * 2) = w;
                    }
                } else {
#pragma unroll
                    for (int c = 0; c < 8; ++c) {
                        u32x2 w;
                        w.x = cvt_pk_bf16(o[0][c] * be[0], o[1][c] * be[1]); w.y = cvt_pk_bf16(o[2][c] * be[2], o[3][c] * be[3]);
                        *reinterpret_cast<u32x2*>(lds + L_VBT + ((c0 + c) * 72 + t0) * 2) = w;
                    }
                }
            }
        }
        __syncthreads();
        {
            CP_LANEVARS
            const int ib = wv;
            f32x4 kk[4], qk[4];
#pragma unroll
            for (int jb = 0; jb < 4; ++jb) { kk[jb] = (f32x4){0.f, 0.f, 0.f, 0.f}; qk[jb] = (f32x4){0.f, 0.f, 0.f, 0.f}; }
            bf16x8 ki[4], qi[4];
#pragma unroll
            for (int ks = 0; ks < 4; ++ks) {
                ki[ks] = lds8(lds + L_KRM + ((ib * 16 + fr) * 136 + ks * 32 + fq * 8) * 2);
                qi[ks] = lds8(lds + L_QRM + ((ib * 16 + fr) * 136 + ks * 32 + fq * 8) * 2);
            }
#pragma unroll
            for (int jb = 0; jb < 4; ++jb) {
                if (jb <= ib) {
#pragma unroll
                    for (int ks = 0; ks < 4; ++ks) {
                        const bf16x8 kj = lds8(lds + L_KRM + ((jb * 16 + fr) * 136 + ks * 32 + fq * 8) * 2);
                        kk[jb] = mfma16(ki[ks], kj, kk[jb]);
                        qk[jb] = mfma16(kj, qi[ks], qk[jb]);
                    }
                }
            }
            __syncthreads();
            float* AP = reinterpret_cast<float*>(lds + L_KRM);
#pragma unroll
            for (int jb = 0; jb < 4; ++jb) {
                if (jb <= ib) {
                    const int j = jb * 16 + fr, i0 = ib * 16 + fq * 4;
                    const float gj = gc_s[j];
#pragma unroll
                    for (int r = 0; r < 4; ++r) {
                        const int i = i0 + r;
                        const float dec = __expf(fminf(gc_s[i] - gj, 0.f));
                        float av_ = (i > j) ? kk[jb][r] * beta_s[i] * dec : 0.f;
#ifdef DIAG3
                        atomicMax(reinterpret_cast<unsigned*>(p.ws + OFF_BAR) + 4011, __float_as_uint(fabsf(kk[jb][r])));
                        atomicMax(reinterpret_cast<unsigned*>(p.ws + OFF_BAR) + 4012, __float_as_uint(fabsf(av_)));
#endif
#ifdef CLAMP_A
                        if (!(fabsf(av_) <= 0.02f)) av_ = 0.f;
#endif
                        AP[j * 64 + r * 16 + ib * 4 + fq] = av_;
                    }
                }
                {
                    const int i = ib * 16 + fr, j0 = jb * 16 + fq * 4;
                    const float gi = gc_s[i];
                    float o[4];
#pragma unroll
                    for (int r = 0; r < 4; ++r) {
                        const int j = j0 + r;
                        const float dec = __expf(fminf(gi - gc_s[j], 0.f));
                        o[r] = (i >= j) ? qk[jb][r] * dec : 0.f;
                    }
                    u32x2 w; w.x = cvt_pk_bf16(o[0], o[1]); w.y = cvt_pk_bf16(o[2], o[3]);
                    *GP(u32x2)(QK + (size_t)(tok0 + i) * 256 + h * 64 + j0) = w;
                }
            }
        }
        __syncthreads();
        {
            CP_LANEVARS
            const float* AP = reinterpret_cast<const float*>(lds + L_KRM);
            const int cl = lane >> 2, pp = lane & 3, ccol = wv * 16 + cl;
            float a[16];
#pragma unroll
            for (int k = 0; k < 16; ++k) a[k] = (4 * k + pp == ccol) ? 1.f : 0.f;
#define INV_STEP(SS) { const int j = jq * 4 + SS; \
                    const float tj = __int_as_float(__builtin_amdgcn_update_dpp(0, __float_as_int(a[jq]), SS * 0x55, 0xf, 0xf, false)); \
                    const float* ap = AP + j * 64 + pp * 16; \
                    _Pragma("unroll") for (int k = jq; k < 16; ++k) a[k] -= ap[k] * tj; }
#pragma unroll
            for (int jq = 0; jq < 16; ++jq) {
                __builtin_amdgcn_sched_barrier(0);
#ifdef NO_INV
                if (false) {
#else
                if (jq >= wv * 4) {
#endif
                    INV_STEP(0) INV_STEP(1) INV_STEP(2)
                    if (jq < 15) INV_STEP(3)
                }
            }
#undef INV_STEP
#ifdef DIAG3
            { float mx = 0.f;
              for (int k = 0; k < 16; ++k) { const float av = fabsf(a[k]); mx = (av > mx || !(av == av)) ? av : mx; }
              atomicMax(reinterpret_cast<unsigned*>(p.ws + OFF_BAR) + 4010, __float_as_uint(mx)); }
#endif
            bf16_t* TR = reinterpret_cast<bf16_t*>(lds + L_QRM);
#pragma unroll
            for (int k = 0; k < 16; ++k) TR[(4 * k + pp) * 72 + ccol] = (bf16_t)(cvt_pk_bf16(a[k], 0.f) & 0xffffu);
        }
        __syncthreads();
        {
            CP_LANEVARS
            bf16x8 tf[2];
#pragma unroll
            for (int ks = 0; ks < 2; ++ks) tf[ks] = lds8(lds + L_QRM + ((wv * 16 + fr) * 72 + ks * 32 + fq * 8) * 2);
#pragma unroll
            for (int db = 0; db < 8; ++db) {
                f32x4 au = (f32x4){0.f, 0.f, 0.f, 0.f}, aw = (f32x4){0.f, 0.f, 0.f, 0.f};
#pragma unroll
                for (int ks = 0; ks < 2; ++ks) {
                    const bf16x8 vb = lds8(lds + L_VBT + ((db * 16 + fr) * 72 + ks * 32 + fq * 8) * 2);
                    const bf16x8 kb = lds8(lds + L_KBGT + ((db * 16 + fr) * 72 + ks * 32 + fq * 8) * 2);
                    au = mfma16(tf[ks], vb, au);
                    aw = mfma16(kb, tf[ks], aw);
                }
                u32x2 w; w.x = cvt_pk_bf16(au[0], au[1]); w.y = cvt_pk_bf16(au[2], au[3]);
                *GP(u32x2)(UT + (size_t)item * 8192 + (db * 16 + fr) * 64 + wv * 16 + fq * 4) = w;
                w.x = cvt_pk_bf16(aw[0], aw[1]); w.y = cvt_pk_bf16(aw[2], aw[3]);
                *GP(u32x2)(W + (size_t)(tok0 + wv * 16 + fr) * 512 + h * 128 + db * 16 + fq * 4) = w;
            }
        }
        __syncthreads();
    }
}

__device__ __forceinline__ void delta_scan(const Params& p_, int blk, int g_wave) {
    Params p = p_; p.ws = opaque_ws(p.ws);
    const int tid = opaque_tid(), lane = tid & 63, w = tid >> 6, fr = lane & 15, fq = lane >> 4;
    const int bh = blk >> 2, sl = blk & 3, b = bh >> 2, h = bh & 3, dv0 = sl * 32;
    bf16_t* ST = reinterpret_cast<bf16_t*>(p.ws + OFF_HA);
    bf16_t* UT = reinterpret_cast<bf16_t*>(p.ws + OFF_UT);
    const bf16_t* W = reinterpret_cast<const bf16_t*>(p.ws + OFF_W);
    const bf16_t* KDT = reinterpret_cast<const bf16_t*>(p.ws + OFF_KDT);
    const float* GT = reinterpret_cast<const float*>(p.ws + OFF_GT);
    unsigned char* STL = dyn_lds;
    unsigned char* VTL = dyn_lds + 8704;
    const int tb = w >> 1, db1 = w & 1;
    f32x4 S[2] = {(f32x4){0.f, 0.f, 0.f, 0.f}, (f32x4){0.f, 0.f, 0.f, 0.f}};
#pragma unroll
    for (int db = 0; db < 2; ++db) {
        const u32x2 z = mk2(0u, 0u);
        *reinterpret_cast<u32x2*>(STL + ((db * 16 + fr) * 136 + w * 16 + fq * 4) * 2) = z;
        *GP(u32x2)(ST + (size_t)(bh * 64) * 16384 + (dv0 + db * 16 + fr) * 128 + w * 16 + fq * 4) = z;
    }
    __syncthreads();
#define SCAN_LOAD(NN, WF, KF, UB, GTV) do { const int item_ = bh * 64 + (NN), tok_ = b * SEQ + (NN) * 64; \
        _Pragma("unroll") for (int ks = 0; ks < 4; ++ks) WF[ks] = ldg8(W + (size_t)(tok_ + tb * 16 + fr) * 512 + h * 128 + ks * 32 + fq * 8); \
        _Pragma("unroll") for (int ks = 0; ks < 2; ++ks) KF[ks] = ldg8(KDT + (size_t)item_ * 8192 + (w * 16 + fr) * 64 + ks * 32 + fq * 8); \
        UB = *GPC(u32x2)(UT + (size_t)item_ * 8192 + (dv0 + db1 * 16 + fr) * 64 + tb * 16 + fq * 4); \
        GTV = *GPC(float)(GT + item_); } while (0)
#define LDS_BAR() do { asm volatile("s_waitcnt lgkmcnt(0)" ::: "memory"); __builtin_amdgcn_s_barrier(); asm volatile("" ::: "memory"); } while (0)
    bf16x8 wfA[4], kfA[2], wfB[4], kfB[2], wfC[4], kfC[2], wfD[4], kfD[2];
    u32x2 ubA, ubB, ubC, ubD; float gtA, gtB, gtC, gtD;
    SCAN_LOAD(0, wfA, kfA, ubA, gtA); SCAN_LOAD(1, wfB, kfB, ubB, gtB); SCAN_LOAD(2, wfC, kfC, ubC, gtC);
#define SCAN_STEP(N_, WF, KF, UB, GTV, NWF, NKF, NUB, NGT) do { \
        const int n = (N_); const int item = bh * 64 + n; \
        { const int nn = n + 3 < 64 ? n + 3 : 63; SCAN_LOAD(nn, NWF, NKF, NUB, NGT); } \
        bf16_t* up = UT + (size_t)item * 8192 + (dv0 + db1 * 16 + fr) * 64 + tb * 16 + fq * 4; \
        f32x4 a1; \
        { bf16x8 sb_[4]; \
          _Pragma("unroll") for (int ks = 0; ks < 4; ++ks) sb_[ks] = lds8(STL + ((db1 * 16 + fr) * 136 + ks * 32 + fq * 8) * 2); \
          f32x4 a1a = (f32x4){0.f, 0.f, 0.f, 0.f}, a1b = (f32x4){0.f, 0.f, 0.f, 0.f}; \
          a1a = mfma16(WF[0], sb_[0], a1a); a1b = mfma16(WF[1], sb_[1], a1b); a1a = mfma16(WF[2], sb_[2], a1a); a1b = mfma16(WF[3], sb_[3], a1b); \
          a1 = a1a + a1b; } \
        { u32x2 vw; \
          vw.x = cvt_pk_bf16(bf_lo(UB.x) - a1[0], bf_hi(UB.x) - a1[1]); vw.y = cvt_pk_bf16(bf_lo(UB.y) - a1[2], bf_hi(UB.y) - a1[3]); \
          *reinterpret_cast<u32x2*>(VTL + ((db1 * 16 + fr) * 72 + tb * 16 + fq * 4) * 2) = vw; \
          *GP(u32x2)(up) = vw; } \
        LDS_BAR(); \
        { bf16x8 vb_[2][2]; \
          _Pragma("unroll") for (int db = 0; db < 2; ++db) _Pragma("unroll") for (int ks = 0; ks < 2; ++ks) vb_[db][ks] = lds8(VTL + ((db * 16 + fr) * 72 + ks * 32 + fq * 8) * 2); \
          f32x4 a20 = S[0] * GTV, a21 = S[1] * GTV; \
          a20 = mfma16(KF[0], vb_[0][0], a20); a21 = mfma16(KF[0], vb_[1][0], a21); a20 = mfma16(KF[1], vb_[0][1], a20); a21 = mfma16(KF[1], vb_[1][1], a21); \
          S[0] = a20; S[1] = a21; \
          if (n < 63) { \
            _Pragma("unroll") for (int db = 0; db < 2; ++db) { \
                u32x2 sw; sw.x = cvt_pk_bf16(S[db][0], S[db][1]); sw.y = cvt_pk_bf16(S[db][2], S[db][3]); \
                *reinterpret_cast<u32x2*>(STL + ((db * 16 + fr) * 136 + w * 16 + fq * 4) * 2) = sw; \
                *GP(u32x2)(ST + (size_t)(item + 1) * 16384 + (dv0 + db * 16 + fr) * 128 + w * 16 + fq * 4) = sw; \
            } } } \
        LDS_BAR(); } while (0)
    for (int n4 = 0; n4 < 64; n4 += 4) {
        SCAN_STEP(n4 + 0, wfA, kfA, ubA, gtA, wfD, kfD, ubD, gtD);
        SCAN_STEP(n4 + 1, wfB, kfB, ubB, gtB, wfA, kfA, ubA, gtA);
        SCAN_STEP(n4 + 2, wfC, kfC, ubC, gtC, wfB, kfB, ubB, gtB);
        SCAN_STEP(n4 + 3, wfD, kfD, ubD, gtD, wfC, kfC, ubC, gtC);
    }
#undef SCAN_STEP
#undef SCAN_LOAD
#undef LDS_BAR
}

__device__ __forceinline__ void swa_phase(const Params& p_, int l, int sblk, int nsb, int g_wave) {
    Params p = p_; p.ws = opaque_ws(p.ws);
    const int tid = opaque_tid(), lane = tid & 63, w = tid >> 6, fr = lane & 15, fq = lane >> 4;
    const bf16_t* HB = reinterpret_cast<const bf16_t*>(p.ws + OFF_HB);
    bf16_t* YM = reinterpret_cast<bf16_t*>(p.ws + OFF_XB);
    unsigned char* VTS = dyn_lds;
    for (int it = sblk; it < 1024; it += nsb) {
        const int b = it >> 8, kvh = (it >> 7) & 1, qt = it & 127, q0 = qt * 32, kbase = q0 - 128;
        for (int idx = tid; idx < 1280; idx += 512) {
            const int key = idx >> 3, ds = idx & 7, kp = kbase + key;
            u32x4 u = mk4(0u, 0u, 0u, 0u);
            if (kp >= 0) u = *GPC(u32x4)(HB + (size_t)(b * SEQ + kp) * HB_LD + HB_VB + kvh * 64 + ds * 8);
            bf16_t* d = reinterpret_cast<bf16_t*>(VTS) + (ds * 8) * 168 + key;
            d[0 * 168] = (bf16_t)(u.x & 0xffffu); d[1 * 168] = (bf16_t)(u.x >> 16);
            d[2 * 168] = (bf16_t)(u.y & 0xffffu); d[3 * 168] = (bf16_t)(u.y >> 16);
            d[4 * 168] = (bf16_t)(u.z & 0xffffu); d[5 * 168] = (bf16_t)(u.z >> 16);
            d[6 * 168] = (bf16_t)(u.w & 0xffffu); d[7 * 168] = (bf16_t)(u.w >> 16);
        }
        const int g = w >> 1, sub = w & 1, qs = q0 + sub * 16, hq = kvh * 4 + g;
        const float slope = exp2f(-(float)(hq + 1)), sink = p.sinks[l * 8 + hq];
        bf16x8 qf[2];
#pragma unroll
        for (int ks = 0; ks < 2; ++ks) qf[ks] = ldg8(HB + (size_t)(b * SEQ + qs + fr) * HB_LD + HB_QB + hq * 64 + ks * 32 + fq * 8);
        f32x4 sc[10];
#pragma unroll
        for (int kt = 0; kt < 10; ++kt) {
            int kp = kbase + kt * 16 + fr; kp = kp < 0 ? 0 : kp;
            const bf16_t* kr = HB + (size_t)(b * SEQ + kp) * HB_LD + HB_KB + kvh * 64 + fq * 8;
            f32x4 a = (f32x4){0.f, 0.f, 0.f, 0.f};
            a = mfma16(ldg8(kr), qf[0], a);
            a = mfma16(ldg8(kr + 32), qf[1], a);
            sc[kt] = a;
        }
        const int qpos = qs + fr;
        float m = -1e30f;
#pragma unroll
        for (int kt = 0; kt < 10; ++kt)
#pragma unroll
            for (int r = 0; r < 4; ++r) {
                const int kpos = kbase + kt * 16 + fq * 4 + r, dist = qpos - kpos;
                const bool valid = (dist >= 0) && (dist < 128) && (kpos >= 0);
                const float s = valid ? sc[kt][r] * 0.125f - slope * (float)dist : -1e30f;
                sc[kt][r] = s; m = fmaxf(m, s);
            }
        m = fmaxf(m, shx(m, 16, lane)); m = fmaxf(m, shx(m, 32, lane));
        m = fmaxf(m, sink);
        float lsum = 0.f;
#pragma unroll
        for (int kt = 0; kt < 10; ++kt)
#pragma unroll
            for (int r = 0; r < 4; ++r) { const float e = __expf(sc[kt][r] - m); sc[kt][r] = e; lsum += e; }
        lsum += shx(lsum, 16, lane); lsum += shx(lsum, 32, lane);
        lsum += __expf(sink - m);
        const float inv = 1.0f / lsum;
        __syncthreads();
        f32x4 o[4];
#pragma unroll
        for (int db = 0; db < 4; ++db) o[db] = (f32x4){0.f, 0.f, 0.f, 0.f};
#pragma unroll
        for (int j = 0; j < 5; ++j) {
            union { bf16x8 v; unsigned u[4]; } pf;
            pf.u[0] = cvt_pk_bf16(sc[2 * j][0], sc[2 * j][1]); pf.u[1] = cvt_pk_bf16(sc[2 * j][2], sc[2 * j][3]);
            pf.u[2] = cvt_pk_bf16(sc[2 * j + 1][0], sc[2 * j + 1][1]); pf.u[3] = cvt_pk_bf16(sc[2 * j + 1][2], sc[2 * j + 1][3]);
#pragma unroll
            for (int db = 0; db < 4; ++db) {
                union { bf16x8 v; u32x2 h[2]; } vf;
                const unsigned char* vr = VTS + ((db * 16 + fr) * 168 + (2 * j) * 16 + fq * 4) * 2;
                vf.h[0] = *reinterpret_cast<const u32x2*>(vr);
                vf.h[1] = *reinterpret_cast<const u32x2*>(vr + 32);
                o[db] = mfma16(vf.v, pf.v, o[db]);
            }
        }
        {
            const size_t tok = (size_t)(b * SEQ + qs + fr);
#pragma unroll
            for (int db = 0; db < 4; ++db) {
                const int col = hq * 64 + db * 16 + fq * 4;
                const u32x2 z = *GPC(u32x2)(HB + tok * HB_LD + HB_ZB + col);
                u32x2 y;
                y.x = cvt_pk_bf16(o[db][0] * inv * silu_f(bf_lo(z.x)), o[db][1] * inv * silu_f(bf_hi(z.x)));
                y.y = cvt_pk_bf16(o[db][2] * inv * silu_f(bf_lo(z.y)), o[db][3] * inv * silu_f(bf_hi(z.y)));
                *GP(u32x2)(YM + tok * DM + 512 + col) = y;
            }
        }
        __syncthreads();
    }
}

__device__ __forceinline__ void delta_out(const Params& p_, int l, int g_wave) {
    Params p = p_; p.ws = opaque_ws(p.ws);
    const int tid = opaque_tid(), grp = tid >> 8, lane = tid & 63, wv = (tid & 255) >> 6, fr = lane & 15, fq = lane >> 4;
    const bf16_t* ST = reinterpret_cast<const bf16_t*>(p.ws + OFF_HA);
    const bf16_t* VT = reinterpret_cast<const bf16_t*>(p.ws + OFF_UT);
    const bf16_t* QD = reinterpret_cast<const bf16_t*>(p.ws + OFF_QD);
    const bf16_t* QK = reinterpret_cast<const bf16_t*>(p.ws + OFF_QK);
    const bf16_t* HB = reinterpret_cast<const bf16_t*>(p.ws + OFF_HB);
    bf16_t* YM = reinterpret_cast<bf16_t*>(p.ws + OFF_XB);
    const float* nw = p.norm_w + l * 128;
    for (int pi = blockIdx.x; pi < 512; pi += gridDim.x) {
        const int item = pi * 2 + grp, bh = item >> 6, n = item & 63, b = bh >> 2, h = bh & 3;
        const int tok = b * SEQ + n * 64 + wv * 16 + fr;
        bf16x8 qd[4], qk[2];
#pragma unroll
        for (int ks = 0; ks < 4; ++ks) qd[ks] = ldg8(QD + (size_t)tok * 512 + h * 128 + ks * 32 + fq * 8);
#pragma unroll
        for (int ks = 0; ks < 2; ++ks) qk[ks] = ldg8(QK + (size_t)tok * 256 + h * 64 + ks * 32 + fq * 8);
        f32x4 o[8];
        float ss = 0.f;
#pragma unroll
        for (int db = 0; db < 8; ++db) {
            if ((db & 1) == 0) __builtin_amdgcn_sched_barrier(0);
            f32x4 a = (f32x4){0.f, 0.f, 0.f, 0.f};
            const bf16_t* sp = ST + (size_t)item * 16384 + (db * 16 + fr) * 128 + fq * 8;
#pragma unroll
            for (int ks = 0; ks < 4; ++ks) a = mfma16(ldg8(sp + ks * 32), qd[ks], a);
            const bf16_t* vp = VT + (size_t)item * 8192 + (db * 16 + fr) * 64 + fq * 8;
#pragma unroll
            for (int ks = 0; ks < 2; ++ks) a = mfma16(ldg8(vp + ks * 32), qk[ks], a);
            o[db] = a;
            ss += (a[0] * a[0] + a[1] * a[1]) + (a[2] * a[2] + a[3] * a[3]);
        }
        ss += shx(ss, 16, lane); ss += shx(ss, 32, lane);
        const float rs = rsqrtf(ss * (1.0f / 128.0f) + 1e-6f);
#pragma unroll
        for (int db = 0; db < 8; ++db) {
            const int dv = db * 16 + fq * 4;
            const f32x4 nv = *GPC(f32x4)(nw + dv);
            const u32x2 z = *GPC(u32x2)(HB + (size_t)tok * HB_LD + HB_ZA + h * 128 + dv);
            u32x2 y;
            y.x = cvt_pk_bf16(o[db][0] * rs * nv[0] * silu_f(bf_lo(z.x)), o[db][1] * rs * nv[1] * silu_f(bf_hi(z.x)));
            y.y = cvt_pk_bf16(o[db][2] * rs * nv[2] * silu_f(bf_lo(z.y)), o[db][3] * rs * nv[3] * silu_f(bf_hi(z.y)));
            *GP(u32x2)(YM + (size_t)tok * DM + h * 128 + dv) = y;
        }
    }
}


__device__ __forceinline__ void diag_rows(const bf16_t* YM, float* out, int g_wave) {
    const int tidx = opaque_tid();
    const int lane = tidx & 63;
    const int gw = blockIdx.x * 8 + (tidx >> 6), nw = gridDim.x * 8;
    for (int row = gw; row < NTOK; row += nw) {
        float ca = 0.f, cb = 0.f;
        for (int i = 0; i < 16; ++i) {
            const int col = i * 64 + lane;
            const float v = bf_lo((unsigned)YM[(size_t)row * DM + col]);
            const bool bad = !(fabsf(v) < 1e30f);
            if (bad) { if (col < 512) ca += 1.f; else cb += 1.f; }
        }
        for (int o = 32; o > 0; o >>= 1) { ca += shx(ca, o, lane); cb += shx(cb, o, lane); }
        for (int i = 0; i < 16; ++i) out[(size_t)row * DM + i * 64 + lane] = 0.f;
        if (lane == 0) out[(size_t)row * DM] = (ca > 0.f ? 1e6f : 0.f) + (cb > 0.f ? 1e5f : 0.f);
    }
}


__device__ __forceinline__ void diag_prep(unsigned char* ws, float* out, int g_wave) {
    const int tidx = opaque_tid();
    const int lane = tidx & 63;
    const int gw = blockIdx.x * 8 + (tidx >> 6), nw = gridDim.x * 8;
    const bf16_t* UT = reinterpret_cast<const bf16_t*>(ws + OFF_UT);
    const bf16_t* W = reinterpret_cast<const bf16_t*>(ws + OFF_W);
    const bf16_t* QD = reinterpret_cast<const bf16_t*>(ws + OFF_QD);
    const bf16_t* KDT = reinterpret_cast<const bf16_t*>(ws + OFF_KDT);
    const bf16_t* QK = reinterpret_cast<const bf16_t*>(ws + OFF_QK);
    const float* GT = reinterpret_cast<const float*>(ws + OFF_GT);
    const float* BA = reinterpret_cast<const float*>(ws + OFF_BA);
    for (int row = gw; row < NTOK; row += nw) {
        float c[6] = {0.f, 0.f, 0.f, 0.f, 0.f, 0.f};
        for (int i = 0; i < 8; ++i) {
            const size_t o = (size_t)row * 512 + i * 64 + lane;
            if (!(fabsf(bf_lo((unsigned)UT[o])) < 1e30f)) c[0] += 1.f;
            if (!(fabsf(bf_lo((unsigned)W[o])) < 1e30f)) c[1] += 1.f;
            if (!(fabsf(bf_lo((unsigned)QD[o])) < 1e30f)) c[2] += 1.f;
            if (!(fabsf(bf_lo((unsigned)KDT[o])) < 1e30f)) c[3] += 1.f;
        }
        for (int i = 0; i < 4; ++i) if (!(fabsf(bf_lo((unsigned)QK[(size_t)row * 256 + i * 64 + lane])) < 1e30f)) c[4] += 1.f;
        if (row < 1024 && lane == 0 && !(fabsf(GT[row]) < 1e30f)) c[5] += 1.f;
        if (lane < 8 && !(fabsf(BA[(size_t)row * 8 + lane]) < 1e30f)) c[5] += 1.f;
        for (int j = 0; j < 6; ++j) for (int o = 32; o > 0; o >>= 1) c[j] += shx(c[j], o, lane);
        unsigned bits = 0;
        for (int j = 0; j < 6; ++j) if (c[j] > 0.f) bits |= (1u << j);
        if (lane == 0 && bits) atomicOr(reinterpret_cast<unsigned*>(ws + OFF_BAR) + 4020, bits);
        for (int i = 0; i < 16; ++i) out[(size_t)row * DM + i * 64 + lane] = 0.f;
    }
}

__global__ void __launch_bounds__(512) fwd_megakernel(Params p) {
    __shared__ u32x4 xb_words;
    const int g_wave = __builtin_amdgcn_readfirstlane((int)(threadIdx.x >> 6));
    if (xb_t0(g_wave)) xb_words = mk4(0u, 0u, 0u, 0u);
    __syncthreads();
    XcdBarrier gb = xcd_barrier_post(reinterpret_cast<unsigned*>(p.ws + OFF_BAR), (volatile LAS unsigned*)&xb_words, g_wave);
#ifdef USE_CG
    gb.x = 0;
#endif

#ifndef PHM
#define PHM 255
#endif
    { int reps_ = PROBE_REPS_W; asm volatile("" : "+s"(reps_)); for (int rep_ = 0; rep_ < reps_; ++rep_) prep_weights(p, g_wave); }
    if (PHM & 2) row_pass(p.x, false, nullptr, nullptr, nullptr, reinterpret_cast<bf16_t*>(p.ws + OFF_XB), p.w_in + 2048, reinterpret_cast<float*>(p.ws + OFF_BA), g_wave);
    xcd_barrier(gb);
    for (int l = 0; l < 2; ++l) {
        unsigned char* wsl = opaque_ws(p.ws);
        bf16_t* XB = reinterpret_cast<bf16_t*>(wsl + OFF_XB);
        float* BA = reinterpret_cast<float*>(wsl + OFF_BA);
        {
            EpiH e; e.ha = reinterpret_cast<bf16_t*>(p.ws + OFF_HA); e.hb = reinterpret_cast<bf16_t*>(p.ws + OFF_HB);
            { int reps = PROBE_REPS_GEMM; asm volatile("" : "+s"(reps));
              for (int rep = 0; rep < reps; ++rep) { gemm_phase(XB, reinterpret_cast<const bf16_t*>(p.ws + OFF_WIN) + (size_t)l * NIN * DM, NTOK, NIN, DM, e, g_wave); } }
        }
        xcd_barrier(gb);
        { int reps_ = PROBE_REPS_PREP; asm volatile("" : "+s"(reps_)); for (int rep_ = 0; rep_ < reps_; ++rep_) { if (PHM & 8) chunk_prep(p, l, g_wave); __syncthreads(); } }
        xcd_barrier(gb);
#ifdef DIAG2
        if (l == 0) { diag_prep(wsl, p.out, g_wave); xcd_barrier(gb);
            if (blockIdx.x == 0 && opaque_tid() == 0) p.out[0] = 1000.f * (float)reinterpret_cast<const unsigned*>(wsl + OFF_BAR)[4020];
            return; }
#endif
#ifdef DIAG3
        if (l == 0) {
            const int tidx = opaque_tid();
            const unsigned* dw = reinterpret_cast<const unsigned*>(wsl + OFF_BAR);
            for (size_t i = (size_t)blockIdx.x * 512 + tidx; i < (size_t)NTOK * DM; i += (size_t)gridDim.x * 512) {
                float v = 0.f;
                if (i == 0) v = fminf(__uint_as_float(dw[4010]), 1e37f) * DIAG3_S0;
                if (i == 1) v = fminf(__uint_as_float(dw[4011]), 1e37f) * DIAG3_S1;
                if (i == 2) v = fminf(__uint_as_float(dw[4012]), 1e37f) * DIAG3_S2;
                p.out[i] = v;
            }
            return;
        }
#endif
        if (blockIdx.x < 64) { if (PHM & 16) delta_scan(p, blockIdx.x, g_wave); }
        else { int reps_ = PROBE_REPS_SWA; asm volatile("" : "+s"(reps_)); for (int rep_ = 0; rep_ < reps_; ++rep_) swa_phase(p, l, blockIdx.x - 64, gridDim.x - 64, g_wave); }
        xcd_barrier(gb);
#ifdef DIAG4
        if (l == 0) {
            const int tidx = opaque_tid();
            const unsigned* dw = reinterpret_cast<const unsigned*>(wsl + OFF_BAR);
            for (size_t i = (size_t)blockIdx.x * 512 + tidx; i < (size_t)NTOK * DM; i += (size_t)gridDim.x * 512) {
                float v = 0.f;
                if (i == 0) v = fminf(__uint_as_float(dw[4013]), 1e37f) * DIAG4_S0;
                if (i == 1) v = fminf(__uint_as_float(dw[4014]), 1e37f) * DIAG4_S1;
                p.out[i] = v;
            }
            return;
        }
#endif
        { int reps_ = PROBE_REPS_DOUT; asm volatile("" : "+s"(reps_)); for (int rep_ = 0; rep_ < reps_; ++rep_) { if (PHM & 64) delta_out(p, l, g_wave); __syncthreads(); } }
        xcd_barrier(gb);
#ifdef DIAG1
        if (l == DIAG1 - 1) { diag_rows(XB, p.out, g_wave); return; }
#endif
        {
            EpiZ e; e.xres = (l == 0) ? p.x : p.out; e.out = p.out;
            if (PHM & 128) gemm_phase(XB, reinterpret_cast<const bf16_t*>(p.ws + OFF_WOUT) + (size_t)l * DM * DM, NTOK, DM, DM, e, g_wave);
        }
        xcd_barrier(gb);
        if (l == 0) row_pass(p.out, true, p.ln_g, p.ln_b, p.out, XB, p.w_in + (size_t)DM * INC + 2048, BA, g_wave);
        else        row_pass(p.out, true, p.ln_g + DM, p.ln_b + DM, p.out, nullptr, nullptr, nullptr, g_wave);
        if (l == 0) xcd_barrier(gb);
    }
}

extern "C" void kernel_launch(void* const* d_in, const int* in_sizes, int n_in, void* d_out, int out_size, void* d_ws, size_t ws_size, hipStream_t stream) {
    static int grid_blocks = 0;
    if (!grid_blocks) {
        int dev = 0, cus = 0, per_cu = 0;
        hipGetDevice(&dev);
        hipDeviceGetAttribute(&cus, hipDeviceAttributeMultiprocessorCount, dev);
        hipFuncSetAttribute((const void*)fwd_megakernel, hipFuncAttributeMaxDynamicSharedMemorySize, LDS_BYTES);
        hipOccupancyMaxActiveBlocksPerMultiprocessor(&per_cu, fwd_megakernel, 512, LDS_BYTES);
        grid_blocks = (per_cu >= 1) ? cus : 0;
        if (grid_blocks > 256) grid_blocks = 256;
        if (ws_size < WS_NEED) { fprintf(stderr, "workspace too small: %zu < %zu\n", ws_size, (size_t)WS_NEED); }
        if (!grid_blocks) { fprintf(stderr, "occupancy query returned 0\n"); grid_blocks = 256; }
    }
    Params p{};
    p.x = (const float*)d_in[0]; p.w_in = (const float*)d_in[1]; p.conv_w = (const float*)d_in[2]; p.a_log = (const float*)d_in[3];
    p.dt_bias = (const float*)d_in[4]; p.norm_w = (const float*)d_in[5]; p.sinks = (const float*)d_in[6]; p.w_out = (const float*)d_in[7];
    p.ln_g = (const float*)d_in[8]; p.ln_b = (const float*)d_in[9]; p.out = (float*)d_out; p.ws = (unsigned char*)d_ws;
    hipMemsetAsync(d_ws, 0, 16384, stream);
    void* args[] = {&p};
    hipError_t e = hipLaunchCooperativeKernel((const void*)fwd_megakernel, dim3(grid_blocks), dim3(512), args, LDS_BYTES, stream);
    if (e != hipSuccess) fprintf(stderr, "cooperative launch failed: %s (grid %d)\n", hipGetErrorString(e), grid_blocks);
}
```

```cpp
#include <hip/hip_runtime.h>
#include <cstdio>
#include <cstdint>

#define PHM 255
#ifndef PROBE_REPS_GEMM
#define PROBE_REPS_GEMM 1
#endif
#ifndef PROBE_REPS_PREP
#define PROBE_REPS_PREP 1
#endif
#ifndef PROBE_REPS_DOUT
#define PROBE_REPS_DOUT 1
#endif
#ifndef PROBE_REPS_SWA
#define PROBE_REPS_SWA 1
#endif
#ifndef PROBE_REPS_W
#define PROBE_REPS_W 1
#endif
#define LAS __attribute__((address_space(3)))
__device__ __forceinline__ int opaque_lane() { int lane; asm volatile("v_mbcnt_lo_u32_b32 %0, -1, 0\n\tv_mbcnt_hi_u32_b32 %0, -1, %0" : "=v"(lane)); return lane; }
typedef unsigned short bf16_t;
typedef short bf16x8 __attribute__((ext_vector_type(8)));
typedef float f32x4 __attribute__((ext_vector_type(4)));
typedef unsigned u32x4 __attribute__((ext_vector_type(4)));
typedef unsigned u32x2 __attribute__((ext_vector_type(2)));
__device__ __forceinline__ u32x4 mk4(unsigned a, unsigned b, unsigned c, unsigned d) { return (u32x4){a, b, c, d}; }
__device__ __forceinline__ u32x2 mk2(unsigned a, unsigned b) { return (u32x2){a, b}; }

constexpr int NTOK = 16384, SEQ = 4096, DM = 1024, INC = 3336, NIN = 3328;
constexpr int HA_LD = 1536, HB_LD = 1792;
constexpr int HB_ZA = 0, HB_QB = 512, HB_KB = 1024, HB_VB = 1152, HB_ZB = 1280;
constexpr float DN_ALPHA = 1.41421356237f;

constexpr size_t OFF_BAR = 0;
constexpr size_t OFF_XB = 16384;
constexpr size_t OFF_WIN = OFF_XB + (size_t)NTOK * DM * 2;
constexpr size_t OFF_WOUT = OFF_WIN + (size_t)2 * NIN * DM * 2;
constexpr size_t OFF_HA = OFF_WOUT + (size_t)2 * DM * DM * 2;
constexpr size_t OFF_HB = OFF_HA + (size_t)NTOK * HA_LD * 2;
constexpr size_t OFF_UT = OFF_HB + (size_t)NTOK * HB_LD * 2;
constexpr size_t OFF_W = OFF_UT + (size_t)NTOK * 512 * 2;
constexpr size_t OFF_QD = OFF_W + (size_t)NTOK * 512 * 2;
constexpr size_t OFF_KDT = OFF_QD + (size_t)NTOK * 512 * 2;
constexpr size_t OFF_QK = OFF_KDT + (size_t)NTOK * 512 * 2;
constexpr size_t OFF_BA = OFF_QK + (size_t)NTOK * 256 * 2;
constexpr size_t OFF_GT = OFF_BA + (size_t)NTOK * 8 * 4;
constexpr size_t WS_NEED = OFF_GT + 4096;

constexpr int LDS_BYTES = 147456;
extern __shared__ __attribute__((aligned(16))) unsigned char dyn_lds[];

struct Params {
    const float* x; const float* w_in; const float* conv_w; const float* a_log; const float* dt_bias;
    const float* norm_w; const float* sinks; const float* w_out; const float* ln_g; const float* ln_b;
    float* out; unsigned char* ws;
};

typedef float f32x2_t __attribute__((ext_vector_type(2)));
typedef __bf16 bf16x2_t __attribute__((ext_vector_type(2)));
__device__ __forceinline__ unsigned cvt_pk_bf16(float lo, float hi) {
    const f32x2_t v = {lo, hi};
    const bf16x2_t r = __builtin_convertvector(v, bf16x2_t);
    return __builtin_bit_cast(unsigned, r);
}
__device__ __forceinline__ float bf_lo(unsigned u) { return __uint_as_float(u << 16); }
__device__ __forceinline__ float bf_hi(unsigned u) { return __uint_as_float(u & 0xffff0000u); }
__device__ __forceinline__ float silu_f(float x) { return x / (1.0f + __expf(-x)); }
__device__ __forceinline__ f32x4 mfma16(bf16x8 a, bf16x8 b, f32x4 c) { return __builtin_amdgcn_mfma_f32_16x16x32_bf16(a, b, c, 0, 0, 0); }
#define GPC(T) (const __attribute__((address_space(1))) T*)
#define GP(T) (__attribute__((address_space(1))) T*)
__device__ __forceinline__ bf16x8 ldg8(const bf16_t* p) { return *GPC(bf16x8)(p); }
__device__ __forceinline__ bf16x8 lds8(const unsigned char* p) { return *reinterpret_cast<const bf16x8*>(p); }

__device__ __forceinline__ int opaque_tid_(int g_wave) {
    int lane; asm volatile("v_mbcnt_lo_u32_b32 %0, -1, 0\n\tv_mbcnt_hi_u32_b32 %0, -1, %0" : "=v"(lane));
    return g_wave * 64 + lane; }
#define opaque_tid() opaque_tid_(g_wave)
__device__ __forceinline__ unsigned char* opaque_ws(unsigned char* w) { asm volatile("" : "+s"(w)); return w; }
__device__ __forceinline__ const bf16_t* uniform_ptr(const bf16_t* p) {
    const unsigned long long v = (unsigned long long)p;
    const unsigned lo = __builtin_amdgcn_readfirstlane((unsigned)v), hi = __builtin_amdgcn_readfirstlane((unsigned)(v >> 32));
    return (const bf16_t*)(((unsigned long long)hi << 32) | lo);
}

__device__ __forceinline__ float shx(float v, int m, int lane) { return __int_as_float(__builtin_amdgcn_ds_bpermute((lane ^ m) << 2, __float_as_int(v))); }

#define XB_TMO      128
#define XB_XCNT(j)  (256  + 64 * (j))
#define XB_XSUB(j)  (1280 + 64 * (j))
#define XB_XGEN(j)  (2304 + 64 * (j))
#define XB_TOP      3328
#define XB_TOPGEN   3392
#define XCD_BAR_WORDS 3456
#define XB_SPIN_CAP (1u << 20)
__device__ __forceinline__ unsigned xb_ld(unsigned* p)              { return __hip_atomic_load(p, __ATOMIC_RELAXED, __HIP_MEMORY_SCOPE_AGENT); }
__device__ __forceinline__ unsigned xb_add(unsigned* p, unsigned v) { return __hip_atomic_fetch_add(p, v, __ATOMIC_RELAXED, __HIP_MEMORY_SCOPE_AGENT); }
__device__ __forceinline__ unsigned xb_xcc_id() { return (unsigned)__builtin_amdgcn_s_getreg((3 << 11) | 20) & 0xFu; }
#define XB_SPIN(cond, bar) do { unsigned _sp = 0; while (cond) { __builtin_amdgcn_s_sleep(1); \
    if ((++_sp & 255u) == 0u) { if (xb_ld(&(bar)[XB_TMO])) break; if (_sp > XB_SPIN_CAP) { atomicAdd(&(bar)[XB_TMO], 1u); break; } } } } while (0)
struct XcdBarrier { unsigned* bar; unsigned x; volatile LAS unsigned* st; int gw; };
__device__ __forceinline__ bool xb_t0(int gw) { return gw == 0 && opaque_lane() == 0; }
__device__ __forceinline__ XcdBarrier xcd_barrier_post(unsigned* bar, volatile LAS unsigned* st, int gw) {
    XcdBarrier b; b.bar = bar; b.x = xb_xcc_id(); b.st = st; b.gw = gw;
    if (xb_t0(gw)) (void)xb_add(&bar[XB_XCNT(b.x)], 1u);
    return b;
}
__device__ __forceinline__ void xcd_barrier_complete(unsigned* bar, unsigned x, unsigned& nloc, unsigned& nx) {
    const unsigned G = gridDim.x * gridDim.y * gridDim.z;
    unsigned sum, cnt, mine, sp = 0u;
    for (;;) {
        sum = 0u; cnt = 0u; mine = 0u;
#pragma unroll
        for (unsigned j = 0; j < 16; ++j) { const unsigned c = xb_ld(&bar[XB_XCNT(j)]); sum += c; cnt += (c > 0u) ? 1u : 0u; mine = (j == x) ? c : mine; }
        if (sum == G) break;
        __builtin_amdgcn_s_sleep(1);
        if ((++sp & 255u) == 0u) { if (xb_ld(&bar[XB_TMO])) break; if (sp > XB_SPIN_CAP) { atomicAdd(&bar[XB_TMO], 1u); break; } }
    }
    nloc = mine > 0u ? mine : 1u; nx = cnt > 0u ? cnt : 1u;
}
#ifdef USE_CG
__device__ __forceinline__ void xcd_barrier(XcdBarrier& b) {
    asm volatile("s_waitcnt vmcnt(0)" ::: "memory");
    __syncthreads();
    b.x = __builtin_amdgcn_readfirstlane(b.x + gridDim.x);
    if (xb_t0(b.gw)) {
        __threadfence();
        unsigned* c = b.bar + 4000;
        xb_add(c, 1u);
        unsigned sp = 0;
        while (xb_ld(c) < b.x) { __builtin_amdgcn_s_sleep(2); if (++sp > (1u << 24)) break; }
        __threadfence();
    }
    __syncthreads();
}
#else
__device__ __forceinline__ void xcd_barrier(const XcdBarrier& b_) {
    asm volatile("s_waitcnt vmcnt(0)" ::: "memory");
    __syncthreads();
    if (xb_t0(b_.gw)) {
        XcdBarrier b = b_; b.x = xb_xcc_id();
        asm volatile("" : "+s"(b.x));
        unsigned* bar = b.bar;
        __builtin_amdgcn_s_waitcnt(0);
        unsigned nloc = b.st[0], nx = b.st[1];
        if (nloc == 0u) { xcd_barrier_complete(bar, b.x, nloc, nx); b.st[0] = nloc; b.st[1] = nx; }
        const unsigned old = xb_add(&bar[XB_XSUB(b.x)], 1u);
        const unsigned gen = old / nloc;
        if (old + 1u == (gen + 1u) * nloc) {
            __builtin_amdgcn_fence(__ATOMIC_RELEASE, "agent");
            asm volatile("s_waitcnt vmcnt(0)" ::: "memory");
            const unsigned og = xb_add(&bar[XB_TOP], 1u);
            const unsigned tg = og / nx;
            if (og + 1u == (tg + 1u) * nx) xb_add(&bar[XB_TOPGEN], 1u);
            else XB_SPIN(xb_ld(&bar[XB_TOPGEN]) == tg, bar);
            __builtin_amdgcn_fence(__ATOMIC_ACQUIRE, "agent");
            xb_add(&bar[XB_XGEN(b.x)], 1u);
            asm volatile("s_waitcnt vmcnt(0)" ::: "memory");
        } else {
            XB_SPIN(xb_ld(&bar[XB_XGEN(b.x)]) == gen, bar);
            __builtin_amdgcn_fence(__ATOMIC_ACQUIRE, "agent");
            asm volatile("s_waitcnt vmcnt(0)" ::: "memory");
        }
    }
    __syncthreads();
}

#endif

constexpr int BM = 256, BK = 64, HALF = 128, NXCD = 8, WGM = 8, HT = HALF * BK;
__device__ __forceinline__ int lds_byte(int r, int c) {
    int st = (r >> 4) * 2 + (c >> 5), rr = r & 15, cc = c & 31, ob = rr * 64 + cc * 2;
    return st * 1024 + (ob ^ (((ob >> 9) & 1) << 5));
}
__device__ __forceinline__ void stage_rc(int b, int& R, int& C) {
    int st = b / 1024, sb = b % 1024, swz = sb ^ (((sb >> 9) & 1) << 5);
    R = (st >> 1) * 16 + swz / 64; C = (st & 1) * 32 + (swz % 64) / 2;
}

struct EpiH {
    bf16_t* ha; bf16_t* hb;
    __device__ __forceinline__ void operator()(const f32x4 (&acc)[2][2][4][2], int brow, int bcol, int wr, int wc, int fr, int fq) const {
        bf16_t* base; int ld, c0;
        if (bcol < HA_LD) { base = ha; ld = HA_LD; c0 = bcol; } else { base = hb; ld = HB_LD; c0 = bcol - HA_LD; }
#pragma unroll
        for (int ai = 0; ai < 2; ++ai)
#pragma unroll
            for (int m = 0; m < 4; ++m) {
                const int row = brow + ai * HALF + wr * 64 + m * 16 + fr;
                bf16_t* rp = base + (size_t)row * ld + c0 + wc * 32 + fq * 4;
#pragma unroll
                for (int bj = 0; bj < 2; ++bj)
#pragma unroll
                    for (int n = 0; n < 2; ++n) {
                        const f32x4 v = acc[ai][bj][m][n];
                        u32x2 w; w.x = cvt_pk_bf16(v[0], v[1]); w.y = cvt_pk_bf16(v[2], v[3]);
                        *GP(u32x2)(rp + bj * HALF + n * 16) = w;
                    }
            }
    }
};
struct EpiZ {
    const float* xres; float* out;
    __device__ __forceinline__ void operator()(const f32x4 (&acc)[2][2][4][2], int brow, int bcol, int wr, int wc, int fr, int fq) const {
#pragma unroll
        for (int ai = 0; ai < 2; ++ai)
#pragma unroll
            for (int m = 0; m < 4; ++m) {
                const int row = brow + ai * HALF + wr * 64 + m * 16 + fr;
                const size_t ro = (size_t)row * DM + bcol + wc * 32 + fq * 4;
#pragma unroll
                for (int bj = 0; bj < 2; ++bj)
#pragma unroll
                    for (int n = 0; n < 2; ++n) {
                        const size_t o = ro + bj * HALF + n * 16;
                        const f32x4 r = *GPC(f32x4)(xres + o);
                        *GP(f32x4)(out + o) = r * DN_ALPHA + acc[ai][bj][m][n];
                    }
            }
    }
};

template <class Epi>
__device__ __forceinline__ void gemm_phase(const bf16_t* __restrict__ A, const bf16_t* __restrict__ Bt, int M, int N, int K, const Epi& epi, int g_wave) {
    bf16_t* shm = reinterpret_cast<bf16_t*>(dyn_lds);
#define SA(b,h) (shm+((b)*2+(h))*HT)
#define SB(b,h) (shm+(4+(b)*2+(h))*HT)
#define STAGE(P,BASE,br,kt) do{const bf16_t* _bp=uniform_ptr((BASE)+((long)(br)*K+(long)(kt)*BK)); \
    __builtin_amdgcn_global_load_lds((const unsigned*)((const char*)_bp+soff0),(unsigned*)((char*)(P)+tidx*16),16,0,0); \
    __builtin_amdgcn_global_load_lds((const unsigned*)((const char*)_bp+soff1),(unsigned*)((char*)(P)+tidx*16+8192),16,0,0);}while(0)
#define LDA(dst,b,h) for(int m=0;m<4;++m)for(int k=0;k<2;++k) \
    dst[m][k]=*reinterpret_cast<const bf16x8*>((char*)SA(b,h)+lds_byte(wr*64+m*16+fr,k*32+fq*8))
#define LDB(dst,b,h) for(int n=0;n<2;++n)for(int k=0;k<2;++k) \
    dst[n][k]=*reinterpret_cast<const bf16x8*>((char*)SB(b,h)+lds_byte(wc*32+n*16+fr,k*32+fq*8))
#define MMA(ai,bj,At,Bt_) do{__builtin_amdgcn_s_setprio(1); \
    for(int m=0;m<4;++m)for(int n=0;n<2;++n)for(int k=0;k<2;++k) \
      acc[ai][bj][m][n]=__builtin_amdgcn_mfma_f32_16x16x32_bf16(Bt_[n][k],At[m][k],acc[ai][bj][m][n],0,0,0); \
    __builtin_amdgcn_s_setprio(0);}while(0)
#define WAIT_V(n) asm volatile("s_waitcnt vmcnt(" #n ")":::"memory")
#define WAIT_L(n) asm volatile("s_waitcnt lgkmcnt(" #n ")":::"memory")
#define BAR __builtin_amdgcn_s_barrier()
#define SCHED __builtin_amdgcn_sched_barrier(0)
    const int nM = M / BM, nN = N / BM, nwg = nM * nN;
    const int tidx = opaque_tid();
    const int wid = tidx >> 6, lane = tidx & 63, wr = wid >> 2, wc = wid & 3, fr = lane & 15, fq = lane >> 4;
    const int nt = K / BK;
    unsigned soff0, soff1;
    { int r_, c_; stage_rc(tidx * 16, r_, c_); soff0 = (unsigned)(r_ * K + c_) * 2u; stage_rc(tidx * 16 + 8192, r_, c_); soff1 = (unsigned)(r_ * K + c_) * 2u; }
    for (int L = blockIdx.x; L < nwg; L += gridDim.x) {
        int wgid = L;
        { int q = nwg / NXCD, r = nwg % NXCD, xcd = wgid % NXCD, off = wgid / NXCD; wgid = (xcd < r ? xcd * (q + 1) : r * (q + 1) + (xcd - r) * q) + off; }
        const int nig = WGM * nN, gid = wgid / nig, fm = gid * WGM, gsz = min(nM - fm, WGM);
        const int pm = fm + ((wgid % nig) % gsz), pn = (wgid % nig) / gsz, brow = pm * BM, bcol = pn * BM;
        f32x4 acc[2][2][4][2] = {};
        bf16x8 At[4][2], B0[2][2], B1[2][2];
        STAGE(SB(0,0),Bt,bcol,0); STAGE(SA(0,0),A,brow,0);
        STAGE(SB(0,1),Bt,bcol+HALF,0); STAGE(SA(0,1),A,brow+HALF,0);
        if(wr==1)BAR;
        WAIT_V(4); BAR;
        STAGE(SB(1,0),Bt,bcol,1); STAGE(SA(1,0),A,brow,1); STAGE(SB(1,1),Bt,bcol+HALF,1);
        WAIT_V(6); BAR;
        for(int t=0;t<nt-2;t+=2){
            LDB(B0,0,0); SCHED; LDA(At,0,0); STAGE(SA(1,1),A,brow+HALF,t+1);
            WAIT_L(8); BAR; WAIT_L(0); MMA(0,0,At,B0); BAR; SCHED;
            LDB(B1,0,1); STAGE(SB(0,0),Bt,bcol,t+2);
            BAR; WAIT_L(0); MMA(0,1,At,B1); BAR;
            LDA(At,0,1); STAGE(SA(0,0),A,brow,t+2);
            BAR; WAIT_L(0); MMA(1,0,At,B0); BAR; SCHED;
            STAGE(SB(0,1),Bt,bcol+HALF,t+2);
            WAIT_V(6); BAR; MMA(1,1,At,B1); BAR;
            LDB(B0,1,0); SCHED; LDA(At,1,0); STAGE(SA(0,1),A,brow+HALF,t+2);
            WAIT_L(8); BAR; WAIT_L(0); MMA(0,0,At,B0); BAR; SCHED;
            LDB(B1,1,1); STAGE(SB(1,0),Bt,bcol,t+3);
            BAR; WAIT_L(0); MMA(0,1,At,B1); BAR;
            LDA(At,1,1); STAGE(SA(1,0),A,brow,t+3);
            BAR; WAIT_L(0); MMA(1,0,At,B0); BAR; SCHED;
            STAGE(SB(1,1),Bt,bcol+HALF,t+3);
            WAIT_V(6); BAR; MMA(1,1,At,B1); BAR;
        }
        { LDB(B0,0,0); LDA(At,0,0); STAGE(SA(1,1),A,brow+HALF,nt-1);
          BAR; WAIT_L(0); MMA(0,0,At,B0); BAR;
          LDB(B1,0,1); BAR; WAIT_L(0); MMA(0,1,At,B1); BAR;
          LDA(At,0,1); WAIT_V(4); BAR; WAIT_L(0); MMA(1,0,At,B0); MMA(1,1,At,B1); BAR; }
        { LDB(B0,1,0); LDA(At,1,0); WAIT_V(2); BAR; WAIT_L(0); MMA(0,0,At,B0); BAR;
          LDB(B1,1,1); WAIT_V(0); BAR; WAIT_L(0); MMA(0,1,At,B1); BAR;
          LDA(At,1,1); BAR; WAIT_L(0); MMA(1,0,At,B0); MMA(1,1,At,B1); BAR; }
        if(wr==0)BAR;
        epi(acc, brow, bcol, wr, wc, fr, fq);
        __syncthreads();
    }
#undef SA
#undef SB
#undef STAGE
#undef LDA
#undef LDB
#undef MMA
}

__device__ __forceinline__ void prep_weights(const Params& p, int g_wave) {
    bf16_t* win = reinterpret_cast<bf16_t*>(p.ws + OFF_WIN);
    bf16_t* wout = reinterpret_cast<bf16_t*>(p.ws + OFF_WOUT);
    const int gtid = blockIdx.x * 512 + opaque_tid(), gsz = gridDim.x * 512;
    const int n_in = 2 * 128 * NIN;
    for (int i = gtid; i < n_in; i += gsz) {
        const int n = i % NIN, kg = (i / NIN) % 128, l = i / (NIN * 128);
        const int sc = n < 2048 ? n : n + 8;
        const float* s = p.w_in + (size_t)l * DM * INC + (size_t)(kg * 8) * INC + sc;
        u32x4 w;
        w.x = cvt_pk_bf16(s[0], s[INC]); w.y = cvt_pk_bf16(s[2 * INC], s[3 * INC]);
        w.z = cvt_pk_bf16(s[4 * INC], s[5 * INC]); w.w = cvt_pk_bf16(s[6 * INC], s[7 * INC]);
        *GP(u32x4)(win + ((size_t)l * NIN + n) * DM + kg * 8) = w;
    }
    const int n_out = 2 * 128 * DM;
    for (int i = gtid; i < n_out; i += gsz) {
        const int n = i % DM, kg = (i / DM) % 128, l = i / (DM * 128);
        const float* s = p.w_out + (size_t)l * DM * DM + (size_t)(kg * 8) * DM + n;
        u32x4 w;
        w.x = cvt_pk_bf16(s[0], s[DM]); w.y = cvt_pk_bf16(s[2 * DM], s[3 * DM]);
        w.z = cvt_pk_bf16(s[4 * DM], s[5 * DM]); w.w = cvt_pk_bf16(s[6 * DM], s[7 * DM]);
        *GP(u32x4)(wout + ((size_t)l * DM + n) * DM + kg * 8) = w;
    }
}

__device__ __forceinline__ void row_pass(const float* src, bool ln, const float* g, const float* bta, float* dstf, bf16_t* xb, const float* wg  , float* BA, int g_wave) {
    const int tidx = opaque_tid();
    const int lane = tidx & 63;
    const int gw = blockIdx.x * 8 + (tidx >> 6), nw = gridDim.x * 8;
    float* wgs = reinterpret_cast<float*>(dyn_lds);
    if (wg) {
        for (int c = tidx; c < DM; c += 512) {
            const f32x4 w0 = *GPC(f32x4)(wg + (size_t)c * INC), w1 = *GPC(f32x4)(wg + (size_t)c * INC + 4);
            *reinterpret_cast<f32x4*>(wgs + c * 8) = w0; *reinterpret_cast<f32x4*>(wgs + c * 8 + 4) = w1;
        }
    }
    __syncthreads();
    f32x4 gg[4], bb[4];
#pragma unroll
    for (int i = 0; i < 4; ++i) { gg[i] = ln ? *GPC(f32x4)(g + i * 256 + lane * 4) : (f32x4){1.f, 1.f, 1.f, 1.f}; bb[i] = ln ? *GPC(f32x4)(bta + i * 256 + lane * 4) : (f32x4){0.f, 0.f, 0.f, 0.f}; }
    f32x4 nv[4];
    if (gw < NTOK) {
#pragma unroll
        for (int i = 0; i < 4; ++i) nv[i] = *GPC(f32x4)(src + (size_t)gw * DM + i * 256 + lane * 4);
    }
    for (int row = gw; row < NTOK; row += nw) {
        f32x4 v[4];
#pragma unroll
        for (int i = 0; i < 4; ++i) v[i] = nv[i];
        if (row + nw < NTOK) {
#pragma unroll
            for (int i = 0; i < 4; ++i) nv[i] = *GPC(f32x4)(src + (size_t)(row + nw) * DM + i * 256 + lane * 4);
        }
        if (ln) {
            float s = 0.f;
#pragma unroll
            for (int i = 0; i < 4; ++i) s += (v[i][0] + v[i][1]) + (v[i][2] + v[i][3]);
#pragma unroll
            for (int o = 32; o > 0; o >>= 1) s += shx(s, o, lane);
            const float mu = s * (1.0f / DM);
            float q = 0.f;
#pragma unroll
            for (int i = 0; i < 4; ++i) { v[i] = v[i] - mu; q += (v[i][0] * v[i][0] + v[i][1] * v[i][1]) + (v[i][2] * v[i][2] + v[i][3] * v[i][3]); }
#pragma unroll
            for (int o = 32; o > 0; o >>= 1) q += shx(q, o, lane);
            const float rstd = rsqrtf(q * (1.0f / DM) + 1e-5f);
#pragma unroll
            for (int i = 0; i < 4; ++i) v[i] = v[i] * rstd * gg[i] + bb[i];
        }
        if (dstf) {
#pragma unroll
            for (int i = 0; i < 4; ++i) *GP(f32x4)(dstf + (size_t)row * DM + i * 256 + lane * 4) = v[i];
        }
        if (xb) {
#pragma unroll
            for (int i = 0; i < 4; ++i) { u32x2 w; w.x = cvt_pk_bf16(v[i][0], v[i][1]); w.y = cvt_pk_bf16(v[i][2], v[i][3]);
                *GP(u32x2)(xb + (size_t)row * DM + i * 256 + lane * 4) = w; }
        }
        if (wg) {
            float d[8] = {0.f, 0.f, 0.f, 0.f, 0.f, 0.f, 0.f, 0.f};
#pragma unroll
            for (int i = 0; i < 4; ++i)
#pragma unroll
                for (int e = 0; e < 4; ++e) {
                    const float* wp = wgs + (i * 256 + lane * 4 + e) * 8;
                    const f32x4 w0 = *reinterpret_cast<const f32x4*>(wp), w1 = *reinterpret_cast<const f32x4*>(wp + 4);
                    const float xv = v[i][e];
                    d[0] += xv * w0[0]; d[1] += xv * w0[1]; d[2] += xv * w0[2]; d[3] += xv * w0[3];
                    d[4] += xv * w1[0]; d[5] += xv * w1[1]; d[6] += xv * w1[2]; d[7] += xv * w1[3];
                }
#pragma unroll
            for (int j = 0; j < 8; ++j) {
#pragma unroll
                for (int o = 32; o > 0; o >>= 1) d[j] += shx(d[j], o, lane);
            }
            if (lane == 0) {
                *GP(f32x4)(BA + (size_t)row * 8) = (f32x4){d[0], d[1], d[2], d[3]};
                *GP(f32x4)(BA + (size_t)row * 8 + 4) = (f32x4){d[4], d[5], d[6], d[7]};
            }
        }
    }
    __syncthreads();
}

constexpr int GRP_LDS = 73728;
constexpr int L_KRM = 0, L_QRM = 17408, L_KBGT = 34816, L_VBT = 53248, L_GC = 71680, L_BETA = 71936;
__device__ __forceinline__ void chunk_prep(const Params& p_, int l, int g_wave) {
    Params p = p_; p.ws = opaque_ws(p.ws);
    const bf16_t* HA = reinterpret_cast<const bf16_t*>(p.ws + OFF_HA);
    const float* BA = reinterpret_cast<const float*>(p.ws + OFF_BA);
    bf16_t* UT = reinterpret_cast<bf16_t*>(p.ws + OFF_UT);
    bf16_t* W = reinterpret_cast<bf16_t*>(p.ws + OFF_W);
    bf16_t* QD = reinterpret_cast<bf16_t*>(p.ws + OFF_QD);
    bf16_t* KDT = reinterpret_cast<bf16_t*>(p.ws + OFF_KDT);
    bf16_t* QK = reinterpret_cast<bf16_t*>(p.ws + OFF_QK);
    float* GT = reinterpret_cast<float*>(p.ws + OFF_GT);
    const float* cw = p.conv_w + (size_t)l * 4 * 1536;
#define CP_LANEVARS const int tid = opaque_tid(), grp = tid >> 8, gt = tid & 255, lane = tid & 63, wv = gt >> 6, fr = lane & 15, fq = lane >> 4; \
    unsigned char* lds = dyn_lds + grp * GRP_LDS; float* gc_s = reinterpret_cast<float*>(lds + L_GC); float* beta_s = reinterpret_cast<float*>(lds + L_BETA); \
    const int tg = gt >> 4, sg = gt & 15, t0 = tg * 4, c0 = sg * 8; (void)fr; (void)fq; (void)wv; (void)t0; (void)c0; (void)gc_s; (void)beta_s; (void)lane;
    for (int pi = blockIdx.x; pi < 512; pi += gridDim.x) {
        const int grp0 = opaque_tid() >> 8;
        const int hp = pi & 1, n = (pi >> 1) & 63, b = pi >> 7, h = hp * 2 + grp0;
        const int item = (b * 4 + h) * 64 + n, tok0 = b * SEQ + n * 64;
        { CP_LANEVARS
        if (wv == 0) {
            const float bv = *GPC(float)(BA + (size_t)(tok0 + lane) * 8 + h), av = *GPC(float)(BA + (size_t)(tok0 + lane) * 8 + 4 + h);
            const float beta = 1.0f / (1.0f + __expf(-bv));
            const float xx = av + p.dt_bias[l * 4 + h];
            const float sp = fmaxf(xx, 0.f) + log1pf(__expf(-fabsf(xx)));
            float gv = -__expf(p.a_log[l * 4 + h]) * sp;
#pragma unroll
            for (int o = 1; o < 64; o <<= 1) { const float t = __int_as_float(__builtin_amdgcn_ds_bpermute((lane - o) << 2, __float_as_int(gv))); if (lane >= o) gv += t; }
            gc_s[lane] = gv; beta_s[lane] = beta;
            if (lane == 63) *GP(float)(GT + item) = __expf(gv);
        } }
        __syncthreads();
        {
            CP_LANEVARS
            const float glast = gc_s[63];
            float eg[4], ek[4], be[4];
#pragma unroll
            for (int i = 0; i < 4; ++i) { const float gci = gc_s[t0 + i]; eg[i] = __expf(gci); ek[i] = __expf(glast - gci); be[i] = beta_s[t0 + i]; }
#pragma unroll
            for (int ten = 0; ten < 3; ++ten) {
                __builtin_amdgcn_sched_barrier(0);
                float raw[7][8];
#pragma unroll
                for (int r = 0; r < 7; ++r) {
                    const int tt = n * 64 + t0 - 3 + r;
                    u32x4 u = mk4(0u, 0u, 0u, 0u);
                    if (tt >= 0) u = *GPC(u32x4)(HA + (size_t)(b * SEQ + tt) * HA_LD + ten * 512 + h * 128 + c0);
                    raw[r][0] = bf_lo(u.x); raw[r][1] = bf_hi(u.x); raw[r][2] = bf_lo(u.y); raw[r][3] = bf_hi(u.y);
                    raw[r][4] = bf_lo(u.z); raw[r][5] = bf_hi(u.z); raw[r][6] = bf_lo(u.w); raw[r][7] = bf_hi(u.w);
                }
                float o[4][8];
#pragma unroll
                for (int i = 0; i < 4; ++i)
#pragma unroll
                    for (int c = 0; c < 8; ++c) o[i][c] = 0.f;
#pragma unroll
                for (int j = 0; j < 4; ++j) {
                    const float* wp = cw + (size_t)j * 1536 + ten * 512 + h * 128 + c0;
                    const f32x4 a = *GPC(f32x4)(wp), c4 = *GPC(f32x4)(wp + 4);
                    const float wj[8] = {a[0], a[1], a[2], a[3], c4[0], c4[1], c4[2], c4[3]};
#pragma unroll
                    for (int i = 0; i < 4; ++i)
#pragma unroll
                        for (int c = 0; c < 8; ++c) o[i][c] += wj[c] * raw[i + j][c];
                }
#pragma unroll
                for (int i = 0; i < 4; ++i)
#pragma unroll
                    for (int c = 0; c < 8; ++c) o[i][c] = silu_f(o[i][c]);
                if (ten < 2) {
#pragma unroll
                    for (int i = 0; i < 4; ++i) {
                        float sq = 0.f;
#pragma unroll
                        for (int c = 0; c < 8; ++c) sq += o[i][c] * o[i][c];
#pragma unroll
                        for (int off = 1; off < 16; off <<= 1) sq += shx(sq, off, lane);
                        const float rq = rsqrtf(sq + 1e-6f) * (ten == 0 ? 0.08838834764831845f : 1.0f);
#pragma unroll
                        for (int c = 0; c < 8; ++c) o[i][c] *= rq;
                    }
                }
                if (ten == 0) {
#pragma unroll
                    for (int i = 0; i < 4; ++i) {
                        u32x4 w;
                        w.x = cvt_pk_bf16(o[i][0] * eg[i], o[i][1] * eg[i]); w.y = cvt_pk_bf16(o[i][2] * eg[i], o[i][3] * eg[i]);
                        w.z = cvt_pk_bf16(o[i][4] * eg[i], o[i][5] * eg[i]); w.w = cvt_pk_bf16(o[i][6] * eg[i], o[i][7] * eg[i]);
                        *GP(u32x4)(QD + (size_t)(tok0 + t0 + i) * 512 + h * 128 + c0) = w;
                        w.x = cvt_pk_bf16(o[i][0], o[i][1]); w.y = cvt_pk_bf16(o[i][2], o[i][3]); w.z = cvt_pk_bf16(o[i][4], o[i][5]); w.w = cvt_pk_bf16(o[i][6], o[i][7]);
                        *reinterpret_cast<u32x4*>(lds + L_QRM + ((t0 + i) * 136 + c0) * 2) = w;
                    }
                } else if (ten == 1) {
#pragma unroll
                    for (int i = 0; i < 4; ++i) {
                        u32x4 w;
                        w.x = cvt_pk_bf16(o[i][0], o[i][1]); w.y = cvt_pk_bf16(o[i][2], o[i][3]); w.z = cvt_pk_bf16(o[i][4], o[i][5]); w.w = cvt_pk_bf16(o[i][6], o[i][7]);
                        *reinterpret_cast<u32x4*>(lds + L_KRM + ((t0 + i) * 136 + c0) * 2) = w;
                    }
#pragma unroll
                    for (int c = 0; c < 8; ++c) {
                        u32x2 w;
                        w.x = cvt_pk_bf16(o[0][c] * ek[0], o[1][c] * ek[1]); w.y = cvt_pk_bf16(o[2][c] * ek[2], o[3][c] * ek[3]);
                        *GP(u32x2)(KDT + (size_t)item * 8192 + (c0 + c) * 64 + t0) = w;
                        w.x = cvt_pk_bf16(o[0][c] * be[0] * eg[0], o[1][c] * be[1] * eg[1]); w.y = cvt_pk_bf16(o[2][c] * be[2] * eg[2], o[3][c] * be[3] * eg[3]);
                        *reinterpret_cast<u32x2*>(lds + L_KBGT + ((c0 + c) * 72 + t0) * 2) = w;
                    }
                } else {
#pragma unroll
                    for (int c = 0; c < 8; ++c) {
                        u32x2 w;
                        w.x = cvt_pk_bf16(o[0][c] * be[0], o[1][c] * be[1]); w.y = cvt_pk_bf16(o[2][c] * be[2], o[3][c] * be[3]);
                        *reinterpret_cast<u32x2*>(lds + L_VBT + ((c0 + c) * 72 + t0) * 2) = w;
                    }
                }
            }
        }
        __syncthreads();
        {
            CP_LANEVARS
            const int ib = wv;
            f32x4 kk[4], qk[4];
#pragma unroll
            for (int jb = 0; jb < 4; ++jb) { kk[jb] = (f32x4){0.f, 0.f, 0.f, 0.f}; qk[jb] = (f32x4){0.f, 0.f, 0.f, 0.f}; }
            bf16x8 ki[4], qi[4];
#pragma unroll
            for (int ks = 0; ks < 4; ++ks) {
                ki[ks] = lds8(lds + L_KRM + ((ib * 16 + fr) * 136 + ks * 32 + fq * 8) * 2);
                qi[ks] = lds8(lds + L_QRM + ((ib * 16 + fr) * 136 + ks * 32 + fq * 8) * 2);
            }
#pragma unroll
            for (int jb = 0; jb < 4; ++jb) {
                if (jb <= ib) {
#pragma unroll
                    for (int ks = 0; ks < 4; ++ks) {
                        const bf16x8 kj = lds8(lds + L_KRM + ((jb * 16 + fr) * 136 + ks * 32 + fq * 8) * 2);
                        kk[jb] = mfma16(ki[ks], kj, kk[jb]);
                        qk[jb] = mfma16(kj, qi[ks], qk[jb]);
                    }
                }
            }
            __syncthreads();
            float* AP = reinterpret_cast<float*>(lds + L_KRM);
#pragma unroll
            for (int jb = 0; jb < 4; ++jb) {
                if (jb <= ib) {
                    const int j = jb * 16 + fr, i0 = ib * 16 + fq * 4;
                    const float gj = gc_s[j];
#pragma unroll
                    for (int r = 0; r < 4; ++r) {
                        const int i = i0 + r;
                        const float dec = __expf(fminf(gc_s[i] - gj, 0.f));
                        float av_ = (i > j) ? kk[jb][r] * beta_s[i] * dec : 0.f;
#ifdef DIAG3
                        atomicMax(reinterpret_cast<unsigned*>(p.ws + OFF_BAR) + 4011, __float_as_uint(fabsf(kk[jb][r])));
                        atomicMax(reinterpret_cast<unsigned*>(p.ws + OFF_BAR) + 4012, __float_as_uint(fabsf(av_)));
#endif
#ifdef CLAMP_A
                        if (!(fabsf(av_) <= 0.02f)) av_ = 0.f;
#endif
                        AP[j * 64 + r * 16 + ib * 4 + fq] = av_;
                    }
                }
                {
                    const int i = ib * 16 + fr, j0 = jb * 16 + fq * 4;
                    const float gi = gc_s[i];
                    float o[4];
#pragma unroll
                    for (int r = 0; r < 4; ++r) {
                        const int j = j0 + r;
                        const float dec = __expf(fminf(gi - gc_s[j], 0.f));
                        o[r] = (i >= j) ? qk[jb][r] * dec : 0.f;
                    }
                    u32x2 w; w.x = cvt_pk_bf16(o[0], o[1]); w.y = cvt_pk_bf16(o[2], o[3]);
                    *GP(u32x2)(QK + (size_t)(tok0 + i) * 256 + h * 64 + j0) = w;
                }
            }
        }
        __syncthreads();
        {
            CP_LANEVARS
            const float* AP = reinterpret_cast<const float*>(lds + L_KRM);
            const int cl = lane >> 2, pp = lane & 3, ccol = wv * 16 + cl;
            float a[16];
#pragma unroll
            for (int k = 0; k < 16; ++k) a[k] = (4 * k + pp == ccol) ? 1.f : 0.f;
#define INV_STEP(SS) { const int j = jq * 4 + SS; \
                    const float tj = __int_as_float(__builtin_amdgcn_update_dpp(0, __float_as_int(a[jq]), SS * 0x55, 0xf, 0xf, false)); \
                    const float* ap = AP + j * 64 + pp * 16; \
                    _Pragma("unroll") for (int k = jq; k < 16; ++k) a[k] -= ap[k] * tj; }
#pragma unroll
            for (int jq = 0; jq < 16; ++jq) {
                __builtin_amdgcn_sched_barrier(0);
#ifdef NO_INV
                if (false) {
#else
                if (jq >= wv * 4) {
#endif
                    INV_STEP(0) INV_STEP(1) INV_STEP(2)
                    if (jq < 15) INV_STEP(3)
                }
            }
#undef INV_STEP
#ifdef DIAG3
            { float mx = 0.f;
              for (int k = 0; k < 16; ++k) { const float av = fabsf(a[k]); mx = (av > mx || !(av == av)) ? av : mx; }
              atomicMax(reinterpret_cast<unsigned*>(p.ws + OFF_BAR) + 4010, __float_as_uint(mx)); }
#endif
            bf16_t* TR = reinterpret_cast<bf16_t*>(lds + L_QRM);
#pragma unroll
            for (int k = 0; k < 16; ++k) TR[(4 * k + pp) * 72 + ccol] = (bf16_t)(cvt_pk_bf16(a[k], 0.f) & 0xffffu);
        }
        __syncthreads();
        {
            CP_LANEVARS
            bf16x8 tf[2];
#pragma unroll
            for (int ks = 0; ks < 2; ++ks) tf[ks] = lds8(lds + L_QRM + ((wv * 16 + fr) * 72 + ks * 32 + fq * 8) * 2);
#pragma unroll
            for (int db = 0; db < 8; ++db) {
                f32x4 au = (f32x4){0.f, 0.f, 0.f, 0.f}, aw = (f32x4){0.f, 0.f, 0.f, 0.f};
#pragma unroll
                for (int ks = 0; ks < 2; ++ks) {
                    const bf16x8 vb = lds8(lds + L_VBT + ((db * 16 + fr) * 72 + ks * 32 + fq * 8) * 2);
                    const bf16x8 kb = lds8(lds + L_KBGT + ((db * 16 + fr) * 72 + ks * 32 + fq * 8) * 2);
                    au = mfma16(tf[ks], vb, au);
                    aw = mfma16(kb, tf[ks], aw);
                }
                u32x2 w; w.x = cvt_pk_bf16(au[0], au[1]); w.y = cvt_pk_bf16(au[2], au[3]);
                *GP(u32x2)(UT + (size_t)item * 8192 + (db * 16 + fr) * 64 + wv * 16 + fq * 4) = w;
                w.x = cvt_pk_bf16(aw[0], aw[1]); w.y = cvt_pk_bf16(aw[2], aw[3]);
                *GP(u32x2)(W + (size_t)(tok0 + wv * 16 + fr) * 512 + h * 128 + db * 16 + fq * 4) = w;
            }
        }
        __syncthreads();
    }
}

__device__ __forceinline__ void delta_scan(const Params& p_, int blk, int g_wave) {
    Params p = p_; p.ws = opaque_ws(p.ws);
    const int tid = opaque_tid(), lane = tid & 63, w = tid >> 6, fr = lane & 15, fq = lane >> 4;
    const int bh = blk >> 2, sl = blk & 3, b = bh >> 2, h = bh & 3, dv0 = sl * 32;
    bf16_t* ST = reinterpret_cast<bf16_t*>(p.ws + OFF_HA);
    bf16_t* UT = reinterpret_cast<bf16_t*>(p.ws + OFF_UT);
    const bf16_t* W = reinterpret_cast<const bf16_t*>(p.ws + OFF_W);
    const bf16_t* KDT = reinterpret_cast<const bf16_t*>(p.ws + OFF_KDT);
    const float* GT = reinterpret_cast<const float*>(p.ws + OFF_GT);
    unsigned char* STL = dyn_lds;
    unsigned char* VTL = dyn_lds + 8704;
#define LDS_BAR() do { asm volatile("s_waitcnt lgkmcnt(0)" ::: "memory"); __builtin_amdgcn_s_barrier(); asm volatile("" ::: "memory"); } while (0)
    if (w >= 4) {
        constexpr int PD = 10;
        const int pl = (w - 4) * 64 + lane;
        __syncthreads();
        for (int n = -PD; n < 64; ++n) {
            const int nn = n + PD;
            if (nn < 64) {
                const int item_ = bh * 64 + nn, tok_ = b * SEQ + nn * 64;
                const unsigned char* a0;
                if (pl < 128) a0 = reinterpret_cast<const unsigned char*>(W + (size_t)(tok_ + (pl >> 1)) * 512 + h * 128) + (pl & 1) * 128;
                else a0 = reinterpret_cast<const unsigned char*>(KDT + (size_t)item_ * 8192) + (pl - 128) * 128;
                __builtin_amdgcn_global_load_lds((const unsigned*)a0, (unsigned*)(dyn_lds + 16384 + (w - 4) * 512), 4, 0, 0);
                if (w == 4) {
                    const unsigned char* a1 = reinterpret_cast<const unsigned char*>(UT + (size_t)item_ * 8192 + (dv0 + (lane & 31)) * 64);
                    __builtin_amdgcn_global_load_lds((const unsigned*)a1, (unsigned*)(dyn_lds + 16384 + (w - 4) * 512 + 256), 4, 0, 0);
                }
            }
            if (n >= 0) {
                const int item = bh * 64 + n;
                __builtin_amdgcn_s_barrier();
                {
                    const int row = pl >> 3, seg = pl & 7;
                    const u32x4 v = *reinterpret_cast<const u32x4*>(VTL + (row * 72 + seg * 8) * 2);
                    *GP(u32x4)(UT + (size_t)item * 8192 + (dv0 + row) * 64 + seg * 8) = v;
                }
                asm volatile("s_waitcnt lgkmcnt(0)" ::: "memory");
                __builtin_amdgcn_s_barrier();
                if (n < 63) {
#pragma unroll
                    for (int j = 0; j < 2; ++j) {
                        const int q = pl + 256 * j, row = q >> 4, seg = q & 15;
                        const u32x4 v = *reinterpret_cast<const u32x4*>(STL + (row * 136 + seg * 8) * 2);
                        *GP(u32x4)(ST + (size_t)(item + 1) * 16384 + (dv0 + row) * 128 + seg * 8) = v;
                    }
                }
                asm volatile("s_waitcnt lgkmcnt(0)" ::: "memory");
            }
        }
        asm volatile("s_waitcnt vmcnt(0)" ::: "memory");
    } else {
        f32x4 S[2][2];
#pragma unroll
        for (int kb = 0; kb < 2; ++kb)
#pragma unroll
            for (int db = 0; db < 2; ++db) {
                S[kb][db] = (f32x4){0.f, 0.f, 0.f, 0.f};
                const u32x2 z = mk2(0u, 0u);
                *reinterpret_cast<u32x2*>(STL + ((db * 16 + fr) * 136 + (2 * w + kb) * 16 + fq * 4) * 2) = z;
                *GP(u32x2)(ST + (size_t)(bh * 64) * 16384 + (dv0 + db * 16 + fr) * 128 + (2 * w + kb) * 16 + fq * 4) = z;
            }
        __syncthreads();
#define SCAN_LOAD(NN, WF, KF, UB, GTV) do { const int item_ = bh * 64 + (NN), tok_ = b * SEQ + (NN) * 64; \
        _Pragma("unroll") for (int ks = 0; ks < 4; ++ks) WF[ks] = ldg8(W + (size_t)(tok_ + w * 16 + fr) * 512 + h * 128 + ks * 32 + fq * 8); \
        _Pragma("unroll") for (int kb = 0; kb < 2; ++kb) _Pragma("unroll") for (int ks = 0; ks < 2; ++ks) KF[kb][ks] = ldg8(KDT + (size_t)item_ * 8192 + ((2 * w + kb) * 16 + fr) * 64 + ks * 32 + fq * 8); \
        _Pragma("unroll") for (int db = 0; db < 2; ++db) UB[db] = *GPC(u32x2)(UT + (size_t)item_ * 8192 + (dv0 + db * 16 + fr) * 64 + w * 16 + fq * 4); \
        GTV = *GPC(float)(GT + item_); } while (0)
        bf16x8 wfA[4], kfA[2][2], wfB[4], kfB[2][2], wfC[4], kfC[2][2];
        u32x2 ubA[2], ubB[2], ubC[2]; float gtA, gtB, gtC;
        SCAN_LOAD(0, wfA, kfA, ubA, gtA); SCAN_LOAD(1, wfB, kfB, ubB, gtB);
#define SCAN_STEP(N_, WF, KF, UB, GTV, NWF, NKF, NUB, NGT) do { \
        const int n = (N_); \
        { const int nn = n + 2 < 64 ? n + 2 : 63; SCAN_LOAD(nn, NWF, NKF, NUB, NGT); } \
        { bf16x8 sb_[2][4]; \
          _Pragma("unroll") for (int db = 0; db < 2; ++db) _Pragma("unroll") for (int ks = 0; ks < 4; ++ks) sb_[db][ks] = lds8(STL + ((db * 16 + fr) * 136 + ks * 32 + fq * 8) * 2); \
          f32x4 a10 = (f32x4){0.f, 0.f, 0.f, 0.f}, a11 = (f32x4){0.f, 0.f, 0.f, 0.f}; \
          _Pragma("unroll") for (int ks = 0; ks < 4; ++ks) { a10 = mfma16(WF[ks], sb_[0][ks], a10); a11 = mfma16(WF[ks], sb_[1][ks], a11); } \
          _Pragma("unroll") for (int db = 0; db < 2; ++db) { \
              const f32x4 a1 = db ? a11 : a10; u32x2 vw; \
              vw.x = cvt_pk_bf16(bf_lo(UB[db].x) - a1[0], bf_hi(UB[db].x) - a1[1]); vw.y = cvt_pk_bf16(bf_lo(UB[db].y) - a1[2], bf_hi(UB[db].y) - a1[3]); \
              *reinterpret_cast<u32x2*>(VTL + ((db * 16 + fr) * 72 + w * 16 + fq * 4) * 2) = vw; \
              } } \
        LDS_BAR(); \
        { bf16x8 vb_[2][2]; \
          _Pragma("unroll") for (int db = 0; db < 2; ++db) _Pragma("unroll") for (int ks = 0; ks < 2; ++ks) vb_[db][ks] = lds8(VTL + ((db * 16 + fr) * 72 + ks * 32 + fq * 8) * 2); \
          _Pragma("unroll") for (int kb = 0; kb < 2; ++kb) _Pragma("unroll") for (int db = 0; db < 2; ++db) { \
              f32x4 a2 = S[kb][db] * GTV; \
              a2 = mfma16(KF[kb][0], vb_[db][0], a2); a2 = mfma16(KF[kb][1], vb_[db][1], a2); \
              S[kb][db] = a2; \
              if (n < 63) { \
                  u32x2 sw; sw.x = cvt_pk_bf16(a2[0], a2[1]); sw.y = cvt_pk_bf16(a2[2], a2[3]); \
                  *reinterpret_cast<u32x2*>(STL + ((db * 16 + fr) * 136 + (2 * w + kb) * 16 + fq * 4) * 2) = sw; \
              } } } \
        LDS_BAR(); } while (0)
        for (int n3 = 0; n3 < 63; n3 += 3) {
            SCAN_STEP(n3 + 0, wfA, kfA, ubA, gtA, wfC, kfC, ubC, gtC);
            SCAN_STEP(n3 + 1, wfB, kfB, ubB, gtB, wfA, kfA, ubA, gtA);
            SCAN_STEP(n3 + 2, wfC, kfC, ubC, gtC, wfB, kfB, ubB, gtB);
        }
        SCAN_STEP(63, wfA, kfA, ubA, gtA, wfC, kfC, ubC, gtC);
#undef SCAN_STEP
#undef SCAN_LOAD
    }
#undef LDS_BAR
}

__device__ __forceinline__ void swa_phase(const Params& p_, int l, int sblk, int nsb, int g_wave) {
    Params p = p_; p.ws = opaque_ws(p.ws);
    const int tid = opaque_tid(), lane = tid & 63, w = tid >> 6, fr = lane & 15, fq = lane >> 4;
    const bf16_t* HB = reinterpret_cast<const bf16_t*>(p.ws + OFF_HB);
    bf16_t* YM = reinterpret_cast<bf16_t*>(p.ws + OFF_XB);
    unsigned char* VTS = dyn_lds;
    for (int it = sblk; it < 1024; it += nsb) {
        const int b = it >> 8, kvh = (it >> 7) & 1, qt = it & 127, q0 = qt * 32, kbase = q0 - 128;
        for (int idx = tid; idx < 1280; idx += 512) {
            const int key = idx >> 3, ds = idx & 7, kp = kbase + key;
            u32x4 u = mk4(0u, 0u, 0u, 0u);
            if (kp >= 0) u = *GPC(u32x4)(HB + (size_t)(b * SEQ + kp) * HB_LD + HB_VB + kvh * 64 + ds * 8);
            bf16_t* d = reinterpret_cast<bf16_t*>(VTS) + (ds * 8) * 168 + key;
            d[0 * 168] = (bf16_t)(u.x & 0xffffu); d[1 * 168] = (bf16_t)(u.x >> 16);
            d[2 * 168] = (bf16_t)(u.y & 0xffffu); d[3 * 168] = (bf16_t)(u.y >> 16);
            d[4 * 168] = (bf16_t)(u.z & 0xffffu); d[5 * 168] = (bf16_t)(u.z >> 16);
            d[6 * 168] = (bf16_t)(u.w & 0xffffu); d[7 * 168] = (bf16_t)(u.w >> 16);
        }
        const int g = w >> 1, sub = w & 1, qs = q0 + sub * 16, hq = kvh * 4 + g;
        const float slope = exp2f(-(float)(hq + 1)), sink = p.sinks[l * 8 + hq];
        bf16x8 qf[2];
#pragma unroll
        for (int ks = 0; ks < 2; ++ks) qf[ks] = ldg8(HB + (size_t)(b * SEQ + qs + fr) * HB_LD + HB_QB + hq * 64 + ks * 32 + fq * 8);
        f32x4 sc[10];
#pragma unroll
        for (int kt = 0; kt < 10; ++kt) {
            int kp = kbase + kt * 16 + fr; kp = kp < 0 ? 0 : kp;
            const bf16_t* kr = HB + (size_t)(b * SEQ + kp) * HB_LD + HB_KB + kvh * 64 + fq * 8;
            f32x4 a = (f32x4){0.f, 0.f, 0.f, 0.f};
            a = mfma16(ldg8(kr), qf[0], a);
            a = mfma16(ldg8(kr + 32), qf[1], a);
            sc[kt] = a;
        }
        const int qpos = qs + fr;
        float m = -1e30f;
#pragma unroll
        for (int kt = 0; kt < 10; ++kt)
#pragma unroll
            for (int r = 0; r < 4; ++r) {
                const int kpos = kbase + kt * 16 + fq * 4 + r, dist = qpos - kpos;
                const bool valid = (dist >= 0) && (dist < 128) && (kpos >= 0);
                const float s = valid ? sc[kt][r] * 0.125f - slope * (float)dist : -1e30f;
                sc[kt][r] = s; m = fmaxf(m, s);
            }
        m = fmaxf(m, shx(m, 16, lane)); m = fmaxf(m, shx(m, 32, lane));
        m = fmaxf(m, sink);
        float lsum = 0.f;
#pragma unroll
        for (int kt = 0; kt < 10; ++kt)
#pragma unroll
            for (int r = 0; r < 4; ++r) { const float e = __expf(sc[kt][r] - m); sc[kt][r] = e; lsum += e; }
        lsum += shx(lsum, 16, lane); lsum += shx(lsum, 32, lane);
        lsum += __expf(sink - m);
        const float inv = 1.0f / lsum;
        __syncthreads();
        f32x4 o[4];
#pragma unroll
        for (int db = 0; db < 4; ++db) o[db] = (f32x4){0.f, 0.f, 0.f, 0.f};
#pragma unroll
        for (int j = 0; j < 5; ++j) {
            union { bf16x8 v; unsigned u[4]; } pf;
            pf.u[0] = cvt_pk_bf16(sc[2 * j][0], sc[2 * j][1]); pf.u[1] = cvt_pk_bf16(sc[2 * j][2], sc[2 * j][3]);
            pf.u[2] = cvt_pk_bf16(sc[2 * j + 1][0], sc[2 * j + 1][1]); pf.u[3] = cvt_pk_bf16(sc[2 * j + 1][2], sc[2 * j + 1][3]);
#pragma unroll
            for (int db = 0; db < 4; ++db) {
                union { bf16x8 v; u32x2 h[2]; } vf;
                const unsigned char* vr = VTS + ((db * 16 + fr) * 168 + (2 * j) * 16 + fq * 4) * 2;
                vf.h[0] = *reinterpret_cast<const u32x2*>(vr);
                vf.h[1] = *reinterpret_cast<const u32x2*>(vr + 32);
                o[db] = mfma16(vf.v, pf.v, o[db]);
            }
        }
        {
            const size_t tok = (size_t)(b * SEQ + qs + fr);
#pragma unroll
            for (int db = 0; db < 4; ++db) {
                const int col = hq * 64 + db * 16 + fq * 4;
                const u32x2 z = *GPC(u32x2)(HB + tok * HB_LD + HB_ZB + col);
                u32x2 y;
                y.x = cvt_pk_bf16(o[db][0] * inv * silu_f(bf_lo(z.x)), o[db][1] * inv * silu_f(bf_hi(z.x)));
                y.y = cvt_pk_bf16(o[db][2] * inv * silu_f(bf_lo(z.y)), o[db][3] * inv * silu_f(bf_hi(z.y)));
                *GP(u32x2)(YM + tok * DM + 512 + col) = y;
            }
        }
        __syncthreads();
    }
}

__device__ __forceinline__ void delta_out(const Params& p_, int l, int g_wave) {
    Params p = p_; p.ws = opaque_ws(p.ws);
    const int tid = opaque_tid(), grp = tid >> 8, lane = tid & 63, wv = (tid & 255) >> 6, fr = lane & 15, fq = lane >> 4;
    const bf16_t* ST = reinterpret_cast<const bf16_t*>(p.ws + OFF_HA);
    const bf16_t* VT = reinterpret_cast<const bf16_t*>(p.ws + OFF_UT);
    const bf16_t* QD = reinterpret_cast<const bf16_t*>(p.ws + OFF_QD);
    const bf16_t* QK = reinterpret_cast<const bf16_t*>(p.ws + OFF_QK);
    const bf16_t* HB = reinterpret_cast<const bf16_t*>(p.ws + OFF_HB);
    bf16_t* YM = reinterpret_cast<bf16_t*>(p.ws + OFF_XB);
    const float* nw = p.norm_w + l * 128;
    for (int pi = blockIdx.x; pi < 512; pi += gridDim.x) {
        const int item = pi * 2 + grp, bh = item >> 6, n = item & 63, b = bh >> 2, h = bh & 3;
        const int tok = b * SEQ + n * 64 + wv * 16 + fr;
        bf16x8 qd[4], qk[2];
#pragma unroll
        for (int ks = 0; ks < 4; ++ks) qd[ks] = ldg8(QD + (size_t)tok * 512 + h * 128 + ks * 32 + fq * 8);
#pragma unroll
        for (int ks = 0; ks < 2; ++ks) qk[ks] = ldg8(QK + (size_t)tok * 256 + h * 64 + ks * 32 + fq * 8);
        f32x4 o[8];
        float ss = 0.f;
#pragma unroll
        for (int db = 0; db < 8; ++db) {
            if ((db & 1) == 0) __builtin_amdgcn_sched_barrier(0);
            f32x4 a = (f32x4){0.f, 0.f, 0.f, 0.f};
            const bf16_t* sp = ST + (size_t)item * 16384 + (db * 16 + fr) * 128 + fq * 8;
#pragma unroll
            for (int ks = 0; ks < 4; ++ks) a = mfma16(ldg8(sp + ks * 32), qd[ks], a);
            const bf16_t* vp = VT + (size_t)item * 8192 + (db * 16 + fr) * 64 + fq * 8;
#pragma unroll
            for (int ks = 0; ks < 2; ++ks) a = mfma16(ldg8(vp + ks * 32), qk[ks], a);
            o[db] = a;
            ss += (a[0] * a[0] + a[1] * a[1]) + (a[2] * a[2] + a[3] * a[3]);
        }
        ss += shx(ss, 16, lane); ss += shx(ss, 32, lane);
        const float rs = rsqrtf(ss * (1.0f / 128.0f) + 1e-6f);
#pragma unroll
        for (int db = 0; db < 8; ++db) {
            const int dv = db * 16 + fq * 4;
            const f32x4 nv = *GPC(f32x4)(nw + dv);
            const u32x2 z = *GPC(u32x2)(HB + (size_t)tok * HB_LD + HB_ZA + h * 128 + dv);
            u32x2 y;
            y.x = cvt_pk_bf16(o[db][0] * rs * nv[0] * silu_f(bf_lo(z.x)), o[db][1] * rs * nv[1] * silu_f(bf_hi(z.x)));
            y.y = cvt_pk_bf16(o[db][2] * rs * nv[2] * silu_f(bf_lo(z.y)), o[db][3] * rs * nv[3] * silu_f(bf_hi(z.y)));
            *GP(u32x2)(YM + (size_t)tok * DM + h * 128 + dv) = y;
        }
    }
}


__device__ __forceinline__ void diag_rows(const bf16_t* YM, float* out, int g_wave) {
    const int tidx = opaque_tid();
    const int lane = tidx & 63;
    const int gw = blockIdx.x * 8 + (tidx >> 6), nw = gridDim.x * 8;
    for (int row = gw; row < NTOK; row += nw) {
        float ca = 0.f, cb = 0.f;
        for (int i = 0; i < 16; ++i) {
            const int col = i * 64 + lane;
            const float v = bf_lo((unsigned)YM[(size_t)row * DM + col]);
            const bool bad = !(fabsf(v) < 1e30f);
            if (bad) { if (col < 512) ca += 1.f; else cb += 1.f; }
        }
        for (int o = 32; o > 0; o >>= 1) { ca += shx(ca, o, lane); cb += shx(cb, o, lane); }
        for (int i = 0; i < 16; ++i) out[(size_t)row * DM + i * 64 + lane] = 0.f;
        if (lane == 0) out[(size_t)row * DM] = (ca > 0.f ? 1e6f : 0.f) + (cb > 0.f ? 1e5f : 0.f);
    }
}


__device__ __forceinline__ void diag_prep(unsigned char* ws, float* out, int g_wave) {
    const int tidx = opaque_tid();
    const int lane = tidx & 63;
    const int gw = blockIdx.x * 8 + (tidx >> 6), nw = gridDim.x * 8;
    const bf16_t* UT = reinterpret_cast<const bf16_t*>(ws + OFF_UT);
    const bf16_t* W = reinterpret_cast<const bf16_t*>(ws + OFF_W);
    const bf16_t* QD = reinterpret_cast<const bf16_t*>(ws + OFF_QD);
    const bf16_t* KDT = reinterpret_cast<const bf16_t*>(ws + OFF_KDT);
    const bf16_t* QK = reinterpret_cast<const bf16_t*>(ws + OFF_QK);
    const float* GT = reinterpret_cast<const float*>(ws + OFF_GT);
    const float* BA = reinterpret_cast<const float*>(ws + OFF_BA);
    for (int row = gw; row < NTOK; row += nw) {
        float c[6] = {0.f, 0.f, 0.f, 0.f, 0.f, 0.f};
        for (int i = 0; i < 8; ++i) {
            const size_t o = (size_t)row * 512 + i * 64 + lane;
            if (!(fabsf(bf_lo((unsigned)UT[o])) < 1e30f)) c[0] += 1.f;
            if (!(fabsf(bf_lo((unsigned)W[o])) < 1e30f)) c[1] += 1.f;
            if (!(fabsf(bf_lo((unsigned)QD[o])) < 1e30f)) c[2] += 1.f;
            if (!(fabsf(bf_lo((unsigned)KDT[o])) < 1e30f)) c[3] += 1.f;
        }
        for (int i = 0; i < 4; ++i) if (!(fabsf(bf_lo((unsigned)QK[(size_t)row * 256 + i * 64 + lane])) < 1e30f)) c[4] += 1.f;
        if (row < 1024 && lane == 0 && !(fabsf(GT[row]) < 1e30f)) c[5] += 1.f;
        if (lane < 8 && !(fabsf(BA[(size_t)row * 8 + lane]) < 1e30f)) c[5] += 1.f;
        for (int j = 0; j < 6; ++j) for (int o = 32; o > 0; o >>= 1) c[j] += shx(c[j], o, lane);
        unsigned bits = 0;
        for (int j = 0; j < 6; ++j) if (c[j] > 0.f) bits |= (1u << j);
        if (lane == 0 && bits) atomicOr(reinterpret_cast<unsigned*>(ws + OFF_BAR) + 4020, bits);
        for (int i = 0; i < 16; ++i) out[(size_t)row * DM + i * 64 + lane] = 0.f;
    }
}

__global__ void __launch_bounds__(512) fwd_megakernel(Params p) {
    __shared__ u32x4 xb_words;
    const int g_wave = __builtin_amdgcn_readfirstlane((int)(threadIdx.x >> 6));
    if (xb_t0(g_wave)) xb_words = mk4(0u, 0u, 0u, 0u);
    __syncthreads();
    XcdBarrier gb = xcd_barrier_post(reinterpret_cast<unsigned*>(p.ws + OFF_BAR), (volatile LAS unsigned*)&xb_words, g_wave);
#ifdef USE_CG
    gb.x = 0;
#endif

#ifndef PHM
#define PHM 255
#endif
    { int reps_ = PROBE_REPS_W; asm volatile("" : "+s"(reps_)); for (int rep_ = 0; rep_ < reps_; ++rep_) prep_weights(p, g_wave); }
    if (PHM & 2) row_pass(p.x, false, nullptr, nullptr, nullptr, reinterpret_cast<bf16_t*>(p.ws + OFF_XB), p.w_in + 2048, reinterpret_cast<float*>(p.ws + OFF_BA), g_wave);
    xcd_barrier(gb);
    for (int l = 0; l < 2; ++l) {
        unsigned char* wsl = opaque_ws(p.ws);
        bf16_t* XB = reinterpret_cast<bf16_t*>(wsl + OFF_XB);
        float* BA = reinterpret_cast<float*>(wsl + OFF_BA);
        {
            EpiH e; e.ha = reinterpret_cast<bf16_t*>(p.ws + OFF_HA); e.hb = reinterpret_cast<bf16_t*>(p.ws + OFF_HB);
            { int reps = PROBE_REPS_GEMM; asm volatile("" : "+s"(reps));
              for (int rep = 0; rep < reps; ++rep) { gemm_phase(XB, reinterpret_cast<const bf16_t*>(p.ws + OFF_WIN) + (size_t)l * NIN * DM, NTOK, NIN, DM, e, g_wave); } }
        }
        xcd_barrier(gb);
        { int reps_ = PROBE_REPS_PREP; asm volatile("" : "+s"(reps_)); for (int rep_ = 0; rep_ < reps_; ++rep_) { if (PHM & 8) chunk_prep(p, l, g_wave); __syncthreads(); } }
        xcd_barrier(gb);
#ifdef DIAG2
        if (l == 0) { diag_prep(wsl, p.out, g_wave); xcd_barrier(gb);
            if (blockIdx.x == 0 && opaque_tid() == 0) p.out[0] = 1000.f * (float)reinterpret_cast<const unsigned*>(wsl + OFF_BAR)[4020];
            return; }
#endif
#ifdef DIAG3
        if (l == 0) {
            const int tidx = opaque_tid();
            const unsigned* dw = reinterpret_cast<const unsigned*>(wsl + OFF_BAR);
            for (size_t i = (size_t)blockIdx.x * 512 + tidx; i < (size_t)NTOK * DM; i += (size_t)gridDim.x * 512) {
                float v = 0.f;
                if (i == 0) v = fminf(__uint_as_float(dw[4010]), 1e37f) * DIAG3_S0;
                if (i == 1) v = fminf(__uint_as_float(dw[4011]), 1e37f) * DIAG3_S1;
                if (i == 2) v = fminf(__uint_as_float(dw[4012]), 1e37f) * DIAG3_S2;
                p.out[i] = v;
            }
            return;
        }
#endif
        if (blockIdx.x < 64) { if (PHM & 16) delta_scan(p, blockIdx.x, g_wave); }
        else { int reps_ = PROBE_REPS_SWA; asm volatile("" : "+s"(reps_)); for (int rep_ = 0; rep_ < reps_; ++rep_) swa_phase(p, l, blockIdx.x - 64, gridDim.x - 64, g_wave); }
        xcd_barrier(gb);
#ifdef DIAG4
        if (l == 0) {
            const int tidx = opaque_tid();
            const unsigned* dw = reinterpret_cast<const unsigned*>(wsl + OFF_BAR);
            for (size_t i = (size_t)blockIdx.x * 512 + tidx; i < (size_t)NTOK * DM; i += (size_t)gridDim.x * 512) {
                float v = 0.f;
                if (i == 0) v = fminf(__uint_as_float(dw[4013]), 1e37f) * DIAG4_S0;
                if (i == 1) v = fminf(__uint_as_float(dw[4014]), 1e37f) * DIAG4_S1;
                p.out[i] = v;
            }
            return;
        }
#endif
        { int reps_ = PROBE_REPS_DOUT; asm volatile("" : "+s"(reps_)); for (int rep_ = 0; rep_ < reps_; ++rep_) { if (PHM & 64) delta_out(p, l, g_wave); __syncthreads(); } }
        xcd_barrier(gb);
#ifdef DIAG1
        if (l == DIAG1 - 1) { diag_rows(XB, p.out, g_wave); return; }
#endif
        {
            EpiZ e; e.xres = (l == 0) ? p.x : p.out; e.out = p.out;
            if (PHM & 128) gemm_phase(XB, reinterpret_cast<const bf16_t*>(p.ws + OFF_WOUT) + (size_t)l * DM * DM, NTOK, DM, DM, e, g_wave);
        }
        xcd_barrier(gb);
        if (l == 0) row_pass(p.out, true, p.ln_g, p.ln_b, p.out, XB, p.w_in + (size_t)DM * INC + 2048, BA, g_wave);
        else        row_pass(p.out, true, p.ln_g + DM, p.ln_b + DM, p.out, nullptr, nullptr, nullptr, g_wave);
        if (l == 0) xcd_barrier(gb);
    }
}

extern "C" void kernel_launch(void* const* d_in, const int* in_sizes, int n_in, void* d_out, int out_size, void* d_ws, size_t ws_size, hipStream_t stream) {
    static int grid_blocks = 0;
    if (!grid_blocks) {
        int dev = 0, cus = 0, per_cu = 0;
        hipGetDevice(&dev);
        hipDeviceGetAttribute(&cus, hipDeviceAttributeMultiprocessorCount, dev);
        hipFuncSetAttribute((const void*)fwd_megakernel, hipFuncAttributeMaxDynamicSharedMemorySize, LDS_BYTES);
        hipOccupancyMaxActiveBlocksPerMultiprocessor(&per_cu, fwd_megakernel, 512, LDS_BYTES);
        grid_blocks = (per_cu >= 1) ? cus : 0;
        if (grid_blocks > 256) grid_blocks = 256;
        if (ws_size < WS_NEED) { fprintf(stderr, "workspace too small: %zu < %zu\n", ws_size, (size_t)WS_NEED); }
        if (!grid_blocks) { fprintf(stderr, "occupancy query returned 0\n"); grid_blocks = 256; }
    }
    Params p{};
    p.x = (const float*)d_in[0]; p.w_in = (const float*)d_in[1]; p.conv_w = (const float*)d_in[2]; p.a_log = (const float*)d_in[3];
    p.dt_bias = (const float*)d_in[4]; p.norm_w = (const float*)d_in[5]; p.sinks = (const float*)d_in[6]; p.w_out = (const float*)d_in[7];
    p.ln_g = (const float*)d_in[8]; p.ln_b = (const float*)d_in[9]; p.out = (float*)d_out; p.ws = (unsigned char*)d_ws;
    hipMemsetAsync(d_ws, 0, 16384, stream);
    void* args[] = {&p};
    hipError_t e = hipLaunchCooperativeKernel((const void*)fwd_megakernel, dim3(grid_blocks), dim3(512), args, LDS_BYTES, stream);
    if (e != hipSuccess) fprintf(stderr, "cooperative launch failed: %s (grid %d)\n", hipGetErrorString(e), grid_blocks);
}
```

```cpp
#include <hip/hip_runtime.h>
#include <cstdio>
#include <cstdint>

#define PHM 255
#ifndef PROBE_REPS_GEMM
#define PROBE_REPS_GEMM 1
#endif
#ifndef PROBE_REPS_PREP
#define PROBE_REPS_PREP 1
#endif
#ifndef PROBE_REPS_DOUT
#define PROBE_REPS_DOUT 1
#endif
#ifndef PROBE_REPS_SWA
#define PROBE_REPS_SWA 1
#endif
#ifndef PROBE_REPS_W
#define PROBE_REPS_W 1
#endif
#define LAS __attribute__((address_space(3)))
__device__ __forceinline__ int opaque_lane() { int lane; asm volatile("v_mbcnt_lo_u32_b32 %0, -1, 0\n\tv_mbcnt_hi_u32_b32 %0, -1, %0" : "=v"(lane)); return lane; }
typedef unsigned short bf16_t;
typedef short bf16x8 __attribute__((ext_vector_type(8)));
typedef float f32x4 __attribute__((ext_vector_type(4)));
typedef unsigned u32x4 __attribute__((ext_vector_type(4)));
typedef unsigned u32x2 __attribute__((ext_vector_type(2)));
__device__ __forceinline__ u32x4 mk4(unsigned a, unsigned b, unsigned c, unsigned d) { return (u32x4){a, b, c, d}; }
__device__ __forceinline__ u32x2 mk2(unsigned a, unsigned b) { return (u32x2){a, b}; }

constexpr int NTOK = 16384, SEQ = 4096, DM = 1024, INC = 3336, NIN = 3328;
constexpr int HA_LD = 1536, HB_LD = 1792;
constexpr int HB_ZA = 0, HB_QB = 512, HB_KB = 1024, HB_VB = 1152, HB_ZB = 1280;
constexpr float DN_ALPHA = 1.41421356237f;

constexpr size_t OFF_BAR = 0;
constexpr size_t OFF_XB = 16384;
constexpr size_t OFF_WIN = OFF_XB + (size_t)NTOK * DM * 2;
constexpr size_t OFF_WOUT = OFF_WIN + (size_t)2 * NIN * DM * 2;
constexpr size_t OFF_HA = OFF_WOUT + (size_t)2 * DM * DM * 2;
constexpr size_t OFF_HB = OFF_HA + (size_t)NTOK * HA_LD * 2;
constexpr size_t OFF_UT = OFF_HB + (size_t)NTOK * HB_LD * 2;
constexpr size_t OFF_W = OFF_UT + (size_t)NTOK * 512 * 2;
constexpr size_t OFF_QD = OFF_W + (size_t)NTOK * 512 * 2;
constexpr size_t OFF_KDT = OFF_QD + (size_t)NTOK * 512 * 2;
constexpr size_t OFF_QK = OFF_KDT + (size_t)NTOK * 512 * 2;
constexpr size_t OFF_BA = OFF_QK + (size_t)NTOK * 256 * 2;
constexpr size_t OFF_GT = OFF_BA + (size_t)NTOK * 8 * 4;
constexpr size_t WS_NEED = OFF_GT + 4096;

constexpr int LDS_BYTES = 147456;
extern __shared__ __attribute__((aligned(16))) unsigned char dyn_lds[];

struct Params {
    const float* x; const float* w_in; const float* conv_w; const float* a_log; const float* dt_bias;
    const float* norm_w; const float* sinks; const float* w_out; const float* ln_g; const float* ln_b;
    float* out; unsigned char* ws;
};

typedef float f32x2_t __attribute__((ext_vector_type(2)));
typedef __bf16 bf16x2_t __attribute__((ext_vector_type(2)));
__device__ __forceinline__ unsigned cvt_pk_bf16(float lo, float hi) {
    const f32x2_t v = {lo, hi};
    const bf16x2_t r = __builtin_convertvector(v, bf16x2_t);
    return __builtin_bit_cast(unsigned, r);
}
__device__ __forceinline__ float bf_lo(unsigned u) { return __uint_as_float(u << 16); }
__device__ __forceinline__ float bf_hi(unsigned u) { return __uint_as_float(u & 0xffff0000u); }
__device__ __forceinline__ float silu_f(float x) { return x / (1.0f + __expf(-x)); }
__device__ __forceinline__ f32x4 mfma16(bf16x8 a, bf16x8 b, f32x4 c) { return __builtin_amdgcn_mfma_f32_16x16x32_bf16(a, b, c, 0, 0, 0); }
#define GPC(T) (const __attribute__((address_space(1))) T*)
#define GP(T) (__attribute__((address_space(1))) T*)
__device__ __forceinline__ bf16x8 ldg8(const bf16_t* p) { return *GPC(bf16x8)(p); }
__device__ __forceinline__ bf16x8 lds8(const unsigned char* p) { return *reinterpret_cast<const bf16x8*>(p); }

__device__ __forceinline__ int opaque_tid_(int g_wave) {
    int lane; asm volatile("v_mbcnt_lo_u32_b32 %0, -1, 0\n\tv_mbcnt_hi_u32_b32 %0, -1, %0" : "=v"(lane));
    return g_wave * 64 + lane; }
#define opaque_tid() opaque_tid_(g_wave)
__device__ __forceinline__ unsigned char* opaque_ws(unsigned char* w) { asm volatile("" : "+s"(w)); return w; }
__device__ __forceinline__ const bf16_t* uniform_ptr(const bf16_t* p) {
    const unsigned long long v = (unsigned long long)p;
    const unsigned lo = __builtin_amdgcn_readfirstlane((unsigned)v), hi = __builtin_amdgcn_readfirstlane((unsigned)(v >> 32));
    return (const bf16_t*)(((unsigned long long)hi << 32) | lo);
}

__device__ __forceinline__ float shx(float v, int m, int lane) { return __int_as_float(__builtin_amdgcn_ds_bpermute((lane ^ m) << 2, __float_as_int(v))); }

#define XB_TMO      128
#define XB_XCNT(j)  (256  + 64 * (j))
#define XB_XSUB(j)  (1280 + 64 * (j))
#define XB_XGEN(j)  (2304 + 64 * (j))
#define XB_TOP      3328
#define XB_TOPGEN   3392
#define XCD_BAR_WORDS 3456
#define XB_SPIN_CAP (1u << 20)
__device__ __forceinline__ unsigned xb_ld(unsigned* p)              { return __hip_atomic_load(p, __ATOMIC_RELAXED, __HIP_MEMORY_SCOPE_AGENT); }
__device__ __forceinline__ unsigned xb_add(unsigned* p, unsigned v) { return __hip_atomic_fetch_add(p, v, __ATOMIC_RELAXED, __HIP_MEMORY_SCOPE_AGENT); }
__device__ __forceinline__ unsigned xb_xcc_id() { return (unsigned)__builtin_amdgcn_s_getreg((3 << 11) | 20) & 0xFu; }
#define XB_SPIN(cond, bar) do { unsigned _sp = 0; while (cond) { __builtin_amdgcn_s_sleep(1); \
    if ((++_sp & 255u) == 0u) { if (xb_ld(&(bar)[XB_TMO])) break; if (_sp > XB_SPIN_CAP) { atomicAdd(&(bar)[XB_TMO], 1u); break; } } } } while (0)
struct XcdBarrier { unsigned* bar; unsigned x; volatile LAS unsigned* st; int gw; };
__device__ __forceinline__ bool xb_t0(int gw) { return gw == 0 && opaque_lane() == 0; }
__device__ __forceinline__ XcdBarrier xcd_barrier_post(unsigned* bar, volatile LAS unsigned* st, int gw) {
    XcdBarrier b; b.bar = bar; b.x = xb_xcc_id(); b.st = st; b.gw = gw;
    if (xb_t0(gw)) (void)xb_add(&bar[XB_XCNT(b.x)], 1u);
    return b;
}
__device__ __forceinline__ void xcd_barrier_complete(unsigned* bar, unsigned x, unsigned& nloc, unsigned& nx) {
    const unsigned G = gridDim.x * gridDim.y * gridDim.z;
    unsigned sum, cnt, mine, sp = 0u;
    for (;;) {
        sum = 0u; cnt = 0u; mine = 0u;
#pragma unroll
        for (unsigned j = 0; j < 16; ++j) { const unsigned c = xb_ld(&bar[XB_XCNT(j)]); sum += c; cnt += (c > 0u) ? 1u : 0u; mine = (j == x) ? c : mine; }
        if (sum == G) break;
        __builtin_amdgcn_s_sleep(1);
        if ((++sp & 255u) == 0u) { if (xb_ld(&bar[XB_TMO])) break; if (sp > XB_SPIN_CAP) { atomicAdd(&bar[XB_TMO], 1u); break; } }
    }
    nloc = mine > 0u ? mine : 1u; nx = cnt > 0u ? cnt : 1u;
}
#ifdef USE_CG
__device__ __forceinline__ void xcd_barrier(XcdBarrier& b) {
    asm volatile("s_waitcnt vmcnt(0)" ::: "memory");
    __syncthreads();
    b.x = __builtin_amdgcn_readfirstlane(b.x + gridDim.x);
    if (xb_t0(b.gw)) {
        __threadfence();
        unsigned* c = b.bar + 4000;
        xb_add(c, 1u);
        unsigned sp = 0;
        while (xb_ld(c) < b.x) { __builtin_amdgcn_s_sleep(2); if (++sp > (1u << 24)) break; }
        __threadfence();
    }
    __syncthreads();
}
#else
__device__ __forceinline__ void xcd_barrier(const XcdBarrier& b_) {
    asm volatile("s_waitcnt vmcnt(0)" ::: "memory");
    __syncthreads();
    if (xb_t0(b_.gw)) {
        XcdBarrier b = b_; b.x = xb_xcc_id();
        asm volatile("" : "+s"(b.x));
        unsigned* bar = b.bar;
        __builtin_amdgcn_s_waitcnt(0);
        unsigned nloc = b.st[0], nx = b.st[1];
        if (nloc == 0u) { xcd_barrier_complete(bar, b.x, nloc, nx); b.st[0] = nloc; b.st[1] = nx; }
        const unsigned old = xb_add(&bar[XB_XSUB(b.x)], 1u);
        const unsigned gen = old / nloc;
        if (old + 1u == (gen + 1u) * nloc) {
            __builtin_amdgcn_fence(__ATOMIC_RELEASE, "agent");
            asm volatile("s_waitcnt vmcnt(0)" ::: "memory");
            const unsigned og = xb_add(&bar[XB_TOP], 1u);
            const unsigned tg = og / nx;
            if (og + 1u == (tg + 1u) * nx) xb_add(&bar[XB_TOPGEN], 1u);
            else XB_SPIN(xb_ld(&bar[XB_TOPGEN]) == tg, bar);
            __builtin_amdgcn_fence(__ATOMIC_ACQUIRE, "agent");
            xb_add(&bar[XB_XGEN(b.x)], 1u);
            asm volatile("s_waitcnt vmcnt(0)" ::: "memory");
        } else {
            XB_SPIN(xb_ld(&bar[XB_XGEN(b.x)]) == gen, bar);
            __builtin_amdgcn_fence(__ATOMIC_ACQUIRE, "agent");
            asm volatile("s_waitcnt vmcnt(0)" ::: "memory");
        }
    }
    __syncthreads();
}

#endif

constexpr int BM = 256, BK = 64, HALF = 128, NXCD = 8, WGM = 8, HT = HALF * BK;
__device__ __forceinline__ int lds_byte(int r, int c) {
    int st = (r >> 4) * 2 + (c >> 5), rr = r & 15, cc = c & 31, ob = rr * 64 + cc * 2;
    return st * 1024 + (ob ^ (((ob >> 9) & 1) << 5));
}
__device__ __forceinline__ void stage_rc(int b, int& R, int& C) {
    int st = b / 1024, sb = b % 1024, swz = sb ^ (((sb >> 9) & 1) << 5);
    R = (st >> 1) * 16 + swz / 64; C = (st & 1) * 32 + (swz % 64) / 2;
}

struct EpiH {
    bf16_t* ha; bf16_t* hb;
    __device__ __forceinline__ void operator()(const f32x4 (&acc)[2][2][4][2], int brow, int bcol, int wr, int wc, int fr, int fq) const {
        bf16_t* base; int ld, c0;
        if (bcol < HA_LD) { base = ha; ld = HA_LD; c0 = bcol; } else { base = hb; ld = HB_LD; c0 = bcol - HA_LD; }
#pragma unroll
        for (int ai = 0; ai < 2; ++ai)
#pragma unroll
            for (int m = 0; m < 4; ++m) {
                const int row = brow + ai * HALF + wr * 64 + m * 16 + fr;
                bf16_t* rp = base + (size_t)row * ld + c0 + wc * 32 + fq * 4;
#pragma unroll
                for (int bj = 0; bj < 2; ++bj)
#pragma unroll
                    for (int n = 0; n < 2; ++n) {
                        const f32x4 v = acc[ai][bj][m][n];
                        u32x2 w; w.x = cvt_pk_bf16(v[0], v[1]); w.y = cvt_pk_bf16(v[2], v[3]);
                        *GP(u32x2)(rp + bj * HALF + n * 16) = w;
                    }
            }
    }
};
struct EpiZ {
    const float* xres; float* out;
    __device__ __forceinline__ void operator()(const f32x4 (&acc)[2][2][4][2], int brow, int bcol, int wr, int wc, int fr, int fq) const {
#pragma unroll
        for (int ai = 0; ai < 2; ++ai)
#pragma unroll
            for (int m = 0; m < 4; ++m) {
                const int row = brow + ai * HALF + wr * 64 + m * 16 + fr;
                const size_t ro = (size_t)row * DM + bcol + wc * 32 + fq * 4;
#pragma unroll
                for (int bj = 0; bj < 2; ++bj)
#pragma unroll
                    for (int n = 0; n < 2; ++n) {
                        const size_t o = ro + bj * HALF + n * 16;
                        const f32x4 r = *GPC(f32x4)(xres + o);
                        *GP(f32x4)(out + o) = r * DN_ALPHA + acc[ai][bj][m][n];
                    }
            }
    }
};

template <class Epi>
__device__ __forceinline__ void gemm_phase(const bf16_t* __restrict__ A, const bf16_t* __restrict__ Bt, int M, int N, int K, const Epi& epi, int g_wave) {
    bf16_t* shm = reinterpret_cast<bf16_t*>(dyn_lds);
#define SA(b,h) (shm+((b)*2+(h))*HT)
#define SB(b,h) (shm+(4+(b)*2+(h))*HT)
#define STAGE(P,BASE,br,kt) do{const bf16_t* _bp=uniform_ptr((BASE)+((long)(br)*K+(long)(kt)*BK)); \
    __builtin_amdgcn_global_load_lds((const unsigned*)((const char*)_bp+soff0),(unsigned*)((char*)(P)+tidx*16),16,0,0); \
    __builtin_amdgcn_global_load_lds((const unsigned*)((const char*)_bp+soff1),(unsigned*)((char*)(P)+tidx*16+8192),16,0,0);}while(0)
#define LDA(dst,b,h) for(int m=0;m<4;++m)for(int k=0;k<2;++k) \
    dst[m][k]=*reinterpret_cast<const bf16x8*>((char*)SA(b,h)+lds_byte(wr*64+m*16+fr,k*32+fq*8))
#define LDB(dst,b,h) for(int n=0;n<2;++n)for(int k=0;k<2;++k) \
    dst[n][k]=*reinterpret_cast<const bf16x8*>((char*)SB(b,h)+lds_byte(wc*32+n*16+fr,k*32+fq*8))
#define MMA(ai,bj,At,Bt_) do{__builtin_amdgcn_s_setprio(1); \
    for(int m=0;m<4;++m)for(int n=0;n<2;++n)for(int k=0;k<2;++k) \
      acc[ai][bj][m][n]=__builtin_amdgcn_mfma_f32_16x16x32_bf16(Bt_[n][k],At[m][k],acc[ai][bj][m][n],0,0,0); \
    __builtin_amdgcn_s_setprio(0);}while(0)
#define WAIT_V(n) asm volatile("s_waitcnt vmcnt(" #n ")":::"memory")
#define WAIT_L(n) asm volatile("s_waitcnt lgkmcnt(" #n ")":::"memory")
#define BAR __builtin_amdgcn_s_barrier()
#define SCHED __builtin_amdgcn_sched_barrier(0)
    const int nM = M / BM, nN = N / BM, nwg = nM * nN;
    const int tidx = opaque_tid();
    const int wid = tidx >> 6, lane = tidx & 63, wr = wid >> 2, wc = wid & 3, fr = lane & 15, fq = lane >> 4;
    const int nt = K / BK;
    unsigned soff0, soff1;
    { int r_, c_; stage_rc(tidx * 16, r_, c_); soff0 = (unsigned)(r_ * K + c_) * 2u; stage_rc(tidx * 16 + 8192, r_, c_); soff1 = (unsigned)(r_ * K + c_) * 2u; }
    for (int L = blockIdx.x; L < nwg; L += gridDim.x) {
        int wgid = L;
        { int q = nwg / NXCD, r = nwg % NXCD, xcd = wgid % NXCD, off = wgid / NXCD; wgid = (xcd < r ? xcd * (q + 1) : r * (q + 1) + (xcd - r) * q) + off; }
        const int nig = WGM * nN, gid = wgid / nig, fm = gid * WGM, gsz = min(nM - fm, WGM);
        const int pm = fm + ((wgid % nig) % gsz), pn = (wgid % nig) / gsz, brow = pm * BM, bcol = pn * BM;
        f32x4 acc[2][2][4][2] = {};
        bf16x8 At[4][2], B0[2][2], B1[2][2];
        STAGE(SB(0,0),Bt,bcol,0); STAGE(SA(0,0),A,brow,0);
        STAGE(SB(0,1),Bt,bcol+HALF,0); STAGE(SA(0,1),A,brow+HALF,0);
        if(wr==1)BAR;
        WAIT_V(4); BAR;
        STAGE(SB(1,0),Bt,bcol,1); STAGE(SA(1,0),A,brow,1); STAGE(SB(1,1),Bt,bcol+HALF,1);
        WAIT_V(6); BAR;
        for(int t=0;t<nt-2;t+=2){
            LDB(B0,0,0); SCHED; LDA(At,0,0); STAGE(SA(1,1),A,brow+HALF,t+1);
            WAIT_L(8); BAR; WAIT_L(0); MMA(0,0,At,B0); BAR; SCHED;
            LDB(B1,0,1); STAGE(SB(0,0),Bt,bcol,t+2);
            BAR; WAIT_L(0); MMA(0,1,At,B1); BAR;
            LDA(At,0,1); STAGE(SA(0,0),A,brow,t+2);
            BAR; WAIT_L(0); MMA(1,0,At,B0); BAR; SCHED;
            STAGE(SB(0,1),Bt,bcol+HALF,t+2);
            WAIT_V(6); BAR; MMA(1,1,At,B1); BAR;
            LDB(B0,1,0); SCHED; LDA(At,1,0); STAGE(SA(0,1),A,brow+HALF,t+2);
            WAIT_L(8); BAR; WAIT_L(0); MMA(0,0,At,B0); BAR; SCHED;
            LDB(B1,1,1); STAGE(SB(1,0),Bt,bcol,t+3);
            BAR; WAIT_L(0); MMA(0,1,At,B1); BAR;
            LDA(At,1,1); STAGE(SA(1,0),A,brow,t+3);
            BAR; WAIT_L(0); MMA(1,0,At,B0); BAR; SCHED;
            STAGE(SB(1,1),Bt,bcol+HALF,t+3);
            WAIT_V(6); BAR; MMA(1,1,At,B1); BAR;
        }
        { LDB(B0,0,0); LDA(At,0,0); STAGE(SA(1,1),A,brow+HALF,nt-1);
          BAR; WAIT_L(0); MMA(0,0,At,B0); BAR;
          LDB(B1,0,1); BAR; WAIT_L(0); MMA(0,1,At,B1); BAR;
          LDA(At,0,1); WAIT_V(4); BAR; WAIT_L(0); MMA(1,0,At,B0); MMA(1,1,At,B1); BAR; }
        { LDB(B0,1,0); LDA(At,1,0); WAIT_V(2); BAR; WAIT_L(0); MMA(0,0,At,B0); BAR;
          LDB(B1,1,1); WAIT_V(0); BAR; WAIT_L(0); MMA(0,1,At,B1); BAR;
          LDA(At,1,1); BAR; WAIT_L(0); MMA(1,0,At,B0); MMA(1,1,At,B1); BAR; }
        if(wr==0)BAR;
        epi(acc, brow, bcol, wr, wc, fr, fq);
        __syncthreads();
    }
#undef SA
#undef SB
#undef STAGE
#undef LDA
#undef LDB
#undef MMA
}

__device__ __forceinline__ void prep_weights(const Params& p, int g_wave) {
    bf16_t* win = reinterpret_cast<bf16_t*>(p.ws + OFF_WIN);
    bf16_t* wout = reinterpret_cast<bf16_t*>(p.ws + OFF_WOUT);
    const int gtid = blockIdx.x * 512 + opaque_tid(), gsz = gridDim.x * 512;
    const int n_in = 2 * 128 * NIN;
    for (int i = gtid; i < n_in; i += gsz) {
        const int n = i % NIN, kg = (i / NIN) % 128, l = i / (NIN * 128);
        const int sc = n < 2048 ? n : n + 8;
        const float* s = p.w_in + (size_t)l * DM * INC + (size_t)(kg * 8) * INC + sc;
        u32x4 w;
        w.x = cvt_pk_bf16(s[0], s[INC]); w.y = cvt_pk_bf16(s[2 * INC], s[3 * INC]);
        w.z = cvt_pk_bf16(s[4 * INC], s[5 * INC]); w.w = cvt_pk_bf16(s[6 * INC], s[7 * INC]);
        *GP(u32x4)(win + ((size_t)l * NIN + n) * DM + kg * 8) = w;
    }
    const int n_out = 2 * 128 * DM;
    for (int i = gtid; i < n_out; i += gsz) {
        const int n = i % DM, kg = (i / DM) % 128, l = i / (DM * 128);
        const float* s = p.w_out + (size_t)l * DM * DM + (size_t)(kg * 8) * DM + n;
        u32x4 w;
        w.x = cvt_pk_bf16(s[0], s[DM]); w.y = cvt_pk_bf16(s[2 * DM], s[3 * DM]);
        w.z = cvt_pk_bf16(s[4 * DM], s[5 * DM]); w.w = cvt_pk_bf16(s[6 * DM], s[7 * DM]);
        *GP(u32x4)(wout + ((size_t)l * DM + n) * DM + kg * 8) = w;
    }
}

__device__ __forceinline__ void row_pass(const float* src, bool ln, const float* g, const float* bta, float* dstf, bf16_t* xb, const float* wg  , float* BA, int g_wave) {
    const int tidx = opaque_tid();
    const int lane = tidx & 63;
    const int gw = blockIdx.x * 8 + (tidx >> 6), nw = gridDim.x * 8;
    float* wgs = reinterpret_cast<float*>(dyn_lds);
    if (wg) {
        for (int c = tidx; c < DM; c += 512) {
            const f32x4 w0 = *GPC(f32x4)(wg + (size_t)c * INC), w1 = *GPC(f32x4)(wg + (size_t)c * INC + 4);
            *reinterpret_cast<f32x4*>(wgs + c * 8) = w0; *reinterpret_cast<f32x4*>(wgs + c * 8 + 4) = w1;
        }
    }
    __syncthreads();
    f32x4 gg[4], bb[4];
#pragma unroll
    for (int i = 0; i < 4; ++i) { gg[i] = ln ? *GPC(f32x4)(g + i * 256 + lane * 4) : (f32x4){1.f, 1.f, 1.f, 1.f}; bb[i] = ln ? *GPC(f32x4)(bta + i * 256 + lane * 4) : (f32x4){0.f, 0.f, 0.f, 0.f}; }
    f32x4 nv[4];
    if (gw < NTOK) {
#pragma unroll
        for (int i = 0; i < 4; ++i) nv[i] = *GPC(f32x4)(src + (size_t)gw * DM + i * 256 + lane * 4);
    }
    for (int row = gw; row < NTOK; row += nw) {
        f32x4 v[4];
#pragma unroll
        for (int i = 0; i < 4; ++i) v[i] = nv[i];
        if (row + nw < NTOK) {
#pragma unroll
            for (int i = 0; i < 4; ++i) nv[i] = *GPC(f32x4)(src + (size_t)(row + nw) * DM + i * 256 + lane * 4);
        }
        if (ln) {
            float s = 0.f;
#pragma unroll
            for (int i = 0; i < 4; ++i) s += (v[i][0] + v[i][1]) + (v[i][2] + v[i][3]);
#pragma unroll
            for (int o = 32; o > 0; o >>= 1) s += shx(s, o, lane);
            const float mu = s * (1.0f / DM);
            float q = 0.f;
#pragma unroll
            for (int i = 0; i < 4; ++i) { v[i] = v[i] - mu; q += (v[i][0] * v[i][0] + v[i][1] * v[i][1]) + (v[i][2] * v[i][2] + v[i][3] * v[i][3]); }
#pragma unroll
            for (int o = 32; o > 0; o >>= 1) q += shx(q, o, lane);
            const float rstd = rsqrtf(q * (1.0f / DM) + 1e-5f);
#pragma unroll
            for (int i = 0; i < 4; ++i) v[i] = v[i] * rstd * gg[i] + bb[i];
        }
        if (dstf) {
#pragma unroll
            for (int i = 0; i < 4; ++i) *GP(f32x4)(dstf + (size_t)row * DM + i * 256 + lane * 4) = v[i];
        }
        if (xb) {
#pragma unroll
            for (int i = 0; i < 4; ++i) { u32x2 w; w.x = cvt_pk_bf16(v[i][0], v[i][1]); w.y = cvt_pk_bf16(v[i][2], v[i][3]);
                *GP(u32x2)(xb + (size_t)row * DM + i * 256 + lane * 4) = w; }
        }
        if (wg) {
            float d[8] = {0.f, 0.f, 0.f, 0.f, 0.f, 0.f, 0.f, 0.f};
#pragma unroll
            for (int i = 0; i < 4; ++i)
#pragma unroll
                for (int e = 0; e < 4; ++e) {
                    const float* wp = wgs + (i * 256 + lane * 4 + e) * 8;
                    const f32x4 w0 = *reinterpret_cast<const f32x4*>(wp), w1 = *reinterpret_cast<const f32x4*>(wp + 4);
                    const float xv = v[i][e];
                    d[0] += xv * w0[0]; d[1] += xv * w0[1]; d[2] += xv * w0[2]; d[3] += xv * w0[3];
                    d[4] += xv * w1[0]; d[5] += xv * w1[1]; d[6] += xv * w1[2]; d[7] += xv * w1[3];
                }
#pragma unroll
            for (int j = 0; j < 8; ++j) {
#pragma unroll
                for (int o = 32; o > 0; o >>= 1) d[j] += shx(d[j], o, lane);
            }
            if (lane == 0) {
                *GP(f32x4)(BA + (size_t)row * 8) = (f32x4){d[0], d[1], d[2], d[3]};
                *GP(f32x4)(BA + (size_t)row * 8 + 4) = (f32x4){d[4], d[5], d[6], d[7]};
            }
        }
    }
    __syncthreads();
}

constexpr int GRP_LDS = 73728;
constexpr int L_KRM = 0, L_QRM = 17408, L_KBGT = 34816, L_VBT = 53248, L_GC = 71680, L_BETA = 71936;
__device__ __forceinline__ void chunk_prep(const Params& p_, int l, int g_wave) {
    Params p = p_; p.ws = opaque_ws(p.ws);
    const bf16_t* HA = reinterpret_cast<const bf16_t*>(p.ws + OFF_HA);
    const float* BA = reinterpret_cast<const float*>(p.ws + OFF_BA);
    bf16_t* UT = reinterpret_cast<bf16_t*>(p.ws + OFF_UT);
    bf16_t* W = reinterpret_cast<bf16_t*>(p.ws + OFF_W);
    bf16_t* QD = reinterpret_cast<bf16_t*>(p.ws + OFF_QD);
    bf16_t* KDT = reinterpret_cast<bf16_t*>(p.ws + OFF_KDT);
    bf16_t* QK = reinterpret_cast<bf16_t*>(p.ws + OFF_QK);
    float* GT = reinterpret_cast<float*>(p.ws + OFF_GT);
    const float* cw = p.conv_w + (size_t)l * 4 * 1536;
#define CP_LANEVARS const int tid = opaque_tid(), grp = tid >> 8, gt = tid & 255, lane = tid & 63, wv = gt >> 6, fr = lane & 15, fq = lane >> 4; \
    unsigned char* lds = dyn_lds + grp * GRP_LDS; float* gc_s = reinterpret_cast<float*>(lds + L_GC); float* beta_s = reinterpret_cast<float*>(lds + L_BETA); \
    const int tg = gt >> 4, sg = gt & 15, t0 = tg * 4, c0 = sg * 8; (void)fr; (void)fq; (void)wv; (void)t0; (void)c0; (void)gc_s; (void)beta_s; (void)lane;
    for (int pi = blockIdx.x; pi < 512; pi += gridDim.x) {
        const int grp0 = opaque_tid() >> 8;
        const int hp = pi & 1, n = (pi >> 1) & 63, b = pi >> 7, h = hp * 2 + grp0;
        const int item = (b * 4 + h) * 64 + n, tok0 = b * SEQ + n * 64;
        u32x4 rawp[3][7];
        { CP_LANEVARS
#pragma unroll
          for (int ten = 0; ten < 3; ++ten)
#pragma unroll
            for (int r = 0; r < 7; ++r) {
                const int tt = n * 64 + t0 - 3 + r;
                rawp[ten][r] = mk4(0u, 0u, 0u, 0u);
                if (tt >= 0) rawp[ten][r] = *GPC(u32x4)(HA + (size_t)(b * SEQ + tt) * HA_LD + ten * 512 + h * 128 + c0);
            } }
        { CP_LANEVARS
        if (wv == 0) {
            const float bv = *GPC(float)(BA + (size_t)(tok0 + lane) * 8 + h), av = *GPC(float)(BA + (size_t)(tok0 + lane) * 8 + 4 + h);
            const float beta = 1.0f / (1.0f + __expf(-bv));
            const float xx = av + p.dt_bias[l * 4 + h];
            const float sp = fmaxf(xx, 0.f) + log1pf(__expf(-fabsf(xx)));
            float gv = -__expf(p.a_log[l * 4 + h]) * sp;
#pragma unroll
            for (int o = 1; o < 64; o <<= 1) { const float t = __int_as_float(__builtin_amdgcn_ds_bpermute((lane - o) << 2, __float_as_int(gv))); if (lane >= o) gv += t; }
            gc_s[lane] = gv; beta_s[lane] = beta;
            if (lane == 63) *GP(float)(GT + item) = __expf(gv);
        } }
        __syncthreads();
        {
            CP_LANEVARS
            const float glast = gc_s[63];
            float eg[4], ek[4], be[4];
#pragma unroll
            for (int i = 0; i < 4; ++i) { const float gci = gc_s[t0 + i]; eg[i] = __expf(gci); ek[i] = __expf(glast - gci); be[i] = beta_s[t0 + i]; }
#pragma unroll
            for (int ten = 0; ten < 3; ++ten) {
                __builtin_amdgcn_sched_barrier(0);
                float raw[7][8];
#pragma unroll
                for (int r = 0; r < 7; ++r) {
                    const u32x4 u = rawp[ten][r];
                    raw[r][0] = bf_lo(u.x); raw[r][1] = bf_hi(u.x); raw[r][2] = bf_lo(u.y); raw[r][3] = bf_hi(u.y);
                    raw[r][4] = bf_lo(u.z); raw[r][5] = bf_hi(u.z); raw[r][6] = bf_lo(u.w); raw[r][7] = bf_hi(u.w);
                }
                float o[4][8];
#pragma unroll
                for (int i = 0; i < 4; ++i)
#pragma unroll
                    for (int c = 0; c < 8; ++c) o[i][c] = 0.f;
#pragma unroll
                for (int j = 0; j < 4; ++j) {
                    const float* wp = cw + (size_t)j * 1536 + ten * 512 + h * 128 + c0;
                    const f32x4 a = *GPC(f32x4)(wp), c4 = *GPC(f32x4)(wp + 4);
                    const float wj[8] = {a[0], a[1], a[2], a[3], c4[0], c4[1], c4[2], c4[3]};
#pragma unroll
                    for (int i = 0; i < 4; ++i)
#pragma unroll
                        for (int c = 0; c < 8; ++c) o[i][c] += wj[c] * raw[i + j][c];
                }
#pragma unroll
                for (int i = 0; i < 4; ++i)
#pragma unroll
                    for (int c = 0; c < 8; ++c) o[i][c] = silu_f(o[i][c]);
                if (ten < 2) {
#pragma unroll
                    for (int i = 0; i < 4; ++i) {
                        float sq = 0.f;
#pragma unroll
                        for (int c = 0; c < 8; ++c) sq += o[i][c] * o[i][c];
#pragma unroll
                        for (int off = 1; off < 16; off <<= 1) sq += shx(sq, off, lane);
                        const float rq = rsqrtf(sq + 1e-6f) * (ten == 0 ? 0.08838834764831845f : 1.0f);
#pragma unroll
                        for (int c = 0; c < 8; ++c) o[i][c] *= rq;
                    }
                }
                if (ten == 0) {
#pragma unroll
                    for (int i = 0; i < 4; ++i) {
                        u32x4 w;
                        w.x = cvt_pk_bf16(o[i][0] * eg[i], o[i][1] * eg[i]); w.y = cvt_pk_bf16(o[i][2] * eg[i], o[i][3] * eg[i]);
                        w.z = cvt_pk_bf16(o[i][4] * eg[i], o[i][5] * eg[i]); w.w = cvt_pk_bf16(o[i][6] * eg[i], o[i][7] * eg[i]);
                        { const int t_ = t0 + i; *GP(u32x4)(QD + ((((size_t)item * 4 + (t_ >> 4)) * 4 + (sg >> 2)) * 64 + (t_ & 15) + 16 * (sg & 3)) * 8) = w; }
                        w.x = cvt_pk_bf16(o[i][0], o[i][1]); w.y = cvt_pk_bf16(o[i][2], o[i][3]); w.z = cvt_pk_bf16(o[i][4], o[i][5]); w.w = cvt_pk_bf16(o[i][6], o[i][7]);
                        *reinterpret_cast<u32x4*>(lds + L_QRM + ((t0 + i) * 136 + c0) * 2) = w;
                    }
                } else if (ten == 1) {
#pragma unroll
                    for (int i = 0; i < 4; ++i) {
                        u32x4 w;
                        w.x = cvt_pk_bf16(o[i][0], o[i][1]); w.y = cvt_pk_bf16(o[i][2], o[i][3]); w.z = cvt_pk_bf16(o[i][4], o[i][5]); w.w = cvt_pk_bf16(o[i][6], o[i][7]);
                        *reinterpret_cast<u32x4*>(lds + L_KRM + ((t0 + i) * 136 + c0) * 2) = w;
                    }
#pragma unroll
                    for (int c = 0; c < 8; ++c) {
                        u32x2 w;
                        w.x = cvt_pk_bf16(o[0][c] * ek[0], o[1][c] * ek[1]); w.y = cvt_pk_bf16(o[2][c] * ek[2], o[3][c] * ek[3]);
                        { const int dk_ = c0 + c; *GP(u32x2)(KDT + ((((size_t)item * 8 + (dk_ >> 4)) * 2 + (t0 >> 5)) * 64 + (dk_ & 15) + 16 * ((t0 & 31) >> 3)) * 8 + ((t0 & 7) >> 2) * 4) = w; }
                        w.x = cvt_pk_bf16(o[0][c] * be[0] * eg[0], o[1][c] * be[1] * eg[1]); w.y = cvt_pk_bf16(o[2][c] * be[2] * eg[2], o[3][c] * be[3] * eg[3]);
                        *reinterpret_cast<u32x2*>(lds + L_KBGT + ((c0 + c) * 72 + t0) * 2) = w;
                    }
                } else {
#pragma unroll
                    for (int c = 0; c < 8; ++c) {
                        u32x2 w;
                        w.x = cvt_pk_bf16(o[0][c] * be[0], o[1][c] * be[1]); w.y = cvt_pk_bf16(o[2][c] * be[2], o[3][c] * be[3]);
                        *reinterpret_cast<u32x2*>(lds + L_VBT + ((c0 + c) * 72 + t0) * 2) = w;
                    }
                }
            }
        }
        __syncthreads();
        {
            CP_LANEVARS
            const int ib = wv;
            f32x4 kk[4], qk[4];
#pragma unroll
            for (int jb = 0; jb < 4; ++jb) { kk[jb] = (f32x4){0.f, 0.f, 0.f, 0.f}; qk[jb] = (f32x4){0.f, 0.f, 0.f, 0.f}; }
            bf16x8 ki[4], qi[4];
#pragma unroll
            for (int ks = 0; ks < 4; ++ks) {
                ki[ks] = lds8(lds + L_KRM + ((ib * 16 + fr) * 136 + ks * 32 + fq * 8) * 2);
                qi[ks] = lds8(lds + L_QRM + ((ib * 16 + fr) * 136 + ks * 32 + fq * 8) * 2);
            }
#pragma unroll
            for (int jb = 0; jb < 4; ++jb) {
                if (jb <= ib) {
#pragma unroll
                    for (int ks = 0; ks < 4; ++ks) {
                        const bf16x8 kj = lds8(lds + L_KRM + ((jb * 16 + fr) * 136 + ks * 32 + fq * 8) * 2);
                        kk[jb] = mfma16(ki[ks], kj, kk[jb]);
                        qk[jb] = mfma16(kj, qi[ks], qk[jb]);
                    }
                }
            }
            __syncthreads();
            float* AP = reinterpret_cast<float*>(lds + L_KRM);
#pragma unroll
            for (int jb = 0; jb < 4; ++jb) {
                if (jb <= ib) {
                    const int j = jb * 16 + fr, i0 = ib * 16 + fq * 4;
                    const float gj = gc_s[j];
#pragma unroll
                    for (int r = 0; r < 4; ++r) {
                        const int i = i0 + r;
                        const float dec = __expf(fminf(gc_s[i] - gj, 0.f));
                        float av_ = (i > j) ? kk[jb][r] * beta_s[i] * dec : 0.f;
#ifdef DIAG3
                        atomicMax(reinterpret_cast<unsigned*>(p.ws + OFF_BAR) + 4011, __float_as_uint(fabsf(kk[jb][r])));
                        atomicMax(reinterpret_cast<unsigned*>(p.ws + OFF_BAR) + 4012, __float_as_uint(fabsf(av_)));
#endif
#ifdef CLAMP_A
                        if (!(fabsf(av_) <= 0.02f)) av_ = 0.f;
#endif
                        AP[j * 64 + r * 16 + ib * 4 + fq] = av_;
                    }
                }
                {
                    const int i = ib * 16 + fr, j0 = jb * 16 + fq * 4;
                    const float gi = gc_s[i];
                    float o[4];
#pragma unroll
                    for (int r = 0; r < 4; ++r) {
                        const int j = j0 + r;
                        const float dec = __expf(fminf(gi - gc_s[j], 0.f));
                        o[r] = (i >= j) ? qk[jb][r] * dec : 0.f;
                    }
                    u32x2 w; w.x = cvt_pk_bf16(o[0], o[1]); w.y = cvt_pk_bf16(o[2], o[3]);
                    *GP(u32x2)(QK + ((((size_t)item * 4 + ib) * 2 + (jb >> 1)) * 64 + fr + 16 * ((jb & 1) * 2 + (fq >> 1))) * 8 + (fq & 1) * 4) = w;
                }
            }
        }
        __syncthreads();
        {
            CP_LANEVARS
            const float* AP = reinterpret_cast<const float*>(lds + L_KRM);
            const int cl = lane >> 2, pp = lane & 3, ccol = wv * 16 + cl;
            float a[16];
#pragma unroll
            for (int k = 0; k < 16; ++k) a[k] = (4 * k + pp == ccol) ? 1.f : 0.f;
#define INV_STEP(SS) { const int j = jq * 4 + SS; \
                    const float tj = __int_as_float(__builtin_amdgcn_update_dpp(0, __float_as_int(a[jq]), SS * 0x55, 0xf, 0xf, false)); \
                    const float* ap = AP + j * 64 + pp * 16; \
                    _Pragma("unroll") for (int k = jq; k < 16; ++k) a[k] -= ap[k] * tj; }
#pragma unroll
            for (int jq = 0; jq < 16; ++jq) {
                __builtin_amdgcn_sched_barrier(0);
#ifdef NO_INV
                if (false) {
#else
                if (jq >= wv * 4) {
#endif
                    INV_STEP(0) INV_STEP(1) INV_STEP(2)
                    if (jq < 15) INV_STEP(3)
                }
            }
#undef INV_STEP
#ifdef DIAG3
            { float mx = 0.f;
              for (int k = 0; k < 16; ++k) { const float av = fabsf(a[k]); mx = (av > mx || !(av == av)) ? av : mx; }
              atomicMax(reinterpret_cast<unsigned*>(p.ws + OFF_BAR) + 4010, __float_as_uint(mx)); }
#endif
            bf16_t* TR = reinterpret_cast<bf16_t*>(lds + L_QRM);
#pragma unroll
            for (int k = 0; k < 16; ++k) TR[(4 * k + pp) * 72 + ccol] = (bf16_t)(cvt_pk_bf16(a[k], 0.f) & 0xffffu);
        }
        __syncthreads();
        {
            CP_LANEVARS
            bf16x8 tf[2];
#pragma unroll
            for (int ks = 0; ks < 2; ++ks) tf[ks] = lds8(lds + L_QRM + ((wv * 16 + fr) * 72 + ks * 32 + fq * 8) * 2);
#pragma unroll
            for (int db = 0; db < 8; ++db) {
                f32x4 au = (f32x4){0.f, 0.f, 0.f, 0.f}, aw = (f32x4){0.f, 0.f, 0.f, 0.f};
#pragma unroll
                for (int ks = 0; ks < 2; ++ks) {
                    const bf16x8 vb = lds8(lds + L_VBT + ((db * 16 + fr) * 72 + ks * 32 + fq * 8) * 2);
                    const bf16x8 kb = lds8(lds + L_KBGT + ((db * 16 + fr) * 72 + ks * 32 + fq * 8) * 2);
                    au = mfma16(tf[ks], vb, au);
                    aw = mfma16(kb, tf[ks], aw);
                }
                u32x2 w; w.x = cvt_pk_bf16(au[0], au[1]); w.y = cvt_pk_bf16(au[2], au[3]);
                *GP(u32x2)(UT + ((((size_t)item * 8 + db) * 2 + (wv >> 1)) * 64 + fr + 16 * ((wv & 1) * 2 + (fq >> 1))) * 8 + (fq & 1) * 4) = w;
                w.x = cvt_pk_bf16(aw[0], aw[1]); w.y = cvt_pk_bf16(aw[2], aw[3]);
                *GP(u32x2)(W + ((((size_t)item * 4 + wv) * 4 + (db >> 1)) * 64 + fr + 16 * ((db & 1) * 2 + (fq >> 1))) * 8 + (fq & 1) * 4) = w;
            }
        }
        __syncthreads();
    }
}

__device__ __forceinline__ void delta_scan(const Params& p_, int blk, int g_wave) {
    Params p = p_; p.ws = opaque_ws(p.ws);
    const int tid = opaque_tid(), lane = tid & 63, w = tid >> 6, fr = lane & 15, fq = lane >> 4;
    const int bh = (blk & 7) + 8 * ((blk >> 3) & 1), sl = blk >> 4, b = bh >> 2, h = bh & 3, dv0 = sl * 32;
    bf16_t* ST = reinterpret_cast<bf16_t*>(p.ws + OFF_HA);
    bf16_t* UT = reinterpret_cast<bf16_t*>(p.ws + OFF_UT);
    const bf16_t* W = reinterpret_cast<const bf16_t*>(p.ws + OFF_W);
    const bf16_t* KDT = reinterpret_cast<const bf16_t*>(p.ws + OFF_KDT);
    const float* GT = reinterpret_cast<const float*>(p.ws + OFF_GT);
    unsigned char* STL = dyn_lds;
    unsigned char* VTL = dyn_lds + 8704;
#define LDS_BAR() do { asm volatile("s_waitcnt lgkmcnt(0)" ::: "memory"); __builtin_amdgcn_s_barrier(); asm volatile("" ::: "memory"); } while (0)
    if (w >= 4) {
        constexpr int PD = 10;
        const int pl = (w - 4) * 64 + lane;
        __syncthreads();
        for (int n = -PD; n < 64; ++n) {
            const int nn = n + PD;
            if (nn < 64) {
                const int item_ = bh * 64 + nn;
                if (w == 4) {
                    const int li = sl * 32 + (lane & 31);
                    const unsigned char* a0 = (lane < 32)
                        ? reinterpret_cast<const unsigned char*>(W + (size_t)item_ * 8192) + li * 128
                        : reinterpret_cast<const unsigned char*>(KDT + (size_t)item_ * 8192) + li * 128;
                    __builtin_amdgcn_global_load_lds((const unsigned*)a0, (unsigned*)(dyn_lds + 16384), 4, 0, 0);
                }
                if (w == 5) {
                    const unsigned char* a1 = reinterpret_cast<const unsigned char*>(UT + ((size_t)item_ * 8 + sl * 2) * 1024) + (lane & 31) * 128;
                    __builtin_amdgcn_global_load_lds((const unsigned*)a1, (unsigned*)(dyn_lds + 16384 + 512), 4, 0, 0);
                }
            }
            if (n >= 0) {
                const int item = bh * 64 + n;
                __builtin_amdgcn_s_barrier();
                {
                    const int dvb_ = pl >> 7, ks_ = (pl >> 6) & 1, l_ = pl & 63;
                    const u32x4 v = *reinterpret_cast<const u32x4*>(VTL + ((dvb_ * 16 + (l_ & 15)) * 72 + ks_ * 32 + (l_ >> 4) * 8) * 2);
                    *GP(u32x4)(UT + (((size_t)item * 8 + sl * 2) * 128 + pl) * 8) = v;
                }
                asm volatile("s_waitcnt lgkmcnt(0)" ::: "memory");
                __builtin_amdgcn_s_barrier();
                if (n < 63) {
#pragma unroll
                    for (int j = 0; j < 2; ++j) {
                        const int q = pl + 256 * j, dvb_ = q >> 8, ks_ = (q >> 6) & 3, l_ = q & 63;
                        const u32x4 v = *reinterpret_cast<const u32x4*>(STL + ((dvb_ * 16 + (l_ & 15)) * 136 + ks_ * 32 + (l_ >> 4) * 8) * 2);
                        *GP(u32x4)(ST + (((size_t)(item + 1) * 8 + sl * 2) * 256 + q) * 8) = v;
                    }
                }
                asm volatile("s_waitcnt lgkmcnt(0)" ::: "memory");
            }
        }
        asm volatile("s_waitcnt vmcnt(0)" ::: "memory");
    } else {
        f32x4 S[2][2];
#pragma unroll
        for (int kb = 0; kb < 2; ++kb)
#pragma unroll
            for (int db = 0; db < 2; ++db) {
                S[kb][db] = (f32x4){0.f, 0.f, 0.f, 0.f};
                const u32x2 z = mk2(0u, 0u);
                *reinterpret_cast<u32x2*>(STL + ((db * 16 + fr) * 136 + (2 * w + kb) * 16 + fq * 4) * 2) = z;
                *GP(u32x2)(ST + (((size_t)(bh * 64) * 8 + sl * 2) * 256) * 8 + (size_t)(((kb * 2 + db) * 256 + w * 64 + lane)) * 4) = z;
            }
        __syncthreads();
#define SCAN_LOAD(NN, WF, KF, UB, GTV) do { const int item_ = bh * 64 + (NN); \
        _Pragma("unroll") for (int ks = 0; ks < 4; ++ks) WF[ks] = ldg8(W + ((((size_t)item_ * 4 + w) * 4 + ks) * 64 + lane) * 8); \
        _Pragma("unroll") for (int kb = 0; kb < 2; ++kb) _Pragma("unroll") for (int ks = 0; ks < 2; ++ks) KF[kb][ks] = ldg8(KDT + ((((size_t)item_ * 8 + 2 * w + kb) * 2 + ks) * 64 + lane) * 8); \
        _Pragma("unroll") for (int db = 0; db < 2; ++db) UB[db] = *GPC(u32x2)(UT + ((((size_t)item_ * 8 + sl * 2 + db) * 2 + (w >> 1)) * 64 + fr + 16 * ((w & 1) * 2 + (fq >> 1))) * 8 + (fq & 1) * 4); \
        GTV = *GPC(float)(GT + item_); } while (0)
        bf16x8 wfA[4], kfA[2][2], wfB[4], kfB[2][2], wfC[4], kfC[2][2];
        u32x2 ubA[2], ubB[2], ubC[2]; float gtA, gtB, gtC;
        SCAN_LOAD(0, wfA, kfA, ubA, gtA); SCAN_LOAD(1, wfB, kfB, ubB, gtB);
#define SCAN_STEP(N_, WF, KF, UB, GTV, NWF, NKF, NUB, NGT) do { \
        const int n = (N_); \
        { const int nn = n + 2 < 64 ? n + 2 : 63; SCAN_LOAD(nn, NWF, NKF, NUB, NGT); } \
        { bf16x8 sb_[2][4]; \
          _Pragma("unroll") for (int db = 0; db < 2; ++db) _Pragma("unroll") for (int ks = 0; ks < 4; ++ks) sb_[db][ks] = lds8(STL + ((db * 16 + fr) * 136 + ks * 32 + fq * 8) * 2); \
          f32x4 a10 = (f32x4){0.f, 0.f, 0.f, 0.f}, a11 = (f32x4){0.f, 0.f, 0.f, 0.f}; \
          _Pragma("unroll") for (int ks = 0; ks < 4; ++ks) { a10 = mfma16(WF[ks], sb_[0][ks], a10); a11 = mfma16(WF[ks], sb_[1][ks], a11); } \
          _Pragma("unroll") for (int db = 0; db < 2; ++db) { \
              const f32x4 a1 = db ? a11 : a10; u32x2 vw; \
              vw.x = cvt_pk_bf16(bf_lo(UB[db].x) - a1[0], bf_hi(UB[db].x) - a1[1]); vw.y = cvt_pk_bf16(bf_lo(UB[db].y) - a1[2], bf_hi(UB[db].y) - a1[3]); \
              *reinterpret_cast<u32x2*>(VTL + ((db * 16 + fr) * 72 + w * 16 + fq * 4) * 2) = vw; \
              } } \
        LDS_BAR(); \
        { bf16x8 vb_[2][2]; \
          _Pragma("unroll") for (int db = 0; db < 2; ++db) _Pragma("unroll") for (int ks = 0; ks < 2; ++ks) vb_[db][ks] = lds8(VTL + ((db * 16 + fr) * 72 + ks * 32 + fq * 8) * 2); \
          _Pragma("unroll") for (int kb = 0; kb < 2; ++kb) _Pragma("unroll") for (int db = 0; db < 2; ++db) { \
              f32x4 a2 = S[kb][db] * GTV; \
              a2 = mfma16(KF[kb][0], vb_[db][0], a2); a2 = mfma16(KF[kb][1], vb_[db][1], a2); \
              S[kb][db] = a2; \
              if (n < 63) { \
                  u32x2 sw; sw.x = cvt_pk_bf16(a2[0], a2[1]); sw.y = cvt_pk_bf16(a2[2], a2[3]); \
                  *reinterpret_cast<u32x2*>(STL + ((db * 16 + fr) * 136 + (2 * w + kb) * 16 + fq * 4) * 2) = sw; \
              } } } \
        LDS_BAR(); } while (0)
        for (int n3 = 0; n3 < 63; n3 += 3) {
            SCAN_STEP(n3 + 0, wfA, kfA, ubA, gtA, wfC, kfC, ubC, gtC);
            SCAN_STEP(n3 + 1, wfB, kfB, ubB, gtB, wfA, kfA, ubA, gtA);
            SCAN_STEP(n3 + 2, wfC, kfC, ubC, gtC, wfB, kfB, ubB, gtB);
        }
        SCAN_STEP(63, wfA, kfA, ubA, gtA, wfC, kfC, ubC, gtC);
#undef SCAN_STEP
#undef SCAN_LOAD
    }
#undef LDS_BAR
}

__device__ __forceinline__ void swa_phase(const Params& p_, int l, int sblk, int nsb, int g_wave) {
    Params p = p_; p.ws = opaque_ws(p.ws);
    const int tid = opaque_tid(), lane = tid & 63, w = tid >> 6, fr = lane & 15, fq = lane >> 4;
    const bf16_t* HB = reinterpret_cast<const bf16_t*>(p.ws + OFF_HB);
    bf16_t* YM = reinterpret_cast<bf16_t*>(p.ws + OFF_XB);
    unsigned char* VTS = dyn_lds;
    unsigned char* KSL = dyn_lds + 21504;
    for (int it = sblk; it < 1024; it += nsb) {
        const int b = it >> 8, kvh = (it >> 7) & 1, qt = it & 127, q0 = qt * 32, kbase = q0 - 128;
        for (int idx = tid; idx < 1280; idx += 512) {
            const int key = idx >> 3, sg = idx & 7, kp = kbase + key;
            u32x4 u = mk4(0u, 0u, 0u, 0u);
            if (kp >= 0) u = *GPC(u32x4)(HB + (size_t)(b * SEQ + kp) * HB_LD + HB_KB + kvh * 64 + sg * 8);
            *reinterpret_cast<u32x4*>(KSL + (key * 72 + sg * 8) * 2) = u;
        }
        if (tid < 320) {
            const int kg = tid >> 3, sg = tid & 7;
            u32x4 u[4];
#pragma unroll
            for (int k = 0; k < 4; ++k) {
                const int kp = kbase + kg * 4 + k;
                u[k] = mk4(0u, 0u, 0u, 0u);
                if (kp >= 0) u[k] = *GPC(u32x4)(HB + (size_t)(b * SEQ + kp) * HB_LD + HB_VB + kvh * 64 + sg * 8);
            }
#pragma unroll
            for (int dp = 0; dp < 4; ++dp) {
                u32x2 lo, hi;
                lo.x = (u[0][dp] & 0xffffu) | (u[1][dp] << 16); lo.y = (u[2][dp] & 0xffffu) | (u[3][dp] << 16);
                hi.x = (u[0][dp] >> 16) | (u[1][dp] & 0xffff0000u); hi.y = (u[2][dp] >> 16) | (u[3][dp] & 0xffff0000u);
                *reinterpret_cast<u32x2*>(VTS + ((sg * 8 + dp * 2) * 168 + kg * 4) * 2) = lo;
                *reinterpret_cast<u32x2*>(VTS + ((sg * 8 + dp * 2 + 1) * 168 + kg * 4) * 2) = hi;
            }
        }
        const int g = w >> 1, sub = w & 1, qs = q0 + sub * 16, hq = kvh * 4 + g;
        const float slope = exp2f(-(float)(hq + 1)), sink = p.sinks[l * 8 + hq];
        bf16x8 qf[2];
#pragma unroll
        for (int ks = 0; ks < 2; ++ks) qf[ks] = ldg8(HB + (size_t)(b * SEQ + qs + fr) * HB_LD + HB_QB + hq * 64 + ks * 32 + fq * 8);
        __syncthreads();
        f32x4 sc[10];
#pragma unroll
        for (int kt = 0; kt < 10; ++kt) {
            const unsigned char* kr = KSL + ((kt * 16 + fr) * 72 + fq * 8) * 2;
            f32x4 a = (f32x4){0.f, 0.f, 0.f, 0.f};
            a = mfma16(lds8(kr), qf[0], a);
            a = mfma16(lds8(kr + 64), qf[1], a);
            sc[kt] = a;
        }
        const int qpos = qs + fr;
        float m = -1e30f;
#pragma unroll
        for (int kt = 0; kt < 10; ++kt)
#pragma unroll
            for (int r = 0; r < 4; ++r) {
                const int kpos = kbase + kt * 16 + fq * 4 + r, dist = qpos - kpos;
                const bool valid = (dist >= 0) && (dist < 128) && (kpos >= 0);
                const float s = valid ? sc[kt][r] * 0.125f - slope * (float)dist : -1e30f;
                sc[kt][r] = s; m = fmaxf(m, s);
            }
        m = fmaxf(m, shx(m, 16, lane)); m = fmaxf(m, shx(m, 32, lane));
        m = fmaxf(m, sink);
        float lsum = 0.f;
#pragma unroll
        for (int kt = 0; kt < 10; ++kt)
#pragma unroll
            for (int r = 0; r < 4; ++r) { const float e = __expf(sc[kt][r] - m); sc[kt][r] = e; lsum += e; }
        lsum += shx(lsum, 16, lane); lsum += shx(lsum, 32, lane);
        lsum += __expf(sink - m);
        const float inv = 1.0f / lsum;
        f32x4 o[4];
#pragma unroll
        for (int db = 0; db < 4; ++db) o[db] = (f32x4){0.f, 0.f, 0.f, 0.f};
#pragma unroll
        for (int j = 0; j < 5; ++j) {
            union { bf16x8 v; unsigned u[4]; } pf;
            pf.u[0] = cvt_pk_bf16(sc[2 * j][0], sc[2 * j][1]); pf.u[1] = cvt_pk_bf16(sc[2 * j][2], sc[2 * j][3]);
            pf.u[2] = cvt_pk_bf16(sc[2 * j + 1][0], sc[2 * j + 1][1]); pf.u[3] = cvt_pk_bf16(sc[2 * j + 1][2], sc[2 * j + 1][3]);
#pragma unroll
            for (int db = 0; db < 4; ++db) {
                union { bf16x8 v; u32x2 h[2]; } vf;
                const unsigned char* vr = VTS + ((db * 16 + fr) * 168 + (2 * j) * 16 + fq * 4) * 2;
                vf.h[0] = *reinterpret_cast<const u32x2*>(vr);
                vf.h[1] = *reinterpret_cast<const u32x2*>(vr + 32);
                o[db] = mfma16(vf.v, pf.v, o[db]);
            }
        }
        {
            const size_t tok = (size_t)(b * SEQ + qs + fr);
#pragma unroll
            for (int db = 0; db < 4; ++db) {
                const int col = hq * 64 + db * 16 + fq * 4;
                const u32x2 z = *GPC(u32x2)(HB + tok * HB_LD + HB_ZB + col);
                u32x2 y;
                y.x = cvt_pk_bf16(o[db][0] * inv * silu_f(bf_lo(z.x)), o[db][1] * inv * silu_f(bf_hi(z.x)));
                y.y = cvt_pk_bf16(o[db][2] * inv * silu_f(bf_lo(z.y)), o[db][3] * inv * silu_f(bf_hi(z.y)));
                *GP(u32x2)(YM + tok * DM + 512 + col) = y;
            }
        }
        __syncthreads();
    }
}

__device__ __forceinline__ void delta_out(const Params& p_, int l, int g_wave) {
    Params p = p_; p.ws = opaque_ws(p.ws);
    const int tid = opaque_tid(), grp = tid >> 8, lane = tid & 63, wv = (tid & 255) >> 6, fr = lane & 15, fq = lane >> 4;
    const bf16_t* ST = reinterpret_cast<const bf16_t*>(p.ws + OFF_HA);
    const bf16_t* VT = reinterpret_cast<const bf16_t*>(p.ws + OFF_UT);
    const bf16_t* QD = reinterpret_cast<const bf16_t*>(p.ws + OFF_QD);
    const bf16_t* QK = reinterpret_cast<const bf16_t*>(p.ws + OFF_QK);
    const bf16_t* HB = reinterpret_cast<const bf16_t*>(p.ws + OFF_HB);
    bf16_t* YM = reinterpret_cast<bf16_t*>(p.ws + OFF_XB);
    const float* nw = p.norm_w + l * 128;
    for (int pi = blockIdx.x; pi < 512; pi += gridDim.x) {
        const int item = pi * 2 + grp, bh = item >> 6, n = item & 63, b = bh >> 2, h = bh & 3;
        const int tok = b * SEQ + n * 64 + wv * 16 + fr;
        bf16x8 qd[4], qk[2];
#pragma unroll
        for (int ks = 0; ks < 4; ++ks) qd[ks] = ldg8(QD + ((((size_t)item * 4 + wv) * 4 + ks) * 64 + lane) * 8);
#pragma unroll
        for (int ks = 0; ks < 2; ++ks) qk[ks] = ldg8(QK + ((((size_t)item * 4 + wv) * 2 + ks) * 64 + lane) * 8);
        u32x2 zz[8];
#pragma unroll
        for (int db = 0; db < 8; ++db) zz[db] = *GPC(u32x2)(HB + (size_t)tok * HB_LD + HB_ZA + h * 128 + db * 16 + fq * 4);
        f32x4 o[8];
        float ss = 0.f;
        bf16x8 sfA[4], vfA[2], sfB[4], vfB[2];
#define DO_LOAD(DB, SF, VF) do { const bf16_t* sp = ST + ((((size_t)item * 8 + (DB)) * 4) * 64 + lane) * 8; const bf16_t* vp = VT + ((((size_t)item * 8 + (DB)) * 2) * 64 + lane) * 8; \
            _Pragma("unroll") for (int ks = 0; ks < 4; ++ks) SF[ks] = ldg8(sp + ks * 512); \
            _Pragma("unroll") for (int ks = 0; ks < 2; ++ks) VF[ks] = ldg8(vp + ks * 512); } while (0)
#define DO_MMA(DB, SF, VF) do { f32x4 a = (f32x4){0.f, 0.f, 0.f, 0.f}; \
            _Pragma("unroll") for (int ks = 0; ks < 4; ++ks) a = mfma16(SF[ks], qd[ks], a); \
            _Pragma("unroll") for (int ks = 0; ks < 2; ++ks) a = mfma16(VF[ks], qk[ks], a); \
            o[DB] = a; ss += (a[0] * a[0] + a[1] * a[1]) + (a[2] * a[2] + a[3] * a[3]); } while (0)
        DO_LOAD(0, sfA, vfA); DO_LOAD(1, sfB, vfB);
#pragma unroll
        for (int db = 0; db < 8; db += 2) {
            DO_MMA(db, sfA, vfA);
            if (db + 2 < 8) DO_LOAD(db + 2, sfA, vfA);
            DO_MMA(db + 1, sfB, vfB);
            if (db + 3 < 8) DO_LOAD(db + 3, sfB, vfB);
        }
#undef DO_LOAD
#undef DO_MMA
        ss += shx(ss, 16, lane); ss += shx(ss, 32, lane);
        const float rs = rsqrtf(ss * (1.0f / 128.0f) + 1e-6f);
#pragma unroll
        for (int db = 0; db < 8; ++db) {
            const int dv = db * 16 + fq * 4;
            const f32x4 nv = *GPC(f32x4)(nw + dv);
            const u32x2 z = zz[db];
            u32x2 y;
            y.x = cvt_pk_bf16(o[db][0] * rs * nv[0] * silu_f(bf_lo(z.x)), o[db][1] * rs * nv[1] * silu_f(bf_hi(z.x)));
            y.y = cvt_pk_bf16(o[db][2] * rs * nv[2] * silu_f(bf_lo(z.y)), o[db][3] * rs * nv[3] * silu_f(bf_hi(z.y)));
            *GP(u32x2)(YM + (size_t)tok * DM + h * 128 + dv) = y;
        }
    }
}


__device__ __forceinline__ void diag_rows(const bf16_t* YM, float* out, int g_wave) {
    const int tidx = opaque_tid();
    const int lane = tidx & 63;
    const int gw = blockIdx.x * 8 + (tidx >> 6), nw = gridDim.x * 8;
    for (int row = gw; row < NTOK; row += nw) {
        float ca = 0.f, cb = 0.f;
        for (int i = 0; i < 16; ++i) {
            const int col = i * 64 + lane;
            const float v = bf_lo((unsigned)YM[(size_t)row * DM + col]);
            const bool bad = !(fabsf(v) < 1e30f);
            if (bad) { if (col < 512) ca += 1.f; else cb += 1.f; }
        }
        for (int o = 32; o > 0; o >>= 1) { ca += shx(ca, o, lane); cb += shx(cb, o, lane); }
        for (int i = 0; i < 16; ++i) out[(size_t)row * DM + i * 64 + lane] = 0.f;
        if (lane == 0) out[(size_t)row * DM] = (ca > 0.f ? 1e6f : 0.f) + (cb > 0.f ? 1e5f : 0.f);
    }
}


__device__ __forceinline__ void diag_prep(unsigned char* ws, float* out, int g_wave) {
    const int tidx = opaque_tid();
    const int lane = tidx & 63;
    const int gw = blockIdx.x * 8 + (tidx >> 6), nw = gridDim.x * 8;
    const bf16_t* UT = reinterpret_cast<const bf16_t*>(ws + OFF_UT);
    const bf16_t* W = reinterpret_cast<const bf16_t*>(ws + OFF_W);
    const bf16_t* QD = reinterpret_cast<const bf16_t*>(ws + OFF_QD);
    const bf16_t* KDT = reinterpret_cast<const bf16_t*>(ws + OFF_KDT);
    const bf16_t* QK = reinterpret_cast<const bf16_t*>(ws + OFF_QK);
    const float* GT = reinterpret_cast<const float*>(ws + OFF_GT);
    const float* BA = reinterpret_cast<const float*>(ws + OFF_BA);
    for (int row = gw; row < NTOK; row += nw) {
        float c[6] = {0.f, 0.f, 0.f, 0.f, 0.f, 0.f};
        for (int i = 0; i < 8; ++i) {
            const size_t o = (size_t)row * 512 + i * 64 + lane;
            if (!(fabsf(bf_lo((unsigned)UT[o])) < 1e30f)) c[0] += 1.f;
            if (!(fabsf(bf_lo((unsigned)W[o])) < 1e30f)) c[1] += 1.f;
            if (!(fabsf(bf_lo((unsigned)QD[o])) < 1e30f)) c[2] += 1.f;
            if (!(fabsf(bf_lo((unsigned)KDT[o])) < 1e30f)) c[3] += 1.f;
        }
        for (int i = 0; i < 4; ++i) if (!(fabsf(bf_lo((unsigned)QK[(size_t)row * 256 + i * 64 + lane])) < 1e30f)) c[4] += 1.f;
        if (row < 1024 && lane == 0 && !(fabsf(GT[row]) < 1e30f)) c[5] += 1.f;
        if (lane < 8 && !(fabsf(BA[(size_t)row * 8 + lane]) < 1e30f)) c[5] += 1.f;
        for (int j = 0; j < 6; ++j) for (int o = 32; o > 0; o >>= 1) c[j] += shx(c[j], o, lane);
        unsigned bits = 0;
        for (int j = 0; j < 6; ++j) if (c[j] > 0.f) bits |= (1u << j);
        if (lane == 0 && bits) atomicOr(reinterpret_cast<unsigned*>(ws + OFF_BAR) + 4020, bits);
        for (int i = 0; i < 16; ++i) out[(size_t)row * DM + i * 64 + lane] = 0.f;
    }
}

__global__ void __launch_bounds__(512) fwd_megakernel(Params p) {
    __shared__ u32x4 xb_words;
    const int g_wave = __builtin_amdgcn_readfirstlane((int)(threadIdx.x >> 6));
    if (xb_t0(g_wave)) xb_words = mk4(0u, 0u, 0u, 0u);
    __syncthreads();
    XcdBarrier gb = xcd_barrier_post(reinterpret_cast<unsigned*>(p.ws + OFF_BAR), (volatile LAS unsigned*)&xb_words, g_wave);
#ifdef USE_CG
    gb.x = 0;
#endif

#ifndef PHM
#define PHM 255
#endif
    { int reps_ = PROBE_REPS_W; asm volatile("" : "+s"(reps_)); for (int rep_ = 0; rep_ < reps_; ++rep_) prep_weights(p, g_wave); }
    if (PHM & 2) row_pass(p.x, false, nullptr, nullptr, nullptr, reinterpret_cast<bf16_t*>(p.ws + OFF_XB), p.w_in + 2048, reinterpret_cast<float*>(p.ws + OFF_BA), g_wave);
    xcd_barrier(gb);
    for (int l = 0; l < 2; ++l) {
        unsigned char* wsl = opaque_ws(p.ws);
        bf16_t* XB = reinterpret_cast<bf16_t*>(wsl + OFF_XB);
        float* BA = reinterpret_cast<float*>(wsl + OFF_BA);
        {
            EpiH e; e.ha = reinterpret_cast<bf16_t*>(p.ws + OFF_HA); e.hb = reinterpret_cast<bf16_t*>(p.ws + OFF_HB);
            { int reps = PROBE_REPS_GEMM; asm volatile("" : "+s"(reps));
              for (int rep = 0; rep < reps; ++rep) { gemm_phase(XB, reinterpret_cast<const bf16_t*>(p.ws + OFF_WIN) + (size_t)l * NIN * DM, NTOK, NIN, DM, e, g_wave); } }
        }
        xcd_barrier(gb);
        { int reps_ = PROBE_REPS_PREP; asm volatile("" : "+s"(reps_)); for (int rep_ = 0; rep_ < reps_; ++rep_) { if (PHM & 8) chunk_prep(p, l, g_wave); __syncthreads(); } }
        xcd_barrier(gb);
#ifdef DIAG2
        if (l == 0) { diag_prep(wsl, p.out, g_wave); xcd_barrier(gb);
            if (blockIdx.x == 0 && opaque_tid() == 0) p.out[0] = 1000.f * (float)reinterpret_cast<const unsigned*>(wsl + OFF_BAR)[4020];
            return; }
#endif
#ifdef DIAG3
        if (l == 0) {
            const int tidx = opaque_tid();
            const unsigned* dw = reinterpret_cast<const unsigned*>(wsl + OFF_BAR);
            for (size_t i = (size_t)blockIdx.x * 512 + tidx; i < (size_t)NTOK * DM; i += (size_t)gridDim.x * 512) {
                float v = 0.f;
                if (i == 0) v = fminf(__uint_as_float(dw[4010]), 1e37f) * DIAG3_S0;
                if (i == 1) v = fminf(__uint_as_float(dw[4011]), 1e37f) * DIAG3_S1;
                if (i == 2) v = fminf(__uint_as_float(dw[4012]), 1e37f) * DIAG3_S2;
                p.out[i] = v;
            }
            return;
        }
#endif
        if (blockIdx.x < 64) { if (PHM & 16) delta_scan(p, blockIdx.x, g_wave); }
        else { int reps_ = PROBE_REPS_SWA; asm volatile("" : "+s"(reps_)); for (int rep_ = 0; rep_ < reps_; ++rep_) swa_phase(p, l, blockIdx.x - 64, gridDim.x - 64, g_wave); }
        xcd_barrier(gb);
#ifdef DIAG4
        if (l == 0) {
            const int tidx = opaque_tid();
            const unsigned* dw = reinterpret_cast<const unsigned*>(wsl + OFF_BAR);
            for (size_t i = (size_t)blockIdx.x * 512 + tidx; i < (size_t)NTOK * DM; i += (size_t)gridDim.x * 512) {
                float v = 0.f;
                if (i == 0) v = fminf(__uint_as_float(dw[4013]), 1e37f) * DIAG4_S0;
                if (i == 1) v = fminf(__uint_as_float(dw[4014]), 1e37f) * DIAG4_S1;
                p.out[i] = v;
            }
            return;
        }
#endif
        { int reps_ = PROBE_REPS_DOUT; asm volatile("" : "+s"(reps_)); for (int rep_ = 0; rep_ < reps_; ++rep_) { if (PHM & 64) delta_out(p, l, g_wave); __syncthreads(); } }
        xcd_barrier(gb);
#ifdef DIAG1
        if (l == DIAG1 - 1) { diag_rows(XB, p.out, g_wave); return; }
#endif
        {
            EpiZ e; e.xres = (l == 0) ? p.x : p.out; e.out = p.out;
            if (PHM & 128) gemm_phase(XB, reinterpret_cast<const bf16_t*>(p.ws + OFF_WOUT) + (size_t)l * DM * DM, NTOK, DM, DM, e, g_wave);
        }
        xcd_barrier(gb);
        if (l == 0) row_pass(p.out, true, p.ln_g, p.ln_b, p.out, XB, p.w_in + (size_t)DM * INC + 2048, BA, g_wave);
        else        row_pass(p.out, true, p.ln_g + DM, p.ln_b + DM, p.out, nullptr, nullptr, nullptr, g_wave);
        if (l == 0) xcd_barrier(gb);
    }
}

extern "C" void kernel_launch(void* const* d_in, const int* in_sizes, int n_in, void* d_out, int out_size, void* d_ws, size_t ws_size, hipStream_t stream) {
    static int grid_blocks = 0;
    if (!grid_blocks) {
        int dev = 0, cus = 0, per_cu = 0;
        hipGetDevice(&dev);
        hipDeviceGetAttribute(&cus, hipDeviceAttributeMultiprocessorCount, dev);
        hipFuncSetAttribute((const void*)fwd_megakernel, hipFuncAttributeMaxDynamicSharedMemorySize, LDS_BYTES);
        hipOccupancyMaxActiveBlocksPerMultiprocessor(&per_cu, fwd_megakernel, 512, LDS_BYTES);
        grid_blocks = (per_cu >= 1) ? cus : 0;
        if (grid_blocks > 256) grid_blocks = 256;
        if (ws_size < WS_NEED) { fprintf(stderr, "workspace too small: %zu < %zu\n", ws_size, (size_t)WS_NEED); }
        if (!grid_blocks) { fprintf(stderr, "occupancy query returned 0\n"); grid_blocks = 256; }
    }
    Params p{};
    p.x = (const float*)d_in[0]; p.w_in = (const float*)d_in[1]; p.conv_w = (const float*)d_in[2]; p.a_log = (const float*)d_in[3];
    p.dt_bias = (const float*)d_in[4]; p.norm_w = (const float*)d_in[5]; p.sinks = (const float*)d_in[6]; p.w_out = (const float*)d_in[7];
    p.ln_g = (const float*)d_in[8]; p.ln_b = (const float*)d_in[9]; p.out = (float*)d_out; p.ws = (unsigned char*)d_ws;
    hipMemsetAsync(d_ws, 0, 16384, stream);
    void* args[] = {&p};
    hipError_t e = hipLaunchCooperativeKernel((const void*)fwd_megakernel, dim3(grid_blocks), dim3(512), args, LDS_BYTES, stream);
    if (e != hipSuccess) fprintf(stderr, "cooperative launch failed: %s (grid %d)\n", hipGetErrorString(e), grid_blocks);
}
```

```cpp
#include <hip/hip_runtime.h>
#include <cstdio>
#include <cstdint>

#define PHM 255
#ifndef PROBE_REPS_GEMM
#define PROBE_REPS_GEMM 1
#endif
#ifndef PROBE_REPS_PREP
#define PROBE_REPS_PREP 1
#endif
#ifndef PROBE_REPS_DOUT
#define PROBE_REPS_DOUT 1
#endif
#ifndef PROBE_REPS_SWA
#define PROBE_REPS_SWA 1
#endif
#ifndef PROBE_REPS_W
#define PROBE_REPS_W 1
#endif
#define LAS __attribute__((address_space(3)))
__device__ __forceinline__ int opaque_lane() { int lane; asm volatile("v_mbcnt_lo_u32_b32 %0, -1, 0\n\tv_mbcnt_hi_u32_b32 %0, -1, %0" : "=v"(lane)); return lane; }
typedef unsigned short bf16_t;
typedef short bf16x8 __attribute__((ext_vector_type(8)));
typedef float f32x4 __attribute__((ext_vector_type(4)));
typedef unsigned u32x4 __attribute__((ext_vector_type(4)));
typedef unsigned u32x2 __attribute__((ext_vector_type(2)));
__device__ __forceinline__ u32x4 mk4(unsigned a, unsigned b, unsigned c, unsigned d) { return (u32x4){a, b, c, d}; }
__device__ __forceinline__ u32x2 mk2(unsigned a, unsigned b) { return (u32x2){a, b}; }

constexpr int NTOK = 16384, SEQ = 4096, DM = 1024, INC = 3336, NIN = 3328;
constexpr int HA_LD = 1536, HB_LD = 1792;
constexpr int HB_ZA = 0, HB_QB = 512, HB_KB = 1024, HB_VB = 1152, HB_ZB = 1280;
constexpr float DN_ALPHA = 1.41421356237f;

constexpr size_t OFF_BAR = 0;
constexpr size_t OFF_XB = 16384;
constexpr size_t OFF_WIN = OFF_XB + (size_t)NTOK * DM * 2;
constexpr size_t OFF_WOUT = OFF_WIN + (size_t)2 * NIN * DM * 2;
constexpr size_t OFF_HA = OFF_WOUT + (size_t)2 * DM * DM * 2;
constexpr size_t OFF_HB = OFF_HA + (size_t)NTOK * HA_LD * 2;
constexpr size_t OFF_UT = OFF_HB + (size_t)NTOK * HB_LD * 2;
constexpr size_t OFF_W = OFF_UT + (size_t)NTOK * 512 * 2;
constexpr size_t OFF_QD = OFF_W + (size_t)NTOK * 512 * 2;
constexpr size_t OFF_KDT = OFF_QD + (size_t)NTOK * 512 * 2;
constexpr size_t OFF_QK = OFF_KDT + (size_t)NTOK * 512 * 2;
constexpr size_t OFF_BA = OFF_QK + (size_t)NTOK * 256 * 2;
constexpr size_t OFF_GT = OFF_BA + (size_t)NTOK * 8 * 4;
constexpr size_t WS_NEED = OFF_GT + 4096;

constexpr int LDS_BYTES = 147456;
extern __shared__ __attribute__((aligned(16))) unsigned char dyn_lds[];

struct Params {
    const float* x; const float* w_in; const float* conv_w; const float* a_log; const float* dt_bias;
    const float* norm_w; const float* sinks; const float* w_out; const float* ln_g; const float* ln_b;
    float* out; unsigned char* ws;
};

typedef float f32x2_t __attribute__((ext_vector_type(2)));
typedef __bf16 bf16x2_t __attribute__((ext_vector_type(2)));
__device__ __forceinline__ unsigned cvt_pk_bf16(float lo, float hi) {
    const f32x2_t v = {lo, hi};
    const bf16x2_t r = __builtin_convertvector(v, bf16x2_t);
    return __builtin_bit_cast(unsigned, r);
}
__device__ __forceinline__ float bf_lo(unsigned u) { return __uint_as_float(u << 16); }
__device__ __forceinline__ float bf_hi(unsigned u) { return __uint_as_float(u & 0xffff0000u); }
__device__ __forceinline__ float silu_f(float x) { return x * __builtin_amdgcn_rcpf(1.0f + __expf(-x)); }
__device__ __forceinline__ f32x4 mfma16(bf16x8 a, bf16x8 b, f32x4 c) { return __builtin_amdgcn_mfma_f32_16x16x32_bf16(a, b, c, 0, 0, 0); }
#define GPC(T) (const __attribute__((address_space(1))) T*)
#define GP(T) (__attribute__((address_space(1))) T*)
__device__ __forceinline__ bf16x8 ldg8(const bf16_t* p) { return *GPC(bf16x8)(p); }
__device__ __forceinline__ bf16x8 lds8(const unsigned char* p) { return *reinterpret_cast<const bf16x8*>(p); }

__device__ __forceinline__ int opaque_tid_(int g_wave) {
    int lane; asm volatile("v_mbcnt_lo_u32_b32 %0, -1, 0\n\tv_mbcnt_hi_u32_b32 %0, -1, %0" : "=v"(lane));
    return g_wave * 64 + lane; }
#define opaque_tid() opaque_tid_(g_wave)
__device__ __forceinline__ unsigned char* opaque_ws(unsigned char* w) { asm volatile("" : "+s"(w)); return w; }
__device__ __forceinline__ const bf16_t* uniform_ptr(const bf16_t* p) {
    const unsigned long long v = (unsigned long long)p;
    const unsigned lo = __builtin_amdgcn_readfirstlane((unsigned)v), hi = __builtin_amdgcn_readfirstlane((unsigned)(v >> 32));
    return (const bf16_t*)(((unsigned long long)hi << 32) | lo);
}

__device__ __forceinline__ float shx(float v, int m, int lane) { return __int_as_float(__builtin_amdgcn_ds_bpermute((lane ^ m) << 2, __float_as_int(v))); }

#define XB_TMO      128
#define XB_XCNT(j)  (256  + 64 * (j))
#define XB_XSUB(j)  (1280 + 64 * (j))
#define XB_XGEN(j)  (2304 + 64 * (j))
#define XB_TOP      3328
#define XB_TOPGEN   3392
#define XCD_BAR_WORDS 3456
#define XB_SPIN_CAP (1u << 20)
__device__ __forceinline__ unsigned xb_ld(unsigned* p)              { return __hip_atomic_load(p, __ATOMIC_RELAXED, __HIP_MEMORY_SCOPE_AGENT); }
__device__ __forceinline__ unsigned xb_add(unsigned* p, unsigned v) { return __hip_atomic_fetch_add(p, v, __ATOMIC_RELAXED, __HIP_MEMORY_SCOPE_AGENT); }
__device__ __forceinline__ unsigned xb_xcc_id() { return (unsigned)__builtin_amdgcn_s_getreg((3 << 11) | 20) & 0xFu; }
#define XB_SPIN(cond, bar) do { unsigned _sp = 0; while (cond) { __builtin_amdgcn_s_sleep(1); \
    if ((++_sp & 255u) == 0u) { if (xb_ld(&(bar)[XB_TMO])) break; if (_sp > XB_SPIN_CAP) { atomicAdd(&(bar)[XB_TMO], 1u); break; } } } } while (0)
struct XcdBarrier { unsigned* bar; unsigned x; volatile LAS unsigned* st; int gw; };
__device__ __forceinline__ bool xb_t0(int gw) { return gw == 0 && opaque_lane() == 0; }
__device__ __forceinline__ XcdBarrier xcd_barrier_post(unsigned* bar, volatile LAS unsigned* st, int gw) {
    XcdBarrier b; b.bar = bar; b.x = xb_xcc_id(); b.st = st; b.gw = gw;
    if (xb_t0(gw)) (void)xb_add(&bar[XB_XCNT(b.x)], 1u);
    return b;
}
__device__ __forceinline__ void xcd_barrier_complete(unsigned* bar, unsigned x, unsigned& nloc, unsigned& nx) {
    const unsigned G = gridDim.x * gridDim.y * gridDim.z;
    unsigned sum, cnt, mine, sp = 0u;
    for (;;) {
        sum = 0u; cnt = 0u; mine = 0u;
#pragma unroll
        for (unsigned j = 0; j < 16; ++j) { const unsigned c = xb_ld(&bar[XB_XCNT(j)]); sum += c; cnt += (c > 0u) ? 1u : 0u; mine = (j == x) ? c : mine; }
        if (sum == G) break;
        __builtin_amdgcn_s_sleep(1);
        if ((++sp & 255u) == 0u) { if (xb_ld(&bar[XB_TMO])) break; if (sp > XB_SPIN_CAP) { atomicAdd(&bar[XB_TMO], 1u); break; } }
    }
    nloc = mine > 0u ? mine : 1u; nx = cnt > 0u ? cnt : 1u;
}
#ifdef USE_CG
__device__ __forceinline__ void xcd_barrier(XcdBarrier& b) {
    asm volatile("s_waitcnt vmcnt(0)" ::: "memory");
    __syncthreads();
    b.x = __builtin_amdgcn_readfirstlane(b.x + gridDim.x);
    if (xb_t0(b.gw)) {
        __threadfence();
        unsigned* c = b.bar + 4000;
        xb_add(c, 1u);
        unsigned sp = 0;
        while (xb_ld(c) < b.x) { __builtin_amdgcn_s_sleep(2); if (++sp > (1u << 24)) break; }
        __threadfence();
    }
    __syncthreads();
}
#else
__device__ __forceinline__ void xcd_barrier(const XcdBarrier& b_) {
    asm volatile("s_waitcnt vmcnt(0)" ::: "memory");
    __syncthreads();
    if (xb_t0(b_.gw)) {
        XcdBarrier b = b_; b.x = xb_xcc_id();
        asm volatile("" : "+s"(b.x));
        unsigned* bar = b.bar;
        __builtin_amdgcn_s_waitcnt(0);
        unsigned nloc = b.st[0], nx = b.st[1];
        if (nloc == 0u) { xcd_barrier_complete(bar, b.x, nloc, nx); b.st[0] = nloc; b.st[1] = nx; }
        const unsigned old = xb_add(&bar[XB_XSUB(b.x)], 1u);
        const unsigned gen = old / nloc;
        if (old + 1u == (gen + 1u) * nloc) {
            __builtin_amdgcn_fence(__ATOMIC_RELEASE, "agent");
            asm volatile("s_waitcnt vmcnt(0)" ::: "memory");
            const unsigned og = xb_add(&bar[XB_TOP], 1u);
            const unsigned tg = og / nx;
            if (og + 1u == (tg + 1u) * nx) xb_add(&bar[XB_TOPGEN], 1u);
            else XB_SPIN(xb_ld(&bar[XB_TOPGEN]) == tg, bar);
            __builtin_amdgcn_fence(__ATOMIC_ACQUIRE, "agent");
            xb_add(&bar[XB_XGEN(b.x)], 1u);
            asm volatile("s_waitcnt vmcnt(0)" ::: "memory");
        } else {
            XB_SPIN(xb_ld(&bar[XB_XGEN(b.x)]) == gen, bar);
            __builtin_amdgcn_fence(__ATOMIC_ACQUIRE, "agent");
            asm volatile("s_waitcnt vmcnt(0)" ::: "memory");
        }
    }
    __syncthreads();
}

#endif

constexpr int BM = 256, BK = 64, HALF = 128, NXCD = 8, WGM = 8, HT = HALF * BK;
__device__ __forceinline__ int lds_byte(int r, int c) {
    int st = (r >> 4) * 2 + (c >> 5), rr = r & 15, cc = c & 31, ob = rr * 64 + cc * 2;
    return st * 1024 + (ob ^ (((ob >> 9) & 1) << 5));
}
__device__ __forceinline__ void stage_rc(int b, int& R, int& C) {
    int st = b / 1024, sb = b % 1024, swz = sb ^ (((sb >> 9) & 1) << 5);
    R = (st >> 1) * 16 + swz / 64; C = (st & 1) * 32 + (swz % 64) / 2;
}

struct EpiH {
    bf16_t* ha; bf16_t* hb;
    __device__ __forceinline__ void operator()(const f32x4 (&acc)[2][2][4][2], int brow, int bcol, int wr, int wc, int fr, int fq) const {
        bf16_t* base; int ld, c0;
        if (bcol < HA_LD) { base = ha; ld = HA_LD; c0 = bcol; } else { base = hb; ld = HB_LD; c0 = bcol - HA_LD; }
#pragma unroll
        for (int ai = 0; ai < 2; ++ai)
#pragma unroll
            for (int m = 0; m < 4; ++m) {
                const int row = brow + ai * HALF + wr * 64 + m * 16 + fr;
                bf16_t* rp = base + (size_t)row * ld + c0 + wc * 32 + fq * 4;
#pragma unroll
                for (int bj = 0; bj < 2; ++bj)
#pragma unroll
                    for (int n = 0; n < 2; ++n) {
                        const f32x4 v = acc[ai][bj][m][n];
                        u32x2 w; w.x = cvt_pk_bf16(v[0], v[1]); w.y = cvt_pk_bf16(v[2], v[3]);
                        *GP(u32x2)(rp + bj * HALF + n * 16) = w;
                    }
            }
    }
};
struct EpiZ {
    const float* xres; float* out;
    __device__ __forceinline__ void operator()(const f32x4 (&acc)[2][2][4][2], int brow, int bcol, int wr, int wc, int fr, int fq) const {
#pragma unroll
        for (int ai = 0; ai < 2; ++ai)
#pragma unroll
            for (int m = 0; m < 4; ++m) {
                const int row = brow + ai * HALF + wr * 64 + m * 16 + fr;
                const size_t ro = (size_t)row * DM + bcol + wc * 32 + fq * 4;
#pragma unroll
                for (int bj = 0; bj < 2; ++bj)
#pragma unroll
                    for (int n = 0; n < 2; ++n) {
                        const size_t o = ro + bj * HALF + n * 16;
                        const f32x4 r = *GPC(f32x4)(xres + o);
                        *GP(f32x4)(out + o) = r * DN_ALPHA + acc[ai][bj][m][n];
                    }
            }
    }
};

template <class Epi>
__device__ __forceinline__ void gemm_phase(const bf16_t* __restrict__ A, const bf16_t* __restrict__ Bt, int M, int N, int K, const Epi& epi, int g_wave) {
    bf16_t* shm = reinterpret_cast<bf16_t*>(dyn_lds);
#define SA(b,h) (shm+((b)*2+(h))*HT)
#define SB(b,h) (shm+(4+(b)*2+(h))*HT)
#define STAGE(P,BASE,br,kt) do{const bf16_t* _bp=uniform_ptr((BASE)+((long)(br)*K+(long)(kt)*BK)); \
    __builtin_amdgcn_global_load_lds((const unsigned*)((const char*)_bp+soff0),(unsigned*)((char*)(P)+tidx*16),16,0,0); \
    __builtin_amdgcn_global_load_lds((const unsigned*)((const char*)_bp+soff1),(unsigned*)((char*)(P)+tidx*16+8192),16,0,0);}while(0)
#define LDA(dst,b,h) for(int m=0;m<4;++m)for(int k=0;k<2;++k) \
    dst[m][k]=*reinterpret_cast<const bf16x8*>((char*)SA(b,h)+lds_byte(wr*64+m*16+fr,k*32+fq*8))
#define LDB(dst,b,h) for(int n=0;n<2;++n)for(int k=0;k<2;++k) \
    dst[n][k]=*reinterpret_cast<const bf16x8*>((char*)SB(b,h)+lds_byte(wc*32+n*16+fr,k*32+fq*8))
#define MMA(ai,bj,At,Bt_) do{__builtin_amdgcn_s_setprio(1); \
    for(int m=0;m<4;++m)for(int n=0;n<2;++n)for(int k=0;k<2;++k) \
      acc[ai][bj][m][n]=__builtin_amdgcn_mfma_f32_16x16x32_bf16(Bt_[n][k],At[m][k],acc[ai][bj][m][n],0,0,0); \
    __builtin_amdgcn_s_setprio(0);}while(0)
#define WAIT_V(n) asm volatile("s_waitcnt vmcnt(" #n ")":::"memory")
#define WAIT_L(n) asm volatile("s_waitcnt lgkmcnt(" #n ")":::"memory")
#define BAR __builtin_amdgcn_s_barrier()
#define SCHED __builtin_amdgcn_sched_barrier(0)
    const int nM = M / BM, nN = N / BM, nwg = nM * nN;
    const int tidx = opaque_tid();
    const int wid = tidx >> 6, lane = tidx & 63, wr = wid >> 2, wc = wid & 3, fr = lane & 15, fq = lane >> 4;
    const int nt = K / BK;
    unsigned soff0, soff1;
    { int r_, c_; stage_rc(tidx * 16, r_, c_); soff0 = (unsigned)(r_ * K + c_) * 2u; stage_rc(tidx * 16 + 8192, r_, c_); soff1 = (unsigned)(r_ * K + c_) * 2u; }
    for (int L = blockIdx.x; L < nwg; L += gridDim.x) {
        int wgid = L;
        { int q = nwg / NXCD, r = nwg % NXCD, xcd = wgid % NXCD, off = wgid / NXCD; wgid = (xcd < r ? xcd * (q + 1) : r * (q + 1) + (xcd - r) * q) + off; }
        const int nig = WGM * nN, gid = wgid / nig, fm = gid * WGM, gsz = min(nM - fm, WGM);
        const int pm = fm + ((wgid % nig) % gsz), pn = (wgid % nig) / gsz, brow = pm * BM, bcol = pn * BM;
        f32x4 acc[2][2][4][2] = {};
        bf16x8 At[4][2], B0[2][2], B1[2][2];
        STAGE(SB(0,0),Bt,bcol,0); STAGE(SA(0,0),A,brow,0);
        STAGE(SB(0,1),Bt,bcol+HALF,0); STAGE(SA(0,1),A,brow+HALF,0);
        if(wr==1)BAR;
        WAIT_V(4); BAR;
        STAGE(SB(1,0),Bt,bcol,1); STAGE(SA(1,0),A,brow,1); STAGE(SB(1,1),Bt,bcol+HALF,1);
        WAIT_V(6); BAR;
        for(int t=0;t<nt-2;t+=2){
            LDB(B0,0,0); SCHED; LDA(At,0,0); STAGE(SA(1,1),A,brow+HALF,t+1);
            WAIT_L(8); BAR; WAIT_L(0); MMA(0,0,At,B0); BAR; SCHED;
            LDB(B1,0,1); STAGE(SB(0,0),Bt,bcol,t+2);
            BAR; WAIT_L(0); MMA(0,1,At,B1); BAR;
            LDA(At,0,1); STAGE(SA(0,0),A,brow,t+2);
            BAR; WAIT_L(0); MMA(1,0,At,B0); BAR; SCHED;
            STAGE(SB(0,1),Bt,bcol+HALF,t+2);
            WAIT_V(6); BAR; MMA(1,1,At,B1); BAR;
            LDB(B0,1,0); SCHED; LDA(At,1,0); STAGE(SA(0,1),A,brow+HALF,t+2);
            WAIT_L(8); BAR; WAIT_L(0); MMA(0,0,At,B0); BAR; SCHED;
            LDB(B1,1,1); STAGE(SB(1,0),Bt,bcol,t+3);
            BAR; WAIT_L(0); MMA(0,1,At,B1); BAR;
            LDA(At,1,1); STAGE(SA(1,0),A,brow,t+3);
            BAR; WAIT_L(0); MMA(1,0,At,B0); BAR; SCHED;
            STAGE(SB(1,1),Bt,bcol+HALF,t+3);
            WAIT_V(6); BAR; MMA(1,1,At,B1); BAR;
        }
        { LDB(B0,0,0); LDA(At,0,0); STAGE(SA(1,1),A,brow+HALF,nt-1);
          BAR; WAIT_L(0); MMA(0,0,At,B0); BAR;
          LDB(B1,0,1); BAR; WAIT_L(0); MMA(0,1,At,B1); BAR;
          LDA(At,0,1); WAIT_V(4); BAR; WAIT_L(0); MMA(1,0,At,B0); MMA(1,1,At,B1); BAR; }
        { LDB(B0,1,0); LDA(At,1,0); WAIT_V(2); BAR; WAIT_L(0); MMA(0,0,At,B0); BAR;
          LDB(B1,1,1); WAIT_V(0); BAR; WAIT_L(0); MMA(0,1,At,B1); BAR;
          LDA(At,1,1); BAR; WAIT_L(0); MMA(1,0,At,B0); MMA(1,1,At,B1); BAR; }
        if(wr==0)BAR;
        epi(acc, brow, bcol, wr, wc, fr, fq);
        __syncthreads();
    }
#undef SA
#undef SB
#undef STAGE
#undef LDA
#undef LDB
#undef MMA
}

__device__ __forceinline__ void prep_weights(const Params& p, int part, int vblk, int nvblk, int g_wave) {
    bf16_t* win = reinterpret_cast<bf16_t*>(p.ws + OFF_WIN);
    bf16_t* wout = reinterpret_cast<bf16_t*>(p.ws + OFF_WOUT);
    const int gtid = vblk * 512 + opaque_tid(), gsz = nvblk * 512;
    const int n_in = 128 * NIN;
    for (int i = gtid; i < n_in; i += gsz) {
        const int n = i % NIN, kg = i / NIN, l = part;
        const int sc = n < 2048 ? n : n + 8;
        const float* s = p.w_in + (size_t)l * DM * INC + (size_t)(kg * 8) * INC + sc;
        u32x4 w;
        w.x = cvt_pk_bf16(s[0], s[INC]); w.y = cvt_pk_bf16(s[2 * INC], s[3 * INC]);
        w.z = cvt_pk_bf16(s[4 * INC], s[5 * INC]); w.w = cvt_pk_bf16(s[6 * INC], s[7 * INC]);
        *GP(u32x4)(win + ((size_t)l * NIN + n) * DM + kg * 8) = w;
    }
    if (part == 1) {
        const int n_out = 2 * 128 * DM;
        for (int i = gtid; i < n_out; i += gsz) {
            const int n = i % DM, kg = (i / DM) % 128, l = i / (DM * 128);
            const float* s = p.w_out + (size_t)l * DM * DM + (size_t)(kg * 8) * DM + n;
            u32x4 w;
            w.x = cvt_pk_bf16(s[0], s[DM]); w.y = cvt_pk_bf16(s[2 * DM], s[3 * DM]);
            w.z = cvt_pk_bf16(s[4 * DM], s[5 * DM]); w.w = cvt_pk_bf16(s[6 * DM], s[7 * DM]);
            *GP(u32x4)(wout + ((size_t)l * DM + n) * DM + kg * 8) = w;
        }
    }
}

__device__ __forceinline__ void row_pass(const float* src, bool ln, const float* g, const float* bta, float* dstf, bf16_t* xb, const float* wg  , float* BA, int g_wave) {
    const int tidx = opaque_tid();
    const int lane = tidx & 63;
    const int gw = blockIdx.x * 8 + (tidx >> 6), nw = gridDim.x * 8;
    float* wgs = reinterpret_cast<float*>(dyn_lds);
    if (wg) {
        for (int c = tidx; c < DM; c += 512) {
            const f32x4 w0 = *GPC(f32x4)(wg + (size_t)c * INC), w1 = *GPC(f32x4)(wg + (size_t)c * INC + 4);
            *reinterpret_cast<f32x4*>(wgs + c * 8) = w0; *reinterpret_cast<f32x4*>(wgs + c * 8 + 4) = w1;
        }
    }
    __syncthreads();
    f32x4 gg[4], bb[4];
#pragma unroll
    for (int i = 0; i < 4; ++i) { gg[i] = ln ? *GPC(f32x4)(g + i * 256 + lane * 4) : (f32x4){1.f, 1.f, 1.f, 1.f}; bb[i] = ln ? *GPC(f32x4)(bta + i * 256 + lane * 4) : (f32x4){0.f, 0.f, 0.f, 0.f}; }
    f32x4 nv[4];
    if (gw < NTOK) {
#pragma unroll
        for (int i = 0; i < 4; ++i) nv[i] = *GPC(f32x4)(src + (size_t)gw * DM + i * 256 + lane * 4);
    }
    for (int row = gw; row < NTOK; row += nw) {
        f32x4 v[4];
#pragma unroll
        for (int i = 0; i < 4; ++i) v[i] = nv[i];
        if (row + nw < NTOK) {
#pragma unroll
            for (int i = 0; i < 4; ++i) nv[i] = *GPC(f32x4)(src + (size_t)(row + nw) * DM + i * 256 + lane * 4);
        }
        if (ln) {
            float s = 0.f;
#pragma unroll
            for (int i = 0; i < 4; ++i) s += (v[i][0] + v[i][1]) + (v[i][2] + v[i][3]);
#pragma unroll
            for (int o = 32; o > 0; o >>= 1) s += shx(s, o, lane);
            const float mu = s * (1.0f / DM);
            float q = 0.f;
#pragma unroll
            for (int i = 0; i < 4; ++i) { v[i] = v[i] - mu; q += (v[i][0] * v[i][0] + v[i][1] * v[i][1]) + (v[i][2] * v[i][2] + v[i][3] * v[i][3]); }
#pragma unroll
            for (int o = 32; o > 0; o >>= 1) q += shx(q, o, lane);
            const float rstd = rsqrtf(q * (1.0f / DM) + 1e-5f);
#pragma unroll
            for (int i = 0; i < 4; ++i) v[i] = v[i] * rstd * gg[i] + bb[i];
        }
        if (dstf) {
#pragma unroll
            for (int i = 0; i < 4; ++i) *GP(f32x4)(dstf + (size_t)row * DM + i * 256 + lane * 4) = v[i];
        }
        if (xb) {
#pragma unroll
            for (int i = 0; i < 4; ++i) { u32x2 w; w.x = cvt_pk_bf16(v[i][0], v[i][1]); w.y = cvt_pk_bf16(v[i][2], v[i][3]);
                *GP(u32x2)(xb + (size_t)row * DM + i * 256 + lane * 4) = w; }
        }
        if (wg) {
            float d[8] = {0.f, 0.f, 0.f, 0.f, 0.f, 0.f, 0.f, 0.f};
#pragma unroll
            for (int i = 0; i < 4; ++i)
#pragma unroll
                for (int e = 0; e < 4; ++e) {
                    const float* wp = wgs + (i * 256 + lane * 4 + e) * 8;
                    const f32x4 w0 = *reinterpret_cast<const f32x4*>(wp), w1 = *reinterpret_cast<const f32x4*>(wp + 4);
                    const float xv = v[i][e];
                    d[0] += xv * w0[0]; d[1] += xv * w0[1]; d[2] += xv * w0[2]; d[3] += xv * w0[3];
                    d[4] += xv * w1[0]; d[5] += xv * w1[1]; d[6] += xv * w1[2]; d[7] += xv * w1[3];
                }
#pragma unroll
            for (int j = 0; j < 8; ++j) {
#pragma unroll
                for (int o = 32; o > 0; o >>= 1) d[j] += shx(d[j], o, lane);
            }
            if (lane == 0) {
                *GP(f32x4)(BA + (size_t)row * 8) = (f32x4){d[0], d[1], d[2], d[3]};
                *GP(f32x4)(BA + (size_t)row * 8 + 4) = (f32x4){d[4], d[5], d[6], d[7]};
            }
        }
    }
    __syncthreads();
}

constexpr int GRP_LDS = 73728;
constexpr int L_KRM = 0, L_QRM = 17408, L_KBGT = 34816, L_VBT = 53248, L_GC = 71680, L_BETA = 71936;
__device__ __forceinline__ void chunk_prep(const Params& p_, int l, int g_wave) {
    Params p = p_; p.ws = opaque_ws(p.ws);
    const bf16_t* HA = reinterpret_cast<const bf16_t*>(p.ws + OFF_HA);
    const float* BA = reinterpret_cast<const float*>(p.ws + OFF_BA);
    bf16_t* UT = reinterpret_cast<bf16_t*>(p.ws + OFF_UT);
    bf16_t* W = reinterpret_cast<bf16_t*>(p.ws + OFF_W);
    bf16_t* QD = reinterpret_cast<bf16_t*>(p.ws + OFF_QD);
    bf16_t* KDT = reinterpret_cast<bf16_t*>(p.ws + OFF_KDT);
    bf16_t* QK = reinterpret_cast<bf16_t*>(p.ws + OFF_QK);
    float* GT = reinterpret_cast<float*>(p.ws + OFF_GT);
    const float* cw = p.conv_w + (size_t)l * 4 * 1536;
#define CP_LANEVARS const int tid = opaque_tid(), grp = tid >> 8, gt = tid & 255, lane = tid & 63, wv = gt >> 6, fr = lane & 15, fq = lane >> 4; \
    unsigned char* lds = dyn_lds + grp * GRP_LDS; float* gc_s = reinterpret_cast<float*>(lds + L_GC); float* beta_s = reinterpret_cast<float*>(lds + L_BETA); \
    const int tg = gt >> 4, sg = gt & 15, t0 = tg * 4, c0 = sg * 8; (void)fr; (void)fq; (void)wv; (void)t0; (void)c0; (void)gc_s; (void)beta_s; (void)lane;
    for (int pi = blockIdx.x; pi < 512; pi += gridDim.x) {
        const int grp0 = opaque_tid() >> 8;
        const int hp = pi & 1, n = (pi >> 1) & 63, b = pi >> 7, h = hp * 2 + grp0;
        const int item = (b * 4 + h) * 64 + n, tok0 = b * SEQ + n * 64;
        u32x4 rawp[3][7];
        { CP_LANEVARS
#pragma unroll
          for (int ten = 0; ten < 3; ++ten)
#pragma unroll
            for (int r = 0; r < 7; ++r) {
                const int tt = n * 64 + t0 - 3 + r;
                rawp[ten][r] = mk4(0u, 0u, 0u, 0u);
                if (tt >= 0) rawp[ten][r] = *GPC(u32x4)(HA + (size_t)(b * SEQ + tt) * HA_LD + ten * 512 + h * 128 + c0);
            } }
        { CP_LANEVARS
        if (wv == 0) {
            const float bv = *GPC(float)(BA + (size_t)(tok0 + lane) * 8 + h), av = *GPC(float)(BA + (size_t)(tok0 + lane) * 8 + 4 + h);
            const float beta = __builtin_amdgcn_rcpf(1.0f + __expf(-bv));
            const float xx = av + p.dt_bias[l * 4 + h];
            const float sp = fmaxf(xx, 0.f) + log1pf(__expf(-fabsf(xx)));
            float gv = -__expf(p.a_log[l * 4 + h]) * sp;
#pragma unroll
            for (int o = 1; o < 64; o <<= 1) { const float t = __int_as_float(__builtin_amdgcn_ds_bpermute((lane - o) << 2, __float_as_int(gv))); if (lane >= o) gv += t; }
            gc_s[lane] = gv; beta_s[lane] = beta;
            if (lane == 63) *GP(float)(GT + item) = __expf(gv);
        } }
        __syncthreads();
        {
            CP_LANEVARS
            const float glast = gc_s[63];
            float eg[4], ek[4], be[4];
#pragma unroll
            for (int i = 0; i < 4; ++i) { const float gci = gc_s[t0 + i]; eg[i] = __expf(gci); ek[i] = __expf(glast - gci); be[i] = beta_s[t0 + i]; }
#pragma unroll
            for (int ten = 0; ten < 3; ++ten) {
                __builtin_amdgcn_sched_barrier(0);
                float raw[7][8];
#pragma unroll
                for (int r = 0; r < 7; ++r) {
                    const u32x4 u = rawp[ten][r];
                    raw[r][0] = bf_lo(u.x); raw[r][1] = bf_hi(u.x); raw[r][2] = bf_lo(u.y); raw[r][3] = bf_hi(u.y);
                    raw[r][4] = bf_lo(u.z); raw[r][5] = bf_hi(u.z); raw[r][6] = bf_lo(u.w); raw[r][7] = bf_hi(u.w);
                }
                float o[4][8];
#pragma unroll
                for (int i = 0; i < 4; ++i)
#pragma unroll
                    for (int c = 0; c < 8; ++c) o[i][c] = 0.f;
#pragma unroll
                for (int j = 0; j < 4; ++j) {
                    const float* wp = cw + (size_t)j * 1536 + ten * 512 + h * 128 + c0;
                    const f32x4 a = *GPC(f32x4)(wp), c4 = *GPC(f32x4)(wp + 4);
                    const float wj[8] = {a[0], a[1], a[2], a[3], c4[0], c4[1], c4[2], c4[3]};
#pragma unroll
                    for (int i = 0; i < 4; ++i)
#pragma unroll
                        for (int c = 0; c < 8; ++c) o[i][c] += wj[c] * raw[i + j][c];
                }
#pragma unroll
                for (int i = 0; i < 4; ++i)
#pragma unroll
                    for (int c = 0; c < 8; ++c) o[i][c] = silu_f(o[i][c]);
                if (ten < 2) {
#pragma unroll
                    for (int i = 0; i < 4; ++i) {
                        float sq = 0.f;
#pragma unroll
                        for (int c = 0; c < 8; ++c) sq += o[i][c] * o[i][c];
#pragma unroll
                        for (int off = 1; off < 16; off <<= 1) sq += shx(sq, off, lane);
                        const float rq = rsqrtf(sq + 1e-6f) * (ten == 0 ? 0.08838834764831845f : 1.0f);
#pragma unroll
                        for (int c = 0; c < 8; ++c) o[i][c] *= rq;
                    }
                }
                if (ten == 0) {
#pragma unroll
                    for (int i = 0; i < 4; ++i) {
                        u32x4 w;
                        w.x = cvt_pk_bf16(o[i][0] * eg[i], o[i][1] * eg[i]); w.y = cvt_pk_bf16(o[i][2] * eg[i], o[i][3] * eg[i]);
                        w.z = cvt_pk_bf16(o[i][4] * eg[i], o[i][5] * eg[i]); w.w = cvt_pk_bf16(o[i][6] * eg[i], o[i][7] * eg[i]);
                        { const int t_ = t0 + i; *GP(u32x4)(QD + ((((size_t)item * 4 + (t_ >> 4)) * 4 + (sg >> 2)) * 64 + (t_ & 15) + 16 * (sg & 3)) * 8) = w; }
                        w.x = cvt_pk_bf16(o[i][0], o[i][1]); w.y = cvt_pk_bf16(o[i][2], o[i][3]); w.z = cvt_pk_bf16(o[i][4], o[i][5]); w.w = cvt_pk_bf16(o[i][6], o[i][7]);
                        *reinterpret_cast<u32x4*>(lds + L_QRM + ((t0 + i) * 136 + c0) * 2) = w;
                    }
                } else if (ten == 1) {
#pragma unroll
                    for (int i = 0; i < 4; ++i) {
                        u32x4 w;
                        w.x = cvt_pk_bf16(o[i][0], o[i][1]); w.y = cvt_pk_bf16(o[i][2], o[i][3]); w.z = cvt_pk_bf16(o[i][4], o[i][5]); w.w = cvt_pk_bf16(o[i][6], o[i][7]);
                        *reinterpret_cast<u32x4*>(lds + L_KRM + ((t0 + i) * 136 + c0) * 2) = w;
                    }
#pragma unroll
                    for (int c = 0; c < 8; ++c) {
                        u32x2 w;
                        w.x = cvt_pk_bf16(o[0][c] * ek[0], o[1][c] * ek[1]); w.y = cvt_pk_bf16(o[2][c] * ek[2], o[3][c] * ek[3]);
                        { const int dk_ = c0 + c; *GP(u32x2)(KDT + ((((size_t)item * 8 + (dk_ >> 4)) * 2 + (t0 >> 5)) * 64 + (dk_ & 15) + 16 * ((t0 & 31) >> 3)) * 8 + ((t0 & 7) >> 2) * 4) = w; }
                        w.x = cvt_pk_bf16(o[0][c] * be[0] * eg[0], o[1][c] * be[1] * eg[1]); w.y = cvt_pk_bf16(o[2][c] * be[2] * eg[2], o[3][c] * be[3] * eg[3]);
                        *reinterpret_cast<u32x2*>(lds + L_KBGT + ((c0 + c) * 72 + t0) * 2) = w;
                    }
                } else {
#pragma unroll
                    for (int c = 0; c < 8; ++c) {
                        u32x2 w;
                        w.x = cvt_pk_bf16(o[0][c] * be[0], o[1][c] * be[1]); w.y = cvt_pk_bf16(o[2][c] * be[2], o[3][c] * be[3]);
                        *reinterpret_cast<u32x2*>(lds + L_VBT + ((c0 + c) * 72 + t0) * 2) = w;
                    }
                }
            }
        }
        __syncthreads();
        {
            CP_LANEVARS
            const int ib = wv;
            f32x4 kk[4], qk[4];
#pragma unroll
            for (int jb = 0; jb < 4; ++jb) { kk[jb] = (f32x4){0.f, 0.f, 0.f, 0.f}; qk[jb] = (f32x4){0.f, 0.f, 0.f, 0.f}; }
            bf16x8 ki[4], qi[4];
#pragma unroll
            for (int ks = 0; ks < 4; ++ks) {
                ki[ks] = lds8(lds + L_KRM + ((ib * 16 + fr) * 136 + ks * 32 + fq * 8) * 2);
                qi[ks] = lds8(lds + L_QRM + ((ib * 16 + fr) * 136 + ks * 32 + fq * 8) * 2);
            }
#pragma unroll
            for (int jb = 0; jb < 4; ++jb) {
                if (jb <= ib) {
#pragma unroll
                    for (int ks = 0; ks < 4; ++ks) {
                        const bf16x8 kj = lds8(lds + L_KRM + ((jb * 16 + fr) * 136 + ks * 32 + fq * 8) * 2);
                        kk[jb] = mfma16(ki[ks], kj, kk[jb]);
                        qk[jb] = mfma16(kj, qi[ks], qk[jb]);
                    }
                }
            }
            __syncthreads();
            float* AP = reinterpret_cast<float*>(lds + L_KRM);
#pragma unroll
            for (int jb = 0; jb < 4; ++jb) {
                if (jb <= ib) {
                    const int j = jb * 16 + fr, i0 = ib * 16 + fq * 4;
                    const float gj = gc_s[j];
#pragma unroll
                    for (int r = 0; r < 4; ++r) {
                        const int i = i0 + r;
                        const float dec = __expf(fminf(gc_s[i] - gj, 0.f));
                        float av_ = (i > j) ? kk[jb][r] * beta_s[i] * dec : 0.f;
#ifdef DIAG3
                        atomicMax(reinterpret_cast<unsigned*>(p.ws + OFF_BAR) + 4011, __float_as_uint(fabsf(kk[jb][r])));
                        atomicMax(reinterpret_cast<unsigned*>(p.ws + OFF_BAR) + 4012, __float_as_uint(fabsf(av_)));
#endif
#ifdef CLAMP_A
                        if (!(fabsf(av_) <= 0.02f)) av_ = 0.f;
#endif
                        AP[j * 64 + r * 16 + ib * 4 + fq] = av_;
                    }
                }
                {
                    const int i = ib * 16 + fr, j0 = jb * 16 + fq * 4;
                    const float gi = gc_s[i];
                    float o[4];
#pragma unroll
                    for (int r = 0; r < 4; ++r) {
                        const int j = j0 + r;
                        const float dec = __expf(fminf(gi - gc_s[j], 0.f));
                        o[r] = (i >= j) ? qk[jb][r] * dec : 0.f;
                    }
                    u32x2 w; w.x = cvt_pk_bf16(o[0], o[1]); w.y = cvt_pk_bf16(o[2], o[3]);
                    *GP(u32x2)(QK + ((((size_t)item * 4 + ib) * 2 + (jb >> 1)) * 64 + fr + 16 * ((jb & 1) * 2 + (fq >> 1))) * 8 + (fq & 1) * 4) = w;
                }
            }
        }
        __syncthreads();
        {
            CP_LANEVARS
            const float* AP = reinterpret_cast<const float*>(lds + L_KRM);
            const int cl = lane >> 2, pp = lane & 3, ccol = wv * 16 + cl;
            float a[16];
#pragma unroll
            for (int k = 0; k < 16; ++k) a[k] = (4 * k + pp == ccol) ? 1.f : 0.f;
#define INV_STEP(SS) { const int j = jq * 4 + SS; \
                    const float tj = __int_as_float(__builtin_amdgcn_update_dpp(0, __float_as_int(a[jq]), SS * 0x55, 0xf, 0xf, false)); \
                    const float* ap = AP + j * 64 + pp * 16; \
                    _Pragma("unroll") for (int k = jq; k < 16; ++k) a[k] -= ap[k] * tj; }
#pragma unroll
            for (int jq = 0; jq < 16; ++jq) {
                __builtin_amdgcn_sched_barrier(0);
#ifdef NO_INV
                if (false) {
#else
                if (jq >= wv * 4) {
#endif
                    INV_STEP(0) INV_STEP(1) INV_STEP(2)
                    if (jq < 15) INV_STEP(3)
                }
            }
#undef INV_STEP
#ifdef DIAG3
            { float mx = 0.f;
              for (int k = 0; k < 16; ++k) { const float av = fabsf(a[k]); mx = (av > mx || !(av == av)) ? av : mx; }
              atomicMax(reinterpret_cast<unsigned*>(p.ws + OFF_BAR) + 4010, __float_as_uint(mx)); }
#endif
            bf16_t* TR = reinterpret_cast<bf16_t*>(lds + L_QRM);
#pragma unroll
            for (int k = 0; k < 16; ++k) TR[(4 * k + pp) * 72 + ccol] = (bf16_t)(cvt_pk_bf16(a[k], 0.f) & 0xffffu);
        }
        __syncthreads();
        {
            CP_LANEVARS
            bf16x8 tf[2];
#pragma unroll
            for (int ks = 0; ks < 2; ++ks) tf[ks] = lds8(lds + L_QRM + ((wv * 16 + fr) * 72 + ks * 32 + fq * 8) * 2);
#pragma unroll
            for (int db = 0; db < 8; ++db) {
                f32x4 au = (f32x4){0.f, 0.f, 0.f, 0.f}, aw = (f32x4){0.f, 0.f, 0.f, 0.f};
#pragma unroll
                for (int ks = 0; ks < 2; ++ks) {
                    const bf16x8 vb = lds8(lds + L_VBT + ((db * 16 + fr) * 72 + ks * 32 + fq * 8) * 2);
                    const bf16x8 kb = lds8(lds + L_KBGT + ((db * 16 + fr) * 72 + ks * 32 + fq * 8) * 2);
                    au = mfma16(tf[ks], vb, au);
                    aw = mfma16(kb, tf[ks], aw);
                }
                u32x2 w; w.x = cvt_pk_bf16(au[0], au[1]); w.y = cvt_pk_bf16(au[2], au[3]);
                *GP(u32x2)(UT + ((((size_t)item * 8 + db) * 2 + (wv >> 1)) * 64 + fr + 16 * ((wv & 1) * 2 + (fq >> 1))) * 8 + (fq & 1) * 4) = w;
                w.x = cvt_pk_bf16(aw[0], aw[1]); w.y = cvt_pk_bf16(aw[2], aw[3]);
                *GP(u32x2)(W + ((((size_t)item * 4 + wv) * 4 + (db >> 1)) * 64 + fr + 16 * ((db & 1) * 2 + (fq >> 1))) * 8 + (fq & 1) * 4) = w;
            }
        }
        __syncthreads();
    }
}

__device__ __forceinline__ void delta_scan(const Params& p_, int blk, int g_wave) {
    Params p = p_; p.ws = opaque_ws(p.ws);
    const int tid = opaque_tid(), lane = tid & 63, w = tid >> 6, fr = lane & 15, fq = lane >> 4;
    const int bh = (blk & 7) + 8 * ((blk >> 3) & 1), sl = blk >> 4, dv0 = sl * 32;
    bf16_t* ST = reinterpret_cast<bf16_t*>(p.ws + OFF_HA);
    bf16_t* UT = reinterpret_cast<bf16_t*>(p.ws + OFF_UT);
    const bf16_t* W = reinterpret_cast<const bf16_t*>(p.ws + OFF_W);
    const bf16_t* KDT = reinterpret_cast<const bf16_t*>(p.ws + OFF_KDT);
    const float* GT = reinterpret_cast<const float*>(p.ws + OFF_GT);
    unsigned char* STL = dyn_lds;
    unsigned char* VTL = dyn_lds + 8704;
    unsigned char* DMY = dyn_lds + 13312;
    unsigned char* RING = dyn_lds + 16384;
    (void)dv0;
#define LDS_BAR() do { asm volatile("s_waitcnt lgkmcnt(0)" ::: "memory"); __builtin_amdgcn_s_barrier(); asm volatile("" ::: "memory"); } while (0)
    if (w >= 4) {
        constexpr int PD = 10;
        const int hw = w - 4, pl = hw * 64 + lane;
#define RING_LOAD(C) do { const int c_ = (C) < 64 ? (C) : 63; const int slot_ = (C) & 3; \
            const bf16_t* wsrc = W + (size_t)(bh * 64 + c_) * 8192 + (hw * 4) * 512 + lane * 8; \
            const bf16_t* ksrc = KDT + (size_t)(bh * 64 + c_) * 8192 + (hw * 4) * 512 + lane * 8; \
            _Pragma("unroll") for (int j = 0; j < 4; ++j) { \
                __builtin_amdgcn_global_load_lds((const unsigned*)(wsrc + j * 512), (unsigned*)(RING + slot_ * 32768 + (hw * 4 + j) * 1024), 16, 0, 0); \
                __builtin_amdgcn_global_load_lds((const unsigned*)(ksrc + j * 512), (unsigned*)(RING + slot_ * 32768 + 16384 + (hw * 4 + j) * 1024), 16, 0, 0); } } while (0)
#define TOUCH(C) do { const int c_ = (C) < 64 ? (C) : 63; const int item_ = bh * 64 + c_; \
            const int li = sl * 32 + (lane & 31); \
            const unsigned char* a0 = (hw == 0) ? ((lane < 32) ? reinterpret_cast<const unsigned char*>(W + (size_t)item_ * 8192) + li * 128 \
                                                               : reinterpret_cast<const unsigned char*>(KDT + (size_t)item_ * 8192) + li * 128) \
                                                : reinterpret_cast<const unsigned char*>(UT + ((size_t)item_ * 8 + sl * 2) * 1024) + (lane & 31) * 128; \
            __builtin_amdgcn_global_load_lds((const unsigned*)a0, (unsigned*)(DMY + hw * 256), 4, 0, 0); } while (0)
        for (int c = 0; c < PD; ++c) TOUCH(c);
        RING_LOAD(0); RING_LOAD(1); RING_LOAD(2);
        asm volatile("s_waitcnt vmcnt(0)" ::: "memory");
        __syncthreads();
        for (int n = 0; n < 64; ++n) {
            const int item = bh * 64 + n;
            __builtin_amdgcn_s_barrier();
            {
                const int dvb_ = pl >> 7, ks_ = (pl >> 6) & 1, l_ = pl & 63;
                const u32x4 v = *reinterpret_cast<const u32x4*>(VTL + ((dvb_ * 16 + (l_ & 15)) * 72 + ks_ * 32 + (l_ >> 4) * 8) * 2);
                *GP(u32x4)(UT + (((size_t)item * 8 + sl * 2) * 128 + pl) * 8) = v;
            }
            asm volatile("s_waitcnt vmcnt(14) lgkmcnt(0)" ::: "memory");
            __builtin_amdgcn_s_barrier();
            {
                bf16_t* dst = (n < 63) ? ST + (((size_t)(item + 1) * 8 + sl * 2) * 256) * 8 : ST + (size_t)1024 * 16384 + (size_t)blk * 4096;
#pragma unroll
                for (int j = 0; j < 2; ++j) {
                    const int q = pl + 256 * j, dvb_ = q >> 8, ks_ = (q >> 6) & 3, l_ = q & 63;
                    const u32x4 v = *reinterpret_cast<const u32x4*>(STL + ((dvb_ * 16 + (l_ & 15)) * 136 + ks_ * 32 + (l_ >> 4) * 8) * 2);
                    *GP(u32x4)(dst + (size_t)q * 8) = v;
                }
            }
            RING_LOAD(n + 3);
            TOUCH(n + PD);
            asm volatile("s_waitcnt lgkmcnt(0)" ::: "memory");
        }
        asm volatile("s_waitcnt vmcnt(0)" ::: "memory");
#undef RING_LOAD
#undef TOUCH
    } else {
        f32x4 S[2][2];
#pragma unroll
        for (int kb = 0; kb < 2; ++kb)
#pragma unroll
            for (int db = 0; db < 2; ++db) {
                S[kb][db] = (f32x4){0.f, 0.f, 0.f, 0.f};
                const u32x2 z = mk2(0u, 0u);
                *reinterpret_cast<u32x2*>(STL + ((db * 16 + fr) * 136 + (2 * w + kb) * 16 + fq * 4) * 2) = z;
                *GP(u32x2)(ST + (((size_t)(bh * 64) * 8 + sl * 2) * 256) * 8 + (size_t)(((kb * 2 + db) * 256 + w * 64 + lane)) * 4) = z;
            }
        __syncthreads();
#define SCAN_LOAD(NN, UB, GTV) do { const int item_ = bh * 64 + (NN); \
        _Pragma("unroll") for (int db = 0; db < 2; ++db) UB[db] = *GPC(u32x2)(UT + ((((size_t)item_ * 8 + sl * 2 + db) * 2 + (w >> 1)) * 64 + fr + 16 * ((w & 1) * 2 + (fq >> 1))) * 8 + (fq & 1) * 4); \
        GTV = *GPC(float)(GT + item_); } while (0)
        u32x2 ubA[2], ubB[2], ubC[2]; float gtA, gtB, gtC;
        SCAN_LOAD(0, ubA, gtA); SCAN_LOAD(1, ubB, gtB);
#define SCAN_STEP(N_, UB, GTV, NUB, NGT) do { \
        const int n = (N_); \
        { const int nn = n + 2 < 64 ? n + 2 : 63; SCAN_LOAD(nn, NUB, NGT); } \
        const unsigned char* slot = RING + (n & 3) * 32768; \
        { bf16x8 sb_[2][4], wf_[4]; \
          _Pragma("unroll") for (int ks = 0; ks < 4; ++ks) wf_[ks] = lds8(slot + ((w * 4 + ks) * 64 + lane) * 16); \
          _Pragma("unroll") for (int db = 0; db < 2; ++db) _Pragma("unroll") for (int ks = 0; ks < 4; ++ks) sb_[db][ks] = lds8(STL + ((db * 16 + fr) * 136 + ks * 32 + fq * 8) * 2); \
          f32x4 a10 = (f32x4){0.f, 0.f, 0.f, 0.f}, a11 = (f32x4){0.f, 0.f, 0.f, 0.f}; \
          _Pragma("unroll") for (int ks = 0; ks < 4; ++ks) { a10 = mfma16(wf_[ks], sb_[0][ks], a10); a11 = mfma16(wf_[ks], sb_[1][ks], a11); } \
          _Pragma("unroll") for (int db = 0; db < 2; ++db) { \
              const f32x4 a1 = db ? a11 : a10; u32x2 vw; \
              vw.x = cvt_pk_bf16(bf_lo(UB[db].x) - a1[0], bf_hi(UB[db].x) - a1[1]); vw.y = cvt_pk_bf16(bf_lo(UB[db].y) - a1[2], bf_hi(UB[db].y) - a1[3]); \
              *reinterpret_cast<u32x2*>(VTL + ((db * 16 + fr) * 72 + w * 16 + fq * 4) * 2) = vw; \
              } } \
        LDS_BAR(); \
        { bf16x8 vb_[2][2], kf_[2][2]; \
          _Pragma("unroll") for (int kb = 0; kb < 2; ++kb) _Pragma("unroll") for (int ks = 0; ks < 2; ++ks) kf_[kb][ks] = lds8(slot + 16384 + (((2 * w + kb) * 2 + ks) * 64 + lane) * 16); \
          _Pragma("unroll") for (int db = 0; db < 2; ++db) _Pragma("unroll") for (int ks = 0; ks < 2; ++ks) vb_[db][ks] = lds8(VTL + ((db * 16 + fr) * 72 + ks * 32 + fq * 8) * 2); \
          _Pragma("unroll") for (int kb = 0; kb < 2; ++kb) _Pragma("unroll") for (int db = 0; db < 2; ++db) { \
              f32x4 a2 = S[kb][db] * GTV; \
              a2 = mfma16(kf_[kb][0], vb_[db][0], a2); a2 = mfma16(kf_[kb][1], vb_[db][1], a2); \
              S[kb][db] = a2; \
              if (n < 63) { \
                  u32x2 sw; sw.x = cvt_pk_bf16(a2[0], a2[1]); sw.y = cvt_pk_bf16(a2[2], a2[3]); \
                  *reinterpret_cast<u32x2*>(STL + ((db * 16 + fr) * 136 + (2 * w + kb) * 16 + fq * 4) * 2) = sw; \
              } } } \
        LDS_BAR(); } while (0)
        for (int n3 = 0; n3 < 63; n3 += 3) {
            SCAN_STEP(n3 + 0, ubA, gtA, ubC, gtC);
            SCAN_STEP(n3 + 1, ubB, gtB, ubA, gtA);
            SCAN_STEP(n3 + 2, ubC, gtC, ubB, gtB);
        }
        SCAN_STEP(63, ubA, gtA, ubC, gtC);
#undef SCAN_STEP
#undef SCAN_LOAD
    }
#undef LDS_BAR
}

__device__ __forceinline__ void swa_phase(const Params& p_, int l, int sblk, int nsb, int g_wave) {
    Params p = p_; p.ws = opaque_ws(p.ws);
    const int tid = opaque_tid(), lane = tid & 63, w = tid >> 6, fr = lane & 15, fq = lane >> 4;
    const bf16_t* HB = reinterpret_cast<const bf16_t*>(p.ws + OFF_HB);
    bf16_t* YM = reinterpret_cast<bf16_t*>(p.ws + OFF_XB);
    unsigned char* VTS = dyn_lds;
    unsigned char* KSL = dyn_lds + 21504;
    for (int it = sblk; it < 1024; it += nsb) {
        const int b = it >> 8, kvh = (it >> 7) & 1, qt = it & 127, q0 = qt * 32, kbase = q0 - 128;
        for (int idx = tid; idx < 1280; idx += 512) {
            const int key = idx >> 3, sg = idx & 7, kp = kbase + key;
            u32x4 u = mk4(0u, 0u, 0u, 0u);
            if (kp >= 0) u = *GPC(u32x4)(HB + (size_t)(b * SEQ + kp) * HB_LD + HB_KB + kvh * 64 + sg * 8);
            *reinterpret_cast<u32x4*>(KSL + (key * 72 + sg * 8) * 2) = u;
        }
        if (tid < 320) {
            const int kg = tid >> 3, sg = tid & 7;
            u32x4 u[4];
#pragma unroll
            for (int k = 0; k < 4; ++k) {
                const int kp = kbase + kg * 4 + k;
                u[k] = mk4(0u, 0u, 0u, 0u);
                if (kp >= 0) u[k] = *GPC(u32x4)(HB + (size_t)(b * SEQ + kp) * HB_LD + HB_VB + kvh * 64 + sg * 8);
            }
#pragma unroll
            for (int dp = 0; dp < 4; ++dp) {
                u32x2 lo, hi;
                lo.x = (u[0][dp] & 0xffffu) | (u[1][dp] << 16); lo.y = (u[2][dp] & 0xffffu) | (u[3][dp] << 16);
                hi.x = (u[0][dp] >> 16) | (u[1][dp] & 0xffff0000u); hi.y = (u[2][dp] >> 16) | (u[3][dp] & 0xffff0000u);
                *reinterpret_cast<u32x2*>(VTS + ((sg * 8 + dp * 2) * 168 + kg * 4) * 2) = lo;
                *reinterpret_cast<u32x2*>(VTS + ((sg * 8 + dp * 2 + 1) * 168 + kg * 4) * 2) = hi;
            }
        }
        const int g = w >> 1, sub = w & 1, qs = q0 + sub * 16, hq = kvh * 4 + g;
        const float slope = exp2f(-(float)(hq + 1)), sink = p.sinks[l * 8 + hq];
        bf16x8 qf[2];
#pragma unroll
        for (int ks = 0; ks < 2; ++ks) qf[ks] = ldg8(HB + (size_t)(b * SEQ + qs + fr) * HB_LD + HB_QB + hq * 64 + ks * 32 + fq * 8);
        __syncthreads();
        f32x4 sc[10];
#pragma unroll
        for (int kt = 0; kt < 10; ++kt) {
            const unsigned char* kr = KSL + ((kt * 16 + fr) * 72 + fq * 8) * 2;
            f32x4 a = (f32x4){0.f, 0.f, 0.f, 0.f};
            a = mfma16(lds8(kr), qf[0], a);
            a = mfma16(lds8(kr + 64), qf[1], a);
            sc[kt] = a;
        }
        const int qpos = qs + fr;
        float m = -1e30f;
#pragma unroll
        for (int kt = 0; kt < 10; ++kt)
#pragma unroll
            for (int r = 0; r < 4; ++r) {
                const int kpos = kbase + kt * 16 + fq * 4 + r, dist = qpos - kpos;
                const bool valid = (dist >= 0) && (dist < 128) && (kpos >= 0);
                const float s = valid ? sc[kt][r] * 0.125f - slope * (float)dist : -1e30f;
                sc[kt][r] = s; m = fmaxf(m, s);
            }
        m = fmaxf(m, shx(m, 16, lane)); m = fmaxf(m, shx(m, 32, lane));
        m = fmaxf(m, sink);
        float lsum = 0.f;
#pragma unroll
        for (int kt = 0; kt < 10; ++kt)
#pragma unroll
            for (int r = 0; r < 4; ++r) { const float e = __expf(sc[kt][r] - m); sc[kt][r] = e; lsum += e; }
        lsum += shx(lsum, 16, lane); lsum += shx(lsum, 32, lane);
        lsum += __expf(sink - m);
        const float inv = __builtin_amdgcn_rcpf(lsum);
        f32x4 o[4];
#pragma unroll
        for (int db = 0; db < 4; ++db) o[db] = (f32x4){0.f, 0.f, 0.f, 0.f};
#pragma unroll
        for (int j = 0; j < 5; ++j) {
            union { bf16x8 v; unsigned u[4]; } pf;
            pf.u[0] = cvt_pk_bf16(sc[2 * j][0], sc[2 * j][1]); pf.u[1] = cvt_pk_bf16(sc[2 * j][2], sc[2 * j][3]);
            pf.u[2] = cvt_pk_bf16(sc[2 * j + 1][0], sc[2 * j + 1][1]); pf.u[3] = cvt_pk_bf16(sc[2 * j + 1][2], sc[2 * j + 1][3]);
#pragma unroll
            for (int db = 0; db < 4; ++db) {
                union { bf16x8 v; u32x2 h[2]; } vf;
                const unsigned char* vr = VTS + ((db * 16 + fr) * 168 + (2 * j) * 16 + fq * 4) * 2;
                vf.h[0] = *reinterpret_cast<const u32x2*>(vr);
                vf.h[1] = *reinterpret_cast<const u32x2*>(vr + 32);
                o[db] = mfma16(vf.v, pf.v, o[db]);
            }
        }
        {
            const size_t tok = (size_t)(b * SEQ + qs + fr);
#pragma unroll
            for (int db = 0; db < 4; ++db) {
                const int col = hq * 64 + db * 16 + fq * 4;
                const u32x2 z = *GPC(u32x2)(HB + tok * HB_LD + HB_ZB + col);
                u32x2 y;
                y.x = cvt_pk_bf16(o[db][0] * inv * silu_f(bf_lo(z.x)), o[db][1] * inv * silu_f(bf_hi(z.x)));
                y.y = cvt_pk_bf16(o[db][2] * inv * silu_f(bf_lo(z.y)), o[db][3] * inv * silu_f(bf_hi(z.y)));
                *GP(u32x2)(YM + tok * DM + 512 + col) = y;
            }
        }
        __syncthreads();
    }
}

__device__ __forceinline__ void delta_out(const Params& p_, int l, int g_wave) {
    Params p = p_; p.ws = opaque_ws(p.ws);
    const int tid = opaque_tid(), grp = tid >> 8, lane = tid & 63, wv = (tid & 255) >> 6, fr = lane & 15, fq = lane >> 4;
    const bf16_t* ST = reinterpret_cast<const bf16_t*>(p.ws + OFF_HA);
    const bf16_t* VT = reinterpret_cast<const bf16_t*>(p.ws + OFF_UT);
    const bf16_t* QD = reinterpret_cast<const bf16_t*>(p.ws + OFF_QD);
    const bf16_t* QK = reinterpret_cast<const bf16_t*>(p.ws + OFF_QK);
    const bf16_t* HB = reinterpret_cast<const bf16_t*>(p.ws + OFF_HB);
    bf16_t* YM = reinterpret_cast<bf16_t*>(p.ws + OFF_XB);
    const float* nw = p.norm_w + l * 128;
    for (int pi = blockIdx.x; pi < 512; pi += gridDim.x) {
        const int item = pi * 2 + grp, bh = item >> 6, n = item & 63, b = bh >> 2, h = bh & 3;
        const int tok = b * SEQ + n * 64 + wv * 16 + fr;
        bf16x8 qd[4], qk[2];
#pragma unroll
        for (int ks = 0; ks < 4; ++ks) qd[ks] = ldg8(QD + ((((size_t)item * 4 + wv) * 4 + ks) * 64 + lane) * 8);
#pragma unroll
        for (int ks = 0; ks < 2; ++ks) qk[ks] = ldg8(QK + ((((size_t)item * 4 + wv) * 2 + ks) * 64 + lane) * 8);
        u32x2 zz[8];
#pragma unroll
        for (int db = 0; db < 8; ++db) zz[db] = *GPC(u32x2)(HB + (size_t)tok * HB_LD + HB_ZA + h * 128 + db * 16 + fq * 4);
        f32x4 o[8];
        float ss = 0.f;
        bf16x8 sfA[4], vfA[2], sfB[4], vfB[2];
#define DO_LOAD(DB, SF, VF) do { const bf16_t* sp = ST + ((((size_t)item * 8 + (DB)) * 4) * 64 + lane) * 8; const bf16_t* vp = VT + ((((size_t)item * 8 + (DB)) * 2) * 64 + lane) * 8; \
            _Pragma("unroll") for (int ks = 0; ks < 4; ++ks) SF[ks] = ldg8(sp + ks * 512); \
            _Pragma("unroll") for (int ks = 0; ks < 2; ++ks) VF[ks] = ldg8(vp + ks * 512); } while (0)
#define DO_MMA(DB, SF, VF) do { f32x4 a = (f32x4){0.f, 0.f, 0.f, 0.f}; \
            _Pragma("unroll") for (int ks = 0; ks < 4; ++ks) a = mfma16(SF[ks], qd[ks], a); \
            _Pragma("unroll") for (int ks = 0; ks < 2; ++ks) a = mfma16(VF[ks], qk[ks], a); \
            o[DB] = a; ss += (a[0] * a[0] + a[1] * a[1]) + (a[2] * a[2] + a[3] * a[3]); } while (0)
        DO_LOAD(0, sfA, vfA); DO_LOAD(1, sfB, vfB);
#pragma unroll
        for (int db = 0; db < 8; db += 2) {
            DO_MMA(db, sfA, vfA);
            if (db + 2 < 8) DO_LOAD(db + 2, sfA, vfA);
            DO_MMA(db + 1, sfB, vfB);
            if (db + 3 < 8) DO_LOAD(db + 3, sfB, vfB);
        }
#undef DO_LOAD
#undef DO_MMA
        ss += shx(ss, 16, lane); ss += shx(ss, 32, lane);
        const float rs = rsqrtf(ss * (1.0f / 128.0f) + 1e-6f);
#pragma unroll
        for (int db = 0; db < 8; ++db) {
            const int dv = db * 16 + fq * 4;
            const f32x4 nv = *GPC(f32x4)(nw + dv);
            const u32x2 z = zz[db];
            u32x2 y;
            y.x = cvt_pk_bf16(o[db][0] * rs * nv[0] * silu_f(bf_lo(z.x)), o[db][1] * rs * nv[1] * silu_f(bf_hi(z.x)));
            y.y = cvt_pk_bf16(o[db][2] * rs * nv[2] * silu_f(bf_lo(z.y)), o[db][3] * rs * nv[3] * silu_f(bf_hi(z.y)));
            *GP(u32x2)(YM + (size_t)tok * DM + h * 128 + dv) = y;
        }
    }
}


__device__ __forceinline__ void diag_rows(const bf16_t* YM, float* out, int g_wave) {
    const int tidx = opaque_tid();
    const int lane = tidx & 63;
    const int gw = blockIdx.x * 8 + (tidx >> 6), nw = gridDim.x * 8;
    for (int row = gw; row < NTOK; row += nw) {
        float ca = 0.f, cb = 0.f;
        for (int i = 0; i < 16; ++i) {
            const int col = i * 64 + lane;
            const float v = bf_lo((unsigned)YM[(size_t)row * DM + col]);
            const bool bad = !(fabsf(v) < 1e30f);
            if (bad) { if (col < 512) ca += 1.f; else cb += 1.f; }
        }
        for (int o = 32; o > 0; o >>= 1) { ca += shx(ca, o, lane); cb += shx(cb, o, lane); }
        for (int i = 0; i < 16; ++i) out[(size_t)row * DM + i * 64 + lane] = 0.f;
        if (lane == 0) out[(size_t)row * DM] = (ca > 0.f ? 1e6f : 0.f) + (cb > 0.f ? 1e5f : 0.f);
    }
}


__device__ __forceinline__ void diag_prep(unsigned char* ws, float* out, int g_wave) {
    const int tidx = opaque_tid();
    const int lane = tidx & 63;
    const int gw = blockIdx.x * 8 + (tidx >> 6), nw = gridDim.x * 8;
    const bf16_t* UT = reinterpret_cast<const bf16_t*>(ws + OFF_UT);
    const bf16_t* W = reinterpret_cast<const bf16_t*>(ws + OFF_W);
    const bf16_t* QD = reinterpret_cast<const bf16_t*>(ws + OFF_QD);
    const bf16_t* KDT = reinterpret_cast<const bf16_t*>(ws + OFF_KDT);
    const bf16_t* QK = reinterpret_cast<const bf16_t*>(ws + OFF_QK);
    const float* GT = reinterpret_cast<const float*>(ws + OFF_GT);
    const float* BA = reinterpret_cast<const float*>(ws + OFF_BA);
    for (int row = gw; row < NTOK; row += nw) {
        float c[6] = {0.f, 0.f, 0.f, 0.f, 0.f, 0.f};
        for (int i = 0; i < 8; ++i) {
            const size_t o = (size_t)row * 512 + i * 64 + lane;
            if (!(fabsf(bf_lo((unsigned)UT[o])) < 1e30f)) c[0] += 1.f;
            if (!(fabsf(bf_lo((unsigned)W[o])) < 1e30f)) c[1] += 1.f;
            if (!(fabsf(bf_lo((unsigned)QD[o])) < 1e30f)) c[2] += 1.f;
            if (!(fabsf(bf_lo((unsigned)KDT[o])) < 1e30f)) c[3] += 1.f;
        }
        for (int i = 0; i < 4; ++i) if (!(fabsf(bf_lo((unsigned)QK[(size_t)row * 256 + i * 64 + lane])) < 1e30f)) c[4] += 1.f;
        if (row < 1024 && lane == 0 && !(fabsf(GT[row]) < 1e30f)) c[5] += 1.f;
        if (lane < 8 && !(fabsf(BA[(size_t)row * 8 + lane]) < 1e30f)) c[5] += 1.f;
        for (int j = 0; j < 6; ++j) for (int o = 32; o > 0; o >>= 1) c[j] += shx(c[j], o, lane);
        unsigned bits = 0;
        for (int j = 0; j < 6; ++j) if (c[j] > 0.f) bits |= (1u << j);
        if (lane == 0 && bits) atomicOr(reinterpret_cast<unsigned*>(ws + OFF_BAR) + 4020, bits);
        for (int i = 0; i < 16; ++i) out[(size_t)row * DM + i * 64 + lane] = 0.f;
    }
}

__global__ void __launch_bounds__(512) fwd_megakernel(Params p) {
    __shared__ u32x4 xb_words;
    const int g_wave = __builtin_amdgcn_readfirstlane((int)(threadIdx.x >> 6));
    if (xb_t0(g_wave)) xb_words = mk4(0u, 0u, 0u, 0u);
    __syncthreads();
    XcdBarrier gb = xcd_barrier_post(reinterpret_cast<unsigned*>(p.ws + OFF_BAR), (volatile LAS unsigned*)&xb_words, g_wave);
#ifdef USE_CG
    gb.x = 0;
#endif

#ifndef PHM
#define PHM 255
#endif
    prep_weights(p, 0, blockIdx.x, gridDim.x, g_wave);
    if (PHM & 2) row_pass(p.x, false, nullptr, nullptr, nullptr, reinterpret_cast<bf16_t*>(p.ws + OFF_XB), p.w_in + 2048, reinterpret_cast<float*>(p.ws + OFF_BA), g_wave);
    xcd_barrier(gb);
    for (int l = 0; l < 2; ++l) {
        unsigned char* wsl = opaque_ws(p.ws);
        bf16_t* XB = reinterpret_cast<bf16_t*>(wsl + OFF_XB);
        float* BA = reinterpret_cast<float*>(wsl + OFF_BA);
        {
            EpiH e; e.ha = reinterpret_cast<bf16_t*>(p.ws + OFF_HA); e.hb = reinterpret_cast<bf16_t*>(p.ws + OFF_HB);
            { int reps = PROBE_REPS_GEMM; asm volatile("" : "+s"(reps));
              for (int rep = 0; rep < reps; ++rep) { gemm_phase(XB, reinterpret_cast<const bf16_t*>(p.ws + OFF_WIN) + (size_t)l * NIN * DM, NTOK, NIN, DM, e, g_wave); } }
            if (l == 0 && blockIdx.x >= 64) prep_weights(p, 1, blockIdx.x - 64, gridDim.x - 64, g_wave);
        }
        xcd_barrier(gb);
        { int reps_ = PROBE_REPS_PREP; asm volatile("" : "+s"(reps_)); for (int rep_ = 0; rep_ < reps_; ++rep_) { if (PHM & 8) chunk_prep(p, l, g_wave); __syncthreads(); } }
        xcd_barrier(gb);
#ifdef DIAG2
        if (l == 0) { diag_prep(wsl, p.out, g_wave); xcd_barrier(gb);
            if (blockIdx.x == 0 && opaque_tid() == 0) p.out[0] = 1000.f * (float)reinterpret_cast<const unsigned*>(wsl + OFF_BAR)[4020];
            return; }
#endif
#ifdef DIAG3
        if (l == 0) {
            const int tidx = opaque_tid();
            const unsigned* dw = reinterpret_cast<const unsigned*>(wsl + OFF_BAR);
            for (size_t i = (size_t)blockIdx.x * 512 + tidx; i < (size_t)NTOK * DM; i += (size_t)gridDim.x * 512) {
                float v = 0.f;
                if (i == 0) v = fminf(__uint_as_float(dw[4010]), 1e37f) * DIAG3_S0;
                if (i == 1) v = fminf(__uint_as_float(dw[4011]), 1e37f) * DIAG3_S1;
                if (i == 2) v = fminf(__uint_as_float(dw[4012]), 1e37f) * DIAG3_S2;
                p.out[i] = v;
            }
            return;
        }
#endif
        if (blockIdx.x < 64) { if (PHM & 16) delta_scan(p, blockIdx.x, g_wave); }
        else { int reps_ = PROBE_REPS_SWA; asm volatile("" : "+s"(reps_)); for (int rep_ = 0; rep_ < reps_; ++rep_) swa_phase(p, l, blockIdx.x - 64, gridDim.x - 64, g_wave); }
        xcd_barrier(gb);
#ifdef DIAG4
        if (l == 0) {
            const int tidx = opaque_tid();
            const unsigned* dw = reinterpret_cast<const unsigned*>(wsl + OFF_BAR);
            for (size_t i = (size_t)blockIdx.x * 512 + tidx; i < (size_t)NTOK * DM; i += (size_t)gridDim.x * 512) {
                float v = 0.f;
                if (i == 0) v = fminf(__uint_as_float(dw[4013]), 1e37f) * DIAG4_S0;
                if (i == 1) v = fminf(__uint_as_float(dw[4014]), 1e37f) * DIAG4_S1;
                p.out[i] = v;
            }
            return;
        }
#endif
        { int reps_ = PROBE_REPS_DOUT; asm volatile("" : "+s"(reps_)); for (int rep_ = 0; rep_ < reps_; ++rep_) { if (PHM & 64) delta_out(p, l, g_wave); __syncthreads(); } }
        xcd_barrier(gb);
#ifdef DIAG1
        if (l == DIAG1 - 1) { diag_rows(XB, p.out, g_wave); return; }
#endif
        {
            EpiZ e; e.xres = (l == 0) ? p.x : p.out; e.out = p.out;
            if (PHM & 128) gemm_phase(XB, reinterpret_cast<const bf16_t*>(p.ws + OFF_WOUT) + (size_t)l * DM * DM, NTOK, DM, DM, e, g_wave);
        }
        xcd_barrier(gb);
        if (l == 0) row_pass(p.out, true, p.ln_g, p.ln_b, p.out, XB, p.w_in + (size_t)DM * INC + 2048, BA, g_wave);
        else        row_pass(p.out, true, p.ln_g + DM, p.ln_b + DM, p.out, nullptr, nullptr, nullptr, g_wave);
        if (l == 0) xcd_barrier(gb);
    }
}

extern "C" void kernel_launch(void* const* d_in, const int* in_sizes, int n_in, void* d_out, int out_size, void* d_ws, size_t ws_size, hipStream_t stream) {
    static int grid_blocks = 0;
    if (!grid_blocks) {
        int dev = 0, cus = 0, per_cu = 0;
        hipGetDevice(&dev);
        hipDeviceGetAttribute(&cus, hipDeviceAttributeMultiprocessorCount, dev);
        hipFuncSetAttribute((const void*)fwd_megakernel, hipFuncAttributeMaxDynamicSharedMemorySize, LDS_BYTES);
        hipOccupancyMaxActiveBlocksPerMultiprocessor(&per_cu, fwd_megakernel, 512, LDS_BYTES);
        grid_blocks = (per_cu >= 1) ? cus : 0;
        if (grid_blocks > 256) grid_blocks = 256;
        if (ws_size < WS_NEED) { fprintf(stderr, "workspace too small: %zu < %zu\n", ws_size, (size_t)WS_NEED); }
        if (!grid_blocks) { fprintf(stderr, "occupancy query returned 0\n"); grid_blocks = 256; }
    }
    Params p{};
    p.x = (const float*)d_in[0]; p.w_in = (const float*)d_in[1]; p.conv_w = (const float*)d_in[2]; p.a_log = (const float*)d_in[3];
    p.dt_bias = (const float*)d_in[4]; p.norm_w = (const float*)d_in[5]; p.sinks = (const float*)d_in[6]; p.w_out = (const float*)d_in[7];
    p.ln_g = (const float*)d_in[8]; p.ln_b = (const float*)d_in[9]; p.out = (float*)d_out; p.ws = (unsigned char*)d_ws;
    hipMemsetAsync(d_ws, 0, 16384, stream);
    void* args[] = {&p};
    hipError_t e = hipLaunchCooperativeKernel((const void*)fwd_megakernel, dim3(grid_blocks), dim3(512), args, LDS_BYTES, stream);
    if (e != hipSuccess) fprintf(stderr, "cooperative launch failed: %s (grid %d)\n", hipGetErrorString(e), grid_blocks);
}
```

```cpp
#include <hip/hip_runtime.h>
#include <cstdio>
#include <cstdint>

#define PHM 255
#ifndef PROBE_REPS_GEMM
#define PROBE_REPS_GEMM 1
#endif
#ifndef PROBE_REPS_PREP
#define PROBE_REPS_PREP 1
#endif
#ifndef PROBE_REPS_DOUT
#define PROBE_REPS_DOUT 1
#endif
#ifndef PROBE_REPS_SWA
#define PROBE_REPS_SWA 1
#endif
#ifndef PROBE_REPS_W
#define PROBE_REPS_W 1
#endif
#define LAS __attribute__((address_space(3)))
__device__ __forceinline__ int opaque_lane() { int lane; asm volatile("v_mbcnt_lo_u32_b32 %0, -1, 0\n\tv_mbcnt_hi_u32_b32 %0, -1, %0" : "=v"(lane)); return lane; }
typedef unsigned short bf16_t;
typedef short bf16x8 __attribute__((ext_vector_type(8)));
typedef float f32x4 __attribute__((ext_vector_type(4)));
typedef unsigned u32x4 __attribute__((ext_vector_type(4)));
typedef unsigned u32x2 __attribute__((ext_vector_type(2)));
__device__ __forceinline__ u32x4 mk4(unsigned a, unsigned b, unsigned c, unsigned d) { return (u32x4){a, b, c, d}; }
__device__ __forceinline__ u32x2 mk2(unsigned a, unsigned b) { return (u32x2){a, b}; }

constexpr int NTOK = 16384, SEQ = 4096, DM = 1024, INC = 3336, NIN = 3328;
constexpr int HA_LD = 1536, HB_LD = 1792;
constexpr int HB_ZA = 0, HB_QB = 512, HB_KB = 1024, HB_VB = 1152, HB_ZB = 1280;
constexpr float DN_ALPHA = 1.41421356237f;

constexpr size_t OFF_BAR = 0;
constexpr size_t OFF_XB = 16384;
constexpr size_t OFF_WIN = OFF_XB + (size_t)NTOK * DM * 2;
constexpr size_t OFF_WOUT = OFF_WIN + (size_t)2 * NIN * DM * 2;
constexpr size_t OFF_HA = OFF_WOUT + (size_t)2 * DM * DM * 2;
constexpr size_t OFF_HB = OFF_HA + (size_t)NTOK * HA_LD * 2;
constexpr size_t OFF_UT = OFF_HB + (size_t)NTOK * HB_LD * 2;
constexpr size_t OFF_W = OFF_UT + (size_t)NTOK * 512 * 2;
constexpr size_t OFF_QD = OFF_W + (size_t)NTOK * 512 * 2;
constexpr size_t OFF_KDT = OFF_QD + (size_t)NTOK * 512 * 2;
constexpr size_t OFF_QK = OFF_KDT + (size_t)NTOK * 512 * 2;
constexpr size_t OFF_BA = OFF_QK + (size_t)NTOK * 256 * 2;
constexpr size_t OFF_GT = OFF_BA + (size_t)NTOK * 8 * 4;
constexpr size_t OFF_XS = OFF_GT + 4096;
constexpr size_t WS_NEED = OFF_XS + (size_t)2 * NTOK * 4 * 8;

constexpr int LDS_BYTES = 147456;
extern __shared__ __attribute__((aligned(16))) unsigned char dyn_lds[];

struct Params {
    const float* x; const float* w_in; const float* conv_w; const float* a_log; const float* dt_bias;
    const float* norm_w; const float* sinks; const float* w_out; const float* ln_g; const float* ln_b;
    float* out; unsigned char* ws;
};

typedef float f32x2_t __attribute__((ext_vector_type(2)));
typedef __bf16 bf16x2_t __attribute__((ext_vector_type(2)));
__device__ __forceinline__ unsigned cvt_pk_bf16(float lo, float hi) {
    const f32x2_t v = {lo, hi};
    const bf16x2_t r = __builtin_convertvector(v, bf16x2_t);
    return __builtin_bit_cast(unsigned, r);
}
__device__ __forceinline__ float bf_lo(unsigned u) { return __uint_as_float(u << 16); }
__device__ __forceinline__ float bf_hi(unsigned u) { return __uint_as_float(u & 0xffff0000u); }
__device__ __forceinline__ float silu_f(float x) { return x * __builtin_amdgcn_rcpf(1.0f + __expf(-x)); }
__device__ __forceinline__ f32x4 mfma16(bf16x8 a, bf16x8 b, f32x4 c) { return __builtin_amdgcn_mfma_f32_16x16x32_bf16(a, b, c, 0, 0, 0); }
#define GPC(T) (const __attribute__((address_space(1))) T*)
#define GP(T) (__attribute__((address_space(1))) T*)
__device__ __forceinline__ bf16x8 ldg8(const bf16_t* p) { return *GPC(bf16x8)(p); }
__device__ __forceinline__ bf16x8 lds8(const unsigned char* p) { return *reinterpret_cast<const bf16x8*>(p); }

__device__ __forceinline__ int opaque_tid_(int g_wave) {
    int lane; asm volatile("v_mbcnt_lo_u32_b32 %0, -1, 0\n\tv_mbcnt_hi_u32_b32 %0, -1, %0" : "=v"(lane));
    return g_wave * 64 + lane; }
#define opaque_tid() opaque_tid_(g_wave)
__device__ __forceinline__ unsigned char* opaque_ws(unsigned char* w) { asm volatile("" : "+s"(w)); return w; }
__device__ __forceinline__ const bf16_t* uniform_ptr(const bf16_t* p) {
    const unsigned long long v = (unsigned long long)p;
    const unsigned lo = __builtin_amdgcn_readfirstlane((unsigned)v), hi = __builtin_amdgcn_readfirstlane((unsigned)(v >> 32));
    return (const bf16_t*)(((unsigned long long)hi << 32) | lo);
}

__device__ __forceinline__ float shx(float v, int m, int lane) { return __int_as_float(__builtin_amdgcn_ds_bpermute((lane ^ m) << 2, __float_as_int(v))); }

#define XB_TMO      128
#define XB_XCNT(j)  (256  + 64 * (j))
#define XB_XSUB(j)  (1280 + 64 * (j))
#define XB_XGEN(j)  (2304 + 64 * (j))
#define XB_TOP      3328
#define XB_TOPGEN   3392
#define XCD_BAR_WORDS 3456
#define XB_SPIN_CAP (1u << 20)
__device__ __forceinline__ unsigned xb_ld(unsigned* p)              { return __hip_atomic_load(p, __ATOMIC_RELAXED, __HIP_MEMORY_SCOPE_AGENT); }
__device__ __forceinline__ unsigned xb_add(unsigned* p, unsigned v) { return __hip_atomic_fetch_add(p, v, __ATOMIC_RELAXED, __HIP_MEMORY_SCOPE_AGENT); }
__device__ __forceinline__ unsigned xb_xcc_id() { return (unsigned)__builtin_amdgcn_s_getreg((3 << 11) | 20) & 0xFu; }
#define XB_SPIN(cond, bar) do { unsigned _sp = 0; while (cond) { __builtin_amdgcn_s_sleep(1); \
    if ((++_sp & 255u) == 0u) { if (xb_ld(&(bar)[XB_TMO])) break; if (_sp > XB_SPIN_CAP) { atomicAdd(&(bar)[XB_TMO], 1u); break; } } } } while (0)
struct XcdBarrier { unsigned* bar; unsigned x; volatile LAS unsigned* st; int gw; };
__device__ __forceinline__ bool xb_t0(int gw) { return gw == 0 && opaque_lane() == 0; }
__device__ __forceinline__ XcdBarrier xcd_barrier_post(unsigned* bar, volatile LAS unsigned* st, int gw) {
    XcdBarrier b; b.bar = bar; b.x = xb_xcc_id(); b.st = st; b.gw = gw;
    if (xb_t0(gw)) (void)xb_add(&bar[XB_XCNT(b.x)], 1u);
    return b;
}
__device__ __forceinline__ void xcd_barrier_complete(unsigned* bar, unsigned x, unsigned& nloc, unsigned& nx) {
    const unsigned G = gridDim.x * gridDim.y * gridDim.z;
    unsigned sum, cnt, mine, sp = 0u;
    for (;;) {
        sum = 0u; cnt = 0u; mine = 0u;
#pragma unroll
        for (unsigned j = 0; j < 16; ++j) { const unsigned c = xb_ld(&bar[XB_XCNT(j)]); sum += c; cnt += (c > 0u) ? 1u : 0u; mine = (j == x) ? c : mine; }
        if (sum == G) break;
        __builtin_amdgcn_s_sleep(1);
        if ((++sp & 255u) == 0u) { if (xb_ld(&bar[XB_TMO])) break; if (sp > XB_SPIN_CAP) { atomicAdd(&bar[XB_TMO], 1u); break; } }
    }
    nloc = mine > 0u ? mine : 1u; nx = cnt > 0u ? cnt : 1u;
}
#ifdef USE_CG
__device__ __forceinline__ void xcd_barrier(XcdBarrier& b) {
    asm volatile("s_waitcnt vmcnt(0)" ::: "memory");
    __syncthreads();
    b.x = __builtin_amdgcn_readfirstlane(b.x + gridDim.x);
    if (xb_t0(b.gw)) {
        __threadfence();
        unsigned* c = b.bar + 4000;
        xb_add(c, 1u);
        unsigned sp = 0;
        while (xb_ld(c) < b.x) { __builtin_amdgcn_s_sleep(2); if (++sp > (1u << 24)) break; }
        __threadfence();
    }
    __syncthreads();
}
#else
__device__ __forceinline__ void xcd_barrier(const XcdBarrier& b_) {
    asm volatile("s_waitcnt vmcnt(0)" ::: "memory");
    __syncthreads();
    if (xb_t0(b_.gw)) {
        XcdBarrier b = b_; b.x = xb_xcc_id();
        asm volatile("" : "+s"(b.x));
        unsigned* bar = b.bar;
        __builtin_amdgcn_s_waitcnt(0);
        unsigned nloc = b.st[0], nx = b.st[1];
        if (nloc == 0u) { xcd_barrier_complete(bar, b.x, nloc, nx); b.st[0] = nloc; b.st[1] = nx; }
        const unsigned old = xb_add(&bar[XB_XSUB(b.x)], 1u);
        const unsigned gen = old / nloc;
        if (old + 1u == (gen + 1u) * nloc) {
            __builtin_amdgcn_fence(__ATOMIC_RELEASE, "agent");
            asm volatile("s_waitcnt vmcnt(0)" ::: "memory");
            const unsigned og = xb_add(&bar[XB_TOP], 1u);
            const unsigned tg = og / nx;
            if (og + 1u == (tg + 1u) * nx) xb_add(&bar[XB_TOPGEN], 1u);
            else XB_SPIN(xb_ld(&bar[XB_TOPGEN]) == tg, bar);
            __builtin_amdgcn_fence(__ATOMIC_ACQUIRE, "agent");
            xb_add(&bar[XB_XGEN(b.x)], 1u);
            asm volatile("s_waitcnt vmcnt(0)" ::: "memory");
        } else {
            XB_SPIN(xb_ld(&bar[XB_XGEN(b.x)]) == gen, bar);
            __builtin_amdgcn_fence(__ATOMIC_ACQUIRE, "agent");
            asm volatile("s_waitcnt vmcnt(0)" ::: "memory");
        }
    }
    __syncthreads();
}

#endif

constexpr int BM = 256, BK = 64, HALF = 128, NXCD = 8, WGM = 8, HT = HALF * BK;
__device__ __forceinline__ int lds_byte(int r, int c) {
    int st = (r >> 4) * 2 + (c >> 5), rr = r & 15, cc = c & 31, ob = rr * 64 + cc * 2;
    return st * 1024 + (ob ^ (((ob >> 9) & 1) << 5));
}
__device__ __forceinline__ void stage_rc(int b, int& R, int& C) {
    int st = b / 1024, sb = b % 1024, swz = sb ^ (((sb >> 9) & 1) << 5);
    R = (st >> 1) * 16 + swz / 64; C = (st & 1) * 32 + (swz % 64) / 2;
}

struct EpiH {
    bf16_t* ha; bf16_t* hb;
    __device__ __forceinline__ void operator()(const f32x4 (&acc)[2][2][4][2], int brow, int bcol, int wr, int wc, int fr, int fq) const {
        bf16_t* base; int ld, c0;
        if (bcol < HA_LD) { base = ha; ld = HA_LD; c0 = bcol; } else { base = hb; ld = HB_LD; c0 = bcol - HA_LD; }
#pragma unroll
        for (int ai = 0; ai < 2; ++ai)
#pragma unroll
            for (int m = 0; m < 4; ++m) {
                const int row = brow + ai * HALF + wr * 64 + m * 16 + fr;
                bf16_t* rp = base + (size_t)row * ld + c0 + wc * 32 + fq * 4;
#pragma unroll
                for (int bj = 0; bj < 2; ++bj)
#pragma unroll
                    for (int n = 0; n < 2; ++n) {
                        const f32x4 v = acc[ai][bj][m][n];
                        u32x2 w; w.x = cvt_pk_bf16(v[0], v[1]); w.y = cvt_pk_bf16(v[2], v[3]);
                        *GP(u32x2)(rp + bj * HALF + n * 16) = w;
                    }
            }
    }
};
struct EpiZ {
    const float* xres; float* out;
    __device__ __forceinline__ void operator()(const f32x4 (&acc)[2][2][4][2], int brow, int bcol, int wr, int wc, int fr, int fq) const {
#pragma unroll
        for (int ai = 0; ai < 2; ++ai)
#pragma unroll
            for (int m = 0; m < 4; ++m) {
                const int row = brow + ai * HALF + wr * 64 + m * 16 + fr;
                const size_t ro = (size_t)row * DM + bcol + wc * 32 + fq * 4;
#pragma unroll
                for (int bj = 0; bj < 2; ++bj)
#pragma unroll
                    for (int n = 0; n < 2; ++n) {
                        const size_t o = ro + bj * HALF + n * 16;
                        const f32x4 r = *GPC(f32x4)(xres + o);
                        *GP(f32x4)(out + o) = r * DN_ALPHA + acc[ai][bj][m][n];
                    }
            }
    }
};


struct EpiLN {
    const float* xres; float* out; bf16_t* xb; const float* g; const float* b; const float* wg; float* BA; float* xbuf; unsigned* cnt; unsigned* tmo; int gw;
    __device__ __forceinline__ void operator()(f32x4 (&acc)[2][2][4][2], int brow, int bcol, int, int, int, int) const {
        const int tid = opaque_tid_(gw), lane = tid & 63, wr = tid >> 8, wc = (tid >> 6) & 3, fr = lane & 15, fq = lane >> 4, pm = brow >> 8, pn = bcol >> 8;
        f32x2_t* P = reinterpret_cast<f32x2_t*>(dyn_lds);
        f32x2_t* STATS = reinterpret_cast<f32x2_t*>(dyn_lds + 8192);
        float* WG = reinterpret_cast<float*>(dyn_lds + 10240);
        float* GP4 = reinterpret_cast<float*>(dyn_lds + 18432);
        if (wg) {
            for (int c = tid; c < 256; c += 512) {
                const float* wp = wg + (size_t)(bcol + c) * INC;
                *reinterpret_cast<f32x4*>(WG + c * 8) = *GPC(f32x4)(wp); *reinterpret_cast<f32x4*>(WG + c * 8 + 4) = *GPC(f32x4)(wp + 4);
            }
        }
#pragma unroll
        for (int ai = 0; ai < 2; ++ai)
#pragma unroll
            for (int m = 0; m < 4; ++m) {
                __builtin_amdgcn_sched_barrier(0);
                const int rl = ai * HALF + wr * 64 + m * 16 + fr;
                const size_t ro = (size_t)(brow + rl) * DM + bcol + wc * 32 + fq * 4;
                float s1 = 0.f, s2 = 0.f;
#pragma unroll
                for (int bj = 0; bj < 2; ++bj)
#pragma unroll
                    for (int n = 0; n < 2; ++n) {
                        const f32x4 r = *GPC(f32x4)(xres + ro + bj * HALF + n * 16);
                        const f32x4 v = r * DN_ALPHA + acc[ai][bj][m][n];
                        acc[ai][bj][m][n] = v;
                        s1 += (v[0] + v[1]) + (v[2] + v[3]);
                        s2 += (v[0] * v[0] + v[1] * v[1]) + (v[2] * v[2] + v[3] * v[3]);
                    }
                s1 += shx(s1, 16, lane); s1 += shx(s1, 32, lane);
                s2 += shx(s2, 16, lane); s2 += shx(s2, 32, lane);
                if (fq == 0) P[rl * 4 + wc] = (f32x2_t){s1, s2};
            }
        __syncthreads();
        if (tid < 256) {
            const f32x2_t a = P[tid * 4 + 0], b2 = P[tid * 4 + 1], c = P[tid * 4 + 2], d = P[tid * 4 + 3];
            *GP(f32x2_t)(xbuf + ((size_t)(brow + tid) * 4 + pn) * 2) = (f32x2_t){(a.x + b2.x) + (c.x + d.x), (a.y + b2.y) + (c.y + d.y)};
        }
        asm volatile("s_waitcnt vmcnt(0)" ::: "memory");
        __syncthreads();
        if (tid == 0) {
            __threadfence();
            xb_add(cnt + pm, 1u);
            unsigned sp = 0;
            while (xb_ld(cnt + pm) < 4u) { __builtin_amdgcn_s_sleep(1); if (++sp > (1u << 22)) { atomicAdd(tmo, 1u); break; } }
            __threadfence();
        }
        __syncthreads();
        if (tid < 256) {
            float S1 = 0.f, S2 = 0.f;
#pragma unroll
            for (int t = 0; t < 4; ++t) {
                const f32x2_t v = *GPC(f32x2_t)(xbuf + ((size_t)(brow + tid) * 4 + t) * 2);
                S1 += v.x; S2 += v.y;
            }
            const float mean = S1 * (1.0f / DM);
            const float var = fmaxf(S2 * (1.0f / DM) - mean * mean, 0.f);
            STATS[tid] = (f32x2_t){mean, rsqrtf(var + 1e-5f)};
        }
        __syncthreads();
#pragma unroll
        for (int ai = 0; ai < 2; ++ai)
#pragma unroll
            for (int m = 0; m < 4; ++m) {
                __builtin_amdgcn_sched_barrier(0);
                const int rl = ai * HALF + wr * 64 + m * 16 + fr;
                const f32x2_t st = STATS[rl];
                const size_t ro = (size_t)(brow + rl) * DM + bcol + wc * 32 + fq * 4;
                float d[8] = {0.f, 0.f, 0.f, 0.f, 0.f, 0.f, 0.f, 0.f};
#pragma unroll
                for (int bj = 0; bj < 2; ++bj)
#pragma unroll
                    for (int n = 0; n < 2; ++n) {
                        const int cl = bj * HALF + wc * 32 + n * 16 + fq * 4;
                        const f32x4 gg = *GPC(f32x4)(g + bcol + cl), bb = *GPC(f32x4)(b + bcol + cl);
                        const f32x4 v = (acc[ai][bj][m][n] - st.x) * st.y * gg + bb;
                        *GP(f32x4)(out + ro + bj * HALF + n * 16) = v;
                        if (xb) { u32x2 w; w.x = cvt_pk_bf16(v[0], v[1]); w.y = cvt_pk_bf16(v[2], v[3]); *GP(u32x2)(xb + ro + bj * HALF + n * 16) = w; }
                        if (wg) {
#pragma unroll
                            for (int j = 0; j < 4; ++j) {
                                const f32x4 w0 = *reinterpret_cast<const f32x4*>(WG + (cl + j) * 8), w1 = *reinterpret_cast<const f32x4*>(WG + (cl + j) * 8 + 4);
                                d[0] += v[j] * w0[0]; d[1] += v[j] * w0[1]; d[2] += v[j] * w0[2]; d[3] += v[j] * w0[3];
                                d[4] += v[j] * w1[0]; d[5] += v[j] * w1[1]; d[6] += v[j] * w1[2]; d[7] += v[j] * w1[3];
                            }
                        }
                    }
                if (wg) {
#pragma unroll
                    for (int k = 0; k < 8; ++k) { d[k] += shx(d[k], 16, lane); d[k] += shx(d[k], 32, lane); }
                    if (fq == 0) {
                        *reinterpret_cast<f32x4*>(GP4 + (rl * 4 + wc) * 8) = (f32x4){d[0], d[1], d[2], d[3]};
                        *reinterpret_cast<f32x4*>(GP4 + (rl * 4 + wc) * 8 + 4) = (f32x4){d[4], d[5], d[6], d[7]};
                    }
                }
            }
        if (wg) {
            __syncthreads();
            for (int i = tid; i < 2048; i += 512) {
                const int rl = i >> 3, k = i & 7;
                const float sgate = (GP4[(rl * 4 + 0) * 8 + k] + GP4[(rl * 4 + 1) * 8 + k]) + (GP4[(rl * 4 + 2) * 8 + k] + GP4[(rl * 4 + 3) * 8 + k]);
                unsafeAtomicAdd(BA + (size_t)(brow + rl) * 8 + k, sgate);
            }
        }
    }
};

template <class Epi>
__device__ __forceinline__ void gemm_phase(const bf16_t* __restrict__ A, const bf16_t* __restrict__ Bt, int M, int N, int K, const Epi& epi, int g_wave) {
    bf16_t* shm = reinterpret_cast<bf16_t*>(dyn_lds);
#define SA(b,h) (shm+((b)*2+(h))*HT)
#define SB(b,h) (shm+(4+(b)*2+(h))*HT)
#define STAGE(P,BASE,br,kt) do{const bf16_t* _bp=uniform_ptr((BASE)+((long)(br)*K+(long)(kt)*BK)); \
    __builtin_amdgcn_global_load_lds((const unsigned*)((const char*)_bp+soff0),(unsigned*)((char*)(P)+tidx*16),16,0,0); \
    __builtin_amdgcn_global_load_lds((const unsigned*)((const char*)_bp+soff1),(unsigned*)((char*)(P)+tidx*16+8192),16,0,0);}while(0)
#define LDA(dst,b,h) for(int m=0;m<4;++m)for(int k=0;k<2;++k) \
    dst[m][k]=*reinterpret_cast<const bf16x8*>((char*)SA(b,h)+lds_byte(wr*64+m*16+fr,k*32+fq*8))
#define LDB(dst,b,h) for(int n=0;n<2;++n)for(int k=0;k<2;++k) \
    dst[n][k]=*reinterpret_cast<const bf16x8*>((char*)SB(b,h)+lds_byte(wc*32+n*16+fr,k*32+fq*8))
#define MMA(ai,bj,At,Bt_) do{__builtin_amdgcn_s_setprio(1); \
    for(int m=0;m<4;++m)for(int n=0;n<2;++n)for(int k=0;k<2;++k) \
      acc[ai][bj][m][n]=__builtin_amdgcn_mfma_f32_16x16x32_bf16(Bt_[n][k],At[m][k],acc[ai][bj][m][n],0,0,0); \
    __builtin_amdgcn_s_setprio(0);}while(0)
#define WAIT_V(n) asm volatile("s_waitcnt vmcnt(" #n ")":::"memory")
#define WAIT_L(n) asm volatile("s_waitcnt lgkmcnt(" #n ")":::"memory")
#define BAR __builtin_amdgcn_s_barrier()
#define SCHED __builtin_amdgcn_sched_barrier(0)
    const int nM = M / BM, nN = N / BM, nwg = nM * nN;
    const int tidx = opaque_tid();
    const int wid = tidx >> 6, lane = tidx & 63, wr = wid >> 2, wc = wid & 3, fr = lane & 15, fq = lane >> 4;
    const int nt = K / BK;
    unsigned soff0, soff1;
    { int r_, c_; stage_rc(tidx * 16, r_, c_); soff0 = (unsigned)(r_ * K + c_) * 2u; stage_rc(tidx * 16 + 8192, r_, c_); soff1 = (unsigned)(r_ * K + c_) * 2u; }
    for (int L = blockIdx.x; L < nwg; L += gridDim.x) {
        int wgid = L;
        { int q = nwg / NXCD, r = nwg % NXCD, xcd = wgid % NXCD, off = wgid / NXCD; wgid = (xcd < r ? xcd * (q + 1) : r * (q + 1) + (xcd - r) * q) + off; }
        const int nig = WGM * nN, gid = wgid / nig, fm = gid * WGM, gsz = min(nM - fm, WGM);
        const int pm = fm + ((wgid % nig) % gsz), pn = (wgid % nig) / gsz, brow = pm * BM, bcol = pn * BM;
        f32x4 acc[2][2][4][2] = {};
        bf16x8 At[4][2], B0[2][2], B1[2][2];
        STAGE(SB(0,0),Bt,bcol,0); STAGE(SA(0,0),A,brow,0);
        STAGE(SB(0,1),Bt,bcol+HALF,0); STAGE(SA(0,1),A,brow+HALF,0);
        if(wr==1)BAR;
        WAIT_V(4); BAR;
        STAGE(SB(1,0),Bt,bcol,1); STAGE(SA(1,0),A,brow,1); STAGE(SB(1,1),Bt,bcol+HALF,1);
        WAIT_V(6); BAR;
        for(int t=0;t<nt-2;t+=2){
            LDB(B0,0,0); SCHED; LDA(At,0,0); STAGE(SA(1,1),A,brow+HALF,t+1);
            WAIT_L(8); BAR; WAIT_L(0); MMA(0,0,At,B0); BAR; SCHED;
            LDB(B1,0,1); STAGE(SB(0,0),Bt,bcol,t+2);
            BAR; WAIT_L(0); MMA(0,1,At,B1); BAR;
            LDA(At,0,1); STAGE(SA(0,0),A,brow,t+2);
            BAR; WAIT_L(0); MMA(1,0,At,B0); BAR; SCHED;
            STAGE(SB(0,1),Bt,bcol+HALF,t+2);
            WAIT_V(6); BAR; MMA(1,1,At,B1); BAR;
            LDB(B0,1,0); SCHED; LDA(At,1,0); STAGE(SA(0,1),A,brow+HALF,t+2);
            WAIT_L(8); BAR; WAIT_L(0); MMA(0,0,At,B0); BAR; SCHED;
            LDB(B1,1,1); STAGE(SB(1,0),Bt,bcol,t+3);
            BAR; WAIT_L(0); MMA(0,1,At,B1); BAR;
            LDA(At,1,1); STAGE(SA(1,0),A,brow,t+3);
            BAR; WAIT_L(0); MMA(1,0,At,B0); BAR; SCHED;
            STAGE(SB(1,1),Bt,bcol+HALF,t+3);
            WAIT_V(6); BAR; MMA(1,1,At,B1); BAR;
        }
        { LDB(B0,0,0); LDA(At,0,0); STAGE(SA(1,1),A,brow+HALF,nt-1);
          BAR; WAIT_L(0); MMA(0,0,At,B0); BAR;
          LDB(B1,0,1); BAR; WAIT_L(0); MMA(0,1,At,B1); BAR;
          LDA(At,0,1); WAIT_V(4); BAR; WAIT_L(0); MMA(1,0,At,B0); MMA(1,1,At,B1); BAR; }
        { LDB(B0,1,0); LDA(At,1,0); WAIT_V(2); BAR; WAIT_L(0); MMA(0,0,At,B0); BAR;
          LDB(B1,1,1); WAIT_V(0); BAR; WAIT_L(0); MMA(0,1,At,B1); BAR;
          LDA(At,1,1); BAR; WAIT_L(0); MMA(1,0,At,B0); MMA(1,1,At,B1); BAR; }
        if(wr==0)BAR;
        epi(acc, brow, bcol, wr, wc, fr, fq);
        __syncthreads();
    }
#undef SA
#undef SB
#undef STAGE
#undef LDA
#undef LDB
#undef MMA
}

__device__ __forceinline__ void prep_weights(const Params& p, int part, int vblk, int nvblk, int g_wave) {
    bf16_t* win = reinterpret_cast<bf16_t*>(p.ws + OFF_WIN);
    bf16_t* wout = reinterpret_cast<bf16_t*>(p.ws + OFF_WOUT);
    const int gtid = vblk * 512 + opaque_tid(), gsz = nvblk * 512;
    const int n_in = 128 * NIN;
    for (int i = gtid; i < n_in; i += gsz) {
        const int n = i % NIN, kg = i / NIN, l = part;
        const int sc = n < 2048 ? n : n + 8;
        const float* s = p.w_in + (size_t)l * DM * INC + (size_t)(kg * 8) * INC + sc;
        u32x4 w;
        w.x = cvt_pk_bf16(s[0], s[INC]); w.y = cvt_pk_bf16(s[2 * INC], s[3 * INC]);
        w.z = cvt_pk_bf16(s[4 * INC], s[5 * INC]); w.w = cvt_pk_bf16(s[6 * INC], s[7 * INC]);
        *GP(u32x4)(win + ((size_t)l * NIN + n) * DM + kg * 8) = w;
    }
    if (part == 1) {
        const int n_out = 2 * 128 * DM;
        for (int i = gtid; i < n_out; i += gsz) {
            const int n = i % DM, kg = (i / DM) % 128, l = i / (DM * 128);
            const float* s = p.w_out + (size_t)l * DM * DM + (size_t)(kg * 8) * DM + n;
            u32x4 w;
            w.x = cvt_pk_bf16(s[0], s[DM]); w.y = cvt_pk_bf16(s[2 * DM], s[3 * DM]);
            w.z = cvt_pk_bf16(s[4 * DM], s[5 * DM]); w.w = cvt_pk_bf16(s[6 * DM], s[7 * DM]);
            *GP(u32x4)(wout + ((size_t)l * DM + n) * DM + kg * 8) = w;
        }
    }
}

__device__ __forceinline__ void row_pass(const float* src, bool ln, const float* g, const float* bta, float* dstf, bf16_t* xb, const float* wg  , float* BA, int g_wave) {
    const int tidx = opaque_tid();
    const int lane = tidx & 63;
    const int gw = blockIdx.x * 8 + (tidx >> 6), nw = gridDim.x * 8;
    float* wgs = reinterpret_cast<float*>(dyn_lds);
    if (wg) {
        for (int c = tidx; c < DM; c += 512) {
            const f32x4 w0 = *GPC(f32x4)(wg + (size_t)c * INC), w1 = *GPC(f32x4)(wg + (size_t)c * INC + 4);
            *reinterpret_cast<f32x4*>(wgs + c * 8) = w0; *reinterpret_cast<f32x4*>(wgs + c * 8 + 4) = w1;
        }
    }
    __syncthreads();
    f32x4 gg[4], bb[4];
#pragma unroll
    for (int i = 0; i < 4; ++i) { gg[i] = ln ? *GPC(f32x4)(g + i * 256 + lane * 4) : (f32x4){1.f, 1.f, 1.f, 1.f}; bb[i] = ln ? *GPC(f32x4)(bta + i * 256 + lane * 4) : (f32x4){0.f, 0.f, 0.f, 0.f}; }
    f32x4 nv[4];
    if (gw < NTOK) {
#pragma unroll
        for (int i = 0; i < 4; ++i) nv[i] = *GPC(f32x4)(src + (size_t)gw * DM + i * 256 + lane * 4);
    }
    for (int row = gw; row < NTOK; row += nw) {
        f32x4 v[4];
#pragma unroll
        for (int i = 0; i < 4; ++i) v[i] = nv[i];
        if (row + nw < NTOK) {
#pragma unroll
            for (int i = 0; i < 4; ++i) nv[i] = *GPC(f32x4)(src + (size_t)(row + nw) * DM + i * 256 + lane * 4);
        }
        if (ln) {
            float s = 0.f;
#pragma unroll
            for (int i = 0; i < 4; ++i) s += (v[i][0] + v[i][1]) + (v[i][2] + v[i][3]);
#pragma unroll
            for (int o = 32; o > 0; o >>= 1) s += shx(s, o, lane);
            const float mu = s * (1.0f / DM);
            float q = 0.f;
#pragma unroll
            for (int i = 0; i < 4; ++i) { v[i] = v[i] - mu; q += (v[i][0] * v[i][0] + v[i][1] * v[i][1]) + (v[i][2] * v[i][2] + v[i][3] * v[i][3]); }
#pragma unroll
            for (int o = 32; o > 0; o >>= 1) q += shx(q, o, lane);
            const float rstd = rsqrtf(q * (1.0f / DM) + 1e-5f);
#pragma unroll
            for (int i = 0; i < 4; ++i) v[i] = v[i] * rstd * gg[i] + bb[i];
        }
        if (dstf) {
#pragma unroll
            for (int i = 0; i < 4; ++i) *GP(f32x4)(dstf + (size_t)row * DM + i * 256 + lane * 4) = v[i];
        }
        if (xb) {
#pragma unroll
            for (int i = 0; i < 4; ++i) { u32x2 w; w.x = cvt_pk_bf16(v[i][0], v[i][1]); w.y = cvt_pk_bf16(v[i][2], v[i][3]);
                *GP(u32x2)(xb + (size_t)row * DM + i * 256 + lane * 4) = w; }
        }
        if (wg) {
            float d[8] = {0.f, 0.f, 0.f, 0.f, 0.f, 0.f, 0.f, 0.f};
#pragma unroll
            for (int i = 0; i < 4; ++i)
#pragma unroll
                for (int e = 0; e < 4; ++e) {
                    const float* wp = wgs + (i * 256 + lane * 4 + e) * 8;
                    const f32x4 w0 = *reinterpret_cast<const f32x4*>(wp), w1 = *reinterpret_cast<const f32x4*>(wp + 4);
                    const float xv = v[i][e];
                    d[0] += xv * w0[0]; d[1] += xv * w0[1]; d[2] += xv * w0[2]; d[3] += xv * w0[3];
                    d[4] += xv * w1[0]; d[5] += xv * w1[1]; d[6] += xv * w1[2]; d[7] += xv * w1[3];
                }
#pragma unroll
            for (int j = 0; j < 8; ++j) {
#pragma unroll
                for (int o = 32; o > 0; o >>= 1) d[j] += shx(d[j], o, lane);
            }
            if (lane == 0) {
                *GP(f32x4)(BA + (size_t)row * 8) = (f32x4){d[0], d[1], d[2], d[3]};
                *GP(f32x4)(BA + (size_t)row * 8 + 4) = (f32x4){d[4], d[5], d[6], d[7]};
            }
        }
    }
    __syncthreads();
}

constexpr int GRP_LDS = 73728;
constexpr int L_KRM = 0, L_QRM = 17408, L_KBGT = 34816, L_VBT = 53248, L_GC = 71680, L_BETA = 71936;
__device__ __forceinline__ void chunk_prep(const Params& p_, int l, int g_wave) {
    Params p = p_; p.ws = opaque_ws(p.ws);
    const bf16_t* HA = reinterpret_cast<const bf16_t*>(p.ws + OFF_HA);
    const float* BA = reinterpret_cast<const float*>(p.ws + OFF_BA);
    bf16_t* UT = reinterpret_cast<bf16_t*>(p.ws + OFF_UT);
    bf16_t* W = reinterpret_cast<bf16_t*>(p.ws + OFF_W);
    bf16_t* QD = reinterpret_cast<bf16_t*>(p.ws + OFF_QD);
    bf16_t* KDT = reinterpret_cast<bf16_t*>(p.ws + OFF_KDT);
    bf16_t* QK = reinterpret_cast<bf16_t*>(p.ws + OFF_QK);
    float* GT = reinterpret_cast<float*>(p.ws + OFF_GT);
    const float* cw = p.conv_w + (size_t)l * 4 * 1536;
#define CP_LANEVARS const int tid = opaque_tid(), grp = tid >> 8, gt = tid & 255, lane = tid & 63, wv = gt >> 6, fr = lane & 15, fq = lane >> 4; \
    unsigned char* lds = dyn_lds + grp * GRP_LDS; float* gc_s = reinterpret_cast<float*>(lds + L_GC); float* beta_s = reinterpret_cast<float*>(lds + L_BETA); \
    const int tg = gt >> 4, sg = gt & 15, t0 = tg * 4, c0 = sg * 8; (void)fr; (void)fq; (void)wv; (void)t0; (void)c0; (void)gc_s; (void)beta_s; (void)lane;
    for (int pi = blockIdx.x; pi < 512; pi += gridDim.x) {
        const int grp0 = opaque_tid() >> 8;
        const int hp = pi & 1, n = (pi >> 1) & 63, b = pi >> 7, h = hp * 2 + grp0;
        const int item = (b * 4 + h) * 64 + n, tok0 = b * SEQ + n * 64;
        u32x4 rawp[3][7];
        { CP_LANEVARS
#pragma unroll
          for (int ten = 0; ten < 3; ++ten)
#pragma unroll
            for (int r = 0; r < 7; ++r) {
                const int tt = n * 64 + t0 - 3 + r;
                rawp[ten][r] = mk4(0u, 0u, 0u, 0u);
                if (tt >= 0) rawp[ten][r] = *GPC(u32x4)(HA + (size_t)(b * SEQ + tt) * HA_LD + ten * 512 + h * 128 + c0);
            } }
        { CP_LANEVARS
        if (wv == 0) {
            const float bv = *GPC(float)(BA + (size_t)(tok0 + lane) * 8 + h), av = *GPC(float)(BA + (size_t)(tok0 + lane) * 8 + 4 + h);
            const float beta = __builtin_amdgcn_rcpf(1.0f + __expf(-bv));
            const float xx = av + p.dt_bias[l * 4 + h];
            const float sp = fmaxf(xx, 0.f) + log1pf(__expf(-fabsf(xx)));
            float gv = -__expf(p.a_log[l * 4 + h]) * sp;
#pragma unroll
            for (int o = 1; o < 64; o <<= 1) { const float t = __int_as_float(__builtin_amdgcn_ds_bpermute((lane - o) << 2, __float_as_int(gv))); if (lane >= o) gv += t; }
            gc_s[lane] = gv; beta_s[lane] = beta;
            if (lane == 63) *GP(float)(GT + item) = __expf(gv);
        } }
        __syncthreads();
        {
            CP_LANEVARS
            const float glast = gc_s[63];
            float eg[4], ek[4], be[4];
#pragma unroll
            for (int i = 0; i < 4; ++i) { const float gci = gc_s[t0 + i]; eg[i] = __expf(gci); ek[i] = __expf(glast - gci); be[i] = beta_s[t0 + i]; }
#pragma unroll
            for (int ten = 0; ten < 3; ++ten) {
                __builtin_amdgcn_sched_barrier(0);
                float raw[7][8];
#pragma unroll
                for (int r = 0; r < 7; ++r) {
                    const u32x4 u = rawp[ten][r];
                    raw[r][0] = bf_lo(u.x); raw[r][1] = bf_hi(u.x); raw[r][2] = bf_lo(u.y); raw[r][3] = bf_hi(u.y);
                    raw[r][4] = bf_lo(u.z); raw[r][5] = bf_hi(u.z); raw[r][6] = bf_lo(u.w); raw[r][7] = bf_hi(u.w);
                }
                float o[4][8];
#pragma unroll
                for (int i = 0; i < 4; ++i)
#pragma unroll
                    for (int c = 0; c < 8; ++c) o[i][c] = 0.f;
#pragma unroll
                for (int j = 0; j < 4; ++j) {
                    const float* wp = cw + (size_t)j * 1536 + ten * 512 + h * 128 + c0;
                    const f32x4 a = *GPC(f32x4)(wp), c4 = *GPC(f32x4)(wp + 4);
                    const float wj[8] = {a[0], a[1], a[2], a[3], c4[0], c4[1], c4[2], c4[3]};
#pragma unroll
                    for (int i = 0; i < 4; ++i)
#pragma unroll
                        for (int c = 0; c < 8; ++c) o[i][c] += wj[c] * raw[i + j][c];
                }
#pragma unroll
                for (int i = 0; i < 4; ++i)
#pragma unroll
                    for (int c = 0; c < 8; ++c) o[i][c] = silu_f(o[i][c]);
                if (ten < 2) {
#pragma unroll
                    for (int i = 0; i < 4; ++i) {
                        float sq = 0.f;
#pragma unroll
                        for (int c = 0; c < 8; ++c) sq += o[i][c] * o[i][c];
#pragma unroll
                        for (int off = 1; off < 16; off <<= 1) sq += shx(sq, off, lane);
                        const float rq = rsqrtf(sq + 1e-6f) * (ten == 0 ? 0.08838834764831845f : 1.0f);
#pragma unroll
                        for (int c = 0; c < 8; ++c) o[i][c] *= rq;
                    }
                }
                if (ten == 0) {
#pragma unroll
                    for (int i = 0; i < 4; ++i) {
                        u32x4 w;
                        w.x = cvt_pk_bf16(o[i][0] * eg[i], o[i][1] * eg[i]); w.y = cvt_pk_bf16(o[i][2] * eg[i], o[i][3] * eg[i]);
                        w.z = cvt_pk_bf16(o[i][4] * eg[i], o[i][5] * eg[i]); w.w = cvt_pk_bf16(o[i][6] * eg[i], o[i][7] * eg[i]);
                        { const int t_ = t0 + i; *GP(u32x4)(QD + ((((size_t)item * 4 + (t_ >> 4)) * 4 + (sg >> 2)) * 64 + (t_ & 15) + 16 * (sg & 3)) * 8) = w; }
                        w.x = cvt_pk_bf16(o[i][0], o[i][1]); w.y = cvt_pk_bf16(o[i][2], o[i][3]); w.z = cvt_pk_bf16(o[i][4], o[i][5]); w.w = cvt_pk_bf16(o[i][6], o[i][7]);
                        *reinterpret_cast<u32x4*>(lds + L_QRM + ((t0 + i) * 136 + c0) * 2) = w;
                    }
                } else if (ten == 1) {
#pragma unroll
                    for (int i = 0; i < 4; ++i) {
                        u32x4 w;
                        w.x = cvt_pk_bf16(o[i][0], o[i][1]); w.y = cvt_pk_bf16(o[i][2], o[i][3]); w.z = cvt_pk_bf16(o[i][4], o[i][5]); w.w = cvt_pk_bf16(o[i][6], o[i][7]);
                        *reinterpret_cast<u32x4*>(lds + L_KRM + ((t0 + i) * 136 + c0) * 2) = w;
                    }
#pragma unroll
                    for (int c = 0; c < 8; ++c) {
                        u32x2 w;
                        w.x = cvt_pk_bf16(o[0][c] * ek[0], o[1][c] * ek[1]); w.y = cvt_pk_bf16(o[2][c] * ek[2], o[3][c] * ek[3]);
                        { const int dk_ = c0 + c; *GP(u32x2)(KDT + ((((size_t)item * 8 + (dk_ >> 4)) * 2 + (t0 >> 5)) * 64 + (dk_ & 15) + 16 * ((t0 & 31) >> 3)) * 8 + ((t0 & 7) >> 2) * 4) = w; }
                        w.x = cvt_pk_bf16(o[0][c] * be[0] * eg[0], o[1][c] * be[1] * eg[1]); w.y = cvt_pk_bf16(o[2][c] * be[2] * eg[2], o[3][c] * be[3] * eg[3]);
                        *reinterpret_cast<u32x2*>(lds + L_KBGT + ((c0 + c) * 72 + t0) * 2) = w;
                    }
                } else {
#pragma unroll
                    for (int c = 0; c < 8; ++c) {
                        u32x2 w;
                        w.x = cvt_pk_bf16(o[0][c] * be[0], o[1][c] * be[1]); w.y = cvt_pk_bf16(o[2][c] * be[2], o[3][c] * be[3]);
                        *reinterpret_cast<u32x2*>(lds + L_VBT + ((c0 + c) * 72 + t0) * 2) = w;
                    }
                }
            }
        }
        __syncthreads();
        {
            CP_LANEVARS
            const int ib = wv;
            f32x4 kk[4], qk[4];
#pragma unroll
            for (int jb = 0; jb < 4; ++jb) { kk[jb] = (f32x4){0.f, 0.f, 0.f, 0.f}; qk[jb] = (f32x4){0.f, 0.f, 0.f, 0.f}; }
            bf16x8 ki[4], qi[4];
#pragma unroll
            for (int ks = 0; ks < 4; ++ks) {
                ki[ks] = lds8(lds + L_KRM + ((ib * 16 + fr) * 136 + ks * 32 + fq * 8) * 2);
                qi[ks] = lds8(lds + L_QRM + ((ib * 16 + fr) * 136 + ks * 32 + fq * 8) * 2);
            }
#pragma unroll
            for (int jb = 0; jb < 4; ++jb) {
                if (jb <= ib) {
#pragma unroll
                    for (int ks = 0; ks < 4; ++ks) {
                        const bf16x8 kj = lds8(lds + L_KRM + ((jb * 16 + fr) * 136 + ks * 32 + fq * 8) * 2);
                        kk[jb] = mfma16(ki[ks], kj, kk[jb]);
                        qk[jb] = mfma16(kj, qi[ks], qk[jb]);
                    }
                }
            }
            __syncthreads();
            float* AP = reinterpret_cast<float*>(lds + L_KRM);
#pragma unroll
            for (int jb = 0; jb < 4; ++jb) {
                if (jb <= ib) {
                    const int j = jb * 16 + fr, i0 = ib * 16 + fq * 4;
                    const float gj = gc_s[j];
#pragma unroll
                    for (int r = 0; r < 4; ++r) {
                        const int i = i0 + r;
                        const float dec = __expf(fminf(gc_s[i] - gj, 0.f));
                        float av_ = (i > j) ? kk[jb][r] * beta_s[i] * dec : 0.f;
#ifdef DIAG3
                        atomicMax(reinterpret_cast<unsigned*>(p.ws + OFF_BAR) + 4011, __float_as_uint(fabsf(kk[jb][r])));
                        atomicMax(reinterpret_cast<unsigned*>(p.ws + OFF_BAR) + 4012, __float_as_uint(fabsf(av_)));
#endif
#ifdef CLAMP_A
                        if (!(fabsf(av_) <= 0.02f)) av_ = 0.f;
#endif
                        AP[j * 64 + r * 16 + ib * 4 + fq] = av_;
                    }
                }
                {
                    const int i = ib * 16 + fr, j0 = jb * 16 + fq * 4;
                    const float gi = gc_s[i];
                    float o[4];
#pragma unroll
                    for (int r = 0; r < 4; ++r) {
                        const int j = j0 + r;
                        const float dec = __expf(fminf(gi - gc_s[j], 0.f));
                        o[r] = (i >= j) ? qk[jb][r] * dec : 0.f;
                    }
                    u32x2 w; w.x = cvt_pk_bf16(o[0], o[1]); w.y = cvt_pk_bf16(o[2], o[3]);
                    *GP(u32x2)(QK + ((((size_t)item * 4 + ib) * 2 + (jb >> 1)) * 64 + fr + 16 * ((jb & 1) * 2 + (fq >> 1))) * 8 + (fq & 1) * 4) = w;
                }
            }
        }
        __syncthreads();
        {
            CP_LANEVARS
            const float* AP = reinterpret_cast<const float*>(lds + L_KRM);
            const int cl = lane >> 2, pp = lane & 3, ccol = wv * 16 + cl;
            float a[16];
#pragma unroll
            for (int k = 0; k < 16; ++k) a[k] = (4 * k + pp == ccol) ? 1.f : 0.f;
#define INV_STEP(SS) { const int j = jq * 4 + SS; \
                    const float tj = __int_as_float(__builtin_amdgcn_update_dpp(0, __float_as_int(a[jq]), SS * 0x55, 0xf, 0xf, false)); \
                    const float* ap = AP + j * 64 + pp * 16; \
                    _Pragma("unroll") for (int k = jq; k < 16; ++k) a[k] -= ap[k] * tj; }
#pragma unroll
            for (int jq = 0; jq < 16; ++jq) {
                __builtin_amdgcn_sched_barrier(0);
#ifdef NO_INV
                if (false) {
#else
                if (jq >= wv * 4) {
#endif
                    INV_STEP(0) INV_STEP(1) INV_STEP(2)
                    if (jq < 15) INV_STEP(3)
                }
            }
#undef INV_STEP
#ifdef DIAG3
            { float mx = 0.f;
              for (int k = 0; k < 16; ++k) { const float av = fabsf(a[k]); mx = (av > mx || !(av == av)) ? av : mx; }
              atomicMax(reinterpret_cast<unsigned*>(p.ws + OFF_BAR) + 4010, __float_as_uint(mx)); }
#endif
            bf16_t* TR = reinterpret_cast<bf16_t*>(lds + L_QRM);
#pragma unroll
            for (int k = 0; k < 16; ++k) TR[(4 * k + pp) * 72 + ccol] = (bf16_t)(cvt_pk_bf16(a[k], 0.f) & 0xffffu);
        }
        __syncthreads();
        {
            CP_LANEVARS
            bf16x8 tf[2];
#pragma unroll
            for (int ks = 0; ks < 2; ++ks) tf[ks] = lds8(lds + L_QRM + ((wv * 16 + fr) * 72 + ks * 32 + fq * 8) * 2);
#pragma unroll
            for (int db = 0; db < 8; ++db) {
                f32x4 au = (f32x4){0.f, 0.f, 0.f, 0.f}, aw = (f32x4){0.f, 0.f, 0.f, 0.f};
#pragma unroll
                for (int ks = 0; ks < 2; ++ks) {
                    const bf16x8 vb = lds8(lds + L_VBT + ((db * 16 + fr) * 72 + ks * 32 + fq * 8) * 2);
                    const bf16x8 kb = lds8(lds + L_KBGT + ((db * 16 + fr) * 72 + ks * 32 + fq * 8) * 2);
                    au = mfma16(tf[ks], vb, au);
                    aw = mfma16(kb, tf[ks], aw);
                }
                u32x2 w; w.x = cvt_pk_bf16(au[0], au[1]); w.y = cvt_pk_bf16(au[2], au[3]);
                *GP(u32x2)(UT + ((((size_t)item * 8 + db) * 2 + (wv >> 1)) * 64 + fr + 16 * ((wv & 1) * 2 + (fq >> 1))) * 8 + (fq & 1) * 4) = w;
                w.x = cvt_pk_bf16(aw[0], aw[1]); w.y = cvt_pk_bf16(aw[2], aw[3]);
                *GP(u32x2)(W + ((((size_t)item * 4 + wv) * 4 + (db >> 1)) * 64 + fr + 16 * ((db & 1) * 2 + (fq >> 1))) * 8 + (fq & 1) * 4) = w;
            }
        }
        __syncthreads();
    }
}

__device__ __forceinline__ void delta_scan(const Params& p_, int blk, int g_wave) {
    Params p = p_; p.ws = opaque_ws(p.ws);
    const int tid = opaque_tid(), lane = tid & 63, w = tid >> 6, fr = lane & 15, fq = lane >> 4;
    const int bh = (blk & 7) + 8 * ((blk >> 3) & 1), sl = blk >> 4, dv0 = sl * 32;
    bf16_t* ST = reinterpret_cast<bf16_t*>(p.ws + OFF_HA);
    bf16_t* UT = reinterpret_cast<bf16_t*>(p.ws + OFF_UT);
    const bf16_t* W = reinterpret_cast<const bf16_t*>(p.ws + OFF_W);
    const bf16_t* KDT = reinterpret_cast<const bf16_t*>(p.ws + OFF_KDT);
    const float* GT = reinterpret_cast<const float*>(p.ws + OFF_GT);
    unsigned char* STL = dyn_lds;
    unsigned char* VTL = dyn_lds + 8704;
    unsigned char* DMY = dyn_lds + 13312;
    unsigned char* RING = dyn_lds + 16384;
    (void)dv0;
#define LDS_BAR() do { asm volatile("s_waitcnt lgkmcnt(0)" ::: "memory"); __builtin_amdgcn_s_barrier(); asm volatile("" ::: "memory"); } while (0)
    if (w >= 4) {
        constexpr int PD = 10;
        const int hw = w - 4, pl = hw * 64 + lane;
#define RING_LOAD(C) do { const int c_ = (C) < 64 ? (C) : 63; const int slot_ = (C) & 3; \
            const bf16_t* wsrc = W + (size_t)(bh * 64 + c_) * 8192 + (hw * 4) * 512 + lane * 8; \
            const bf16_t* ksrc = KDT + (size_t)(bh * 64 + c_) * 8192 + (hw * 4) * 512 + lane * 8; \
            _Pragma("unroll") for (int j = 0; j < 4; ++j) { \
                __builtin_amdgcn_global_load_lds((const unsigned*)(wsrc + j * 512), (unsigned*)(RING + slot_ * 32768 + (hw * 4 + j) * 1024), 16, 0, 0); \
                __builtin_amdgcn_global_load_lds((const unsigned*)(ksrc + j * 512), (unsigned*)(RING + slot_ * 32768 + 16384 + (hw * 4 + j) * 1024), 16, 0, 0); } } while (0)
#define TOUCH(C) do { const int c_ = (C) < 64 ? (C) : 63; const int item_ = bh * 64 + c_; \
            const int li = sl * 32 + (lane & 31); \
            const unsigned char* a0 = (hw == 0) ? ((lane < 32) ? reinterpret_cast<const unsigned char*>(W + (size_t)item_ * 8192) + li * 128 \
                                                               : reinterpret_cast<const unsigned char*>(KDT + (size_t)item_ * 8192) + li * 128) \
                                                : reinterpret_cast<const unsigned char*>(UT + ((size_t)item_ * 8 + sl * 2) * 1024) + (lane & 31) * 128; \
            __builtin_amdgcn_global_load_lds((const unsigned*)a0, (unsigned*)(DMY + hw * 256), 4, 0, 0); } while (0)
        for (int c = 0; c < PD; ++c) TOUCH(c);
        RING_LOAD(0); RING_LOAD(1); RING_LOAD(2);
        asm volatile("s_waitcnt vmcnt(0)" ::: "memory");
        __syncthreads();
        for (int n = 0; n < 64; ++n) {
            const int item = bh * 64 + n;
            __builtin_amdgcn_s_barrier();
            {
                const int dvb_ = pl >> 7, ks_ = (pl >> 6) & 1, l_ = pl & 63;
                const u32x4 v = *reinterpret_cast<const u32x4*>(VTL + ((dvb_ * 16 + (l_ & 15)) * 72 + ks_ * 32 + (l_ >> 4) * 8) * 2);
                *GP(u32x4)(UT + (((size_t)item * 8 + sl * 2) * 128 + pl) * 8) = v;
            }
            asm volatile("s_waitcnt vmcnt(14) lgkmcnt(0)" ::: "memory");
            __builtin_amdgcn_s_barrier();
            {
                bf16_t* dst = (n < 63) ? ST + (((size_t)(item + 1) * 8 + sl * 2) * 256) * 8 : ST + (size_t)1024 * 16384 + (size_t)blk * 4096;
#pragma unroll
                for (int j = 0; j < 2; ++j) {
                    const int q = pl + 256 * j, dvb_ = q >> 8, ks_ = (q >> 6) & 3, l_ = q & 63;
                    const u32x4 v = *reinterpret_cast<const u32x4*>(STL + ((dvb_ * 16 + (l_ & 15)) * 136 + ks_ * 32 + (l_ >> 4) * 8) * 2);
                    *GP(u32x4)(dst + (size_t)q * 8) = v;
                }
            }
            RING_LOAD(n + 3);
            TOUCH(n + PD);
            asm volatile("s_waitcnt lgkmcnt(0)" ::: "memory");
        }
        asm volatile("s_waitcnt vmcnt(0)" ::: "memory");
#undef RING_LOAD
#undef TOUCH
    } else {
        f32x4 S[2][2];
#pragma unroll
        for (int kb = 0; kb < 2; ++kb)
#pragma unroll
            for (int db = 0; db < 2; ++db) {
                S[kb][db] = (f32x4){0.f, 0.f, 0.f, 0.f};
                const u32x2 z = mk2(0u, 0u);
                *reinterpret_cast<u32x2*>(STL + ((db * 16 + fr) * 136 + (2 * w + kb) * 16 + fq * 4) * 2) = z;
                *GP(u32x2)(ST + (((size_t)(bh * 64) * 8 + sl * 2) * 256) * 8 + (size_t)(((kb * 2 + db) * 256 + w * 64 + lane)) * 4) = z;
            }
        __syncthreads();
#define SCAN_LOAD(NN, UB, GTV) do { const int item_ = bh * 64 + (NN); \
        _Pragma("unroll") for (int db = 0; db < 2; ++db) UB[db] = *GPC(u32x2)(UT + ((((size_t)item_ * 8 + sl * 2 + db) * 2 + (w >> 1)) * 64 + fr + 16 * ((w & 1) * 2 + (fq >> 1))) * 8 + (fq & 1) * 4); \
        GTV = *GPC(float)(GT + item_); } while (0)
        u32x2 ubA[2], ubB[2], ubC[2]; float gtA, gtB, gtC;
        SCAN_LOAD(0, ubA, gtA); SCAN_LOAD(1, ubB, gtB);
#define SCAN_STEP(N_, UB, GTV, NUB, NGT) do { \
        const int n = (N_); \
        { const int nn = n + 2 < 64 ? n + 2 : 63; SCAN_LOAD(nn, NUB, NGT); } \
        const unsigned char* slot = RING + (n & 3) * 32768; \
        { bf16x8 sb_[2][4], wf_[4]; \
          _Pragma("unroll") for (int ks = 0; ks < 4; ++ks) wf_[ks] = lds8(slot + ((w * 4 + ks) * 64 + lane) * 16); \
          _Pragma("unroll") for (int db = 0; db < 2; ++db) _Pragma("unroll") for (int ks = 0; ks < 4; ++ks) sb_[db][ks] = lds8(STL + ((db * 16 + fr) * 136 + ks * 32 + fq * 8) * 2); \
          f32x4 a10 = (f32x4){0.f, 0.f, 0.f, 0.f}, a11 = (f32x4){0.f, 0.f, 0.f, 0.f}; \
          _Pragma("unroll") for (int ks = 0; ks < 4; ++ks) { a10 = mfma16(wf_[ks], sb_[0][ks], a10); a11 = mfma16(wf_[ks], sb_[1][ks], a11); } \
          _Pragma("unroll") for (int db = 0; db < 2; ++db) { \
              const f32x4 a1 = db ? a11 : a10; u32x2 vw; \
              vw.x = cvt_pk_bf16(bf_lo(UB[db].x) - a1[0], bf_hi(UB[db].x) - a1[1]); vw.y = cvt_pk_bf16(bf_lo(UB[db].y) - a1[2], bf_hi(UB[db].y) - a1[3]); \
              *reinterpret_cast<u32x2*>(VTL + ((db * 16 + fr) * 72 + w * 16 + fq * 4) * 2) = vw; \
              } } \
        LDS_BAR(); \
        { bf16x8 vb_[2][2], kf_[2][2]; \
          _Pragma("unroll") for (int kb = 0; kb < 2; ++kb) _Pragma("unroll") for (int ks = 0; ks < 2; ++ks) kf_[kb][ks] = lds8(slot + 16384 + (((2 * w + kb) * 2 + ks) * 64 + lane) * 16); \
          _Pragma("unroll") for (int db = 0; db < 2; ++db) _Pragma("unroll") for (int ks = 0; ks < 2; ++ks) vb_[db][ks] = lds8(VTL + ((db * 16 + fr) * 72 + ks * 32 + fq * 8) * 2); \
          _Pragma("unroll") for (int kb = 0; kb < 2; ++kb) _Pragma("unroll") for (int db = 0; db < 2; ++db) { \
              f32x4 a2 = S[kb][db] * GTV; \
              a2 = mfma16(kf_[kb][0], vb_[db][0], a2); a2 = mfma16(kf_[kb][1], vb_[db][1], a2); \
              S[kb][db] = a2; \
              if (n < 63) { \
                  u32x2 sw; sw.x = cvt_pk_bf16(a2[0], a2[1]); sw.y = cvt_pk_bf16(a2[2], a2[3]); \
                  *reinterpret_cast<u32x2*>(STL + ((db * 16 + fr) * 136 + (2 * w + kb) * 16 + fq * 4) * 2) = sw; \
              } } } \
        LDS_BAR(); } while (0)
        for (int n3 = 0; n3 < 63; n3 += 3) {
            SCAN_STEP(n3 + 0, ubA, gtA, ubC, gtC);
            SCAN_STEP(n3 + 1, ubB, gtB, ubA, gtA);
            SCAN_STEP(n3 + 2, ubC, gtC, ubB, gtB);
        }
        SCAN_STEP(63, ubA, gtA, ubC, gtC);
#undef SCAN_STEP
#undef SCAN_LOAD
    }
#undef LDS_BAR
}

__device__ __forceinline__ void swa_phase(const Params& p_, int l, int sblk, int nsb, int g_wave) {
    Params p = p_; p.ws = opaque_ws(p.ws);
    const int tid = opaque_tid(), lane = tid & 63, w = tid >> 6, fr = lane & 15, fq = lane >> 4;
    const bf16_t* HB = reinterpret_cast<const bf16_t*>(p.ws + OFF_HB);
    bf16_t* YM = reinterpret_cast<bf16_t*>(p.ws + OFF_XB);
    unsigned char* VTS = dyn_lds;
    unsigned char* KSL = dyn_lds + 21504;
    for (int it = sblk; it < 1024; it += nsb) {
        const int b = it >> 8, kvh = (it >> 7) & 1, qt = it & 127, q0 = qt * 32, kbase = q0 - 128;
        for (int idx = tid; idx < 1280; idx += 512) {
            const int key = idx >> 3, sg = idx & 7, kp = kbase + key;
            u32x4 u = mk4(0u, 0u, 0u, 0u);
            if (kp >= 0) u = *GPC(u32x4)(HB + (size_t)(b * SEQ + kp) * HB_LD + HB_KB + kvh * 64 + sg * 8);
            *reinterpret_cast<u32x4*>(KSL + (key * 72 + sg * 8) * 2) = u;
        }
        if (tid < 320) {
            const int kg = tid >> 3, sg = tid & 7;
            u32x4 u[4];
#pragma unroll
            for (int k = 0; k < 4; ++k) {
                const int kp = kbase + kg * 4 + k;
                u[k] = mk4(0u, 0u, 0u, 0u);
                if (kp >= 0) u[k] = *GPC(u32x4)(HB + (size_t)(b * SEQ + kp) * HB_LD + HB_VB + kvh * 64 + sg * 8);
            }
#pragma unroll
            for (int dp = 0; dp < 4; ++dp) {
                u32x2 lo, hi;
                lo.x = (u[0][dp] & 0xffffu) | (u[1][dp] << 16); lo.y = (u[2][dp] & 0xffffu) | (u[3][dp] << 16);
                hi.x = (u[0][dp] >> 16) | (u[1][dp] & 0xffff0000u); hi.y = (u[2][dp] >> 16) | (u[3][dp] & 0xffff0000u);
                *reinterpret_cast<u32x2*>(VTS + ((sg * 8 + dp * 2) * 168 + kg * 4) * 2) = lo;
                *reinterpret_cast<u32x2*>(VTS + ((sg * 8 + dp * 2 + 1) * 168 + kg * 4) * 2) = hi;
            }
        }
        const int g = w >> 1, sub = w & 1, qs = q0 + sub * 16, hq = kvh * 4 + g;
        const float slope = exp2f(-(float)(hq + 1)), sink = p.sinks[l * 8 + hq];
        bf16x8 qf[2];
#pragma unroll
        for (int ks = 0; ks < 2; ++ks) qf[ks] = ldg8(HB + (size_t)(b * SEQ + qs + fr) * HB_LD + HB_QB + hq * 64 + ks * 32 + fq * 8);
        __syncthreads();
        f32x4 sc[10];
#pragma unroll
        for (int kt = 0; kt < 10; ++kt) {
            const unsigned char* kr = KSL + ((kt * 16 + fr) * 72 + fq * 8) * 2;
            f32x4 a = (f32x4){0.f, 0.f, 0.f, 0.f};
            a = mfma16(lds8(kr), qf[0], a);
            a = mfma16(lds8(kr + 64), qf[1], a);
            sc[kt] = a;
        }
        const int qpos = qs + fr;
        float m = -1e30f;
#pragma unroll
        for (int kt = 0; kt < 10; ++kt)
#pragma unroll
            for (int r = 0; r < 4; ++r) {
                const int kpos = kbase + kt * 16 + fq * 4 + r, dist = qpos - kpos;
                const bool valid = (dist >= 0) && (dist < 128) && (kpos >= 0);
                const float s = valid ? sc[kt][r] * 0.125f - slope * (float)dist : -1e30f;
                sc[kt][r] = s; m = fmaxf(m, s);
            }
        m = fmaxf(m, shx(m, 16, lane)); m = fmaxf(m, shx(m, 32, lane));
        m = fmaxf(m, sink);
        float lsum = 0.f;
#pragma unroll
        for (int kt = 0; kt < 10; ++kt)
#pragma unroll
            for (int r = 0; r < 4; ++r) { const float e = __expf(sc[kt][r] - m); sc[kt][r] = e; lsum += e; }
        lsum += shx(lsum, 16, lane); lsum += shx(lsum, 32, lane);
        lsum += __expf(sink - m);
        const float inv = __builtin_amdgcn_rcpf(lsum);
        f32x4 o[4];
#pragma unroll
        for (int db = 0; db < 4; ++db) o[db] = (f32x4){0.f, 0.f, 0.f, 0.f};
#pragma unroll
        for (int j = 0; j < 5; ++j) {
            union { bf16x8 v; unsigned u[4]; } pf;
            pf.u[0] = cvt_pk_bf16(sc[2 * j][0], sc[2 * j][1]); pf.u[1] = cvt_pk_bf16(sc[2 * j][2], sc[2 * j][3]);
            pf.u[2] = cvt_pk_bf16(sc[2 * j + 1][0], sc[2 * j + 1][1]); pf.u[3] = cvt_pk_bf16(sc[2 * j + 1][2], sc[2 * j + 1][3]);
#pragma unroll
            for (int db = 0; db < 4; ++db) {
                union { bf16x8 v; u32x2 h[2]; } vf;
                const unsigned char* vr = VTS + ((db * 16 + fr) * 168 + (2 * j) * 16 + fq * 4) * 2;
                vf.h[0] = *reinterpret_cast<const u32x2*>(vr);
                vf.h[1] = *reinterpret_cast<const u32x2*>(vr + 32);
                o[db] = mfma16(vf.v, pf.v, o[db]);
            }
        }
        {
            const size_t tok = (size_t)(b * SEQ + qs + fr);
#pragma unroll
            for (int db = 0; db < 4; ++db) {
                const int col = hq * 64 + db * 16 + fq * 4;
                const u32x2 z = *GPC(u32x2)(HB + tok * HB_LD + HB_ZB + col);
                u32x2 y;
                y.x = cvt_pk_bf16(o[db][0] * inv * silu_f(bf_lo(z.x)), o[db][1] * inv * silu_f(bf_hi(z.x)));
                y.y = cvt_pk_bf16(o[db][2] * inv * silu_f(bf_lo(z.y)), o[db][3] * inv * silu_f(bf_hi(z.y)));
                *GP(u32x2)(YM + tok * DM + 512 + col) = y;
            }
        }
        __syncthreads();
    }
}

__device__ __forceinline__ void delta_out(const Params& p_, int l, int g_wave) {
    Params p = p_; p.ws = opaque_ws(p.ws);
    const int tid = opaque_tid(), grp = tid >> 8, lane = tid & 63, wv = (tid & 255) >> 6, fr = lane & 15, fq = lane >> 4;
    const bf16_t* ST = reinterpret_cast<const bf16_t*>(p.ws + OFF_HA);
    const bf16_t* VT = reinterpret_cast<const bf16_t*>(p.ws + OFF_UT);
    const bf16_t* QD = reinterpret_cast<const bf16_t*>(p.ws + OFF_QD);
    const bf16_t* QK = reinterpret_cast<const bf16_t*>(p.ws + OFF_QK);
    const bf16_t* HB = reinterpret_cast<const bf16_t*>(p.ws + OFF_HB);
    bf16_t* YM = reinterpret_cast<bf16_t*>(p.ws + OFF_XB);
    const float* nw = p.norm_w + l * 128;
    for (int pi = blockIdx.x; pi < 512; pi += gridDim.x) {
        const int item = pi * 2 + grp, bh = item >> 6, n = item & 63, b = bh >> 2, h = bh & 3;
        const int tok = b * SEQ + n * 64 + wv * 16 + fr;
        bf16x8 qd[4], qk[2];
#pragma unroll
        for (int ks = 0; ks < 4; ++ks) qd[ks] = ldg8(QD + ((((size_t)item * 4 + wv) * 4 + ks) * 64 + lane) * 8);
#pragma unroll
        for (int ks = 0; ks < 2; ++ks) qk[ks] = ldg8(QK + ((((size_t)item * 4 + wv) * 2 + ks) * 64 + lane) * 8);
        u32x2 zz[8];
#pragma unroll
        for (int db = 0; db < 8; ++db) zz[db] = *GPC(u32x2)(HB + (size_t)tok * HB_LD + HB_ZA + h * 128 + db * 16 + fq * 4);
        f32x4 o[8];
        float ss = 0.f;
        bf16x8 sfA[4], vfA[2], sfB[4], vfB[2];
#define DO_LOAD(DB, SF, VF) do { const bf16_t* sp = ST + ((((size_t)item * 8 + (DB)) * 4) * 64 + lane) * 8; const bf16_t* vp = VT + ((((size_t)item * 8 + (DB)) * 2) * 64 + lane) * 8; \
            _Pragma("unroll") for (int ks = 0; ks < 4; ++ks) SF[ks] = ldg8(sp + ks * 512); \
            _Pragma("unroll") for (int ks = 0; ks < 2; ++ks) VF[ks] = ldg8(vp + ks * 512); } while (0)
#define DO_MMA(DB, SF, VF) do { f32x4 a = (f32x4){0.f, 0.f, 0.f, 0.f}; \
            _Pragma("unroll") for (int ks = 0; ks < 4; ++ks) a = mfma16(SF[ks], qd[ks], a); \
            _Pragma("unroll") for (int ks = 0; ks < 2; ++ks) a = mfma16(VF[ks], qk[ks], a); \
            o[DB] = a; ss += (a[0] * a[0] + a[1] * a[1]) + (a[2] * a[2] + a[3] * a[3]); } while (0)
        DO_LOAD(0, sfA, vfA); DO_LOAD(1, sfB, vfB);
#pragma unroll
        for (int db = 0; db < 8; db += 2) {
            DO_MMA(db, sfA, vfA);
            if (db + 2 < 8) DO_LOAD(db + 2, sfA, vfA);
            DO_MMA(db + 1, sfB, vfB);
            if (db + 3 < 8) DO_LOAD(db + 3, sfB, vfB);
        }
#undef DO_LOAD
#undef DO_MMA
        ss += shx(ss, 16, lane); ss += shx(ss, 32, lane);
        const float rs = rsqrtf(ss * (1.0f / 128.0f) + 1e-6f);
#pragma unroll
        for (int db = 0; db < 8; ++db) {
            const int dv = db * 16 + fq * 4;
            const f32x4 nv = *GPC(f32x4)(nw + dv);
            const u32x2 z = zz[db];
            u32x2 y;
            y.x = cvt_pk_bf16(o[db][0] * rs * nv[0] * silu_f(bf_lo(z.x)), o[db][1] * rs * nv[1] * silu_f(bf_hi(z.x)));
            y.y = cvt_pk_bf16(o[db][2] * rs * nv[2] * silu_f(bf_lo(z.y)), o[db][3] * rs * nv[3] * silu_f(bf_hi(z.y)));
            *GP(u32x2)(YM + (size_t)tok * DM + h * 128 + dv) = y;
        }
    }
}


__device__ __forceinline__ void diag_rows(const bf16_t* YM, float* out, int g_wave) {
    const int tidx = opaque_tid();
    const int lane = tidx & 63;
    const int gw = blockIdx.x * 8 + (tidx >> 6), nw = gridDim.x * 8;
    for (int row = gw; row < NTOK; row += nw) {
        float ca = 0.f, cb = 0.f;
        for (int i = 0; i < 16; ++i) {
            const int col = i * 64 + lane;
            const float v = bf_lo((unsigned)YM[(size_t)row * DM + col]);
            const bool bad = !(fabsf(v) < 1e30f);
            if (bad) { if (col < 512) ca += 1.f; else cb += 1.f; }
        }
        for (int o = 32; o > 0; o >>= 1) { ca += shx(ca, o, lane); cb += shx(cb, o, lane); }
        for (int i = 0; i < 16; ++i) out[(size_t)row * DM + i * 64 + lane] = 0.f;
        if (lane == 0) out[(size_t)row * DM] = (ca > 0.f ? 1e6f : 0.f) + (cb > 0.f ? 1e5f : 0.f);
    }
}


__device__ __forceinline__ void diag_prep(unsigned char* ws, float* out, int g_wave) {
    const int tidx = opaque_tid();
    const int lane = tidx & 63;
    const int gw = blockIdx.x * 8 + (tidx >> 6), nw = gridDim.x * 8;
    const bf16_t* UT = reinterpret_cast<const bf16_t*>(ws + OFF_UT);
    const bf16_t* W = reinterpret_cast<const bf16_t*>(ws + OFF_W);
    const bf16_t* QD = reinterpret_cast<const bf16_t*>(ws + OFF_QD);
    const bf16_t* KDT = reinterpret_cast<const bf16_t*>(ws + OFF_KDT);
    const bf16_t* QK = reinterpret_cast<const bf16_t*>(ws + OFF_QK);
    const float* GT = reinterpret_cast<const float*>(ws + OFF_GT);
    const float* BA = reinterpret_cast<const float*>(ws + OFF_BA);
    for (int row = gw; row < NTOK; row += nw) {
        float c[6] = {0.f, 0.f, 0.f, 0.f, 0.f, 0.f};
        for (int i = 0; i < 8; ++i) {
            const size_t o = (size_t)row * 512 + i * 64 + lane;
            if (!(fabsf(bf_lo((unsigned)UT[o])) < 1e30f)) c[0] += 1.f;
            if (!(fabsf(bf_lo((unsigned)W[o])) < 1e30f)) c[1] += 1.f;
            if (!(fabsf(bf_lo((unsigned)QD[o])) < 1e30f)) c[2] += 1.f;
            if (!(fabsf(bf_lo((unsigned)KDT[o])) < 1e30f)) c[3] += 1.f;
        }
        for (int i = 0; i < 4; ++i) if (!(fabsf(bf_lo((unsigned)QK[(size_t)row * 256 + i * 64 + lane])) < 1e30f)) c[4] += 1.f;
        if (row < 1024 && lane == 0 && !(fabsf(GT[row]) < 1e30f)) c[5] += 1.f;
        if (lane < 8 && !(fabsf(BA[(size_t)row * 8 + lane]) < 1e30f)) c[5] += 1.f;
        for (int j = 0; j < 6; ++j) for (int o = 32; o > 0; o >>= 1) c[j] += shx(c[j], o, lane);
        unsigned bits = 0;
        for (int j = 0; j < 6; ++j) if (c[j] > 0.f) bits |= (1u << j);
        if (lane == 0 && bits) atomicOr(reinterpret_cast<unsigned*>(ws + OFF_BAR) + 4020, bits);
        for (int i = 0; i < 16; ++i) out[(size_t)row * DM + i * 64 + lane] = 0.f;
    }
}

__global__ void __launch_bounds__(512) fwd_megakernel(Params p) {
    __shared__ u32x4 xb_words;
    const int g_wave = __builtin_amdgcn_readfirstlane((int)(threadIdx.x >> 6));
    if (xb_t0(g_wave)) xb_words = mk4(0u, 0u, 0u, 0u);
    __syncthreads();
    XcdBarrier gb = xcd_barrier_post(reinterpret_cast<unsigned*>(p.ws + OFF_BAR), (volatile LAS unsigned*)&xb_words, g_wave);
#ifdef USE_CG
    gb.x = 0;
#endif

#ifndef PHM
#define PHM 255
#endif
    prep_weights(p, 0, blockIdx.x, gridDim.x, g_wave);
    if (PHM & 2) row_pass(p.x, false, nullptr, nullptr, nullptr, reinterpret_cast<bf16_t*>(p.ws + OFF_XB), p.w_in + 2048, reinterpret_cast<float*>(p.ws + OFF_BA), g_wave);
    xcd_barrier(gb);
    for (int l = 0; l < 2; ++l) {
        unsigned char* wsl = opaque_ws(p.ws);
        bf16_t* XB = reinterpret_cast<bf16_t*>(wsl + OFF_XB);
        float* BA = reinterpret_cast<float*>(wsl + OFF_BA);
        {
            EpiH e; e.ha = reinterpret_cast<bf16_t*>(p.ws + OFF_HA); e.hb = reinterpret_cast<bf16_t*>(p.ws + OFF_HB);
            { int reps = PROBE_REPS_GEMM; asm volatile("" : "+s"(reps));
              for (int rep = 0; rep < reps; ++rep) { gemm_phase(XB, reinterpret_cast<const bf16_t*>(p.ws + OFF_WIN) + (size_t)l * NIN * DM, NTOK, NIN, DM, e, g_wave); } }
            if (l == 0 && blockIdx.x >= 64) prep_weights(p, 1, blockIdx.x - 64, gridDim.x - 64, g_wave);
        }
        xcd_barrier(gb);
        { int reps_ = PROBE_REPS_PREP; asm volatile("" : "+s"(reps_)); for (int rep_ = 0; rep_ < reps_; ++rep_) { if (PHM & 8) chunk_prep(p, l, g_wave); __syncthreads(); } }
        xcd_barrier(gb);
#ifdef DIAG2
        if (l == 0) { diag_prep(wsl, p.out, g_wave); xcd_barrier(gb);
            if (blockIdx.x == 0 && opaque_tid() == 0) p.out[0] = 1000.f * (float)reinterpret_cast<const unsigned*>(wsl + OFF_BAR)[4020];
            return; }
#endif
#ifdef DIAG3
        if (l == 0) {
            const int tidx = opaque_tid();
            const unsigned* dw = reinterpret_cast<const unsigned*>(wsl + OFF_BAR);
            for (size_t i = (size_t)blockIdx.x * 512 + tidx; i < (size_t)NTOK * DM; i += (size_t)gridDim.x * 512) {
                float v = 0.f;
                if (i == 0) v = fminf(__uint_as_float(dw[4010]), 1e37f) * DIAG3_S0;
                if (i == 1) v = fminf(__uint_as_float(dw[4011]), 1e37f) * DIAG3_S1;
                if (i == 2) v = fminf(__uint_as_float(dw[4012]), 1e37f) * DIAG3_S2;
                p.out[i] = v;
            }
            return;
        }
#endif
        if (blockIdx.x < 64) { if (PHM & 16) delta_scan(p, blockIdx.x, g_wave); }
        else { int reps_ = PROBE_REPS_SWA; asm volatile("" : "+s"(reps_)); for (int rep_ = 0; rep_ < reps_; ++rep_) swa_phase(p, l, blockIdx.x - 64, gridDim.x - 64, g_wave); }
        xcd_barrier(gb);
#ifdef DIAG4
        if (l == 0) {
            const int tidx = opaque_tid();
            const unsigned* dw = reinterpret_cast<const unsigned*>(wsl + OFF_BAR);
            for (size_t i = (size_t)blockIdx.x * 512 + tidx; i < (size_t)NTOK * DM; i += (size_t)gridDim.x * 512) {
                float v = 0.f;
                if (i == 0) v = fminf(__uint_as_float(dw[4013]), 1e37f) * DIAG4_S0;
                if (i == 1) v = fminf(__uint_as_float(dw[4014]), 1e37f) * DIAG4_S1;
                p.out[i] = v;
            }
            return;
        }
#endif
        if (l == 0) { const int t_ = opaque_tid(); float zf_ = 0.f; asm volatile("" : "+v"(zf_)); for (int i = blockIdx.x * 512 + t_; i < NTOK * 2; i += gridDim.x * 512) *GP(f32x4)(BA + (size_t)i * 4) = (f32x4){zf_, zf_, zf_, zf_}; }
        { int reps_ = PROBE_REPS_DOUT; asm volatile("" : "+s"(reps_)); for (int rep_ = 0; rep_ < reps_; ++rep_) { if (PHM & 64) delta_out(p, l, g_wave); __syncthreads(); } }
        xcd_barrier(gb);
#ifdef DIAG1
        if (l == DIAG1 - 1) { diag_rows(XB, p.out, g_wave); return; }
#endif
        {
            EpiLN e; e.xres = (l == 0) ? p.x : p.out; e.out = p.out; e.xb = (l == 0) ? XB : nullptr;
            e.g = p.ln_g + l * DM; e.b = p.ln_b + l * DM; e.wg = (l == 0) ? p.w_in + (size_t)DM * INC + 2048 : nullptr; e.BA = BA;
            e.xbuf = reinterpret_cast<float*>(wsl + OFF_XS) + (size_t)l * NTOK * 8;
            e.cnt = reinterpret_cast<unsigned*>(wsl + OFF_BAR) + 3500 + l * 64; e.tmo = reinterpret_cast<unsigned*>(wsl + OFF_BAR) + XB_TMO; e.gw = g_wave;
            gemm_phase(XB, reinterpret_cast<const bf16_t*>(p.ws + OFF_WOUT) + (size_t)l * DM * DM, NTOK, DM, DM, e, g_wave);
        }
        if (l == 0) xcd_barrier(gb);
    }
}

extern "C" void kernel_launch(void* const* d_in, const int* in_sizes, int n_in, void* d_out, int out_size, void* d_ws, size_t ws_size, hipStream_t stream) {
    static int grid_blocks = 0;
    if (!grid_blocks) {
        int dev = 0, cus = 0, per_cu = 0;
        hipGetDevice(&dev);
        hipDeviceGetAttribute(&cus, hipDeviceAttributeMultiprocessorCount, dev);
        hipFuncSetAttribute((const void*)fwd_megakernel, hipFuncAttributeMaxDynamicSharedMemorySize, LDS_BYTES);
        hipOccupancyMaxActiveBlocksPerMultiprocessor(&per_cu, fwd_megakernel, 512, LDS_BYTES);
        grid_blocks = (per_cu >= 1) ? cus : 0;
        if (grid_blocks > 256) grid_blocks = 256;
        if (ws_size < WS_NEED) { fprintf(stderr, "workspace too small: %zu < %zu\n", ws_size, (size_t)WS_NEED); }
        if (!grid_blocks) { fprintf(stderr, "occupancy query returned 0\n"); grid_blocks = 256; }
    }
    Params p{};
    p.x = (const float*)d_in[0]; p.w_in = (const float*)d_in[1]; p.conv_w = (const float*)d_in[2]; p.a_log = (const float*)d_in[3];
    p.dt_bias = (const float*)d_in[4]; p.norm_w = (const float*)d_in[5]; p.sinks = (const float*)d_in[6]; p.w_out = (const float*)d_in[7];
    p.ln_g = (const float*)d_in[8]; p.ln_b = (const float*)d_in[9]; p.out = (float*)d_out; p.ws = (unsigned char*)d_ws;
    hipMemsetAsync(d_ws, 0, 16384, stream);
    void* args[] = {&p};
    hipError_t e = hipLaunchCooperativeKernel((const void*)fwd_megakernel, dim3(grid_blocks), dim3(512), args, LDS_BYTES, stream);
    if (e != hipSuccess) fprintf(stderr, "cooperative launch failed: %s (grid %d)\n", hipGetErrorString(e), grid_blocks);
}
```

```cpp
#include <hip/hip_runtime.h>
#include <cstdio>
#include <cstdint>

#define LAS __attribute__((address_space(3)))
__device__ __forceinline__ int opaque_lane() { int lane; asm volatile("v_mbcnt_lo_u32_b32 %0, -1, 0\n\tv_mbcnt_hi_u32_b32 %0, -1, %0" : "=v"(lane)); return lane; }
typedef unsigned short bf16_t;
typedef short bf16x8 __attribute__((ext_vector_type(8)));
typedef float f32x4 __attribute__((ext_vector_type(4)));
typedef unsigned u32x4 __attribute__((ext_vector_type(4)));
typedef unsigned u32x2 __attribute__((ext_vector_type(2)));
__device__ __forceinline__ u32x4 mk4(unsigned a, unsigned b, unsigned c, unsigned d) { return (u32x4){a, b, c, d}; }
__device__ __forceinline__ u32x2 mk2(unsigned a, unsigned b) { return (u32x2){a, b}; }

constexpr int NTOK = 16384, SEQ = 4096, DM = 1024, INC = 3336, NIN = 3328;
constexpr int HA_LD = 1536, HB_LD = 1792;
constexpr int HB_ZA = 0, HB_QB = 512, HB_KB = 1024, HB_VB = 1152, HB_ZB = 1280;
constexpr float DN_ALPHA = 1.41421356237f;

constexpr size_t OFF_BAR = 0;
constexpr size_t OFF_XB = 16384;
constexpr size_t OFF_WIN = OFF_XB + (size_t)NTOK * DM * 2;
constexpr size_t OFF_WOUT = OFF_WIN + (size_t)2 * NIN * DM * 2;
constexpr size_t OFF_HA = OFF_WOUT + (size_t)2 * DM * DM * 2;
constexpr size_t OFF_HB = OFF_HA + (size_t)NTOK * HA_LD * 2;
constexpr size_t OFF_UT = OFF_HB + (size_t)NTOK * HB_LD * 2;
constexpr size_t OFF_W = OFF_UT + (size_t)NTOK * 512 * 2;
constexpr size_t OFF_QD = OFF_W + (size_t)NTOK * 512 * 2;
constexpr size_t OFF_KDT = OFF_QD + (size_t)NTOK * 512 * 2;
constexpr size_t OFF_QK = OFF_KDT + (size_t)NTOK * 512 * 2;
constexpr size_t OFF_BA = OFF_QK + (size_t)NTOK * 256 * 2;
constexpr size_t OFF_GT = OFF_BA + (size_t)NTOK * 8 * 4;
constexpr size_t OFF_XS = OFF_GT + 4096;
constexpr size_t WS_NEED = OFF_XS + (size_t)2 * NTOK * 4 * 8;

constexpr int LDS_BYTES = 147456;
extern __shared__ __attribute__((aligned(16))) unsigned char dyn_lds[];

struct Params {
    const float* x; const float* w_in; const float* conv_w; const float* a_log; const float* dt_bias;
    const float* norm_w; const float* sinks; const float* w_out; const float* ln_g; const float* ln_b;
    float* out; unsigned char* ws;
};

typedef float f32x2_t __attribute__((ext_vector_type(2)));
typedef __bf16 bf16x2_t __attribute__((ext_vector_type(2)));
__device__ __forceinline__ unsigned cvt_pk_bf16(float lo, float hi) {
    const f32x2_t v = {lo, hi};
    const bf16x2_t r = __builtin_convertvector(v, bf16x2_t);
    return __builtin_bit_cast(unsigned, r);
}
__device__ __forceinline__ float bf_lo(unsigned u) { return __uint_as_float(u << 16); }
__device__ __forceinline__ float bf_hi(unsigned u) { return __uint_as_float(u & 0xffff0000u); }
__device__ __forceinline__ float silu_f(float x) { return x * __builtin_amdgcn_rcpf(1.0f + __expf(-x)); }
__device__ __forceinline__ f32x4 mfma16(bf16x8 a, bf16x8 b, f32x4 c) { return __builtin_amdgcn_mfma_f32_16x16x32_bf16(a, b, c, 0, 0, 0); }
#define GPC(T) (const __attribute__((address_space(1))) T*)
#define GP(T) (__attribute__((address_space(1))) T*)
__device__ __forceinline__ bf16x8 ldg8(const bf16_t* p) { return *GPC(bf16x8)(p); }
__device__ __forceinline__ bf16x8 lds8(const unsigned char* p) { return *reinterpret_cast<const bf16x8*>(p); }

__device__ __forceinline__ int opaque_tid_(int g_wave) {
    int lane; asm volatile("v_mbcnt_lo_u32_b32 %0, -1, 0\n\tv_mbcnt_hi_u32_b32 %0, -1, %0" : "=v"(lane));
    return g_wave * 64 + lane; }
#define opaque_tid() opaque_tid_(g_wave)
__device__ __forceinline__ unsigned char* opaque_ws(unsigned char* w) { asm volatile("" : "+s"(w)); return w; }
__device__ __forceinline__ const bf16_t* uniform_ptr(const bf16_t* p) {
    const unsigned long long v = (unsigned long long)p;
    const unsigned lo = __builtin_amdgcn_readfirstlane((unsigned)v), hi = __builtin_amdgcn_readfirstlane((unsigned)(v >> 32));
    return (const bf16_t*)(((unsigned long long)hi << 32) | lo);
}

__device__ __forceinline__ float shx(float v, int m, int lane) { return __int_as_float(__builtin_amdgcn_ds_bpermute((lane ^ m) << 2, __float_as_int(v))); }

__device__ __forceinline__ float row_sum16(float x) {
    x += __int_as_float(__builtin_amdgcn_update_dpp(0, __float_as_int(x), 0x128, 0xf, 0xf, false));
    x += __int_as_float(__builtin_amdgcn_update_dpp(0, __float_as_int(x), 0x124, 0xf, 0xf, false));
    x += __int_as_float(__builtin_amdgcn_update_dpp(0, __float_as_int(x), 0x122, 0xf, 0xf, false));
    x += __int_as_float(__builtin_amdgcn_update_dpp(0, __float_as_int(x), 0x121, 0xf, 0xf, false));
    return x;
}

#define XB_TMO      128
#define XB_XCNT(j)  (256  + 64 * (j))
#define XB_XSUB(j)  (1280 + 64 * (j))
#define XB_XGEN(j)  (2304 + 64 * (j))
#define XB_TOP      3328
#define XB_TOPGEN   3392
#define XCD_BAR_WORDS 3456
#define XB_SPIN_CAP (1u << 20)
__device__ __forceinline__ unsigned xb_ld(unsigned* p)              { return __hip_atomic_load(p, __ATOMIC_RELAXED, __HIP_MEMORY_SCOPE_AGENT); }
__device__ __forceinline__ unsigned xb_add(unsigned* p, unsigned v) { return __hip_atomic_fetch_add(p, v, __ATOMIC_RELAXED, __HIP_MEMORY_SCOPE_AGENT); }
__device__ __forceinline__ unsigned xb_xcc_id() { return (unsigned)__builtin_amdgcn_s_getreg((3 << 11) | 20) & 0xFu; }
#define XB_SPIN(cond, bar) do { unsigned _sp = 0; while (cond) { __builtin_amdgcn_s_sleep(1); \
    if ((++_sp & 255u) == 0u) { if (xb_ld(&(bar)[XB_TMO])) break; if (_sp > XB_SPIN_CAP) { atomicAdd(&(bar)[XB_TMO], 1u); break; } } } } while (0)
struct XcdBarrier { unsigned* bar; unsigned x; volatile LAS unsigned* st; int gw; };
__device__ __forceinline__ bool xb_t0(int gw) { return gw == 0 && opaque_lane() == 0; }
__device__ __forceinline__ XcdBarrier xcd_barrier_post(unsigned* bar, volatile LAS unsigned* st, int gw) {
    XcdBarrier b; b.bar = bar; b.x = xb_xcc_id(); b.st = st; b.gw = gw;
    if (xb_t0(gw)) (void)xb_add(&bar[XB_XCNT(b.x)], 1u);
    return b;
}
__device__ __forceinline__ void xcd_barrier_complete(unsigned* bar, unsigned x, unsigned& nloc, unsigned& nx) {
    const unsigned G = gridDim.x * gridDim.y * gridDim.z;
    unsigned sum, cnt, mine, sp = 0u;
    for (;;) {
        sum = 0u; cnt = 0u; mine = 0u;
#pragma unroll
        for (unsigned j = 0; j < 16; ++j) { const unsigned c = xb_ld(&bar[XB_XCNT(j)]); sum += c; cnt += (c > 0u) ? 1u : 0u; mine = (j == x) ? c : mine; }
        if (sum == G) break;
        __builtin_amdgcn_s_sleep(1);
        if ((++sp & 255u) == 0u) { if (xb_ld(&bar[XB_TMO])) break; if (sp > XB_SPIN_CAP) { atomicAdd(&bar[XB_TMO], 1u); break; } }
    }
    nloc = mine > 0u ? mine : 1u; nx = cnt > 0u ? cnt : 1u;
}
__device__ __forceinline__ void xcd_barrier(const XcdBarrier& b_) {
    asm volatile("s_waitcnt vmcnt(0)" ::: "memory");
    __syncthreads();
    if (xb_t0(b_.gw)) {
        XcdBarrier b = b_; b.x = xb_xcc_id();
        asm volatile("" : "+s"(b.x));
        unsigned* bar = b.bar;
        __builtin_amdgcn_s_waitcnt(0);
        unsigned nloc = b.st[0], nx = b.st[1];
        if (nloc == 0u) { xcd_barrier_complete(bar, b.x, nloc, nx); b.st[0] = nloc; b.st[1] = nx; }
        const unsigned old = xb_add(&bar[XB_XSUB(b.x)], 1u);
        const unsigned gen = old / nloc;
        if (old + 1u == (gen + 1u) * nloc) {
            __builtin_amdgcn_fence(__ATOMIC_RELEASE, "agent");
            asm volatile("s_waitcnt vmcnt(0)" ::: "memory");
            const unsigned og = xb_add(&bar[XB_TOP], 1u);
            const unsigned tg = og / nx;
            if (og + 1u == (tg + 1u) * nx) xb_add(&bar[XB_TOPGEN], 1u);
            else XB_SPIN(xb_ld(&bar[XB_TOPGEN]) == tg, bar);
            __builtin_amdgcn_fence(__ATOMIC_ACQUIRE, "agent");
            xb_add(&bar[XB_XGEN(b.x)], 1u);
            asm volatile("s_waitcnt vmcnt(0)" ::: "memory");
        } else {
            XB_SPIN(xb_ld(&bar[XB_XGEN(b.x)]) == gen, bar);
            __builtin_amdgcn_fence(__ATOMIC_ACQUIRE, "agent");
            asm volatile("s_waitcnt vmcnt(0)" ::: "memory");
        }
    }
    __syncthreads();
}


constexpr int BM = 256, BK = 64, HALF = 128, NXCD = 8, WGM = 8, HT = HALF * BK;
__device__ __forceinline__ int lds_byte(int r, int c) {
    int st = (r >> 4) * 2 + (c >> 5), rr = r & 15, cc = c & 31, ob = rr * 64 + cc * 2;
    return st * 1024 + (ob ^ (((ob >> 9) & 1) << 5));
}
__device__ __forceinline__ void stage_rc(int b, int& R, int& C) {
    int st = b / 1024, sb = b % 1024, swz = sb ^ (((sb >> 9) & 1) << 5);
    R = (st >> 1) * 16 + swz / 64; C = (st & 1) * 32 + (swz % 64) / 2;
}

struct EpiH {
    bf16_t* ha; bf16_t* hb;
    __device__ __forceinline__ void operator()(const f32x4 (&acc)[2][2][4][2], int brow, int bcol, int wr, int wc, int fr, int fq) const {
        bf16_t* base; int ld, c0;
        if (bcol < HA_LD) { base = ha; ld = HA_LD; c0 = bcol; } else { base = hb; ld = HB_LD; c0 = bcol - HA_LD; }
#pragma unroll
        for (int ai = 0; ai < 2; ++ai)
#pragma unroll
            for (int m = 0; m < 4; ++m) {
                const int row = brow + ai * HALF + wr * 64 + m * 16 + fr;
                bf16_t* rp = base + (size_t)row * ld + c0 + wc * 32 + fq * 4;
#pragma unroll
                for (int bj = 0; bj < 2; ++bj)
#pragma unroll
                    for (int n = 0; n < 2; ++n) {
                        const f32x4 v = acc[ai][bj][m][n];
                        u32x2 w; w.x = cvt_pk_bf16(v[0], v[1]); w.y = cvt_pk_bf16(v[2], v[3]);
                        *GP(u32x2)(rp + bj * HALF + n * 16) = w;
                    }
            }
    }
};
struct EpiZ {
    const float* xres; float* out;
    __device__ __forceinline__ void operator()(const f32x4 (&acc)[2][2][4][2], int brow, int bcol, int wr, int wc, int fr, int fq) const {
#pragma unroll
        for (int ai = 0; ai < 2; ++ai)
#pragma unroll
            for (int m = 0; m < 4; ++m) {
                const int row = brow + ai * HALF + wr * 64 + m * 16 + fr;
                const size_t ro = (size_t)row * DM + bcol + wc * 32 + fq * 4;
#pragma unroll
                for (int bj = 0; bj < 2; ++bj)
#pragma unroll
                    for (int n = 0; n < 2; ++n) {
                        const size_t o = ro + bj * HALF + n * 16;
                        const f32x4 r = *GPC(f32x4)(xres + o);
                        *GP(f32x4)(out + o) = r * DN_ALPHA + acc[ai][bj][m][n];
                    }
            }
    }
};


struct EpiLN {
    const float* xres; float* out; bf16_t* xb; const float* g; const float* b; const float* wg; float* BA; float* xbuf; unsigned* cnt; unsigned* tmo; int gw;
    __device__ __forceinline__ void operator()(f32x4 (&acc)[2][2][4][2], int brow, int bcol, int, int, int, int) const {
        const int tid = opaque_tid_(gw), lane = tid & 63, wr = tid >> 8, wc = (tid >> 6) & 3, fr = lane & 15, fq = lane >> 4, pm = brow >> 8, pn = bcol >> 8;
        f32x2_t* P = reinterpret_cast<f32x2_t*>(dyn_lds);
        f32x2_t* STATS = reinterpret_cast<f32x2_t*>(dyn_lds + 8192);
        float* WG = reinterpret_cast<float*>(dyn_lds + 10240);
        float* GP4 = reinterpret_cast<float*>(dyn_lds + 18432);
        if (wg) {
            for (int c = tid; c < 256; c += 512) {
                const float* wp = wg + (size_t)(bcol + c) * INC;
                *reinterpret_cast<f32x4*>(WG + c * 8) = *GPC(f32x4)(wp); *reinterpret_cast<f32x4*>(WG + c * 8 + 4) = *GPC(f32x4)(wp + 4);
            }
        }
#pragma unroll
        for (int ai = 0; ai < 2; ++ai)
#pragma unroll
            for (int m = 0; m < 4; ++m) {
                __builtin_amdgcn_sched_barrier(0);
                const int rl = ai * HALF + wr * 64 + m * 16 + fr;
                const size_t ro = (size_t)(brow + rl) * DM + bcol + wc * 32 + fq * 4;
                float s1 = 0.f, s2 = 0.f;
#pragma unroll
                for (int bj = 0; bj < 2; ++bj)
#pragma unroll
                    for (int n = 0; n < 2; ++n) {
                        const f32x4 r = *GPC(f32x4)(xres + ro + bj * HALF + n * 16);
                        const f32x4 v = r * DN_ALPHA + acc[ai][bj][m][n];
                        acc[ai][bj][m][n] = v;
                        s1 += (v[0] + v[1]) + (v[2] + v[3]);
                        s2 += (v[0] * v[0] + v[1] * v[1]) + (v[2] * v[2] + v[3] * v[3]);
                    }
                s1 += shx(s1, 16, lane); s1 += shx(s1, 32, lane);
                s2 += shx(s2, 16, lane); s2 += shx(s2, 32, lane);
                if (fq == 0) P[rl * 4 + wc] = (f32x2_t){s1, s2};
            }
        __syncthreads();
        if (tid < 256) {
            const f32x2_t a = P[tid * 4 + 0], b2 = P[tid * 4 + 1], c = P[tid * 4 + 2], d = P[tid * 4 + 3];
            *GP(f32x2_t)(xbuf + ((size_t)(brow + tid) * 4 + pn) * 2) = (f32x2_t){(a.x + b2.x) + (c.x + d.x), (a.y + b2.y) + (c.y + d.y)};
        }
        asm volatile("s_waitcnt vmcnt(0)" ::: "memory");
        __syncthreads();
        if (tid == 0) {
            __threadfence();
            xb_add(cnt + pm, 1u);
            unsigned sp = 0;
            while (xb_ld(cnt + pm) < 4u) { __builtin_amdgcn_s_sleep(1); if (++sp > (1u << 22)) { atomicAdd(tmo, 1u); break; } }
            __threadfence();
        }
        __syncthreads();
        if (tid < 256) {
            float S1 = 0.f, S2 = 0.f;
#pragma unroll
            for (int t = 0; t < 4; ++t) {
                const f32x2_t v = *GPC(f32x2_t)(xbuf + ((size_t)(brow + tid) * 4 + t) * 2);
                S1 += v.x; S2 += v.y;
            }
            const float mean = S1 * (1.0f / DM);
            const float var = fmaxf(S2 * (1.0f / DM) - mean * mean, 0.f);
            STATS[tid] = (f32x2_t){mean, rsqrtf(var + 1e-5f)};
        }
        __syncthreads();
#pragma unroll
        for (int ai = 0; ai < 2; ++ai)
#pragma unroll
            for (int m = 0; m < 4; ++m) {
                __builtin_amdgcn_sched_barrier(0);
                const int rl = ai * HALF + wr * 64 + m * 16 + fr;
                const f32x2_t st = STATS[rl];
                const size_t ro = (size_t)(brow + rl) * DM + bcol + wc * 32 + fq * 4;
                float d[8] = {0.f, 0.f, 0.f, 0.f, 0.f, 0.f, 0.f, 0.f};
#pragma unroll
                for (int bj = 0; bj < 2; ++bj)
#pragma unroll
                    for (int n = 0; n < 2; ++n) {
                        const int cl = bj * HALF + wc * 32 + n * 16 + fq * 4;
                        const f32x4 gg = *GPC(f32x4)(g + bcol + cl), bb = *GPC(f32x4)(b + bcol + cl);
                        const f32x4 v = (acc[ai][bj][m][n] - st.x) * st.y * gg + bb;
                        *GP(f32x4)(out + ro + bj * HALF + n * 16) = v;
                        if (xb) { u32x2 w; w.x = cvt_pk_bf16(v[0], v[1]); w.y = cvt_pk_bf16(v[2], v[3]); *GP(u32x2)(xb + ro + bj * HALF + n * 16) = w; }
                        if (wg) {
#pragma unroll
                            for (int j = 0; j < 4; ++j) {
                                const f32x4 w0 = *reinterpret_cast<const f32x4*>(WG + (cl + j) * 8), w1 = *reinterpret_cast<const f32x4*>(WG + (cl + j) * 8 + 4);
                                d[0] += v[j] * w0[0]; d[1] += v[j] * w0[1]; d[2] += v[j] * w0[2]; d[3] += v[j] * w0[3];
                                d[4] += v[j] * w1[0]; d[5] += v[j] * w1[1]; d[6] += v[j] * w1[2]; d[7] += v[j] * w1[3];
                            }
                        }
                    }
                if (wg) {
#pragma unroll
                    for (int k = 0; k < 8; ++k) { d[k] += shx(d[k], 16, lane); d[k] += shx(d[k], 32, lane); }
                    if (fq == 0) {
                        *reinterpret_cast<f32x4*>(GP4 + (rl * 4 + wc) * 8) = (f32x4){d[0], d[1], d[2], d[3]};
                        *reinterpret_cast<f32x4*>(GP4 + (rl * 4 + wc) * 8 + 4) = (f32x4){d[4], d[5], d[6], d[7]};
                    }
                }
            }
        if (wg) {
            __syncthreads();
            for (int i = tid; i < 2048; i += 512) {
                const int rl = i >> 3, k = i & 7;
                const float sgate = (GP4[(rl * 4 + 0) * 8 + k] + GP4[(rl * 4 + 1) * 8 + k]) + (GP4[(rl * 4 + 2) * 8 + k] + GP4[(rl * 4 + 3) * 8 + k]);
                unsafeAtomicAdd(BA + (size_t)(brow + rl) * 8 + k, sgate);
            }
        }
    }
};

template <class Epi>
__device__ __forceinline__ void gemm_phase(const bf16_t* __restrict__ A, const bf16_t* __restrict__ Bt, int M, int N, int K, const Epi& epi, int g_wave) {
    bf16_t* shm = reinterpret_cast<bf16_t*>(dyn_lds);
#define SA(b,h) (shm+((b)*2+(h))*HT)
#define SB(b,h) (shm+(4+(b)*2+(h))*HT)
#define STAGE(P,BASE,br,kt) do{const bf16_t* _bp=uniform_ptr((BASE)+((long)(br)*K+(long)(kt)*BK)); \
    __builtin_amdgcn_global_load_lds((const unsigned*)((const char*)_bp+soff0),(unsigned*)((char*)(P)+tidx*16),16,0,0); \
    __builtin_amdgcn_global_load_lds((const unsigned*)((const char*)_bp+soff1),(unsigned*)((char*)(P)+tidx*16+8192),16,0,0);}while(0)
#define LDA(dst,b,h) for(int m=0;m<4;++m)for(int k=0;k<2;++k) \
    dst[m][k]=*reinterpret_cast<const bf16x8*>((char*)SA(b,h)+lds_byte(wr*64+m*16+fr,k*32+fq*8))
#define LDB(dst,b,h) for(int n=0;n<2;++n)for(int k=0;k<2;++k) \
    dst[n][k]=*reinterpret_cast<const bf16x8*>((char*)SB(b,h)+lds_byte(wc*32+n*16+fr,k*32+fq*8))
#define MMA(ai,bj,At,Bt_) do{__builtin_amdgcn_s_setprio(1); \
    for(int m=0;m<4;++m)for(int n=0;n<2;++n)for(int k=0;k<2;++k) \
      acc[ai][bj][m][n]=__builtin_amdgcn_mfma_f32_16x16x32_bf16(Bt_[n][k],At[m][k],acc[ai][bj][m][n],0,0,0); \
    __builtin_amdgcn_s_setprio(0);}while(0)
#define WAIT_V(n) asm volatile("s_waitcnt vmcnt(" #n ")":::"memory")
#define WAIT_L(n) asm volatile("s_waitcnt lgkmcnt(" #n ")":::"memory")
#define BAR __builtin_amdgcn_s_barrier()
#define SCHED __builtin_amdgcn_sched_barrier(0)
    const int nM = M / BM, nN = N / BM, nwg = nM * nN;
    const int tidx = opaque_tid();
    const int wid = tidx >> 6, lane = tidx & 63, wr = wid >> 2, wc = wid & 3, fr = lane & 15, fq = lane >> 4;
    const int nt = K / BK;
    unsigned soff0, soff1;
    { int r_, c_; stage_rc(tidx * 16, r_, c_); soff0 = (unsigned)(r_ * K + c_) * 2u; stage_rc(tidx * 16 + 8192, r_, c_); soff1 = (unsigned)(r_ * K + c_) * 2u; }
    for (int L = blockIdx.x; L < nwg; L += gridDim.x) {
        int wgid = L;
        { int q = nwg / NXCD, r = nwg % NXCD, xcd = wgid % NXCD, off = wgid / NXCD; wgid = (xcd < r ? xcd * (q + 1) : r * (q + 1) + (xcd - r) * q) + off; }
        const int nig = WGM * nN, gid = wgid / nig, fm = gid * WGM, gsz = min(nM - fm, WGM);
        const int pm = fm + ((wgid % nig) % gsz), pn = (wgid % nig) / gsz, brow = pm * BM, bcol = pn * BM;
        f32x4 acc[2][2][4][2] = {};
        bf16x8 At[4][2], B0[2][2], B1[2][2];
        STAGE(SB(0,0),Bt,bcol,0); STAGE(SA(0,0),A,brow,0);
        STAGE(SB(0,1),Bt,bcol+HALF,0); STAGE(SA(0,1),A,brow+HALF,0);
        if(wr==1)BAR;
        WAIT_V(4); BAR;
        STAGE(SB(1,0),Bt,bcol,1); STAGE(SA(1,0),A,brow,1); STAGE(SB(1,1),Bt,bcol+HALF,1);
        WAIT_V(6); BAR;
        for(int t=0;t<nt-2;t+=2){
            LDB(B0,0,0); SCHED; LDA(At,0,0); STAGE(SA(1,1),A,brow+HALF,t+1);
            WAIT_L(8); BAR; WAIT_L(0); MMA(0,0,At,B0); BAR; SCHED;
            LDB(B1,0,1); STAGE(SB(0,0),Bt,bcol,t+2);
            BAR; WAIT_L(0); MMA(0,1,At,B1); BAR;
            LDA(At,0,1); STAGE(SA(0,0),A,brow,t+2);
            BAR; WAIT_L(0); MMA(1,0,At,B0); BAR; SCHED;
            STAGE(SB(0,1),Bt,bcol+HALF,t+2);
            WAIT_V(6); BAR; MMA(1,1,At,B1); BAR;
            LDB(B0,1,0); SCHED; LDA(At,1,0); STAGE(SA(0,1),A,brow+HALF,t+2);
            WAIT_L(8); BAR; WAIT_L(0); MMA(0,0,At,B0); BAR; SCHED;
            LDB(B1,1,1); STAGE(SB(1,0),Bt,bcol,t+3);
            BAR; WAIT_L(0); MMA(0,1,At,B1); BAR;
            LDA(At,1,1); STAGE(SA(1,0),A,brow,t+3);
            BAR; WAIT_L(0); MMA(1,0,At,B0); BAR; SCHED;
            STAGE(SB(1,1),Bt,bcol+HALF,t+3);
            WAIT_V(6); BAR; MMA(1,1,At,B1); BAR;
        }
        { LDB(B0,0,0); LDA(At,0,0); STAGE(SA(1,1),A,brow+HALF,nt-1);
          BAR; WAIT_L(0); MMA(0,0,At,B0); BAR;
          LDB(B1,0,1); BAR; WAIT_L(0); MMA(0,1,At,B1); BAR;
          LDA(At,0,1); WAIT_V(4); BAR; WAIT_L(0); MMA(1,0,At,B0); MMA(1,1,At,B1); BAR; }
        { LDB(B0,1,0); LDA(At,1,0); WAIT_V(2); BAR; WAIT_L(0); MMA(0,0,At,B0); BAR;
          LDB(B1,1,1); WAIT_V(0); BAR; WAIT_L(0); MMA(0,1,At,B1); BAR;
          LDA(At,1,1); BAR; WAIT_L(0); MMA(1,0,At,B0); MMA(1,1,At,B1); BAR; }
        if(wr==0)BAR;
        epi(acc, brow, bcol, wr, wc, fr, fq);
        __syncthreads();
    }
#undef SA
#undef SB
#undef STAGE
#undef LDA
#undef LDB
#undef MMA
}

__device__ __forceinline__ void prep_weights(const Params& p, int part, int vblk, int nvblk, int g_wave) {
    bf16_t* win = reinterpret_cast<bf16_t*>(p.ws + OFF_WIN);
    bf16_t* wout = reinterpret_cast<bf16_t*>(p.ws + OFF_WOUT);
    const int gtid = vblk * 512 + opaque_tid(), gsz = nvblk * 512;
    const int n_in = 128 * NIN;
    for (int i = gtid; i < n_in; i += gsz) {
        const int n = i % NIN, kg = i / NIN, l = part;
        const int sc = n < 2048 ? n : n + 8;
        const float* s = p.w_in + (size_t)l * DM * INC + (size_t)(kg * 8) * INC + sc;
        u32x4 w;
        w.x = cvt_pk_bf16(s[0], s[INC]); w.y = cvt_pk_bf16(s[2 * INC], s[3 * INC]);
        w.z = cvt_pk_bf16(s[4 * INC], s[5 * INC]); w.w = cvt_pk_bf16(s[6 * INC], s[7 * INC]);
        *GP(u32x4)(win + ((size_t)l * NIN + n) * DM + kg * 8) = w;
    }
    if (part == 1) {
        const int n_out = 2 * 128 * DM;
        for (int i = gtid; i < n_out; i += gsz) {
            const int n = i % DM, kg = (i / DM) % 128, l = i / (DM * 128);
            const float* s = p.w_out + (size_t)l * DM * DM + (size_t)(kg * 8) * DM + n;
            u32x4 w;
            w.x = cvt_pk_bf16(s[0], s[DM]); w.y = cvt_pk_bf16(s[2 * DM], s[3 * DM]);
            w.z = cvt_pk_bf16(s[4 * DM], s[5 * DM]); w.w = cvt_pk_bf16(s[6 * DM], s[7 * DM]);
            *GP(u32x4)(wout + ((size_t)l * DM + n) * DM + kg * 8) = w;
        }
    }
}

__device__ __forceinline__ void row_pass(const float* src, bool ln, const float* g, const float* bta, float* dstf, bf16_t* xb, const float* wg  , float* BA, int g_wave) {
    const int tidx = opaque_tid();
    const int lane = tidx & 63;
    const int gw = blockIdx.x * 8 + (tidx >> 6), nw = gridDim.x * 8;
    float* wgs = reinterpret_cast<float*>(dyn_lds);
    if (wg) {
        for (int c = tidx; c < DM; c += 512) {
            const f32x4 w0 = *GPC(f32x4)(wg + (size_t)c * INC), w1 = *GPC(f32x4)(wg + (size_t)c * INC + 4);
            *reinterpret_cast<f32x4*>(wgs + c * 8) = w0; *reinterpret_cast<f32x4*>(wgs + c * 8 + 4) = w1;
        }
    }
    __syncthreads();
    f32x4 gg[4], bb[4];
#pragma unroll
    for (int i = 0; i < 4; ++i) { gg[i] = ln ? *GPC(f32x4)(g + i * 256 + lane * 4) : (f32x4){1.f, 1.f, 1.f, 1.f}; bb[i] = ln ? *GPC(f32x4)(bta + i * 256 + lane * 4) : (f32x4){0.f, 0.f, 0.f, 0.f}; }
    f32x4 nv[4];
    if (gw < NTOK) {
#pragma unroll
        for (int i = 0; i < 4; ++i) nv[i] = *GPC(f32x4)(src + (size_t)gw * DM + i * 256 + lane * 4);
    }
    for (int row = gw; row < NTOK; row += nw) {
        f32x4 v[4];
#pragma unroll
        for (int i = 0; i < 4; ++i) v[i] = nv[i];
        if (row + nw < NTOK) {
#pragma unroll
            for (int i = 0; i < 4; ++i) nv[i] = *GPC(f32x4)(src + (size_t)(row + nw) * DM + i * 256 + lane * 4);
        }
        if (ln) {
            float s = 0.f;
#pragma unroll
            for (int i = 0; i < 4; ++i) s += (v[i][0] + v[i][1]) + (v[i][2] + v[i][3]);
#pragma unroll
            for (int o = 32; o > 0; o >>= 1) s += shx(s, o, lane);
            const float mu = s * (1.0f / DM);
            float q = 0.f;
#pragma unroll
            for (int i = 0; i < 4; ++i) { v[i] = v[i] - mu; q += (v[i][0] * v[i][0] + v[i][1] * v[i][1]) + (v[i][2] * v[i][2] + v[i][3] * v[i][3]); }
#pragma unroll
            for (int o = 32; o > 0; o >>= 1) q += shx(q, o, lane);
            const float rstd = rsqrtf(q * (1.0f / DM) + 1e-5f);
#pragma unroll
            for (int i = 0; i < 4; ++i) v[i] = v[i] * rstd * gg[i] + bb[i];
        }
        if (dstf) {
#pragma unroll
            for (int i = 0; i < 4; ++i) *GP(f32x4)(dstf + (size_t)row * DM + i * 256 + lane * 4) = v[i];
        }
        if (xb) {
#pragma unroll
            for (int i = 0; i < 4; ++i) { u32x2 w; w.x = cvt_pk_bf16(v[i][0], v[i][1]); w.y = cvt_pk_bf16(v[i][2], v[i][3]);
                *GP(u32x2)(xb + (size_t)row * DM + i * 256 + lane * 4) = w; }
        }
        if (wg) {
            float d[8] = {0.f, 0.f, 0.f, 0.f, 0.f, 0.f, 0.f, 0.f};
#pragma unroll
            for (int i = 0; i < 4; ++i)
#pragma unroll
                for (int e = 0; e < 4; ++e) {
                    const float* wp = wgs + (i * 256 + lane * 4 + e) * 8;
                    const f32x4 w0 = *reinterpret_cast<const f32x4*>(wp), w1 = *reinterpret_cast<const f32x4*>(wp + 4);
                    const float xv = v[i][e];
                    d[0] += xv * w0[0]; d[1] += xv * w0[1]; d[2] += xv * w0[2]; d[3] += xv * w0[3];
                    d[4] += xv * w1[0]; d[5] += xv * w1[1]; d[6] += xv * w1[2]; d[7] += xv * w1[3];
                }
#pragma unroll
            for (int j = 0; j < 8; ++j) {
#pragma unroll
                for (int o = 32; o > 0; o >>= 1) d[j] += shx(d[j], o, lane);
            }
            if (lane == 0) {
                *GP(f32x4)(BA + (size_t)row * 8) = (f32x4){d[0], d[1], d[2], d[3]};
                *GP(f32x4)(BA + (size_t)row * 8 + 4) = (f32x4){d[4], d[5], d[6], d[7]};
            }
        }
    }
    __syncthreads();
}

constexpr int GRP_LDS = 73728;
constexpr int L_KRM = 0, L_QRM = 17408, L_KBGT = 34816, L_VBT = 53248, L_GC = 71680, L_BETA = 71936;
__device__ __forceinline__ void chunk_prep(const Params& p_, int l, int g_wave) {
    Params p = p_; p.ws = opaque_ws(p.ws);
    const bf16_t* HA = reinterpret_cast<const bf16_t*>(p.ws + OFF_HA);
    const float* BA = reinterpret_cast<const float*>(p.ws + OFF_BA);
    bf16_t* UT = reinterpret_cast<bf16_t*>(p.ws + OFF_UT);
    bf16_t* W = reinterpret_cast<bf16_t*>(p.ws + OFF_W);
    bf16_t* QD = reinterpret_cast<bf16_t*>(p.ws + OFF_QD);
    bf16_t* KDT = reinterpret_cast<bf16_t*>(p.ws + OFF_KDT);
    bf16_t* QK = reinterpret_cast<bf16_t*>(p.ws + OFF_QK);
    float* GT = reinterpret_cast<float*>(p.ws + OFF_GT);
    const float* cw = p.conv_w + (size_t)l * 4 * 1536;
#define CP_LANEVARS const int tid = opaque_tid(), grp = tid >> 8, gt = tid & 255, lane = tid & 63, wv = gt >> 6, fr = lane & 15, fq = lane >> 4; \
    unsigned char* lds = dyn_lds + grp * GRP_LDS; float* gc_s = reinterpret_cast<float*>(lds + L_GC); float* beta_s = reinterpret_cast<float*>(lds + L_BETA); \
    const int tg = gt >> 4, sg = gt & 15, t0 = tg * 4, c0 = sg * 8; (void)fr; (void)fq; (void)wv; (void)t0; (void)c0; (void)gc_s; (void)beta_s; (void)lane;
    for (int pi = blockIdx.x; pi < 512; pi += gridDim.x) {
        const int grp0 = opaque_tid() >> 8;
        const int hp = pi & 1, n = (pi >> 1) & 63, b = pi >> 7, h = hp * 2 + grp0;
        const int item = (b * 4 + h) * 64 + n, tok0 = b * SEQ + n * 64;
        u32x4 rawp[3][7];
        { CP_LANEVARS
#pragma unroll
          for (int ten = 0; ten < 3; ++ten)
#pragma unroll
            for (int r = 0; r < 7; ++r) {
                const int tt = n * 64 + t0 - 3 + r;
                rawp[ten][r] = mk4(0u, 0u, 0u, 0u);
                if (tt >= 0) rawp[ten][r] = *GPC(u32x4)(HA + (size_t)(b * SEQ + tt) * HA_LD + ten * 512 + h * 128 + c0);
            } }
        { CP_LANEVARS
        if (wv == 0) {
            const float bv = *GPC(float)(BA + (size_t)(tok0 + lane) * 8 + h), av = *GPC(float)(BA + (size_t)(tok0 + lane) * 8 + 4 + h);
            const float beta = __builtin_amdgcn_rcpf(1.0f + __expf(-bv));
            const float xx = av + p.dt_bias[l * 4 + h];
            const float sp = fmaxf(xx, 0.f) + log1pf(__expf(-fabsf(xx)));
            float gv = -__expf(p.a_log[l * 4 + h]) * sp;
#pragma unroll
            for (int o = 1; o < 64; o <<= 1) { const float t = __int_as_float(__builtin_amdgcn_ds_bpermute((lane - o) << 2, __float_as_int(gv))); if (lane >= o) gv += t; }
            gc_s[lane] = gv; beta_s[lane] = beta;
            if (lane == 63) *GP(float)(GT + item) = __expf(gv);
        } }
        __syncthreads();
        {
            CP_LANEVARS
            const float glast = gc_s[63];
            float eg[4], ek[4], be[4];
#pragma unroll
            for (int i = 0; i < 4; ++i) { const float gci = gc_s[t0 + i]; eg[i] = __expf(gci); ek[i] = __expf(glast - gci); be[i] = beta_s[t0 + i]; }
#pragma unroll
            for (int ten = 0; ten < 3; ++ten) {
                __builtin_amdgcn_sched_barrier(0);
                float raw[7][8];
#pragma unroll
                for (int r = 0; r < 7; ++r) {
                    const u32x4 u = rawp[ten][r];
                    raw[r][0] = bf_lo(u.x); raw[r][1] = bf_hi(u.x); raw[r][2] = bf_lo(u.y); raw[r][3] = bf_hi(u.y);
                    raw[r][4] = bf_lo(u.z); raw[r][5] = bf_hi(u.z); raw[r][6] = bf_lo(u.w); raw[r][7] = bf_hi(u.w);
                }
                float o[4][8];
#pragma unroll
                for (int i = 0; i < 4; ++i)
#pragma unroll
                    for (int c = 0; c < 8; ++c) o[i][c] = 0.f;
#pragma unroll
                for (int j = 0; j < 4; ++j) {
                    const float* wp = cw + (size_t)j * 1536 + ten * 512 + h * 128 + c0;
                    const f32x4 a = *GPC(f32x4)(wp), c4 = *GPC(f32x4)(wp + 4);
                    const float wj[8] = {a[0], a[1], a[2], a[3], c4[0], c4[1], c4[2], c4[3]};
#pragma unroll
                    for (int i = 0; i < 4; ++i)
#pragma unroll
                        for (int c = 0; c < 8; ++c) o[i][c] += wj[c] * raw[i + j][c];
                }
#pragma unroll
                for (int i = 0; i < 4; ++i)
#pragma unroll
                    for (int c = 0; c < 8; ++c) o[i][c] = silu_f(o[i][c]);
                if (ten < 2) {
#pragma unroll
                    for (int i = 0; i < 4; ++i) {
                        float sq = 0.f;
#pragma unroll
                        for (int c = 0; c < 8; ++c) sq += o[i][c] * o[i][c];
                        sq = row_sum16(sq);
                        const float rq = rsqrtf(sq + 1e-6f) * (ten == 0 ? 0.08838834764831845f : 1.0f);
#pragma unroll
                        for (int c = 0; c < 8; ++c) o[i][c] *= rq;
                    }
                }
                if (ten == 0) {
#pragma unroll
                    for (int i = 0; i < 4; ++i) {
                        u32x4 w;
                        w.x = cvt_pk_bf16(o[i][0] * eg[i], o[i][1] * eg[i]); w.y = cvt_pk_bf16(o[i][2] * eg[i], o[i][3] * eg[i]);
                        w.z = cvt_pk_bf16(o[i][4] * eg[i], o[i][5] * eg[i]); w.w = cvt_pk_bf16(o[i][6] * eg[i], o[i][7] * eg[i]);
                        { const int t_ = t0 + i; *GP(u32x4)(QD + ((((size_t)item * 4 + (t_ >> 4)) * 4 + (sg >> 2)) * 64 + (t_ & 15) + 16 * (sg & 3)) * 8) = w; }
                        w.x = cvt_pk_bf16(o[i][0], o[i][1]); w.y = cvt_pk_bf16(o[i][2], o[i][3]); w.z = cvt_pk_bf16(o[i][4], o[i][5]); w.w = cvt_pk_bf16(o[i][6], o[i][7]);
                        *reinterpret_cast<u32x4*>(lds + L_QRM + ((t0 + i) * 136 + c0) * 2) = w;
                    }
                } else if (ten == 1) {
#pragma unroll
                    for (int i = 0; i < 4; ++i) {
                        u32x4 w;
                        w.x = cvt_pk_bf16(o[i][0], o[i][1]); w.y = cvt_pk_bf16(o[i][2], o[i][3]); w.z = cvt_pk_bf16(o[i][4], o[i][5]); w.w = cvt_pk_bf16(o[i][6], o[i][7]);
                        *reinterpret_cast<u32x4*>(lds + L_KRM + ((t0 + i) * 136 + c0) * 2) = w;
                    }
#pragma unroll
                    for (int c = 0; c < 8; ++c) {
                        u32x2 w;
                        w.x = cvt_pk_bf16(o[0][c] * ek[0], o[1][c] * ek[1]); w.y = cvt_pk_bf16(o[2][c] * ek[2], o[3][c] * ek[3]);
                        { const int dk_ = c0 + c; *GP(u32x2)(KDT + ((((size_t)item * 8 + (dk_ >> 4)) * 2 + (t0 >> 5)) * 64 + (dk_ & 15) + 16 * ((t0 & 31) >> 3)) * 8 + ((t0 & 7) >> 2) * 4) = w; }
                        w.x = cvt_pk_bf16(o[0][c] * be[0] * eg[0], o[1][c] * be[1] * eg[1]); w.y = cvt_pk_bf16(o[2][c] * be[2] * eg[2], o[3][c] * be[3] * eg[3]);
                        *reinterpret_cast<u32x2*>(lds + L_KBGT + ((c0 + c) * 72 + t0) * 2) = w;
                    }
                } else {
#pragma unroll
                    for (int c = 0; c < 8; ++c) {
                        u32x2 w;
                        w.x = cvt_pk_bf16(o[0][c] * be[0], o[1][c] * be[1]); w.y = cvt_pk_bf16(o[2][c] * be[2], o[3][c] * be[3]);
                        *reinterpret_cast<u32x2*>(lds + L_VBT + ((c0 + c) * 72 + t0) * 2) = w;
                    }
                }
            }
        }
        __syncthreads();
        {
            CP_LANEVARS
            const int ib = wv;
            f32x4 kk[4], qk[4];
#pragma unroll
            for (int jb = 0; jb < 4; ++jb) { kk[jb] = (f32x4){0.f, 0.f, 0.f, 0.f}; qk[jb] = (f32x4){0.f, 0.f, 0.f, 0.f}; }
            bf16x8 ki[4], qi[4];
#pragma unroll
            for (int ks = 0; ks < 4; ++ks) {
                ki[ks] = lds8(lds + L_KRM + ((ib * 16 + fr) * 136 + ks * 32 + fq * 8) * 2);
                qi[ks] = lds8(lds + L_QRM + ((ib * 16 + fr) * 136 + ks * 32 + fq * 8) * 2);
            }
#pragma unroll
            for (int jb = 0; jb < 4; ++jb) {
                if (jb <= ib) {
#pragma unroll
                    for (int ks = 0; ks < 4; ++ks) {
                        const bf16x8 kj = lds8(lds + L_KRM + ((jb * 16 + fr) * 136 + ks * 32 + fq * 8) * 2);
                        kk[jb] = mfma16(ki[ks], kj, kk[jb]);
                        qk[jb] = mfma16(kj, qi[ks], qk[jb]);
                    }
                }
            }
            __syncthreads();
            float* AP = reinterpret_cast<float*>(lds + L_KRM);
#pragma unroll
            for (int jb = 0; jb < 4; ++jb) {
                if (jb <= ib) {
                    const int j = jb * 16 + fr, i0 = ib * 16 + fq * 4;
                    const float gj = gc_s[j];
#pragma unroll
                    for (int r = 0; r < 4; ++r) {
                        const int i = i0 + r;
                        const float dec = __expf(fminf(gc_s[i] - gj, 0.f));
                        float av_ = (i > j) ? kk[jb][r] * beta_s[i] * dec : 0.f;
                        AP[j * 64 + r * 16 + ib * 4 + fq] = av_;
                    }
                }
                {
                    const int i = ib * 16 + fr, j0 = jb * 16 + fq * 4;
                    const float gi = gc_s[i];
                    float o[4];
#pragma unroll
                    for (int r = 0; r < 4; ++r) {
                        const int j = j0 + r;
                        const float dec = __expf(fminf(gi - gc_s[j], 0.f));
                        o[r] = (i >= j) ? qk[jb][r] * dec : 0.f;
                    }
                    u32x2 w; w.x = cvt_pk_bf16(o[0], o[1]); w.y = cvt_pk_bf16(o[2], o[3]);
                    *GP(u32x2)(QK + ((((size_t)item * 4 + ib) * 2 + (jb >> 1)) * 64 + fr + 16 * ((jb & 1) * 2 + (fq >> 1))) * 8 + (fq & 1) * 4) = w;
                }
            }
        }
        __syncthreads();
        {
            CP_LANEVARS
            const float* AP = reinterpret_cast<const float*>(lds + L_KRM);
            const int cbk = grp ? 3 - wv : wv;
            const int cl = lane >> 2, pp = lane & 3, ccol = cbk * 16 + cl;
            float a[16];
#pragma unroll
            for (int k = 0; k < 16; ++k) a[k] = (4 * k + pp == ccol) ? 1.f : 0.f;
#define INV_STEP(SS) { const int j = jq * 4 + SS; \
                    const float tj = __int_as_float(__builtin_amdgcn_update_dpp(0, __float_as_int(a[jq]), SS * 0x55, 0xf, 0xf, false)); \
                    const float* ap = AP + j * 64 + pp * 16; \
                    _Pragma("unroll") for (int k = jq; k < 16; ++k) a[k] -= ap[k] * tj; }
#pragma unroll
            for (int jq = 0; jq < 16; ++jq) {
                __builtin_amdgcn_sched_barrier(0);
                if (jq >= cbk * 4) {
                    INV_STEP(0) INV_STEP(1) INV_STEP(2)
                    if (jq < 15) INV_STEP(3)
                }
            }
#undef INV_STEP
            bf16_t* TR = reinterpret_cast<bf16_t*>(lds + L_QRM);
#pragma unroll
            for (int k = 0; k < 16; ++k) TR[(4 * k + pp) * 72 + ccol] = (bf16_t)(cvt_pk_bf16(a[k], 0.f) & 0xffffu);
        }
        __syncthreads();
        {
            CP_LANEVARS
            bf16x8 tf[2];
#pragma unroll
            for (int ks = 0; ks < 2; ++ks) tf[ks] = lds8(lds + L_QRM + ((wv * 16 + fr) * 72 + ks * 32 + fq * 8) * 2);
#pragma unroll
            for (int db = 0; db < 8; ++db) {
                f32x4 au = (f32x4){0.f, 0.f, 0.f, 0.f}, aw = (f32x4){0.f, 0.f, 0.f, 0.f};
#pragma unroll
                for (int ks = 0; ks < 2; ++ks) {
                    const bf16x8 vb = lds8(lds + L_VBT + ((db * 16 + fr) * 72 + ks * 32 + fq * 8) * 2);
                    const bf16x8 kb = lds8(lds + L_KBGT + ((db * 16 + fr) * 72 + ks * 32 + fq * 8) * 2);
                    au = mfma16(tf[ks], vb, au);
                    aw = mfma16(kb, tf[ks], aw);
                }
                u32x2 w; w.x = cvt_pk_bf16(au[0], au[1]); w.y = cvt_pk_bf16(au[2], au[3]);
                *GP(u32x2)(UT + ((((size_t)item * 8 + db) * 2 + (wv >> 1)) * 64 + fr + 16 * ((wv & 1) * 2 + (fq >> 1))) * 8 + (fq & 1) * 4) = w;
                w.x = cvt_pk_bf16(aw[0], aw[1]); w.y = cvt_pk_bf16(aw[2], aw[3]);
                *GP(u32x2)(W + ((((size_t)item * 4 + wv) * 4 + (db >> 1)) * 64 + fr + 16 * ((db & 1) * 2 + (fq >> 1))) * 8 + (fq & 1) * 4) = w;
            }
        }
        __syncthreads();
    }
}

__device__ __forceinline__ void delta_scan(const Params& p_, int blk, int g_wave) {
    Params p = p_; p.ws = opaque_ws(p.ws);
    const int tid = opaque_tid(), lane = tid & 63, w = tid >> 6, fr = lane & 15, fq = lane >> 4;
    const int bh = (blk & 7) + 8 * ((blk >> 3) & 1), sl = blk >> 4, dv0 = sl * 32;
    bf16_t* ST = reinterpret_cast<bf16_t*>(p.ws + OFF_HA);
    bf16_t* UT = reinterpret_cast<bf16_t*>(p.ws + OFF_UT);
    const bf16_t* W = reinterpret_cast<const bf16_t*>(p.ws + OFF_W);
    const bf16_t* KDT = reinterpret_cast<const bf16_t*>(p.ws + OFF_KDT);
    const float* GT = reinterpret_cast<const float*>(p.ws + OFF_GT);
    unsigned char* STL = dyn_lds;
    unsigned char* VTL = dyn_lds + 8704;
    unsigned char* DMY = dyn_lds + 13312;
    unsigned char* RING = dyn_lds + 16384;
    (void)dv0;
#define LDS_BAR() do { asm volatile("s_waitcnt lgkmcnt(0)" ::: "memory"); __builtin_amdgcn_s_barrier(); asm volatile("" ::: "memory"); } while (0)
    if (w >= 4) {
        constexpr int PD = 10;
        const int hw = w - 4, pl = hw * 64 + lane;
#define RING_LOAD(C) do { const int c_ = (C) < 64 ? (C) : 63; const int slot_ = (C) & 3; \
            const bf16_t* wsrc = W + (size_t)(bh * 64 + c_) * 8192 + (hw * 4) * 512 + lane * 8; \
            const bf16_t* ksrc = KDT + (size_t)(bh * 64 + c_) * 8192 + (hw * 4) * 512 + lane * 8; \
            _Pragma("unroll") for (int j = 0; j < 4; ++j) { \
                __builtin_amdgcn_global_load_lds((const unsigned*)(wsrc + j * 512), (unsigned*)(RING + slot_ * 32768 + (hw * 4 + j) * 1024), 16, 0, 0); \
                __builtin_amdgcn_global_load_lds((const unsigned*)(ksrc + j * 512), (unsigned*)(RING + slot_ * 32768 + 16384 + (hw * 4 + j) * 1024), 16, 0, 0); } } while (0)
#define TOUCH(C) do { const int c_ = (C) < 64 ? (C) : 63; const int item_ = bh * 64 + c_; \
            const int li = sl * 32 + (lane & 31); \
            const unsigned char* a0 = (hw == 0) ? ((lane < 32) ? reinterpret_cast<const unsigned char*>(W + (size_t)item_ * 8192) + li * 128 \
                                                               : reinterpret_cast<const unsigned char*>(KDT + (size_t)item_ * 8192) + li * 128) \
                                                : reinterpret_cast<const unsigned char*>(UT + ((size_t)item_ * 8 + sl * 2) * 1024) + (lane & 31) * 128; \
            __builtin_amdgcn_global_load_lds((const unsigned*)a0, (unsigned*)(DMY + hw * 256), 4, 0, 0); } while (0)
        for (int c = 0; c < PD; ++c) TOUCH(c);
        RING_LOAD(0); RING_LOAD(1); RING_LOAD(2);
        asm volatile("s_waitcnt vmcnt(0)" ::: "memory");
        __syncthreads();
        for (int n = 0; n < 64; ++n) {
            const int item = bh * 64 + n;
            __builtin_amdgcn_s_barrier();
            {
                const int dvb_ = pl >> 7, ks_ = (pl >> 6) & 1, l_ = pl & 63;
                const u32x4 v = *reinterpret_cast<const u32x4*>(VTL + ((dvb_ * 16 + (l_ & 15)) * 72 + ks_ * 32 + (l_ >> 4) * 8) * 2);
                *GP(u32x4)(UT + (((size_t)item * 8 + sl * 2) * 128 + pl) * 8) = v;
            }
            asm volatile("s_waitcnt vmcnt(14) lgkmcnt(0)" ::: "memory");
            __builtin_amdgcn_s_barrier();
            {
                bf16_t* dst = (n < 63) ? ST + (((size_t)(item + 1) * 8 + sl * 2) * 256) * 8 : ST + (size_t)1024 * 16384 + (size_t)blk * 4096;
#pragma unroll
                for (int j = 0; j < 2; ++j) {
                    const int q = pl + 256 * j, dvb_ = q >> 8, ks_ = (q >> 6) & 3, l_ = q & 63;
                    const u32x4 v = *reinterpret_cast<const u32x4*>(STL + ((dvb_ * 16 + (l_ & 15)) * 136 + ks_ * 32 + (l_ >> 4) * 8) * 2);
                    *GP(u32x4)(dst + (size_t)q * 8) = v;
                }
            }
            RING_LOAD(n + 3);
            TOUCH(n + PD);
            asm volatile("s_waitcnt lgkmcnt(0)" ::: "memory");
        }
        asm volatile("s_waitcnt vmcnt(0)" ::: "memory");
#undef RING_LOAD
#undef TOUCH
    } else {
        f32x4 S[2][2];
#pragma unroll
        for (int kb = 0; kb < 2; ++kb)
#pragma unroll
            for (int db = 0; db < 2; ++db) {
                S[kb][db] = (f32x4){0.f, 0.f, 0.f, 0.f};
                const u32x2 z = mk2(0u, 0u);
                *reinterpret_cast<u32x2*>(STL + ((db * 16 + fr) * 136 + (2 * w + kb) * 16 + fq * 4) * 2) = z;
                *GP(u32x2)(ST + (((size_t)(bh * 64) * 8 + sl * 2) * 256) * 8 + (size_t)(((kb * 2 + db) * 256 + w * 64 + lane)) * 4) = z;
            }
        __syncthreads();
#define SCAN_LOAD(NN, UB, GTV) do { const int item_ = bh * 64 + (NN); \
        _Pragma("unroll") for (int db = 0; db < 2; ++db) UB[db] = *GPC(u32x2)(UT + ((((size_t)item_ * 8 + sl * 2 + db) * 2 + (w >> 1)) * 64 + fr + 16 * ((w & 1) * 2 + (fq >> 1))) * 8 + (fq & 1) * 4); \
        GTV = *GPC(float)(GT + item_); } while (0)
        u32x2 ubA[2], ubB[2], ubC[2]; float gtA, gtB, gtC;
        SCAN_LOAD(0, ubA, gtA); SCAN_LOAD(1, ubB, gtB);
#define SCAN_STEP(N_, UB, GTV, NUB, NGT) do { \
        const int n = (N_); \
        { const int nn = n + 2 < 64 ? n + 2 : 63; SCAN_LOAD(nn, NUB, NGT); } \
        const unsigned char* slot = RING + (n & 3) * 32768; \
        { bf16x8 sb_[2][4], wf_[4]; \
          _Pragma("unroll") for (int ks = 0; ks < 4; ++ks) wf_[ks] = lds8(slot + ((w * 4 + ks) * 64 + lane) * 16); \
          _Pragma("unroll") for (int db = 0; db < 2; ++db) _Pragma("unroll") for (int ks = 0; ks < 4; ++ks) sb_[db][ks] = lds8(STL + ((db * 16 + fr) * 136 + ks * 32 + fq * 8) * 2); \
          f32x4 a10 = (f32x4){0.f, 0.f, 0.f, 0.f}, a11 = (f32x4){0.f, 0.f, 0.f, 0.f}; \
          _Pragma("unroll") for (int ks = 0; ks < 4; ++ks) { a10 = mfma16(wf_[ks], sb_[0][ks], a10); a11 = mfma16(wf_[ks], sb_[1][ks], a11); } \
          _Pragma("unroll") for (int db = 0; db < 2; ++db) { \
              const f32x4 a1 = db ? a11 : a10; u32x2 vw; \
              vw.x = cvt_pk_bf16(bf_lo(UB[db].x) - a1[0], bf_hi(UB[db].x) - a1[1]); vw.y = cvt_pk_bf16(bf_lo(UB[db].y) - a1[2], bf_hi(UB[db].y) - a1[3]); \
              *reinterpret_cast<u32x2*>(VTL + ((db * 16 + fr) * 72 + w * 16 + fq * 4) * 2) = vw; \
              } } \
        LDS_BAR(); \
        { bf16x8 vb_[2][2], kf_[2][2]; \
          _Pragma("unroll") for (int kb = 0; kb < 2; ++kb) _Pragma("unroll") for (int ks = 0; ks < 2; ++ks) kf_[kb][ks] = lds8(slot + 16384 + (((2 * w + kb) * 2 + ks) * 64 + lane) * 16); \
          _Pragma("unroll") for (int db = 0; db < 2; ++db) _Pragma("unroll") for (int ks = 0; ks < 2; ++ks) vb_[db][ks] = lds8(VTL + ((db * 16 + fr) * 72 + ks * 32 + fq * 8) * 2); \
          _Pragma("unroll") for (int kb = 0; kb < 2; ++kb) _Pragma("unroll") for (int db = 0; db < 2; ++db) { \
              f32x4 a2 = S[kb][db] * GTV; \
              a2 = mfma16(kf_[kb][0], vb_[db][0], a2); a2 = mfma16(kf_[kb][1], vb_[db][1], a2); \
              S[kb][db] = a2; \
              if (n < 63) { \
                  u32x2 sw; sw.x = cvt_pk_bf16(a2[0], a2[1]); sw.y = cvt_pk_bf16(a2[2], a2[3]); \
                  *reinterpret_cast<u32x2*>(STL + ((db * 16 + fr) * 136 + (2 * w + kb) * 16 + fq * 4) * 2) = sw; \
              } } } \
        LDS_BAR(); } while (0)
        for (int n3 = 0; n3 < 63; n3 += 3) {
            SCAN_STEP(n3 + 0, ubA, gtA, ubC, gtC);
            SCAN_STEP(n3 + 1, ubB, gtB, ubA, gtA);
            SCAN_STEP(n3 + 2, ubC, gtC, ubB, gtB);
        }
        SCAN_STEP(63, ubA, gtA, ubC, gtC);
#undef SCAN_STEP
#undef SCAN_LOAD
    }
#undef LDS_BAR
}

__device__ __forceinline__ void swa_phase(const Params& p_, int l, int sblk, int nsb, int g_wave) {
    Params p = p_; p.ws = opaque_ws(p.ws);
    const int tid = opaque_tid(), lane = tid & 63, w = tid >> 6, fr = lane & 15, fq = lane >> 4;
    const bf16_t* HB = reinterpret_cast<const bf16_t*>(p.ws + OFF_HB);
    bf16_t* YM = reinterpret_cast<bf16_t*>(p.ws + OFF_XB);
    unsigned char* VTS = dyn_lds;
    unsigned char* KSL = dyn_lds + 21504;
    for (int it = sblk; it < 1024; it += nsb) {
        const int b = it >> 8, kvh = (it >> 7) & 1, qt = it & 127, q0 = qt * 32, kbase = q0 - 128;
        for (int idx = tid; idx < 1280; idx += 512) {
            const int key = idx >> 3, sg = idx & 7, kp = kbase + key;
            u32x4 u = mk4(0u, 0u, 0u, 0u);
            if (kp >= 0) u = *GPC(u32x4)(HB + (size_t)(b * SEQ + kp) * HB_LD + HB_KB + kvh * 64 + sg * 8);
            *reinterpret_cast<u32x4*>(KSL + (key * 72 + sg * 8) * 2) = u;
        }
        if (tid < 320) {
            const int kg = tid >> 3, sg = tid & 7;
            u32x4 u[4];
#pragma unroll
            for (int k = 0; k < 4; ++k) {
                const int kp = kbase + kg * 4 + k;
                u[k] = mk4(0u, 0u, 0u, 0u);
                if (kp >= 0) u[k] = *GPC(u32x4)(HB + (size_t)(b * SEQ + kp) * HB_LD + HB_VB + kvh * 64 + sg * 8);
            }
#pragma unroll
            for (int dp = 0; dp < 4; ++dp) {
                u32x2 lo, hi;
                lo.x = (u[0][dp] & 0xffffu) | (u[1][dp] << 16); lo.y = (u[2][dp] & 0xffffu) | (u[3][dp] << 16);
                hi.x = (u[0][dp] >> 16) | (u[1][dp] & 0xffff0000u); hi.y = (u[2][dp] >> 16) | (u[3][dp] & 0xffff0000u);
                *reinterpret_cast<u32x2*>(VTS + ((sg * 8 + dp * 2) * 168 + kg * 4) * 2) = lo;
                *reinterpret_cast<u32x2*>(VTS + ((sg * 8 + dp * 2 + 1) * 168 + kg * 4) * 2) = hi;
            }
        }
        const int g = w >> 1, sub = w & 1, qs = q0 + sub * 16, hq = kvh * 4 + g;
        const float slope = exp2f(-(float)(hq + 1)), sink = p.sinks[l * 8 + hq];
        bf16x8 qf[2];
#pragma unroll
        for (int ks = 0; ks < 2; ++ks) qf[ks] = ldg8(HB + (size_t)(b * SEQ + qs + fr) * HB_LD + HB_QB + hq * 64 + ks * 32 + fq * 8);
        __syncthreads();
        f32x4 sc[10];
#pragma unroll
        for (int kt = 0; kt < 10; ++kt) {
            const unsigned char* kr = KSL + ((kt * 16 + fr) * 72 + fq * 8) * 2;
            f32x4 a = (f32x4){0.f, 0.f, 0.f, 0.f};
            a = mfma16(lds8(kr), qf[0], a);
            a = mfma16(lds8(kr + 64), qf[1], a);
            sc[kt] = a;
        }
        const int qpos = qs + fr;
        float m = -1e30f;
#pragma unroll
        for (int kt = 0; kt < 10; ++kt)
#pragma unroll
            for (int r = 0; r < 4; ++r) {
                const int kpos = kbase + kt * 16 + fq * 4 + r, dist = qpos - kpos;
                const bool valid = (dist >= 0) && (dist < 128) && (kpos >= 0);
                const float s = valid ? sc[kt][r] * 0.125f - slope * (float)dist : -1e30f;
                sc[kt][r] = s; m = fmaxf(m, s);
            }
        m = fmaxf(m, shx(m, 16, lane)); m = fmaxf(m, shx(m, 32, lane));
        m = fmaxf(m, sink);
        float lsum = 0.f;
#pragma unroll
        for (int kt = 0; kt < 10; ++kt)
#pragma unroll
            for (int r = 0; r < 4; ++r) { const float e = __expf(sc[kt][r] - m); sc[kt][r] = e; lsum += e; }
        lsum += shx(lsum, 16, lane); lsum += shx(lsum, 32, lane);
        lsum += __expf(sink - m);
        const float inv = __builtin_amdgcn_rcpf(lsum);
        f32x4 o[4];
#pragma unroll
        for (int db = 0; db < 4; ++db) o[db] = (f32x4){0.f, 0.f, 0.f, 0.f};
#pragma unroll
        for (int j = 0; j < 5; ++j) {
            union { bf16x8 v; unsigned u[4]; } pf;
            pf.u[0] = cvt_pk_bf16(sc[2 * j][0], sc[2 * j][1]); pf.u[1] = cvt_pk_bf16(sc[2 * j][2], sc[2 * j][3]);
            pf.u[2] = cvt_pk_bf16(sc[2 * j + 1][0], sc[2 * j + 1][1]); pf.u[3] = cvt_pk_bf16(sc[2 * j + 1][2], sc[2 * j + 1][3]);
#pragma unroll
            for (int db = 0; db < 4; ++db) {
                union { bf16x8 v; u32x2 h[2]; } vf;
                const unsigned char* vr = VTS + ((db * 16 + fr) * 168 + (2 * j) * 16 + fq * 4) * 2;
                vf.h[0] = *reinterpret_cast<const u32x2*>(vr);
                vf.h[1] = *reinterpret_cast<const u32x2*>(vr + 32);
                o[db] = mfma16(vf.v, pf.v, o[db]);
            }
        }
        {
            const size_t tok = (size_t)(b * SEQ + qs + fr);
#pragma unroll
            for (int db = 0; db < 4; ++db) {
                const int col = hq * 64 + db * 16 + fq * 4;
                const u32x2 z = *GPC(u32x2)(HB + tok * HB_LD + HB_ZB + col);
                u32x2 y;
                y.x = cvt_pk_bf16(o[db][0] * inv * silu_f(bf_lo(z.x)), o[db][1] * inv * silu_f(bf_hi(z.x)));
                y.y = cvt_pk_bf16(o[db][2] * inv * silu_f(bf_lo(z.y)), o[db][3] * inv * silu_f(bf_hi(z.y)));
                *GP(u32x2)(YM + tok * DM + 512 + col) = y;
            }
        }
        __syncthreads();
    }
}

__device__ __forceinline__ void delta_out(const Params& p_, int l, int g_wave) {
    Params p = p_; p.ws = opaque_ws(p.ws);
    const int tid = opaque_tid(), grp = tid >> 8, lane = tid & 63, wv = (tid & 255) >> 6, fr = lane & 15, fq = lane >> 4;
    const bf16_t* ST = reinterpret_cast<const bf16_t*>(p.ws + OFF_HA);
    const bf16_t* VT = reinterpret_cast<const bf16_t*>(p.ws + OFF_UT);
    const bf16_t* QD = reinterpret_cast<const bf16_t*>(p.ws + OFF_QD);
    const bf16_t* QK = reinterpret_cast<const bf16_t*>(p.ws + OFF_QK);
    const bf16_t* HB = reinterpret_cast<const bf16_t*>(p.ws + OFF_HB);
    bf16_t* YM = reinterpret_cast<bf16_t*>(p.ws + OFF_XB);
    const float* nw = p.norm_w + l * 128;
    for (int pi = blockIdx.x; pi < 512; pi += gridDim.x) {
        const int item = pi * 2 + grp, bh = item >> 6, n = item & 63, b = bh >> 2, h = bh & 3;
        const int tok = b * SEQ + n * 64 + wv * 16 + fr;
        bf16x8 qd[4], qk[2];
#pragma unroll
        for (int ks = 0; ks < 4; ++ks) qd[ks] = ldg8(QD + ((((size_t)item * 4 + wv) * 4 + ks) * 64 + lane) * 8);
#pragma unroll
        for (int ks = 0; ks < 2; ++ks) qk[ks] = ldg8(QK + ((((size_t)item * 4 + wv) * 2 + ks) * 64 + lane) * 8);
        u32x2 zz[8];
#pragma unroll
        for (int db = 0; db < 8; ++db) zz[db] = *GPC(u32x2)(HB + (size_t)tok * HB_LD + HB_ZA + h * 128 + db * 16 + fq * 4);
        f32x4 o[8];
        float ss = 0.f;
        bf16x8 sfA[4], vfA[2], sfB[4], vfB[2];
#define DO_LOAD(DB, SF, VF) do { const bf16_t* sp = ST + ((((size_t)item * 8 + (DB)) * 4) * 64 + lane) * 8; const bf16_t* vp = VT + ((((size_t)item * 8 + (DB)) * 2) * 64 + lane) * 8; \
            _Pragma("unroll") for (int ks = 0; ks < 4; ++ks) SF[ks] = ldg8(sp + ks * 512); \
            _Pragma("unroll") for (int ks = 0; ks < 2; ++ks) VF[ks] = ldg8(vp + ks * 512); } while (0)
#define DO_MMA(DB, SF, VF) do { f32x4 a = (f32x4){0.f, 0.f, 0.f, 0.f}; \
            _Pragma("unroll") for (int ks = 0; ks < 4; ++ks) a = mfma16(SF[ks], qd[ks], a); \
            _Pragma("unroll") for (int ks = 0; ks < 2; ++ks) a = mfma16(VF[ks], qk[ks], a); \
            o[DB] = a; ss += (a[0] * a[0] + a[1] * a[1]) + (a[2] * a[2] + a[3] * a[3]); } while (0)
        DO_LOAD(0, sfA, vfA); DO_LOAD(1, sfB, vfB);
#pragma unroll
        for (int db = 0; db < 8; db += 2) {
            DO_MMA(db, sfA, vfA);
            if (db + 2 < 8) DO_LOAD(db + 2, sfA, vfA);
            DO_MMA(db + 1, sfB, vfB);
            if (db + 3 < 8) DO_LOAD(db + 3, sfB, vfB);
        }
#undef DO_LOAD
#undef DO_MMA
        ss += shx(ss, 16, lane); ss += shx(ss, 32, lane);
        const float rs = rsqrtf(ss * (1.0f / 128.0f) + 1e-6f);
#pragma unroll
        for (int db = 0; db < 8; ++db) {
            const int dv = db * 16 + fq * 4;
            const f32x4 nv = *GPC(f32x4)(nw + dv);
            const u32x2 z = zz[db];
            u32x2 y;
            y.x = cvt_pk_bf16(o[db][0] * rs * nv[0] * silu_f(bf_lo(z.x)), o[db][1] * rs * nv[1] * silu_f(bf_hi(z.x)));
            y.y = cvt_pk_bf16(o[db][2] * rs * nv[2] * silu_f(bf_lo(z.y)), o[db][3] * rs * nv[3] * silu_f(bf_hi(z.y)));
            *GP(u32x2)(YM + (size_t)tok * DM + h * 128 + dv) = y;
        }
    }
}


__global__ void __launch_bounds__(512) fwd_megakernel(Params p) {
    __shared__ u32x4 xb_words;
    const int g_wave = __builtin_amdgcn_readfirstlane((int)(threadIdx.x >> 6));
    if (xb_t0(g_wave)) xb_words = mk4(0u, 0u, 0u, 0u);
    __syncthreads();
    XcdBarrier gb = xcd_barrier_post(reinterpret_cast<unsigned*>(p.ws + OFF_BAR), (volatile LAS unsigned*)&xb_words, g_wave);

    prep_weights(p, 0, blockIdx.x, gridDim.x, g_wave);
    row_pass(p.x, false, nullptr, nullptr, nullptr, reinterpret_cast<bf16_t*>(p.ws + OFF_XB), p.w_in + 2048, reinterpret_cast<float*>(p.ws + OFF_BA), g_wave);
    xcd_barrier(gb);
    for (int l = 0; l < 2; ++l) {
        unsigned char* wsl = opaque_ws(p.ws);
        bf16_t* XB = reinterpret_cast<bf16_t*>(wsl + OFF_XB);
        float* BA = reinterpret_cast<float*>(wsl + OFF_BA);
        {
            EpiH e; e.ha = reinterpret_cast<bf16_t*>(p.ws + OFF_HA); e.hb = reinterpret_cast<bf16_t*>(p.ws + OFF_HB);
            gemm_phase(XB, reinterpret_cast<const bf16_t*>(p.ws + OFF_WIN) + (size_t)l * NIN * DM, NTOK, NIN, DM, e, g_wave);
            if (l == 0 && blockIdx.x >= 64) prep_weights(p, 1, blockIdx.x - 64, gridDim.x - 64, g_wave);
        }
        xcd_barrier(gb);
        chunk_prep(p, l, g_wave);
        xcd_barrier(gb);
        if (blockIdx.x < 64) delta_scan(p, blockIdx.x, g_wave);
        else swa_phase(p, l, blockIdx.x - 64, gridDim.x - 64, g_wave);
        xcd_barrier(gb);
        if (l == 0) { const int t_ = opaque_tid(); float zf_ = 0.f; asm volatile("" : "+v"(zf_)); for (int i = blockIdx.x * 512 + t_; i < NTOK * 2; i += gridDim.x * 512) *GP(f32x4)(BA + (size_t)i * 4) = (f32x4){zf_, zf_, zf_, zf_}; }
        delta_out(p, l, g_wave);
        xcd_barrier(gb);
        {
            EpiLN e; e.xres = (l == 0) ? p.x : p.out; e.out = p.out; e.xb = (l == 0) ? XB : nullptr;
            e.g = p.ln_g + l * DM; e.b = p.ln_b + l * DM; e.wg = (l == 0) ? p.w_in + (size_t)DM * INC + 2048 : nullptr; e.BA = BA;
            e.xbuf = reinterpret_cast<float*>(wsl + OFF_XS) + (size_t)l * NTOK * 8;
            e.cnt = reinterpret_cast<unsigned*>(wsl + OFF_BAR) + 3500 + l * 64; e.tmo = reinterpret_cast<unsigned*>(wsl + OFF_BAR) + XB_TMO; e.gw = g_wave;
            gemm_phase(XB, reinterpret_cast<const bf16_t*>(p.ws + OFF_WOUT) + (size_t)l * DM * DM, NTOK, DM, DM, e, g_wave);
        }
        if (l == 0) xcd_barrier(gb);
    }
}

extern "C" void kernel_launch(void* const* d_in, const int* in_sizes, int n_in, void* d_out, int out_size, void* d_ws, size_t ws_size, hipStream_t stream) {
    static int grid_blocks = 0;
    if (!grid_blocks) {
        int dev = 0, cus = 0, per_cu = 0;
        hipGetDevice(&dev);
        hipDeviceGetAttribute(&cus, hipDeviceAttributeMultiprocessorCount, dev);
        hipFuncSetAttribute((const void*)fwd_megakernel, hipFuncAttributeMaxDynamicSharedMemorySize, LDS_BYTES);
        hipOccupancyMaxActiveBlocksPerMultiprocessor(&per_cu, fwd_megakernel, 512, LDS_BYTES);
        grid_blocks = (per_cu >= 1) ? cus : 0;
        if (grid_blocks > 256) grid_blocks = 256;
        if (ws_size < WS_NEED) { fprintf(stderr, "workspace too small: %zu < %zu\n", ws_size, (size_t)WS_NEED); }
        if (!grid_blocks) { fprintf(stderr, "occupancy query returned 0\n"); grid_blocks = 256; }
    }
    Params p{};
    p.x = (const float*)d_in[0]; p.w_in = (const float*)d_in[1]; p.conv_w = (const float*)d_in[2]; p.a_log = (const float*)d_in[3];
    p.dt_bias = (const float*)d_in[4]; p.norm_w = (const float*)d_in[5]; p.sinks = (const float*)d_in[6]; p.w_out = (const float*)d_in[7];
    p.ln_g = (const float*)d_in[8]; p.ln_b = (const float*)d_in[9]; p.out = (float*)d_out; p.ws = (unsigned char*)d_ws;
    hipMemsetAsync(d_ws, 0, 16384, stream);
    void* args[] = {&p};
    hipError_t e = hipLaunchCooperativeKernel((const void*)fwd_megakernel, dim3(grid_blocks), dim3(512), args, LDS_BYTES, stream);
    if (e != hipSuccess) fprintf(stderr, "cooperative launch failed: %s (grid %d)\n", hipGetErrorString(e), grid_blocks);
}
```

```cpp
#include <hip/hip_runtime.h>
#include <cstdio>
#include <cstdint>

#define LAS __attribute__((address_space(3)))
__device__ __forceinline__ int opaque_lane() { int lane; asm volatile("v_mbcnt_lo_u32_b32 %0, -1, 0\n\tv_mbcnt_hi_u32_b32 %0, -1, %0" : "=v"(lane)); return lane; }
typedef unsigned short bf16_t;
typedef short bf16x8 __attribute__((ext_vector_type(8)));
typedef float f32x4 __attribute__((ext_vector_type(4)));
typedef unsigned u32x4 __attribute__((ext_vector_type(4)));
typedef unsigned u32x2 __attribute__((ext_vector_type(2)));
__device__ __forceinline__ u32x4 mk4(unsigned a, unsigned b, unsigned c, unsigned d) { return (u32x4){a, b, c, d}; }
__device__ __forceinline__ u32x2 mk2(unsigned a, unsigned b) { return (u32x2){a, b}; }

constexpr int NTOK = 16384, SEQ = 4096, DM = 1024, INC = 3336, NIN = 3328;
constexpr int HA_LD = 1536, HB_LD = 1792;
constexpr int HB_ZA = 0, HB_QB = 512, HB_KB = 1024, HB_VB = 1152, HB_ZB = 1280;
constexpr float DN_ALPHA = 1.41421356237f;

constexpr size_t OFF_BAR = 0;
constexpr size_t OFF_XB = 16384;
constexpr size_t OFF_WIN = OFF_XB + (size_t)NTOK * DM * 2;
constexpr size_t OFF_WOUT = OFF_WIN + (size_t)2 * NIN * DM * 2;
constexpr size_t OFF_HA = OFF_WOUT + (size_t)2 * DM * DM * 2;
constexpr size_t OFF_HB = OFF_HA + (size_t)NTOK * HA_LD * 2;
constexpr size_t OFF_UT = OFF_HB + (size_t)NTOK * HB_LD * 2;
constexpr size_t OFF_W = OFF_UT + (size_t)NTOK * 512 * 2;
constexpr size_t OFF_QD = OFF_W + (size_t)NTOK * 512 * 2;
constexpr size_t OFF_KDT = OFF_QD + (size_t)NTOK * 512 * 2;
constexpr size_t OFF_QK = OFF_KDT + (size_t)NTOK * 512 * 2;
constexpr size_t OFF_BA = OFF_QK + (size_t)NTOK * 256 * 2;
constexpr size_t OFF_GT = OFF_BA + (size_t)NTOK * 8 * 4;
constexpr size_t OFF_XS = OFF_GT + 4096;
constexpr size_t WS_NEED = OFF_XS + (size_t)2 * NTOK * 4 * 8;

constexpr int LDS_BYTES = 147456;
extern __shared__ __attribute__((aligned(16))) unsigned char dyn_lds[];

struct Params {
    const float* x; const float* w_in; const float* conv_w; const float* a_log; const float* dt_bias;
    const float* norm_w; const float* sinks; const float* w_out; const float* ln_g; const float* ln_b;
    float* out; unsigned char* ws;
};

typedef float f32x2_t __attribute__((ext_vector_type(2)));
typedef __bf16 bf16x2_t __attribute__((ext_vector_type(2)));
__device__ __forceinline__ unsigned cvt_pk_bf16(float lo, float hi) {
    const f32x2_t v = {lo, hi};
    const bf16x2_t r = __builtin_convertvector(v, bf16x2_t);
    return __builtin_bit_cast(unsigned, r);
}
__device__ __forceinline__ float bf_lo(unsigned u) { return __uint_as_float(u << 16); }
__device__ __forceinline__ float bf_hi(unsigned u) { return __uint_as_float(u & 0xffff0000u); }
__device__ __forceinline__ float silu_f(float x) { return x * __builtin_amdgcn_rcpf(1.0f + __expf(-x)); }
__device__ __forceinline__ f32x4 mfma16(bf16x8 a, bf16x8 b, f32x4 c) { return __builtin_amdgcn_mfma_f32_16x16x32_bf16(a, b, c, 0, 0, 0); }
#define GPC(T) (const __attribute__((address_space(1))) T*)
#define GP(T) (__attribute__((address_space(1))) T*)
__device__ __forceinline__ bf16x8 ldg8(const bf16_t* p) { return *GPC(bf16x8)(p); }
__device__ __forceinline__ bf16x8 lds8(const unsigned char* p) { return *reinterpret_cast<const bf16x8*>(p); }

__device__ __forceinline__ int opaque_tid_(int g_wave) {
    int lane; asm volatile("v_mbcnt_lo_u32_b32 %0, -1, 0\n\tv_mbcnt_hi_u32_b32 %0, -1, %0" : "=v"(lane));
    return g_wave * 64 + lane; }
#define opaque_tid() opaque_tid_(g_wave)
__device__ __forceinline__ unsigned char* opaque_ws(unsigned char* w) { asm volatile("" : "+s"(w)); return w; }
__device__ __forceinline__ const bf16_t* uniform_ptr(const bf16_t* p) {
    const unsigned long long v = (unsigned long long)p;
    const unsigned lo = __builtin_amdgcn_readfirstlane((unsigned)v), hi = __builtin_amdgcn_readfirstlane((unsigned)(v >> 32));
    return (const bf16_t*)(((unsigned long long)hi << 32) | lo);
}

__device__ __forceinline__ float shx(float v, int m, int lane) { return __int_as_float(__builtin_amdgcn_ds_bpermute((lane ^ m) << 2, __float_as_int(v))); }

__device__ __forceinline__ float row_sum16(float x) {
    x += __int_as_float(__builtin_amdgcn_update_dpp(0, __float_as_int(x), 0x128, 0xf, 0xf, false));
    x += __int_as_float(__builtin_amdgcn_update_dpp(0, __float_as_int(x), 0x124, 0xf, 0xf, false));
    x += __int_as_float(__builtin_amdgcn_update_dpp(0, __float_as_int(x), 0x122, 0xf, 0xf, false));
    x += __int_as_float(__builtin_amdgcn_update_dpp(0, __float_as_int(x), 0x121, 0xf, 0xf, false));
    return x;
}

#define XB_TMO      128
#define XB_XCNT(j)  (256  + 64 * (j))
#define XB_XSUB(j)  (1280 + 64 * (j))
#define XB_XGEN(j)  (2304 + 64 * (j))
#define XB_TOP      3328
#define XB_TOPGEN   3392
#define XCD_BAR_WORDS 3456
#define XB_SPIN_CAP (1u << 20)
__device__ __forceinline__ unsigned xb_ld(unsigned* p)              { return __hip_atomic_load(p, __ATOMIC_RELAXED, __HIP_MEMORY_SCOPE_AGENT); }
__device__ __forceinline__ unsigned xb_add(unsigned* p, unsigned v) { return __hip_atomic_fetch_add(p, v, __ATOMIC_RELAXED, __HIP_MEMORY_SCOPE_AGENT); }
__device__ __forceinline__ unsigned xb_xcc_id() { return (unsigned)__builtin_amdgcn_s_getreg((3 << 11) | 20) & 0xFu; }
#define XB_SPIN(cond, bar) do { unsigned _sp = 0; while (cond) { __builtin_amdgcn_s_sleep(1); \
    if ((++_sp & 255u) == 0u) { if (xb_ld(&(bar)[XB_TMO])) break; if (_sp > XB_SPIN_CAP) { atomicAdd(&(bar)[XB_TMO], 1u); break; } } } } while (0)
struct XcdBarrier { unsigned* bar; unsigned x; volatile LAS unsigned* st; int gw; };
__device__ __forceinline__ bool xb_t0(int gw) { return gw == 0 && opaque_lane() == 0; }
__device__ __forceinline__ XcdBarrier xcd_barrier_post(unsigned* bar, volatile LAS unsigned* st, int gw) {
    XcdBarrier b; b.bar = bar; b.x = xb_xcc_id(); b.st = st; b.gw = gw;
    if (xb_t0(gw)) (void)xb_add(&bar[XB_XCNT(b.x)], 1u);
    return b;
}
__device__ __forceinline__ void xcd_barrier_complete(unsigned* bar, unsigned x, unsigned& nloc, unsigned& nx) {
    const unsigned G = gridDim.x * gridDim.y * gridDim.z;
    unsigned sum, cnt, mine, sp = 0u;
    for (;;) {
        sum = 0u; cnt = 0u; mine = 0u;
#pragma unroll
        for (unsigned j = 0; j < 16; ++j) { const unsigned c = xb_ld(&bar[XB_XCNT(j)]); sum += c; cnt += (c > 0u) ? 1u : 0u; mine = (j == x) ? c : mine; }
        if (sum == G) break;
        __builtin_amdgcn_s_sleep(1);
        if ((++sp & 255u) == 0u) { if (xb_ld(&bar[XB_TMO])) break; if (sp > XB_SPIN_CAP) { atomicAdd(&bar[XB_TMO], 1u); break; } }
    }
    nloc = mine > 0u ? mine : 1u; nx = cnt > 0u ? cnt : 1u;
}
__device__ __forceinline__ void xcd_barrier(const XcdBarrier& b_) {
    asm volatile("s_waitcnt vmcnt(0)" ::: "memory");
    __syncthreads();
    if (xb_t0(b_.gw)) {
        XcdBarrier b = b_; b.x = xb_xcc_id();
        asm volatile("" : "+s"(b.x));
        unsigned* bar = b.bar;
        __builtin_amdgcn_s_waitcnt(0);
        unsigned nloc = b.st[0], nx = b.st[1];
        if (nloc == 0u) { xcd_barrier_complete(bar, b.x, nloc, nx); b.st[0] = nloc; b.st[1] = nx; }
        const unsigned old = xb_add(&bar[XB_XSUB(b.x)], 1u);
        const unsigned gen = old / nloc;
        if (old + 1u == (gen + 1u) * nloc) {
            __builtin_amdgcn_fence(__ATOMIC_RELEASE, "agent");
            asm volatile("s_waitcnt vmcnt(0)" ::: "memory");
            const unsigned og = xb_add(&bar[XB_TOP], 1u);
            const unsigned tg = og / nx;
            if (og + 1u == (tg + 1u) * nx) xb_add(&bar[XB_TOPGEN], 1u);
            else XB_SPIN(xb_ld(&bar[XB_TOPGEN]) == tg, bar);
            __builtin_amdgcn_fence(__ATOMIC_ACQUIRE, "agent");
            xb_add(&bar[XB_XGEN(b.x)], 1u);
            asm volatile("s_waitcnt vmcnt(0)" ::: "memory");
        } else {
            XB_SPIN(xb_ld(&bar[XB_XGEN(b.x)]) == gen, bar);
            __builtin_amdgcn_fence(__ATOMIC_ACQUIRE, "agent");
            asm volatile("s_waitcnt vmcnt(0)" ::: "memory");
        }
    }
    __syncthreads();
}


constexpr int BM = 256, BK = 64, HALF = 128, NXCD = 8, WGM = 8, HT = HALF * BK;
__device__ __forceinline__ int lds_byte(int r, int c) {
    int st = (r >> 4) * 2 + (c >> 5), rr = r & 15, cc = c & 31, ob = rr * 64 + cc * 2;
    return st * 1024 + (ob ^ (((ob >> 9) & 1) << 5));
}
__device__ __forceinline__ void stage_rc(int b, int& R, int& C) {
    int st = b / 1024, sb = b % 1024, swz = sb ^ (((sb >> 9) & 1) << 5);
    R = (st >> 1) * 16 + swz / 64; C = (st & 1) * 32 + (swz % 64) / 2;
}

struct EpiH {
    bf16_t* ha; bf16_t* hb;
    __device__ __forceinline__ void operator()(const f32x4 (&acc)[2][2][4][2], int brow, int bcol, int wr, int wc, int fr, int fq) const {
        bf16_t* base; int ld, c0;
        if (bcol < HA_LD) { base = ha; ld = HA_LD; c0 = bcol; } else { base = hb; ld = HB_LD; c0 = bcol - HA_LD; }
#pragma unroll
        for (int ai = 0; ai < 2; ++ai)
#pragma unroll
            for (int m = 0; m < 4; ++m) {
                const int row = brow + ai * HALF + wr * 64 + m * 16 + fr;
                bf16_t* rp = base + (size_t)row * ld + c0 + wc * 32 + fq * 8;
#pragma unroll
                for (int bj = 0; bj < 2; ++bj) {
                    const f32x4 v0 = acc[ai][bj][m][0], v1 = acc[ai][bj][m][1];
                    u32x4 w; w.x = cvt_pk_bf16(v0[0], v0[1]); w.y = cvt_pk_bf16(v0[2], v0[3]); w.z = cvt_pk_bf16(v1[0], v1[1]); w.w = cvt_pk_bf16(v1[2], v1[3]);
                    *GP(u32x4)(rp + bj * HALF) = w;
                }
            }
    }
};
struct EpiZ {
    const float* xres; float* out;
    __device__ __forceinline__ void operator()(const f32x4 (&acc)[2][2][4][2], int brow, int bcol, int wr, int wc, int fr, int fq) const {
#pragma unroll
        for (int ai = 0; ai < 2; ++ai)
#pragma unroll
            for (int m = 0; m < 4; ++m) {
                const int row = brow + ai * HALF + wr * 64 + m * 16 + fr;
                const size_t ro = (size_t)row * DM + bcol + wc * 32 + fq * 4;
#pragma unroll
                for (int bj = 0; bj < 2; ++bj)
#pragma unroll
                    for (int n = 0; n < 2; ++n) {
                        const size_t o = ro + bj * HALF + n * 16;
                        const f32x4 r = *GPC(f32x4)(xres + o);
                        *GP(f32x4)(out + o) = r * DN_ALPHA + acc[ai][bj][m][n];
                    }
            }
    }
};


struct EpiLN {
    const float* xres; float* out; bf16_t* xb; const float* g; const float* b; const float* wg; float* BA; float* xbuf; unsigned* cnt; unsigned* tmo; int gw;
    __device__ __forceinline__ void operator()(f32x4 (&acc)[2][2][4][2], int brow, int bcol, int, int, int, int) const {
        const int tid = opaque_tid_(gw), lane = tid & 63, wr = tid >> 8, wc = (tid >> 6) & 3, fr = lane & 15, fq = lane >> 4, pm = brow >> 8, pn = bcol >> 8;
        f32x2_t* P = reinterpret_cast<f32x2_t*>(dyn_lds);
        f32x2_t* STATS = reinterpret_cast<f32x2_t*>(dyn_lds + 8192);
        float* WG = reinterpret_cast<float*>(dyn_lds + 10240);
        float* GP4 = reinterpret_cast<float*>(dyn_lds + 18432);
        if (wg) {
            for (int c = tid; c < 256; c += 512) {
                const float* wp = wg + (size_t)(bcol + c) * INC;
                *reinterpret_cast<f32x4*>(WG + c * 8) = *GPC(f32x4)(wp); *reinterpret_cast<f32x4*>(WG + c * 8 + 4) = *GPC(f32x4)(wp + 4);
            }
        }
#pragma unroll
        for (int ai = 0; ai < 2; ++ai)
#pragma unroll
            for (int m = 0; m < 4; ++m) {
                __builtin_amdgcn_sched_barrier(0);
                const int rl = ai * HALF + wr * 64 + m * 16 + fr;
                const size_t ro = (size_t)(brow + rl) * DM + bcol + wc * 32 + fq * 4;
                float s1 = 0.f, s2 = 0.f;
#pragma unroll
                for (int bj = 0; bj < 2; ++bj)
#pragma unroll
                    for (int n = 0; n < 2; ++n) {
                        const f32x4 r = *GPC(f32x4)(xres + ro + bj * HALF + n * 16);
                        const f32x4 v = r * DN_ALPHA + acc[ai][bj][m][n];
                        acc[ai][bj][m][n] = v;
                        s1 += (v[0] + v[1]) + (v[2] + v[3]);
                        s2 += (v[0] * v[0] + v[1] * v[1]) + (v[2] * v[2] + v[3] * v[3]);
                    }
                s1 += shx(s1, 16, lane); s1 += shx(s1, 32, lane);
                s2 += shx(s2, 16, lane); s2 += shx(s2, 32, lane);
                if (fq == 0) P[rl * 4 + wc] = (f32x2_t){s1, s2};
            }
        __syncthreads();
        if (tid < 256) {
            const f32x2_t a = P[tid * 4 + 0], b2 = P[tid * 4 + 1], c = P[tid * 4 + 2], d = P[tid * 4 + 3];
            *GP(f32x2_t)(xbuf + ((size_t)(brow + tid) * 4 + pn) * 2) = (f32x2_t){(a.x + b2.x) + (c.x + d.x), (a.y + b2.y) + (c.y + d.y)};
        }
        asm volatile("s_waitcnt vmcnt(0)" ::: "memory");
        __syncthreads();
        if (tid == 0) {
            __threadfence();
            xb_add(cnt + pm, 1u);
            unsigned sp = 0;
            while (xb_ld(cnt + pm) < 4u) { __builtin_amdgcn_s_sleep(1); if (++sp > (1u << 22)) { atomicAdd(tmo, 1u); break; } }
            __threadfence();
        }
        __syncthreads();
        if (tid < 256) {
            float S1 = 0.f, S2 = 0.f;
#pragma unroll
            for (int t = 0; t < 4; ++t) {
                const f32x2_t v = *GPC(f32x2_t)(xbuf + ((size_t)(brow + tid) * 4 + t) * 2);
                S1 += v.x; S2 += v.y;
            }
            const float mean = S1 * (1.0f / DM);
            const float var = fmaxf(S2 * (1.0f / DM) - mean * mean, 0.f);
            STATS[tid] = (f32x2_t){mean, rsqrtf(var + 1e-5f)};
        }
        __syncthreads();
#pragma unroll
        for (int ai = 0; ai < 2; ++ai)
#pragma unroll
            for (int m = 0; m < 4; ++m) {
                __builtin_amdgcn_sched_barrier(0);
                const int rl = ai * HALF + wr * 64 + m * 16 + fr;
                const f32x2_t st = STATS[rl];
                const size_t ro = (size_t)(brow + rl) * DM + bcol + wc * 32 + fq * 4;
                float d[8] = {0.f, 0.f, 0.f, 0.f, 0.f, 0.f, 0.f, 0.f};
#pragma unroll
                for (int bj = 0; bj < 2; ++bj)
#pragma unroll
                    for (int n = 0; n < 2; ++n) {
                        const int cl = bj * HALF + wc * 32 + n * 16 + fq * 4;
                        const f32x4 gg = *GPC(f32x4)(g + bcol + cl), bb = *GPC(f32x4)(b + bcol + cl);
                        const f32x4 v = (acc[ai][bj][m][n] - st.x) * st.y * gg + bb;
                        *GP(f32x4)(out + ro + bj * HALF + n * 16) = v;
                        if (xb) { u32x2 w; w.x = cvt_pk_bf16(v[0], v[1]); w.y = cvt_pk_bf16(v[2], v[3]); *GP(u32x2)(xb + ro + bj * HALF + n * 16) = w; }
                        if (wg) {
#pragma unroll
                            for (int j = 0; j < 4; ++j) {
                                const f32x4 w0 = *reinterpret_cast<const f32x4*>(WG + (cl + j) * 8), w1 = *reinterpret_cast<const f32x4*>(WG + (cl + j) * 8 + 4);
                                d[0] += v[j] * w0[0]; d[1] += v[j] * w0[1]; d[2] += v[j] * w0[2]; d[3] += v[j] * w0[3];
                                d[4] += v[j] * w1[0]; d[5] += v[j] * w1[1]; d[6] += v[j] * w1[2]; d[7] += v[j] * w1[3];
                            }
                        }
                    }
                if (wg) {
#pragma unroll
                    for (int k = 0; k < 8; ++k) { d[k] += shx(d[k], 16, lane); d[k] += shx(d[k], 32, lane); }
                    if (fq == 0) {
                        *reinterpret_cast<f32x4*>(GP4 + (rl * 4 + wc) * 8) = (f32x4){d[0], d[1], d[2], d[3]};
                        *reinterpret_cast<f32x4*>(GP4 + (rl * 4 + wc) * 8 + 4) = (f32x4){d[4], d[5], d[6], d[7]};
                    }
                }
            }
        if (wg) {
            __syncthreads();
            for (int i = tid; i < 2048; i += 512) {
                const int rl = i >> 3, k = i & 7;
                const float sgate = (GP4[(rl * 4 + 0) * 8 + k] + GP4[(rl * 4 + 1) * 8 + k]) + (GP4[(rl * 4 + 2) * 8 + k] + GP4[(rl * 4 + 3) * 8 + k]);
                unsafeAtomicAdd(BA + (size_t)(brow + rl) * 8 + k, sgate);
            }
        }
    }
};

template <class Epi>
__device__ __forceinline__ void gemm_phase(const bf16_t* __restrict__ A, const bf16_t* __restrict__ Bt, int M, int N, int K, const Epi& epi, int g_wave) {
    bf16_t* shm = reinterpret_cast<bf16_t*>(dyn_lds);
#define SA(b,h) (shm+((b)*2+(h))*HT)
#define SB(b,h) (shm+(4+(b)*2+(h))*HT)
#define STAGE(P,BASE,br,kt) do{const bf16_t* _bp=uniform_ptr((BASE)+((long)(br)*K+(long)(kt)*BK)); \
    __builtin_amdgcn_global_load_lds((const unsigned*)((const char*)_bp+soff0),(unsigned*)((char*)(P)+tidx*16),16,0,0); \
    __builtin_amdgcn_global_load_lds((const unsigned*)((const char*)_bp+soff1),(unsigned*)((char*)(P)+tidx*16+8192),16,0,0);}while(0)
#define LDA(dst,b,h) for(int m=0;m<4;++m)for(int k=0;k<2;++k) \
    dst[m][k]=*reinterpret_cast<const bf16x8*>((char*)SA(b,h)+lds_byte(wr*64+m*16+fr,k*32+fq*8))
#define LDB(dst,b,h) for(int n=0;n<2;++n)for(int k=0;k<2;++k) \
    dst[n][k]=*reinterpret_cast<const bf16x8*>((char*)SB(b,h)+lds_byte(wc*32+n*16+fr,k*32+fq*8))
#define MMA(ai,bj,At,Bt_) do{__builtin_amdgcn_s_setprio(1); \
    for(int m=0;m<4;++m)for(int n=0;n<2;++n)for(int k=0;k<2;++k) \
      acc[ai][bj][m][n]=__builtin_amdgcn_mfma_f32_16x16x32_bf16(Bt_[n][k],At[m][k],acc[ai][bj][m][n],0,0,0); \
    __builtin_amdgcn_s_setprio(0);}while(0)
#define WAIT_V(n) asm volatile("s_waitcnt vmcnt(" #n ")":::"memory")
#define WAIT_L(n) asm volatile("s_waitcnt lgkmcnt(" #n ")":::"memory")
#define BAR __builtin_amdgcn_s_barrier()
#define SCHED __builtin_amdgcn_sched_barrier(0)
    const int nM = M / BM, nN = N / BM, nwg = nM * nN;
    const int tidx = opaque_tid();
    const int wid = tidx >> 6, lane = tidx & 63, wr = wid >> 2, wc = wid & 3, fr = lane & 15, fq = lane >> 4;
    const int nt = K / BK;
    unsigned soff0, soff1;
    { int r_, c_; stage_rc(tidx * 16, r_, c_); soff0 = (unsigned)(r_ * K + c_) * 2u; stage_rc(tidx * 16 + 8192, r_, c_); soff1 = (unsigned)(r_ * K + c_) * 2u; }
    for (int L = blockIdx.x; L < nwg; L += gridDim.x) {
        int wgid = L;
        { int q = nwg / NXCD, r = nwg % NXCD, xcd = wgid % NXCD, off = wgid / NXCD; wgid = (xcd < r ? xcd * (q + 1) : r * (q + 1) + (xcd - r) * q) + off; }
        const int nig = WGM * nN, gid = wgid / nig, fm = gid * WGM, gsz = min(nM - fm, WGM);
        const int pm = fm + ((wgid % nig) % gsz), pn = (wgid % nig) / gsz, brow = pm * BM, bcol = pn * BM;
        f32x4 acc[2][2][4][2] = {};
        bf16x8 At[4][2], B0[2][2], B1[2][2];
        STAGE(SB(0,0),Bt,bcol,0); STAGE(SA(0,0),A,brow,0);
        STAGE(SB(0,1),Bt,bcol+HALF,0); STAGE(SA(0,1),A,brow+HALF,0);
        if(wr==1)BAR;
        WAIT_V(4); BAR;
        STAGE(SB(1,0),Bt,bcol,1); STAGE(SA(1,0),A,brow,1); STAGE(SB(1,1),Bt,bcol+HALF,1);
        WAIT_V(6); BAR;
        for(int t=0;t<nt-2;t+=2){
            LDB(B0,0,0); SCHED; LDA(At,0,0); STAGE(SA(1,1),A,brow+HALF,t+1);
            WAIT_L(8); BAR; WAIT_L(0); MMA(0,0,At,B0); BAR; SCHED;
            LDB(B1,0,1); STAGE(SB(0,0),Bt,bcol,t+2);
            BAR; WAIT_L(0); MMA(0,1,At,B1); BAR;
            LDA(At,0,1); STAGE(SA(0,0),A,brow,t+2);
            BAR; WAIT_L(0); MMA(1,0,At,B0); BAR; SCHED;
            STAGE(SB(0,1),Bt,bcol+HALF,t+2);
            WAIT_V(6); BAR; MMA(1,1,At,B1); BAR;
            LDB(B0,1,0); SCHED; LDA(At,1,0); STAGE(SA(0,1),A,brow+HALF,t+2);
            WAIT_L(8); BAR; WAIT_L(0); MMA(0,0,At,B0); BAR; SCHED;
            LDB(B1,1,1); STAGE(SB(1,0),Bt,bcol,t+3);
            BAR; WAIT_L(0); MMA(0,1,At,B1); BAR;
            LDA(At,1,1); STAGE(SA(1,0),A,brow,t+3);
            BAR; WAIT_L(0); MMA(1,0,At,B0); BAR; SCHED;
            STAGE(SB(1,1),Bt,bcol+HALF,t+3);
            WAIT_V(6); BAR; MMA(1,1,At,B1); BAR;
        }
        { LDB(B0,0,0); LDA(At,0,0); STAGE(SA(1,1),A,brow+HALF,nt-1);
          BAR; WAIT_L(0); MMA(0,0,At,B0); BAR;
          LDB(B1,0,1); BAR; WAIT_L(0); MMA(0,1,At,B1); BAR;
          LDA(At,0,1); WAIT_V(4); BAR; WAIT_L(0); MMA(1,0,At,B0); MMA(1,1,At,B1); BAR; }
        { LDB(B0,1,0); LDA(At,1,0); WAIT_V(2); BAR; WAIT_L(0); MMA(0,0,At,B0); BAR;
          LDB(B1,1,1); WAIT_V(0); BAR; WAIT_L(0); MMA(0,1,At,B1); BAR;
          LDA(At,1,1); BAR; WAIT_L(0); MMA(1,0,At,B0); MMA(1,1,At,B1); BAR; }
        if(wr==0)BAR;
        epi(acc, brow, bcol, wr, wc, fr, fq);
        __syncthreads();
    }
#undef SA
#undef SB
#undef STAGE
#undef LDA
#undef LDB
#undef MMA
}

__device__ __forceinline__ void prep_weights(const Params& p, int part, int vblk, int nvblk, int g_wave) {
    bf16_t* win = reinterpret_cast<bf16_t*>(p.ws + OFF_WIN);
    bf16_t* wout = reinterpret_cast<bf16_t*>(p.ws + OFF_WOUT);
    const int gtid = vblk * 512 + opaque_tid(), gsz = nvblk * 512;
    const int n_in = 128 * NIN;
    for (int i = gtid; i < n_in; i += gsz) {
        const int n = i % NIN, kg = i / NIN, l = part;
        const int rho = n & 31, ncol = (n & ~31) + 8 * ((rho & 15) >> 2) + 4 * (rho >> 4) + (rho & 3);
        const int sc = ncol < 2048 ? ncol : ncol + 8;
        const float* s = p.w_in + (size_t)l * DM * INC + (size_t)(kg * 8) * INC + sc;
        u32x4 w;
        w.x = cvt_pk_bf16(s[0], s[INC]); w.y = cvt_pk_bf16(s[2 * INC], s[3 * INC]);
        w.z = cvt_pk_bf16(s[4 * INC], s[5 * INC]); w.w = cvt_pk_bf16(s[6 * INC], s[7 * INC]);
        *GP(u32x4)(win + ((size_t)l * NIN + n) * DM + kg * 8) = w;
    }
    if (part == 1) {
        const int n_out = 2 * 128 * DM;
        for (int i = gtid; i < n_out; i += gsz) {
            const int n = i % DM, kg = (i / DM) % 128, l = i / (DM * 128);
            const float* s = p.w_out + (size_t)l * DM * DM + (size_t)(kg * 8) * DM + n;
            u32x4 w;
            w.x = cvt_pk_bf16(s[0], s[DM]); w.y = cvt_pk_bf16(s[2 * DM], s[3 * DM]);
            w.z = cvt_pk_bf16(s[4 * DM], s[5 * DM]); w.w = cvt_pk_bf16(s[6 * DM], s[7 * DM]);
            *GP(u32x4)(wout + ((size_t)l * DM + n) * DM + kg * 8) = w;
        }
    }
}

__device__ __forceinline__ void row_pass(const float* src, bool ln, const float* g, const float* bta, float* dstf, bf16_t* xb, const float* wg  , float* BA, int g_wave) {
    const int tidx = opaque_tid();
    const int lane = tidx & 63;
    const int gw = blockIdx.x * 8 + (tidx >> 6), nw = gridDim.x * 8;
    float* wgs = reinterpret_cast<float*>(dyn_lds);
    if (wg) {
        for (int c = tidx; c < DM; c += 512) {
            const f32x4 w0 = *GPC(f32x4)(wg + (size_t)c * INC), w1 = *GPC(f32x4)(wg + (size_t)c * INC + 4);
            *reinterpret_cast<f32x4*>(wgs + c * 8) = w0; *reinterpret_cast<f32x4*>(wgs + c * 8 + 4) = w1;
        }
    }
    __syncthreads();
    f32x4 gg[4], bb[4];
#pragma unroll
    for (int i = 0; i < 4; ++i) { gg[i] = ln ? *GPC(f32x4)(g + i * 256 + lane * 4) : (f32x4){1.f, 1.f, 1.f, 1.f}; bb[i] = ln ? *GPC(f32x4)(bta + i * 256 + lane * 4) : (f32x4){0.f, 0.f, 0.f, 0.f}; }
    f32x4 nv[4];
    if (gw < NTOK) {
#pragma unroll
        for (int i = 0; i < 4; ++i) nv[i] = *GPC(f32x4)(src + (size_t)gw * DM + i * 256 + lane * 4);
    }
    for (int row = gw; row < NTOK; row += nw) {
        f32x4 v[4];
#pragma unroll
        for (int i = 0; i < 4; ++i) v[i] = nv[i];
        if (row + nw < NTOK) {
#pragma unroll
            for (int i = 0; i < 4; ++i) nv[i] = *GPC(f32x4)(src + (size_t)(row + nw) * DM + i * 256 + lane * 4);
        }
        if (ln) {
            float s = 0.f;
#pragma unroll
            for (int i = 0; i < 4; ++i) s += (v[i][0] + v[i][1]) + (v[i][2] + v[i][3]);
#pragma unroll
            for (int o = 32; o > 0; o >>= 1) s += shx(s, o, lane);
            const float mu = s * (1.0f / DM);
            float q = 0.f;
#pragma unroll
            for (int i = 0; i < 4; ++i) { v[i] = v[i] - mu; q += (v[i][0] * v[i][0] + v[i][1] * v[i][1]) + (v[i][2] * v[i][2] + v[i][3] * v[i][3]); }
#pragma unroll
            for (int o = 32; o > 0; o >>= 1) q += shx(q, o, lane);
            const float rstd = rsqrtf(q * (1.0f / DM) + 1e-5f);
#pragma unroll
            for (int i = 0; i < 4; ++i) v[i] = v[i] * rstd * gg[i] + bb[i];
        }
        if (dstf) {
#pragma unroll
            for (int i = 0; i < 4; ++i) *GP(f32x4)(dstf + (size_t)row * DM + i * 256 + lane * 4) = v[i];
        }
        if (xb) {
#pragma unroll
            for (int i = 0; i < 4; ++i) { u32x2 w; w.x = cvt_pk_bf16(v[i][0], v[i][1]); w.y = cvt_pk_bf16(v[i][2], v[i][3]);
                *GP(u32x2)(xb + (size_t)row * DM + i * 256 + lane * 4) = w; }
        }
        if (wg) {
            float d[8] = {0.f, 0.f, 0.f, 0.f, 0.f, 0.f, 0.f, 0.f};
#pragma unroll
            for (int i = 0; i < 4; ++i)
#pragma unroll
                for (int e = 0; e < 4; ++e) {
                    const float* wp = wgs + (i * 256 + lane * 4 + e) * 8;
                    const f32x4 w0 = *reinterpret_cast<const f32x4*>(wp), w1 = *reinterpret_cast<const f32x4*>(wp + 4);
                    const float xv = v[i][e];
                    d[0] += xv * w0[0]; d[1] += xv * w0[1]; d[2] += xv * w0[2]; d[3] += xv * w0[3];
                    d[4] += xv * w1[0]; d[5] += xv * w1[1]; d[6] += xv * w1[2]; d[7] += xv * w1[3];
                }
#pragma unroll
            for (int j = 0; j < 8; ++j) {
#pragma unroll
                for (int o = 32; o > 0; o >>= 1) d[j] += shx(d[j], o, lane);
            }
            if (lane == 0) {
                *GP(f32x4)(BA + (size_t)row * 8) = (f32x4){d[0], d[1], d[2], d[3]};
                *GP(f32x4)(BA + (size_t)row * 8 + 4) = (f32x4){d[4], d[5], d[6], d[7]};
            }
        }
    }
    __syncthreads();
}

constexpr int GRP_LDS = 73728;
constexpr int L_KRM = 0, L_QRM = 17408, L_KBGT = 34816, L_VBT = 53248, L_GC = 71680, L_BETA = 71936;
__device__ __forceinline__ void chunk_prep(const Params& p_, int l, int g_wave) {
    Params p = p_; p.ws = opaque_ws(p.ws);
    const bf16_t* HA = reinterpret_cast<const bf16_t*>(p.ws + OFF_HA);
    const float* BA = reinterpret_cast<const float*>(p.ws + OFF_BA);
    bf16_t* UT = reinterpret_cast<bf16_t*>(p.ws + OFF_UT);
    bf16_t* W = reinterpret_cast<bf16_t*>(p.ws + OFF_W);
    bf16_t* QD = reinterpret_cast<bf16_t*>(p.ws + OFF_QD);
    bf16_t* KDT = reinterpret_cast<bf16_t*>(p.ws + OFF_KDT);
    bf16_t* QK = reinterpret_cast<bf16_t*>(p.ws + OFF_QK);
    float* GT = reinterpret_cast<float*>(p.ws + OFF_GT);
    const float* cw = p.conv_w + (size_t)l * 4 * 1536;
#define CP_LANEVARS const int tid = opaque_tid(), grp = tid >> 8, gt = tid & 255, lane = tid & 63, wv = gt >> 6, fr = lane & 15, fq = lane >> 4; \
    unsigned char* lds = dyn_lds + grp * GRP_LDS; float* gc_s = reinterpret_cast<float*>(lds + L_GC); float* beta_s = reinterpret_cast<float*>(lds + L_BETA); \
    const int tg = gt >> 4, sg = gt & 15, t0 = tg * 4, c0 = sg * 8; (void)fr; (void)fq; (void)wv; (void)t0; (void)c0; (void)gc_s; (void)beta_s; (void)lane;
    for (int pi = blockIdx.x; pi < 512; pi += gridDim.x) {
        const int grp0 = opaque_tid() >> 8;
        const int hp = pi & 1, n = (pi >> 1) & 63, b = pi >> 7, h = hp * 2 + grp0;
        const int item = (b * 4 + h) * 64 + n, tok0 = b * SEQ + n * 64;
        u32x4 rawp[3][7];
        { CP_LANEVARS
#pragma unroll
          for (int ten = 0; ten < 3; ++ten)
#pragma unroll
            for (int r = 0; r < 7; ++r) {
                const int tt = n * 64 + t0 - 3 + r;
                rawp[ten][r] = mk4(0u, 0u, 0u, 0u);
                if (tt >= 0) rawp[ten][r] = *GPC(u32x4)(HA + (size_t)(b * SEQ + tt) * HA_LD + ten * 512 + h * 128 + c0);
            } }
        { CP_LANEVARS
        if (wv == 0) {
            const float bv = *GPC(float)(BA + (size_t)(tok0 + lane) * 8 + h), av = *GPC(float)(BA + (size_t)(tok0 + lane) * 8 + 4 + h);
            const float beta = __builtin_amdgcn_rcpf(1.0f + __expf(-bv));
            const float xx = av + p.dt_bias[l * 4 + h];
            const float sp = fmaxf(xx, 0.f) + log1pf(__expf(-fabsf(xx)));
            float gv = -__expf(p.a_log[l * 4 + h]) * sp;
#pragma unroll
            for (int o = 1; o < 64; o <<= 1) { const float t = __int_as_float(__builtin_amdgcn_ds_bpermute((lane - o) << 2, __float_as_int(gv))); if (lane >= o) gv += t; }
            gc_s[lane] = gv; beta_s[lane] = beta;
            if (lane == 63) *GP(float)(GT + item) = __expf(gv);
        } }
        __syncthreads();
        {
            CP_LANEVARS
            const float glast = gc_s[63];
            float eg[4], ek[4], be[4];
#pragma unroll
            for (int i = 0; i < 4; ++i) { const float gci = gc_s[t0 + i]; eg[i] = __expf(gci); ek[i] = __expf(glast - gci); be[i] = beta_s[t0 + i]; }
#pragma unroll
            for (int ten = 0; ten < 3; ++ten) {
                __builtin_amdgcn_sched_barrier(0);
                float raw[7][8];
#pragma unroll
                for (int r = 0; r < 7; ++r) {
                    const u32x4 u = rawp[ten][r];
                    raw[r][0] = bf_lo(u.x); raw[r][1] = bf_hi(u.x); raw[r][2] = bf_lo(u.y); raw[r][3] = bf_hi(u.y);
                    raw[r][4] = bf_lo(u.z); raw[r][5] = bf_hi(u.z); raw[r][6] = bf_lo(u.w); raw[r][7] = bf_hi(u.w);
                }
                float o[4][8];
#pragma unroll
                for (int i = 0; i < 4; ++i)
#pragma unroll
                    for (int c = 0; c < 8; ++c) o[i][c] = 0.f;
#pragma unroll
                for (int j = 0; j < 4; ++j) {
                    const float* wp = cw + (size_t)j * 1536 + ten * 512 + h * 128 + c0;
                    const f32x4 a = *GPC(f32x4)(wp), c4 = *GPC(f32x4)(wp + 4);
                    const float wj[8] = {a[0], a[1], a[2], a[3], c4[0], c4[1], c4[2], c4[3]};
#pragma unroll
                    for (int i = 0; i < 4; ++i)
#pragma unroll
                        for (int c = 0; c < 8; ++c) o[i][c] += wj[c] * raw[i + j][c];
                }
#pragma unroll
                for (int i = 0; i < 4; ++i)
#pragma unroll
                    for (int c = 0; c < 8; ++c) o[i][c] = silu_f(o[i][c]);
                if (ten < 2) {
#pragma unroll
                    for (int i = 0; i < 4; ++i) {
                        float sq = 0.f;
#pragma unroll
                        for (int c = 0; c < 8; ++c) sq += o[i][c] * o[i][c];
                        sq = row_sum16(sq);
                        const float rq = rsqrtf(sq + 1e-6f) * (ten == 0 ? 0.08838834764831845f : 1.0f);
#pragma unroll
                        for (int c = 0; c < 8; ++c) o[i][c] *= rq;
                    }
                }
                if (ten == 0) {
#pragma unroll
                    for (int i = 0; i < 4; ++i) {
                        u32x4 w;
                        w.x = cvt_pk_bf16(o[i][0] * eg[i], o[i][1] * eg[i]); w.y = cvt_pk_bf16(o[i][2] * eg[i], o[i][3] * eg[i]);
                        w.z = cvt_pk_bf16(o[i][4] * eg[i], o[i][5] * eg[i]); w.w = cvt_pk_bf16(o[i][6] * eg[i], o[i][7] * eg[i]);
                        { const int t_ = t0 + i; *GP(u32x4)(QD + ((((size_t)item * 4 + (t_ >> 4)) * 4 + (sg >> 2)) * 64 + (t_ & 15) + 16 * (sg & 3)) * 8) = w; }
                        w.x = cvt_pk_bf16(o[i][0], o[i][1]); w.y = cvt_pk_bf16(o[i][2], o[i][3]); w.z = cvt_pk_bf16(o[i][4], o[i][5]); w.w = cvt_pk_bf16(o[i][6], o[i][7]);
                        *reinterpret_cast<u32x4*>(lds + L_QRM + ((t0 + i) * 136 + c0) * 2) = w;
                    }
                } else if (ten == 1) {
#pragma unroll
                    for (int i = 0; i < 4; ++i) {
                        u32x4 w;
                        w.x = cvt_pk_bf16(o[i][0], o[i][1]); w.y = cvt_pk_bf16(o[i][2], o[i][3]); w.z = cvt_pk_bf16(o[i][4], o[i][5]); w.w = cvt_pk_bf16(o[i][6], o[i][7]);
                        *reinterpret_cast<u32x4*>(lds + L_KRM + ((t0 + i) * 136 + c0) * 2) = w;
                    }
#pragma unroll
                    for (int c = 0; c < 8; ++c) {
                        u32x2 w;
                        w.x = cvt_pk_bf16(o[0][c] * ek[0], o[1][c] * ek[1]); w.y = cvt_pk_bf16(o[2][c] * ek[2], o[3][c] * ek[3]);
                        { const int dk_ = c0 + c; *GP(u32x2)(KDT + ((((size_t)item * 8 + (dk_ >> 4)) * 2 + (t0 >> 5)) * 64 + (dk_ & 15) + 16 * ((t0 & 31) >> 3)) * 8 + ((t0 & 7) >> 2) * 4) = w; }
                        w.x = cvt_pk_bf16(o[0][c] * be[0] * eg[0], o[1][c] * be[1] * eg[1]); w.y = cvt_pk_bf16(o[2][c] * be[2] * eg[2], o[3][c] * be[3] * eg[3]);
                        *reinterpret_cast<u32x2*>(lds + L_KBGT + ((c0 + c) * 72 + t0) * 2) = w;
                    }
                } else {
#pragma unroll
                    for (int c = 0; c < 8; ++c) {
                        u32x2 w;
                        w.x = cvt_pk_bf16(o[0][c] * be[0], o[1][c] * be[1]); w.y = cvt_pk_bf16(o[2][c] * be[2], o[3][c] * be[3]);
                        *reinterpret_cast<u32x2*>(lds + L_VBT + ((c0 + c) * 72 + t0) * 2) = w;
                    }
                }
            }
        }
        __syncthreads();
        {
            CP_LANEVARS
            const int ib = wv;
            f32x4 kk[4], qk[4];
#pragma unroll
            for (int jb = 0; jb < 4; ++jb) { kk[jb] = (f32x4){0.f, 0.f, 0.f, 0.f}; qk[jb] = (f32x4){0.f, 0.f, 0.f, 0.f}; }
            bf16x8 ki[4], qi[4];
#pragma unroll
            for (int ks = 0; ks < 4; ++ks) {
                ki[ks] = lds8(lds + L_KRM + ((ib * 16 + fr) * 136 + ks * 32 + fq * 8) * 2);
                qi[ks] = lds8(lds + L_QRM + ((ib * 16 + fr) * 136 + ks * 32 + fq * 8) * 2);
            }
#pragma unroll
            for (int jb = 0; jb < 4; ++jb) {
                if (jb <= ib) {
#pragma unroll
                    for (int ks = 0; ks < 4; ++ks) {
                        const bf16x8 kj = lds8(lds + L_KRM + ((jb * 16 + fr) * 136 + ks * 32 + fq * 8) * 2);
                        kk[jb] = mfma16(ki[ks], kj, kk[jb]);
                        qk[jb] = mfma16(kj, qi[ks], qk[jb]);
                    }
                }
            }
            __syncthreads();
            float* AP = reinterpret_cast<float*>(lds + L_KRM);
#pragma unroll
            for (int jb = 0; jb < 4; ++jb) {
                if (jb <= ib) {
                    const int j = jb * 16 + fr, i0 = ib * 16 + fq * 4;
                    const float gj = gc_s[j];
#pragma unroll
                    for (int r = 0; r < 4; ++r) {
                        const int i = i0 + r;
                        const float dec = __expf(fminf(gc_s[i] - gj, 0.f));
                        float av_ = (i > j) ? kk[jb][r] * beta_s[i] * dec : 0.f;
                        AP[j * 64 + r * 16 + ib * 4 + fq] = av_;
                    }
                }
                {
                    const int i = ib * 16 + fr, j0 = jb * 16 + fq * 4;
                    const float gi = gc_s[i];
                    float o[4];
#pragma unroll
                    for (int r = 0; r < 4; ++r) {
                        const int j = j0 + r;
                        const float dec = __expf(fminf(gi - gc_s[j], 0.f));
                        o[r] = (i >= j) ? qk[jb][r] * dec : 0.f;
                    }
                    u32x2 w; w.x = cvt_pk_bf16(o[0], o[1]); w.y = cvt_pk_bf16(o[2], o[3]);
                    *GP(u32x2)(QK + ((((size_t)item * 4 + ib) * 2 + (jb >> 1)) * 64 + fr + 16 * ((jb & 1) * 2 + (fq >> 1))) * 8 + (fq & 1) * 4) = w;
                }
            }
        }
        __syncthreads();
        {
            CP_LANEVARS
            const float* AP = reinterpret_cast<const float*>(lds + L_KRM);
            const int cbk = grp ? 3 - wv : wv;
            const int cl = lane >> 2, pp = lane & 3, ccol = cbk * 16 + cl;
            float a[16];
#pragma unroll
            for (int k = 0; k < 16; ++k) a[k] = (4 * k + pp == ccol) ? 1.f : 0.f;
#define INV_STEP(SS) { const int j = jq * 4 + SS; \
                    const float tj = __int_as_float(__builtin_amdgcn_update_dpp(0, __float_as_int(a[jq]), SS * 0x55, 0xf, 0xf, false)); \
                    const float* ap = AP + j * 64 + pp * 16; \
                    _Pragma("unroll") for (int k = jq; k < 16; ++k) a[k] -= ap[k] * tj; }
#pragma unroll
            for (int jq = 0; jq < 16; ++jq) {
                __builtin_amdgcn_sched_barrier(0);
                if (jq >= cbk * 4) {
                    INV_STEP(0) INV_STEP(1) INV_STEP(2)
                    if (jq < 15) INV_STEP(3)
                }
            }
#undef INV_STEP
            bf16_t* TR = reinterpret_cast<bf16_t*>(lds + L_QRM);
#pragma unroll
            for (int k = 0; k < 16; ++k) TR[(4 * k + pp) * 72 + ccol] = (bf16_t)(cvt_pk_bf16(a[k], 0.f) & 0xffffu);
        }
        __syncthreads();
        {
            CP_LANEVARS
            bf16x8 tf[2];
#pragma unroll
            for (int ks = 0; ks < 2; ++ks) tf[ks] = lds8(lds + L_QRM + ((wv * 16 + fr) * 72 + ks * 32 + fq * 8) * 2);
#pragma unroll
            for (int db = 0; db < 8; ++db) {
                f32x4 au = (f32x4){0.f, 0.f, 0.f, 0.f}, aw = (f32x4){0.f, 0.f, 0.f, 0.f};
#pragma unroll
                for (int ks = 0; ks < 2; ++ks) {
                    const bf16x8 vb = lds8(lds + L_VBT + ((db * 16 + fr) * 72 + ks * 32 + fq * 8) * 2);
                    const bf16x8 kb = lds8(lds + L_KBGT + ((db * 16 + fr) * 72 + ks * 32 + fq * 8) * 2);
                    au = mfma16(tf[ks], vb, au);
                    aw = mfma16(kb, tf[ks], aw);
                }
                u32x2 w; w.x = cvt_pk_bf16(au[0], au[1]); w.y = cvt_pk_bf16(au[2], au[3]);
                *GP(u32x2)(UT + ((((size_t)item * 8 + db) * 2 + (wv >> 1)) * 64 + fr + 16 * ((wv & 1) * 2 + (fq >> 1))) * 8 + (fq & 1) * 4) = w;
                w.x = cvt_pk_bf16(aw[0], aw[1]); w.y = cvt_pk_bf16(aw[2], aw[3]);
                *GP(u32x2)(W + ((((size_t)item * 4 + wv) * 4 + (db >> 1)) * 64 + fr + 16 * ((db & 1) * 2 + (fq >> 1))) * 8 + (fq & 1) * 4) = w;
            }
        }
        __syncthreads();
    }
}

__device__ __forceinline__ void delta_scan(const Params& p_, int blk, int g_wave) {
    Params p = p_; p.ws = opaque_ws(p.ws);
    const int tid = opaque_tid(), lane = tid & 63, w = tid >> 6, fr = lane & 15, fq = lane >> 4;
    const int bh = (blk & 7) + 8 * ((blk >> 3) & 1), sl = blk >> 4, dv0 = sl * 32;
    bf16_t* ST = reinterpret_cast<bf16_t*>(p.ws + OFF_HA);
    bf16_t* UT = reinterpret_cast<bf16_t*>(p.ws + OFF_UT);
    const bf16_t* W = reinterpret_cast<const bf16_t*>(p.ws + OFF_W);
    const bf16_t* KDT = reinterpret_cast<const bf16_t*>(p.ws + OFF_KDT);
    const float* GT = reinterpret_cast<const float*>(p.ws + OFF_GT);
    unsigned char* STL = dyn_lds;
    unsigned char* VTL = dyn_lds + 8704;
    unsigned char* DMY = dyn_lds + 13312;
    unsigned char* RING = dyn_lds + 16384;
    (void)dv0;
#define LDS_BAR() do { asm volatile("s_waitcnt lgkmcnt(0)" ::: "memory"); __builtin_amdgcn_s_barrier(); asm volatile("" ::: "memory"); } while (0)
    if (w >= 4) {
        constexpr int PD = 10;
        const int hw = w - 4, pl = hw * 64 + lane;
#define RING_LOAD(C) do { const int c_ = (C) < 64 ? (C) : 63; const int slot_ = (C) & 3; \
            const bf16_t* wsrc = W + (size_t)(bh * 64 + c_) * 8192 + (hw * 4) * 512 + lane * 8; \
            const bf16_t* ksrc = KDT + (size_t)(bh * 64 + c_) * 8192 + (hw * 4) * 512 + lane * 8; \
            _Pragma("unroll") for (int j = 0; j < 4; ++j) { \
                __builtin_amdgcn_global_load_lds((const unsigned*)(wsrc + j * 512), (unsigned*)(RING + slot_ * 32768 + (hw * 4 + j) * 1024), 16, 0, 0); \
                __builtin_amdgcn_global_load_lds((const unsigned*)(ksrc + j * 512), (unsigned*)(RING + slot_ * 32768 + 16384 + (hw * 4 + j) * 1024), 16, 0, 0); } } while (0)
#define TOUCH(C) do { const int c_ = (C) < 64 ? (C) : 63; const int item_ = bh * 64 + c_; \
            const int li = sl * 32 + (lane & 31); \
            const unsigned char* a0 = (hw == 0) ? ((lane < 32) ? reinterpret_cast<const unsigned char*>(W + (size_t)item_ * 8192) + li * 128 \
                                                               : reinterpret_cast<const unsigned char*>(KDT + (size_t)item_ * 8192) + li * 128) \
                                                : reinterpret_cast<const unsigned char*>(UT + ((size_t)item_ * 8 + sl * 2) * 1024) + (lane & 31) * 128; \
            __builtin_amdgcn_global_load_lds((const unsigned*)a0, (unsigned*)(DMY + hw * 256), 4, 0, 0); } while (0)
        for (int c = 0; c < PD; ++c) TOUCH(c);
        RING_LOAD(0); RING_LOAD(1); RING_LOAD(2);
        asm volatile("s_waitcnt vmcnt(0)" ::: "memory");
        __syncthreads();
        for (int n = 0; n < 64; ++n) {
            const int item = bh * 64 + n;
            __builtin_amdgcn_s_barrier();
            {
                const int dvb_ = pl >> 7, ks_ = (pl >> 6) & 1, l_ = pl & 63;
                const u32x4 v = *reinterpret_cast<const u32x4*>(VTL + ((dvb_ * 16 + (l_ & 15)) * 72 + ks_ * 32 + (l_ >> 4) * 8) * 2);
                *GP(u32x4)(UT + (((size_t)item * 8 + sl * 2) * 128 + pl) * 8) = v;
            }
            asm volatile("s_waitcnt vmcnt(14) lgkmcnt(0)" ::: "memory");
            __builtin_amdgcn_s_barrier();
            {
                bf16_t* dst = (n < 63) ? ST + (((size_t)(item + 1) * 8 + sl * 2) * 256) * 8 : ST + (size_t)1024 * 16384 + (size_t)blk * 4096;
#pragma unroll
                for (int j = 0; j < 2; ++j) {
                    const int q = pl + 256 * j, dvb_ = q >> 8, ks_ = (q >> 6) & 3, l_ = q & 63;
                    const u32x4 v = *reinterpret_cast<const u32x4*>(STL + ((dvb_ * 16 + (l_ & 15)) * 136 + ks_ * 32 + (l_ >> 4) * 8) * 2);
                    *GP(u32x4)(dst + (size_t)q * 8) = v;
                }
            }
            RING_LOAD(n + 3);
            TOUCH(n + PD);
            asm volatile("s_waitcnt lgkmcnt(0)" ::: "memory");
        }
        asm volatile("s_waitcnt vmcnt(0)" ::: "memory");
#undef RING_LOAD
#undef TOUCH
    } else {
        f32x4 S[2][2];
#pragma unroll
        for (int kb = 0; kb < 2; ++kb)
#pragma unroll
            for (int db = 0; db < 2; ++db) {
                S[kb][db] = (f32x4){0.f, 0.f, 0.f, 0.f};
                const u32x2 z = mk2(0u, 0u);
                *reinterpret_cast<u32x2*>(STL + ((db * 16 + fr) * 136 + (2 * w + kb) * 16 + fq * 4) * 2) = z;
                *GP(u32x2)(ST + (((size_t)(bh * 64) * 8 + sl * 2) * 256) * 8 + (size_t)(((kb * 2 + db) * 256 + w * 64 + lane)) * 4) = z;
            }
        __syncthreads();
#define SCAN_LOAD(NN, UB, GTV) do { const int item_ = bh * 64 + (NN); \
        _Pragma("unroll") for (int db = 0; db < 2; ++db) UB[db] = *GPC(u32x2)(UT + ((((size_t)item_ * 8 + sl * 2 + db) * 2 + (w >> 1)) * 64 + fr + 16 * ((w & 1) * 2 + (fq >> 1))) * 8 + (fq & 1) * 4); \
        GTV = *GPC(float)(GT + item_); } while (0)
        u32x2 ubA[2], ubB[2], ubC[2]; float gtA, gtB, gtC;
        SCAN_LOAD(0, ubA, gtA); SCAN_LOAD(1, ubB, gtB);
#define SCAN_STEP(N_, UB, GTV, NUB, NGT) do { \
        const int n = (N_); \
        { const int nn = n + 2 < 64 ? n + 2 : 63; SCAN_LOAD(nn, NUB, NGT); } \
        const unsigned char* slot = RING + (n & 3) * 32768; \
        { bf16x8 sb_[2][4], wf_[4]; \
          _Pragma("unroll") for (int ks = 0; ks < 4; ++ks) wf_[ks] = lds8(slot + ((w * 4 + ks) * 64 + lane) * 16); \
          _Pragma("unroll") for (int db = 0; db < 2; ++db) _Pragma("unroll") for (int ks = 0; ks < 4; ++ks) sb_[db][ks] = lds8(STL + ((db * 16 + fr) * 136 + ks * 32 + fq * 8) * 2); \
          f32x4 a10 = (f32x4){0.f, 0.f, 0.f, 0.f}, a11 = (f32x4){0.f, 0.f, 0.f, 0.f}; \
          _Pragma("unroll") for (int ks = 0; ks < 4; ++ks) { a10 = mfma16(wf_[ks], sb_[0][ks], a10); a11 = mfma16(wf_[ks], sb_[1][ks], a11); } \
          _Pragma("unroll") for (int db = 0; db < 2; ++db) { \
              const f32x4 a1 = db ? a11 : a10; u32x2 vw; \
              vw.x = cvt_pk_bf16(bf_lo(UB[db].x) - a1[0], bf_hi(UB[db].x) - a1[1]); vw.y = cvt_pk_bf16(bf_lo(UB[db].y) - a1[2], bf_hi(UB[db].y) - a1[3]); \
              *reinterpret_cast<u32x2*>(VTL + ((db * 16 + fr) * 72 + w * 16 + fq * 4) * 2) = vw; \
              } } \
        LDS_BAR(); \
        { bf16x8 vb_[2][2], kf_[2][2]; \
          _Pragma("unroll") for (int kb = 0; kb < 2; ++kb) _Pragma("unroll") for (int ks = 0; ks < 2; ++ks) kf_[kb][ks] = lds8(slot + 16384 + (((2 * w + kb) * 2 + ks) * 64 + lane) * 16); \
          _Pragma("unroll") for (int db = 0; db < 2; ++db) _Pragma("unroll") for (int ks = 0; ks < 2; ++ks) vb_[db][ks] = lds8(VTL + ((db * 16 + fr) * 72 + ks * 32 + fq * 8) * 2); \
          _Pragma("unroll") for (int kb = 0; kb < 2; ++kb) _Pragma("unroll") for (int db = 0; db < 2; ++db) { \
              f32x4 a2 = S[kb][db] * GTV; \
              a2 = mfma16(kf_[kb][0], vb_[db][0], a2); a2 = mfma16(kf_[kb][1], vb_[db][1], a2); \
              S[kb][db] = a2; \
              if (n < 63) { \
                  u32x2 sw; sw.x = cvt_pk_bf16(a2[0], a2[1]); sw.y = cvt_pk_bf16(a2[2], a2[3]); \
                  *reinterpret_cast<u32x2*>(STL + ((db * 16 + fr) * 136 + (2 * w + kb) * 16 + fq * 4) * 2) = sw; \
              } } } \
        LDS_BAR(); } while (0)
        for (int n3 = 0; n3 < 63; n3 += 3) {
            SCAN_STEP(n3 + 0, ubA, gtA, ubC, gtC);
            SCAN_STEP(n3 + 1, ubB, gtB, ubA, gtA);
            SCAN_STEP(n3 + 2, ubC, gtC, ubB, gtB);
        }
        SCAN_STEP(63, ubA, gtA, ubC, gtC);
#undef SCAN_STEP
#undef SCAN_LOAD
    }
#undef LDS_BAR
}

__device__ __forceinline__ void swa_phase(const Params& p_, int l, int sblk, int nsb, int g_wave) {
    Params p = p_; p.ws = opaque_ws(p.ws);
    const int tid = opaque_tid(), lane = tid & 63, w = tid >> 6, fr = lane & 15, fq = lane >> 4;
    const bf16_t* HB = reinterpret_cast<const bf16_t*>(p.ws + OFF_HB);
    bf16_t* YM = reinterpret_cast<bf16_t*>(p.ws + OFF_XB);
    unsigned char* VTS = dyn_lds;
    unsigned char* KSL = dyn_lds + 21504;
    for (int it = sblk; it < 1024; it += nsb) {
        const int b = it >> 8, kvh = (it >> 7) & 1, qt = it & 127, q0 = qt * 32, kbase = q0 - 128;
        for (int idx = tid; idx < 1280; idx += 512) {
            const int key = idx >> 3, sg = idx & 7, kp = kbase + key;
            u32x4 u = mk4(0u, 0u, 0u, 0u);
            if (kp >= 0) u = *GPC(u32x4)(HB + (size_t)(b * SEQ + kp) * HB_LD + HB_KB + kvh * 64 + sg * 8);
            *reinterpret_cast<u32x4*>(KSL + (key * 72 + sg * 8) * 2) = u;
        }
        if (tid < 320) {
            const int kg = tid >> 3, sg = tid & 7;
            u32x4 u[4];
#pragma unroll
            for (int k = 0; k < 4; ++k) {
                const int kp = kbase + kg * 4 + k;
                u[k] = mk4(0u, 0u, 0u, 0u);
                if (kp >= 0) u[k] = *GPC(u32x4)(HB + (size_t)(b * SEQ + kp) * HB_LD + HB_VB + kvh * 64 + sg * 8);
            }
#pragma unroll
            for (int dp = 0; dp < 4; ++dp) {
                u32x2 lo, hi;
                lo.x = (u[0][dp] & 0xffffu) | (u[1][dp] << 16); lo.y = (u[2][dp] & 0xffffu) | (u[3][dp] << 16);
                hi.x = (u[0][dp] >> 16) | (u[1][dp] & 0xffff0000u); hi.y = (u[2][dp] >> 16) | (u[3][dp] & 0xffff0000u);
                *reinterpret_cast<u32x2*>(VTS + ((sg * 8 + dp * 2) * 168 + kg * 4) * 2) = lo;
                *reinterpret_cast<u32x2*>(VTS + ((sg * 8 + dp * 2 + 1) * 168 + kg * 4) * 2) = hi;
            }
        }
        const int g = w >> 1, sub = w & 1, qs = q0 + sub * 16, hq = kvh * 4 + g;
        const float slope = exp2f(-(float)(hq + 1)), sink = p.sinks[l * 8 + hq];
        bf16x8 qf[2];
#pragma unroll
        for (int ks = 0; ks < 2; ++ks) qf[ks] = ldg8(HB + (size_t)(b * SEQ + qs + fr) * HB_LD + HB_QB + hq * 64 + ks * 32 + fq * 8);
        __syncthreads();
        f32x4 sc[10];
#pragma unroll
        for (int kt = 0; kt < 10; ++kt) {
            const unsigned char* kr = KSL + ((kt * 16 + fr) * 72 + fq * 8) * 2;
            f32x4 a = (f32x4){0.f, 0.f, 0.f, 0.f};
            a = mfma16(lds8(kr), qf[0], a);
            a = mfma16(lds8(kr + 64), qf[1], a);
            sc[kt] = a;
        }
        const int qpos = qs + fr;
        float m = -1e30f;
#pragma unroll
        for (int kt = 0; kt < 10; ++kt)
#pragma unroll
            for (int r = 0; r < 4; ++r) {
                const int kpos = kbase + kt * 16 + fq * 4 + r, dist = qpos - kpos;
                const bool valid = (dist >= 0) && (dist < 128) && (kpos >= 0);
                const float s = valid ? sc[kt][r] * 0.125f - slope * (float)dist : -1e30f;
                sc[kt][r] = s; m = fmaxf(m, s);
            }
        m = fmaxf(m, shx(m, 16, lane)); m = fmaxf(m, shx(m, 32, lane));
        m = fmaxf(m, sink);
        float lsum = 0.f;
#pragma unroll
        for (int kt = 0; kt < 10; ++kt)
#pragma unroll
            for (int r = 0; r < 4; ++r) { const float e = __expf(sc[kt][r] - m); sc[kt][r] = e; lsum += e; }
        lsum += shx(lsum, 16, lane); lsum += shx(lsum, 32, lane);
        lsum += __expf(sink - m);
        const float inv = __builtin_amdgcn_rcpf(lsum);
        f32x4 o[4];
#pragma unroll
        for (int db = 0; db < 4; ++db) o[db] = (f32x4){0.f, 0.f, 0.f, 0.f};
#pragma unroll
        for (int j = 0; j < 5; ++j) {
            union { bf16x8 v; unsigned u[4]; } pf;
            pf.u[0] = cvt_pk_bf16(sc[2 * j][0], sc[2 * j][1]); pf.u[1] = cvt_pk_bf16(sc[2 * j][2], sc[2 * j][3]);
            pf.u[2] = cvt_pk_bf16(sc[2 * j + 1][0], sc[2 * j + 1][1]); pf.u[3] = cvt_pk_bf16(sc[2 * j + 1][2], sc[2 * j + 1][3]);
#pragma unroll
            for (int db = 0; db < 4; ++db) {
                union { bf16x8 v; u32x2 h[2]; } vf;
                const unsigned char* vr = VTS + ((db * 16 + fr) * 168 + (2 * j) * 16 + fq * 4) * 2;
                vf.h[0] = *reinterpret_cast<const u32x2*>(vr);
                vf.h[1] = *reinterpret_cast<const u32x2*>(vr + 32);
                o[db] = mfma16(vf.v, pf.v, o[db]);
            }
        }
        {
            const size_t tok = (size_t)(b * SEQ + qs + fr);
#pragma unroll
            for (int db = 0; db < 4; ++db) {
                const int col = hq * 64 + db * 16 + fq * 4;
                const u32x2 z = *GPC(u32x2)(HB + tok * HB_LD + HB_ZB + col);
                u32x2 y;
                y.x = cvt_pk_bf16(o[db][0] * inv * silu_f(bf_lo(z.x)), o[db][1] * inv * silu_f(bf_hi(z.x)));
                y.y = cvt_pk_bf16(o[db][2] * inv * silu_f(bf_lo(z.y)), o[db][3] * inv * silu_f(bf_hi(z.y)));
                *GP(u32x2)(YM + tok * DM + 512 + col) = y;
            }
        }
        __syncthreads();
    }
}

__device__ __forceinline__ void delta_out(const Params& p_, int l, int g_wave) {
    Params p = p_; p.ws = opaque_ws(p.ws);
    const int tid = opaque_tid(), grp = tid >> 8, lane = tid & 63, wv = (tid & 255) >> 6, fr = lane & 15, fq = lane >> 4;
    const bf16_t* ST = reinterpret_cast<const bf16_t*>(p.ws + OFF_HA);
    const bf16_t* VT = reinterpret_cast<const bf16_t*>(p.ws + OFF_UT);
    const bf16_t* QD = reinterpret_cast<const bf16_t*>(p.ws + OFF_QD);
    const bf16_t* QK = reinterpret_cast<const bf16_t*>(p.ws + OFF_QK);
    const bf16_t* HB = reinterpret_cast<const bf16_t*>(p.ws + OFF_HB);
    bf16_t* YM = reinterpret_cast<bf16_t*>(p.ws + OFF_XB);
    const float* nw = p.norm_w + l * 128;
    for (int pi = blockIdx.x; pi < 512; pi += gridDim.x) {
        const int item = pi * 2 + grp, bh = item >> 6, n = item & 63, b = bh >> 2, h = bh & 3;
        const int tok = b * SEQ + n * 64 + wv * 16 + fr;
        bf16x8 qd[4], qk[2];
#pragma unroll
        for (int ks = 0; ks < 4; ++ks) qd[ks] = ldg8(QD + ((((size_t)item * 4 + wv) * 4 + ks) * 64 + lane) * 8);
#pragma unroll
        for (int ks = 0; ks < 2; ++ks) qk[ks] = ldg8(QK + ((((size_t)item * 4 + wv) * 2 + ks) * 64 + lane) * 8);
        u32x2 zz[8];
#pragma unroll
        for (int db = 0; db < 8; ++db) zz[db] = *GPC(u32x2)(HB + (size_t)tok * HB_LD + HB_ZA + h * 128 + db * 16 + fq * 4);
        f32x4 o[8];
        float ss = 0.f;
        bf16x8 sfA[4], vfA[2], sfB[4], vfB[2];
#define DO_LOAD(DB, SF, VF) do { const bf16_t* sp = ST + ((((size_t)item * 8 + (DB)) * 4) * 64 + lane) * 8; const bf16_t* vp = VT + ((((size_t)item * 8 + (DB)) * 2) * 64 + lane) * 8; \
            _Pragma("unroll") for (int ks = 0; ks < 4; ++ks) SF[ks] = ldg8(sp + ks * 512); \
            _Pragma("unroll") for (int ks = 0; ks < 2; ++ks) VF[ks] = ldg8(vp + ks * 512); } while (0)
#define DO_MMA(DB, SF, VF) do { f32x4 a = (f32x4){0.f, 0.f, 0.f, 0.f}; \
            _Pragma("unroll") for (int ks = 0; ks < 4; ++ks) a = mfma16(SF[ks], qd[ks], a); \
            _Pragma("unroll") for (int ks = 0; ks < 2; ++ks) a = mfma16(VF[ks], qk[ks], a); \
            o[DB] = a; ss += (a[0] * a[0] + a[1] * a[1]) + (a[2] * a[2] + a[3] * a[3]); } while (0)
        DO_LOAD(0, sfA, vfA); DO_LOAD(1, sfB, vfB);
#pragma unroll
        for (int db = 0; db < 8; db += 2) {
            DO_MMA(db, sfA, vfA);
            if (db + 2 < 8) DO_LOAD(db + 2, sfA, vfA);
            DO_MMA(db + 1, sfB, vfB);
            if (db + 3 < 8) DO_LOAD(db + 3, sfB, vfB);
        }
#undef DO_LOAD
#undef DO_MMA
        ss += shx(ss, 16, lane); ss += shx(ss, 32, lane);
        const float rs = rsqrtf(ss * (1.0f / 128.0f) + 1e-6f);
#pragma unroll
        for (int db = 0; db < 8; ++db) {
            const int dv = db * 16 + fq * 4;
            const f32x4 nv = *GPC(f32x4)(nw + dv);
            const u32x2 z = zz[db];
            u32x2 y;
            y.x = cvt_pk_bf16(o[db][0] * rs * nv[0] * silu_f(bf_lo(z.x)), o[db][1] * rs * nv[1] * silu_f(bf_hi(z.x)));
            y.y = cvt_pk_bf16(o[db][2] * rs * nv[2] * silu_f(bf_lo(z.y)), o[db][3] * rs * nv[3] * silu_f(bf_hi(z.y)));
            *GP(u32x2)(YM + (size_t)tok * DM + h * 128 + dv) = y;
        }
    }
}


__global__ void __launch_bounds__(512) fwd_megakernel(Params p) {
    __shared__ u32x4 xb_words;
    const int g_wave = __builtin_amdgcn_readfirstlane((int)(threadIdx.x >> 6));
    if (xb_t0(g_wave)) xb_words = mk4(0u, 0u, 0u, 0u);
    __syncthreads();
    XcdBarrier gb = xcd_barrier_post(reinterpret_cast<unsigned*>(p.ws + OFF_BAR), (volatile LAS unsigned*)&xb_words, g_wave);

    prep_weights(p, 0, blockIdx.x, gridDim.x, g_wave);
    row_pass(p.x, false, nullptr, nullptr, nullptr, reinterpret_cast<bf16_t*>(p.ws + OFF_XB), p.w_in + 2048, reinterpret_cast<float*>(p.ws + OFF_BA), g_wave);
    xcd_barrier(gb);
    for (int l = 0; l < 2; ++l) {
        unsigned char* wsl = opaque_ws(p.ws);
        bf16_t* XB = reinterpret_cast<bf16_t*>(wsl + OFF_XB);
        float* BA = reinterpret_cast<float*>(wsl + OFF_BA);
        {
            EpiH e; e.ha = reinterpret_cast<bf16_t*>(p.ws + OFF_HA); e.hb = reinterpret_cast<bf16_t*>(p.ws + OFF_HB);
            gemm_phase(XB, reinterpret_cast<const bf16_t*>(p.ws + OFF_WIN) + (size_t)l * NIN * DM, NTOK, NIN, DM, e, g_wave);
            if (l == 0 && blockIdx.x >= 64) prep_weights(p, 1, blockIdx.x - 64, gridDim.x - 64, g_wave);
        }
        xcd_barrier(gb);
        chunk_prep(p, l, g_wave);
        xcd_barrier(gb);
        if (blockIdx.x < 64) delta_scan(p, blockIdx.x, g_wave);
        else swa_phase(p, l, blockIdx.x - 64, gridDim.x - 64, g_wave);
        xcd_barrier(gb);
        if (l == 0) { const int t_ = opaque_tid(); float zf_ = 0.f; asm volatile("" : "+v"(zf_)); for (int i = blockIdx.x * 512 + t_; i < NTOK * 2; i += gridDim.x * 512) *GP(f32x4)(BA + (size_t)i * 4) = (f32x4){zf_, zf_, zf_, zf_}; }
        delta_out(p, l, g_wave);
        xcd_barrier(gb);
        {
            EpiLN e; e.xres = (l == 0) ? p.x : p.out; e.out = p.out; e.xb = (l == 0) ? XB : nullptr;
            e.g = p.ln_g + l * DM; e.b = p.ln_b + l * DM; e.wg = (l == 0) ? p.w_in + (size_t)DM * INC + 2048 : nullptr; e.BA = BA;
            e.xbuf = reinterpret_cast<float*>(wsl + OFF_XS) + (size_t)l * NTOK * 8;
            e.cnt = reinterpret_cast<unsigned*>(wsl + OFF_BAR) + 3500 + l * 64; e.tmo = reinterpret_cast<unsigned*>(wsl + OFF_BAR) + XB_TMO; e.gw = g_wave;
            gemm_phase(XB, reinterpret_cast<const bf16_t*>(p.ws + OFF_WOUT) + (size_t)l * DM * DM, NTOK, DM, DM, e, g_wave);
        }
        if (l == 0) xcd_barrier(gb);
    }
}

extern "C" void kernel_launch(void* const* d_in, const int* in_sizes, int n_in, void* d_out, int out_size, void* d_ws, size_t ws_size, hipStream_t stream) {
    static int grid_blocks = 0;
    if (!grid_blocks) {
        int dev = 0, cus = 0, per_cu = 0;
        hipGetDevice(&dev);
        hipDeviceGetAttribute(&cus, hipDeviceAttributeMultiprocessorCount, dev);
        hipFuncSetAttribute((const void*)fwd_megakernel, hipFuncAttributeMaxDynamicSharedMemorySize, LDS_BYTES);
        hipOccupancyMaxActiveBlocksPerMultiprocessor(&per_cu, fwd_megakernel, 512, LDS_BYTES);
        grid_blocks = (per_cu >= 1) ? cus : 0;
        if (grid_blocks > 256) grid_blocks = 256;
        if (ws_size < WS_NEED) { fprintf(stderr, "workspace too small: %zu < %zu\n", ws_size, (size_t)WS_NEED); }
        if (!grid_blocks) { fprintf(stderr, "occupancy query returned 0\n"); grid_blocks = 256; }
    }
    Params p{};
    p.x = (const float*)d_in[0]; p.w_in = (const float*)d_in[1]; p.conv_w = (const float*)d_in[2]; p.a_log = (const float*)d_in[3];
    p.dt_bias = (const float*)d_in[4]; p.norm_w = (const float*)d_in[5]; p.sinks = (const float*)d_in[6]; p.w_out = (const float*)d_in[7];
    p.ln_g = (const float*)d_in[8]; p.ln_b = (const float*)d_in[9]; p.out = (float*)d_out; p.ws = (unsigned char*)d_ws;
    hipMemsetAsync(d_ws, 0, 16384, stream);
    void* args[] = {&p};
    hipError_t e = hipLaunchCooperativeKernel((const void*)fwd_megakernel, dim3(grid_blocks), dim3(512), args, LDS_BYTES, stream);
    if (e != hipSuccess) fprintf(stderr, "cooperative launch failed: %s (grid %d)\n", hipGetErrorString(e), grid_blocks);
}
```

```cpp
#include <hip/hip_runtime.h>
#include <cstdio>
#include <cstdint>

#define LAS __attribute__((address_space(3)))
__device__ __forceinline__ int opaque_lane() { int lane; asm volatile("v_mbcnt_lo_u32_b32 %0, -1, 0\n\tv_mbcnt_hi_u32_b32 %0, -1, %0" : "=v"(lane)); return lane; }
typedef unsigned short bf16_t;
typedef short bf16x8 __attribute__((ext_vector_type(8)));
typedef float f32x4 __attribute__((ext_vector_type(4)));
typedef unsigned u32x4 __attribute__((ext_vector_type(4)));
typedef unsigned u32x2 __attribute__((ext_vector_type(2)));
__device__ __forceinline__ u32x4 mk4(unsigned a, unsigned b, unsigned c, unsigned d) { return (u32x4){a, b, c, d}; }
__device__ __forceinline__ u32x2 mk2(unsigned a, unsigned b) { return (u32x2){a, b}; }

constexpr int NTOK = 16384, SEQ = 4096, DM = 1024, INC = 3336, NIN = 3328;
constexpr int HA_LD = 1536, HB_LD = 1792;
constexpr int HB_ZA = 0, HB_QB = 512, HB_KB = 1024, HB_VB = 1152, HB_ZB = 1280;
constexpr float DN_ALPHA = 1.41421356237f;

constexpr size_t OFF_BAR = 0;
constexpr size_t OFF_XB = 16384;
constexpr size_t OFF_WIN = OFF_XB + (size_t)NTOK * DM * 2;
constexpr size_t OFF_WOUT = OFF_WIN + (size_t)2 * NIN * DM * 2;
constexpr size_t OFF_HA = OFF_WOUT + (size_t)2 * DM * DM * 2;
constexpr size_t OFF_HB = OFF_HA + (size_t)NTOK * HA_LD * 2;
constexpr size_t OFF_UT = OFF_HB + (size_t)NTOK * HB_LD * 2;
constexpr size_t OFF_W = OFF_UT + (size_t)NTOK * 512 * 2;
constexpr size_t OFF_QD = OFF_W + (size_t)NTOK * 512 * 2;
constexpr size_t OFF_KDT = OFF_QD + (size_t)NTOK * 512 * 2;
constexpr size_t OFF_QK = OFF_KDT + (size_t)NTOK * 512 * 2;
constexpr size_t OFF_BA = OFF_QK + (size_t)NTOK * 256 * 2;
constexpr size_t OFF_GT = OFF_BA + (size_t)NTOK * 8 * 4;
constexpr size_t OFF_XS = OFF_GT + 4096;
constexpr size_t WS_NEED = OFF_XS + (size_t)2 * NTOK * 4 * 8;

constexpr int LDS_BYTES = 147456;
extern __shared__ __attribute__((aligned(16))) unsigned char dyn_lds[];

struct Params {
    const float* x; const float* w_in; const float* conv_w; const float* a_log; const float* dt_bias;
    const float* norm_w; const float* sinks; const float* w_out; const float* ln_g; const float* ln_b;
    float* out; unsigned char* ws;
};

typedef float f32x2_t __attribute__((ext_vector_type(2)));
typedef __bf16 bf16x2_t __attribute__((ext_vector_type(2)));
__device__ __forceinline__ unsigned cvt_pk_bf16(float lo, float hi) {
    const f32x2_t v = {lo, hi};
    const bf16x2_t r = __builtin_convertvector(v, bf16x2_t);
    return __builtin_bit_cast(unsigned, r);
}
__device__ __forceinline__ float bf_lo(unsigned u) { return __uint_as_float(u << 16); }
__device__ __forceinline__ float bf_hi(unsigned u) { return __uint_as_float(u & 0xffff0000u); }
__device__ __forceinline__ float silu_f(float x) { return x * __builtin_amdgcn_rcpf(1.0f + __expf(-x)); }
__device__ __forceinline__ f32x4 mfma16(bf16x8 a, bf16x8 b, f32x4 c) { return __builtin_amdgcn_mfma_f32_16x16x32_bf16(a, b, c, 0, 0, 0); }
#define GPC(T) (const __attribute__((address_space(1))) T*)
#define GP(T) (__attribute__((address_space(1))) T*)
__device__ __forceinline__ bf16x8 ldg8(const bf16_t* p) { return *GPC(bf16x8)(p); }
__device__ __forceinline__ bf16x8 lds8(const unsigned char* p) { return *reinterpret_cast<const bf16x8*>(p); }

__device__ __forceinline__ int opaque_tid_(int g_wave) {
    int lane; asm volatile("v_mbcnt_lo_u32_b32 %0, -1, 0\n\tv_mbcnt_hi_u32_b32 %0, -1, %0" : "=v"(lane));
    return g_wave * 64 + lane; }
#define opaque_tid() opaque_tid_(g_wave)
__device__ __forceinline__ unsigned char* opaque_ws(unsigned char* w) { asm volatile("" : "+s"(w)); return w; }
__device__ __forceinline__ const bf16_t* uniform_ptr(const bf16_t* p) {
    const unsigned long long v = (unsigned long long)p;
    const unsigned lo = __builtin_amdgcn_readfirstlane((unsigned)v), hi = __builtin_amdgcn_readfirstlane((unsigned)(v >> 32));
    return (const bf16_t*)(((unsigned long long)hi << 32) | lo);
}

__device__ __forceinline__ float shx(float v, int m, int lane) { return __int_as_float(__builtin_amdgcn_ds_bpermute((lane ^ m) << 2, __float_as_int(v))); }

__device__ __forceinline__ float row_sum16(float x) {
    x += __int_as_float(__builtin_amdgcn_update_dpp(0, __float_as_int(x), 0x128, 0xf, 0xf, false));
    x += __int_as_float(__builtin_amdgcn_update_dpp(0, __float_as_int(x), 0x124, 0xf, 0xf, false));
    x += __int_as_float(__builtin_amdgcn_update_dpp(0, __float_as_int(x), 0x122, 0xf, 0xf, false));
    x += __int_as_float(__builtin_amdgcn_update_dpp(0, __float_as_int(x), 0x121, 0xf, 0xf, false));
    return x;
}

#define XB_TMO      128
#define XB_XCNT(j)  (256  + 64 * (j))
#define XB_XSUB(j)  (1280 + 64 * (j))
#define XB_XGEN(j)  (2304 + 64 * (j))
#define XB_TOP      3328
#define XB_TOPGEN   3392
#define XCD_BAR_WORDS 3456
#define XB_SPIN_CAP (1u << 20)
__device__ __forceinline__ unsigned xb_ld(unsigned* p)              { return __hip_atomic_load(p, __ATOMIC_RELAXED, __HIP_MEMORY_SCOPE_AGENT); }
__device__ __forceinline__ unsigned xb_add(unsigned* p, unsigned v) { return __hip_atomic_fetch_add(p, v, __ATOMIC_RELAXED, __HIP_MEMORY_SCOPE_AGENT); }
__device__ __forceinline__ unsigned xb_xcc_id() { return (unsigned)__builtin_amdgcn_s_getreg((3 << 11) | 20) & 0xFu; }
#define XB_SPIN(cond, bar) do { unsigned _sp = 0; while (cond) { __builtin_amdgcn_s_sleep(1); \
    if ((++_sp & 255u) == 0u) { if (xb_ld(&(bar)[XB_TMO])) break; if (_sp > XB_SPIN_CAP) { atomicAdd(&(bar)[XB_TMO], 1u); break; } } } } while (0)
struct XcdBarrier { unsigned* bar; unsigned x; volatile LAS unsigned* st; int gw; };
__device__ __forceinline__ bool xb_t0(int gw) { return gw == 0 && opaque_lane() == 0; }
__device__ __forceinline__ XcdBarrier xcd_barrier_post(unsigned* bar, volatile LAS unsigned* st, int gw) {
    XcdBarrier b; b.bar = bar; b.x = xb_xcc_id(); b.st = st; b.gw = gw;
    if (xb_t0(gw)) (void)xb_add(&bar[XB_XCNT(b.x)], 1u);
    return b;
}
__device__ __forceinline__ void xcd_barrier_complete(unsigned* bar, unsigned x, unsigned& nloc, unsigned& nx) {
    const unsigned G = gridDim.x * gridDim.y * gridDim.z;
    unsigned sum, cnt, mine, sp = 0u;
    for (;;) {
        sum = 0u; cnt = 0u; mine = 0u;
#pragma unroll
        for (unsigned j = 0; j < 16; ++j) { const unsigned c = xb_ld(&bar[XB_XCNT(j)]); sum += c; cnt += (c > 0u) ? 1u : 0u; mine = (j == x) ? c : mine; }
        if (sum == G) break;
        __builtin_amdgcn_s_sleep(1);
        if ((++sp & 255u) == 0u) { if (xb_ld(&bar[XB_TMO])) break; if (sp > XB_SPIN_CAP) { atomicAdd(&bar[XB_TMO], 1u); break; } }
    }
    nloc = mine > 0u ? mine : 1u; nx = cnt > 0u ? cnt : 1u;
}
__device__ __forceinline__ void xcd_barrier(const XcdBarrier& b_) {
    asm volatile("s_waitcnt vmcnt(0)" ::: "memory");
    __syncthreads();
    if (xb_t0(b_.gw)) {
        XcdBarrier b = b_; b.x = xb_xcc_id();
        asm volatile("" : "+s"(b.x));
        unsigned* bar = b.bar;
        __builtin_amdgcn_s_waitcnt(0);
        unsigned nloc = b.st[0], nx = b.st[1];
        if (nloc == 0u) { xcd_barrier_complete(bar, b.x, nloc, nx); b.st[0] = nloc; b.st[1] = nx; }
        const unsigned old = xb_add(&bar[XB_XSUB(b.x)], 1u);
        const unsigned gen = old / nloc;
        if (old + 1u == (gen + 1u) * nloc) {
            __builtin_amdgcn_fence(__ATOMIC_RELEASE, "agent");
            asm volatile("s_waitcnt vmcnt(0)" ::: "memory");
            const unsigned og = xb_add(&bar[XB_TOP], 1u);
            const unsigned tg = og / nx;
            if (og + 1u == (tg + 1u) * nx) xb_add(&bar[XB_TOPGEN], 1u);
            else XB_SPIN(xb_ld(&bar[XB_TOPGEN]) == tg, bar);
            __builtin_amdgcn_fence(__ATOMIC_ACQUIRE, "agent");
            xb_add(&bar[XB_XGEN(b.x)], 1u);
            asm volatile("s_waitcnt vmcnt(0)" ::: "memory");
        } else {
            XB_SPIN(xb_ld(&bar[XB_XGEN(b.x)]) == gen, bar);
            __builtin_amdgcn_fence(__ATOMIC_ACQUIRE, "agent");
            asm volatile("s_waitcnt vmcnt(0)" ::: "memory");
        }
    }
    __syncthreads();
}


constexpr int BM = 256, BK = 64, HALF = 128, NXCD = 8, WGM = 8, HT = HALF * BK;
__device__ __forceinline__ int lds_byte(int r, int c) {
    int st = (r >> 4) * 2 + (c >> 5), rr = r & 15, cc = c & 31, ob = rr * 64 + cc * 2;
    return st * 1024 + (ob ^ (((ob >> 9) & 1) << 5));
}
__device__ __forceinline__ void stage_rc(int b, int& R, int& C) {
    int st = b / 1024, sb = b % 1024, swz = sb ^ (((sb >> 9) & 1) << 5);
    R = (st >> 1) * 16 + swz / 64; C = (st & 1) * 32 + (swz % 64) / 2;
}

struct EpiH {
    bf16_t* ha; bf16_t* hb;
    __device__ __forceinline__ void operator()(const f32x4 (&acc)[2][2][4][2], int brow, int bcol, int wr, int wc, int fr, int fq) const {
        bf16_t* base; int ld, c0;
        if (bcol < HA_LD) { base = ha; ld = HA_LD; c0 = bcol; } else { base = hb; ld = HB_LD; c0 = bcol - HA_LD; }
#pragma unroll
        for (int ai = 0; ai < 2; ++ai)
#pragma unroll
            for (int m = 0; m < 4; ++m) {
                const int row = brow + ai * HALF + wr * 64 + m * 16 + fr;
                bf16_t* rp = base + (size_t)row * ld + c0 + wc * 32 + fq * 8;
#pragma unroll
                for (int bj = 0; bj < 2; ++bj) {
                    const f32x4 v0 = acc[ai][bj][m][0], v1 = acc[ai][bj][m][1];
                    u32x4 w; w.x = cvt_pk_bf16(v0[0], v0[1]); w.y = cvt_pk_bf16(v0[2], v0[3]); w.z = cvt_pk_bf16(v1[0], v1[1]); w.w = cvt_pk_bf16(v1[2], v1[3]);
                    *GP(u32x4)(rp + bj * HALF) = w;
                }
            }
    }
};
struct EpiZ {
    const float* xres; float* out;
    __device__ __forceinline__ void operator()(const f32x4 (&acc)[2][2][4][2], int brow, int bcol, int wr, int wc, int fr, int fq) const {
#pragma unroll
        for (int ai = 0; ai < 2; ++ai)
#pragma unroll
            for (int m = 0; m < 4; ++m) {
                const int row = brow + ai * HALF + wr * 64 + m * 16 + fr;
                const size_t ro = (size_t)row * DM + bcol + wc * 32 + fq * 4;
#pragma unroll
                for (int bj = 0; bj < 2; ++bj)
#pragma unroll
                    for (int n = 0; n < 2; ++n) {
                        const size_t o = ro + bj * HALF + n * 16;
                        const f32x4 r = *GPC(f32x4)(xres + o);
                        *GP(f32x4)(out + o) = r * DN_ALPHA + acc[ai][bj][m][n];
                    }
            }
    }
};


struct EpiLN {
    const float* xres; float* out; bf16_t* xb; const float* g; const float* b; const float* wg; float* BA; float* xbuf; unsigned* cnt; unsigned* tmo; int gw;
    __device__ __forceinline__ void operator()(f32x4 (&acc)[2][2][4][2], int brow, int bcol, int, int, int, int) const {
        const int tid = opaque_tid_(gw), lane = tid & 63, wr = tid >> 8, wc = (tid >> 6) & 3, fr = lane & 15, fq = lane >> 4, pm = brow >> 8, pn = bcol >> 8;
        f32x2_t* P = reinterpret_cast<f32x2_t*>(dyn_lds);
        f32x2_t* STATS = reinterpret_cast<f32x2_t*>(dyn_lds + 8192);
        float* WG = reinterpret_cast<float*>(dyn_lds + 10240);
        float* GP4 = reinterpret_cast<float*>(dyn_lds + 18432);
        if (wg) {
            for (int c = tid; c < 256; c += 512) {
                const float* wp = wg + (size_t)(bcol + c) * INC;
                *reinterpret_cast<f32x4*>(WG + c * 8) = *GPC(f32x4)(wp); *reinterpret_cast<f32x4*>(WG + c * 8 + 4) = *GPC(f32x4)(wp + 4);
            }
        }
#pragma unroll
        for (int ai = 0; ai < 2; ++ai)
#pragma unroll
            for (int m = 0; m < 4; ++m) {
                __builtin_amdgcn_sched_barrier(0);
                const int rl = ai * HALF + wr * 64 + m * 16 + fr;
                const size_t ro = (size_t)(brow + rl) * DM + bcol + wc * 32 + fq * 8;
                float s1 = 0.f, s2 = 0.f;
#pragma unroll
                for (int bj = 0; bj < 2; ++bj)
#pragma unroll
                    for (int n = 0; n < 2; ++n) {
                        const f32x4 r = *GPC(f32x4)(xres + ro + bj * HALF + n * 4);
                        const f32x4 v = r * DN_ALPHA + acc[ai][bj][m][n];
                        acc[ai][bj][m][n] = v;
                        s1 += (v[0] + v[1]) + (v[2] + v[3]);
                        s2 += (v[0] * v[0] + v[1] * v[1]) + (v[2] * v[2] + v[3] * v[3]);
                    }
                s1 += shx(s1, 16, lane); s1 += shx(s1, 32, lane);
                s2 += shx(s2, 16, lane); s2 += shx(s2, 32, lane);
                if (fq == 0) P[rl * 4 + wc] = (f32x2_t){s1, s2};
            }
        __syncthreads();
        if (tid < 256) {
            const f32x2_t a = P[tid * 4 + 0], b2 = P[tid * 4 + 1], c = P[tid * 4 + 2], d = P[tid * 4 + 3];
            *GP(f32x2_t)(xbuf + ((size_t)(brow + tid) * 4 + pn) * 2) = (f32x2_t){(a.x + b2.x) + (c.x + d.x), (a.y + b2.y) + (c.y + d.y)};
        }
        asm volatile("s_waitcnt vmcnt(0)" ::: "memory");
        __syncthreads();
        if (tid == 0) {
            __threadfence();
            xb_add(cnt + pm, 1u);
            unsigned sp = 0;
            while (xb_ld(cnt + pm) < 4u) { __builtin_amdgcn_s_sleep(1); if (++sp > (1u << 22)) { atomicAdd(tmo, 1u); break; } }
            __threadfence();
        }
        __syncthreads();
        if (tid < 256) {
            float S1 = 0.f, S2 = 0.f;
#pragma unroll
            for (int t = 0; t < 4; ++t) {
                const f32x2_t v = *GPC(f32x2_t)(xbuf + ((size_t)(brow + tid) * 4 + t) * 2);
                S1 += v.x; S2 += v.y;
            }
            const float mean = S1 * (1.0f / DM);
            const float var = fmaxf(S2 * (1.0f / DM) - mean * mean, 0.f);
            STATS[tid] = (f32x2_t){mean, rsqrtf(var + 1e-5f)};
        }
        __syncthreads();
#pragma unroll
        for (int ai = 0; ai < 2; ++ai)
#pragma unroll
            for (int m = 0; m < 4; ++m) {
                __builtin_amdgcn_sched_barrier(0);
                const int rl = ai * HALF + wr * 64 + m * 16 + fr;
                const f32x2_t st = STATS[rl];
                const size_t ro = (size_t)(brow + rl) * DM + bcol + wc * 32 + fq * 8;
                float d[8] = {0.f, 0.f, 0.f, 0.f, 0.f, 0.f, 0.f, 0.f};
#pragma unroll
                for (int bj = 0; bj < 2; ++bj) {
                    u32x4 wpk;
#pragma unroll
                    for (int n = 0; n < 2; ++n) {
                        const int cl = bj * HALF + wc * 32 + fq * 8 + n * 4;
                        const f32x4 gg = *GPC(f32x4)(g + bcol + cl), bb = *GPC(f32x4)(b + bcol + cl);
                        const f32x4 v = (acc[ai][bj][m][n] - st.x) * st.y * gg + bb;
                        *GP(f32x4)(out + ro + bj * HALF + n * 4) = v;
                        if (n == 0) { wpk.x = cvt_pk_bf16(v[0], v[1]); wpk.y = cvt_pk_bf16(v[2], v[3]); } else { wpk.z = cvt_pk_bf16(v[0], v[1]); wpk.w = cvt_pk_bf16(v[2], v[3]); }
                        if (wg) {
#pragma unroll
                            for (int j = 0; j < 4; ++j) {
                                const f32x4 w0 = *reinterpret_cast<const f32x4*>(WG + (cl + j) * 8), w1 = *reinterpret_cast<const f32x4*>(WG + (cl + j) * 8 + 4);
                                d[0] += v[j] * w0[0]; d[1] += v[j] * w0[1]; d[2] += v[j] * w0[2]; d[3] += v[j] * w0[3];
                                d[4] += v[j] * w1[0]; d[5] += v[j] * w1[1]; d[6] += v[j] * w1[2]; d[7] += v[j] * w1[3];
                            }
                        }
                    }
                    if (xb) *GP(u32x4)(xb + ro + bj * HALF) = wpk;
                }
                if (wg) {
#pragma unroll
                    for (int k = 0; k < 8; ++k) { d[k] += shx(d[k], 16, lane); d[k] += shx(d[k], 32, lane); }
                    if (fq == 0) {
                        *reinterpret_cast<f32x4*>(GP4 + (rl * 4 + wc) * 8) = (f32x4){d[0], d[1], d[2], d[3]};
                        *reinterpret_cast<f32x4*>(GP4 + (rl * 4 + wc) * 8 + 4) = (f32x4){d[4], d[5], d[6], d[7]};
                    }
                }
            }
        if (wg) {
            __syncthreads();
            for (int i = tid; i < 2048; i += 512) {
                const int rl = i >> 3, k = i & 7;
                const float sgate = (GP4[(rl * 4 + 0) * 8 + k] + GP4[(rl * 4 + 1) * 8 + k]) + (GP4[(rl * 4 + 2) * 8 + k] + GP4[(rl * 4 + 3) * 8 + k]);
                unsafeAtomicAdd(BA + (size_t)(brow + rl) * 8 + k, sgate);
            }
        }
    }
};

template <class Epi>
__device__ __forceinline__ void gemm_phase(const bf16_t* __restrict__ A, const bf16_t* __restrict__ Bt, int M, int N, int K, const Epi& epi, int g_wave) {
    bf16_t* shm = reinterpret_cast<bf16_t*>(dyn_lds);
#define SA(b,h) (shm+((b)*2+(h))*HT)
#define SB(b,h) (shm+(4+(b)*2+(h))*HT)
#define STAGE(P,BASE,br,kt) do{const bf16_t* _bp=uniform_ptr((BASE)+((long)(br)*K+(long)(kt)*BK)); \
    __builtin_amdgcn_global_load_lds((const unsigned*)((const char*)_bp+soff0),(unsigned*)((char*)(P)+tidx*16),16,0,0); \
    __builtin_amdgcn_global_load_lds((const unsigned*)((const char*)_bp+soff1),(unsigned*)((char*)(P)+tidx*16+8192),16,0,0);}while(0)
#define LDA(dst,b,h) for(int m=0;m<4;++m)for(int k=0;k<2;++k) \
    dst[m][k]=*reinterpret_cast<const bf16x8*>((char*)SA(b,h)+lds_byte(wr*64+m*16+fr,k*32+fq*8))
#define LDB(dst,b,h) for(int n=0;n<2;++n)for(int k=0;k<2;++k) \
    dst[n][k]=*reinterpret_cast<const bf16x8*>((char*)SB(b,h)+lds_byte(wc*32+n*16+fr,k*32+fq*8))
#define MMA(ai,bj,At,Bt_) do{__builtin_amdgcn_s_setprio(1); \
    for(int m=0;m<4;++m)for(int n=0;n<2;++n)for(int k=0;k<2;++k) \
      acc[ai][bj][m][n]=__builtin_amdgcn_mfma_f32_16x16x32_bf16(Bt_[n][k],At[m][k],acc[ai][bj][m][n],0,0,0); \
    __builtin_amdgcn_s_setprio(0);}while(0)
#define WAIT_V(n) asm volatile("s_waitcnt vmcnt(" #n ")":::"memory")
#define WAIT_L(n) asm volatile("s_waitcnt lgkmcnt(" #n ")":::"memory")
#define BAR __builtin_amdgcn_s_barrier()
#define SCHED __builtin_amdgcn_sched_barrier(0)
    const int nM = M / BM, nN = N / BM, nwg = nM * nN;
    const int tidx = opaque_tid();
    const int wid = tidx >> 6, lane = tidx & 63, wr = wid >> 2, wc = wid & 3, fr = lane & 15, fq = lane >> 4;
    const int nt = K / BK;
    unsigned soff0, soff1;
    { int r_, c_; stage_rc(tidx * 16, r_, c_); soff0 = (unsigned)(r_ * K + c_) * 2u; stage_rc(tidx * 16 + 8192, r_, c_); soff1 = (unsigned)(r_ * K + c_) * 2u; }
    for (int L = blockIdx.x; L < nwg; L += gridDim.x) {
        int wgid = L;
        { int q = nwg / NXCD, r = nwg % NXCD, xcd = wgid % NXCD, off = wgid / NXCD; wgid = (xcd < r ? xcd * (q + 1) : r * (q + 1) + (xcd - r) * q) + off; }
        const int nig = WGM * nN, gid = wgid / nig, fm = gid * WGM, gsz = min(nM - fm, WGM);
        const int pm = fm + ((wgid % nig) % gsz), pn = (wgid % nig) / gsz, brow = pm * BM, bcol = pn * BM;
        f32x4 acc[2][2][4][2] = {};
        bf16x8 At[4][2], B0[2][2], B1[2][2];
        STAGE(SB(0,0),Bt,bcol,0); STAGE(SA(0,0),A,brow,0);
        STAGE(SB(0,1),Bt,bcol+HALF,0); STAGE(SA(0,1),A,brow+HALF,0);
        if(wr==1)BAR;
        WAIT_V(4); BAR;
        STAGE(SB(1,0),Bt,bcol,1); STAGE(SA(1,0),A,brow,1); STAGE(SB(1,1),Bt,bcol+HALF,1);
        WAIT_V(6); BAR;
        for(int t=0;t<nt-2;t+=2){
            LDB(B0,0,0); SCHED; LDA(At,0,0); STAGE(SA(1,1),A,brow+HALF,t+1);
            WAIT_L(8); BAR; WAIT_L(0); MMA(0,0,At,B0); BAR; SCHED;
            LDB(B1,0,1); STAGE(SB(0,0),Bt,bcol,t+2);
            BAR; WAIT_L(0); MMA(0,1,At,B1); BAR;
            LDA(At,0,1); STAGE(SA(0,0),A,brow,t+2);
            BAR; WAIT_L(0); MMA(1,0,At,B0); BAR; SCHED;
            STAGE(SB(0,1),Bt,bcol+HALF,t+2);
            WAIT_V(6); BAR; MMA(1,1,At,B1); BAR;
            LDB(B0,1,0); SCHED; LDA(At,1,0); STAGE(SA(0,1),A,brow+HALF,t+2);
            WAIT_L(8); BAR; WAIT_L(0); MMA(0,0,At,B0); BAR; SCHED;
            LDB(B1,1,1); STAGE(SB(1,0),Bt,bcol,t+3);
            BAR; WAIT_L(0); MMA(0,1,At,B1); BAR;
            LDA(At,1,1); STAGE(SA(1,0),A,brow,t+3);
            BAR; WAIT_L(0); MMA(1,0,At,B0); BAR; SCHED;
            STAGE(SB(1,1),Bt,bcol+HALF,t+3);
            WAIT_V(6); BAR; MMA(1,1,At,B1); BAR;
        }
        { LDB(B0,0,0); LDA(At,0,0); STAGE(SA(1,1),A,brow+HALF,nt-1);
          BAR; WAIT_L(0); MMA(0,0,At,B0); BAR;
          LDB(B1,0,1); BAR; WAIT_L(0); MMA(0,1,At,B1); BAR;
          LDA(At,0,1); WAIT_V(4); BAR; WAIT_L(0); MMA(1,0,At,B0); MMA(1,1,At,B1); BAR; }
        { LDB(B0,1,0); LDA(At,1,0); WAIT_V(2); BAR; WAIT_L(0); MMA(0,0,At,B0); BAR;
          LDB(B1,1,1); WAIT_V(0); BAR; WAIT_L(0); MMA(0,1,At,B1); BAR;
          LDA(At,1,1); BAR; WAIT_L(0); MMA(1,0,At,B0); MMA(1,1,At,B1); BAR; }
        if(wr==0)BAR;
        epi(acc, brow, bcol, wr, wc, fr, fq);
        __syncthreads();
    }
#undef SA
#undef SB
#undef STAGE
#undef LDA
#undef LDB
#undef MMA
}

__device__ __forceinline__ void prep_weights(const Params& p, int part, int vblk, int nvblk, int g_wave) {
    bf16_t* win = reinterpret_cast<bf16_t*>(p.ws + OFF_WIN);
    bf16_t* wout = reinterpret_cast<bf16_t*>(p.ws + OFF_WOUT);
    const int gtid = vblk * 512 + opaque_tid(), gsz = nvblk * 512;
    const int n_in = 128 * NIN;
    for (int i = gtid; i < n_in; i += gsz) {
        const int n = i % NIN, kg = i / NIN, l = part;
        const int rho = n & 31, ncol = (n & ~31) + 8 * ((rho & 15) >> 2) + 4 * (rho >> 4) + (rho & 3);
        const int sc = ncol < 2048 ? ncol : ncol + 8;
        const float* s = p.w_in + (size_t)l * DM * INC + (size_t)(kg * 8) * INC + sc;
        u32x4 w;
        w.x = cvt_pk_bf16(s[0], s[INC]); w.y = cvt_pk_bf16(s[2 * INC], s[3 * INC]);
        w.z = cvt_pk_bf16(s[4 * INC], s[5 * INC]); w.w = cvt_pk_bf16(s[6 * INC], s[7 * INC]);
        *GP(u32x4)(win + ((size_t)l * NIN + n) * DM + kg * 8) = w;
    }
    if (part == 1) {
        const int n_out = 2 * 128 * DM;
        for (int i = gtid; i < n_out; i += gsz) {
            const int n = i % DM, kg = (i / DM) % 128, l = i / (DM * 128);
            const int rho = n & 31, ncol = (n & ~31) + 8 * ((rho & 15) >> 2) + 4 * (rho >> 4) + (rho & 3);
            const float* s = p.w_out + (size_t)l * DM * DM + (size_t)(kg * 8) * DM + ncol;
            u32x4 w;
            w.x = cvt_pk_bf16(s[0], s[DM]); w.y = cvt_pk_bf16(s[2 * DM], s[3 * DM]);
            w.z = cvt_pk_bf16(s[4 * DM], s[5 * DM]); w.w = cvt_pk_bf16(s[6 * DM], s[7 * DM]);
            *GP(u32x4)(wout + ((size_t)l * DM + n) * DM + kg * 8) = w;
        }
    }
}

__device__ __forceinline__ void row_pass(const float* src, bool ln, const float* g, const float* bta, float* dstf, bf16_t* xb, const float* wg  , float* BA, int g_wave) {
    const int tidx = opaque_tid();
    const int lane = tidx & 63;
    const int gw = blockIdx.x * 8 + (tidx >> 6), nw = gridDim.x * 8;
    float* wgs = reinterpret_cast<float*>(dyn_lds);
    if (wg) {
        for (int c = tidx; c < DM; c += 512) {
            const f32x4 w0 = *GPC(f32x4)(wg + (size_t)c * INC), w1 = *GPC(f32x4)(wg + (size_t)c * INC + 4);
            *reinterpret_cast<f32x4*>(wgs + c * 8) = w0; *reinterpret_cast<f32x4*>(wgs + c * 8 + 4) = w1;
        }
    }
    __syncthreads();
    f32x4 gg[4], bb[4];
#pragma unroll
    for (int i = 0; i < 4; ++i) { gg[i] = ln ? *GPC(f32x4)(g + i * 256 + lane * 4) : (f32x4){1.f, 1.f, 1.f, 1.f}; bb[i] = ln ? *GPC(f32x4)(bta + i * 256 + lane * 4) : (f32x4){0.f, 0.f, 0.f, 0.f}; }
    f32x4 nv[4];
    if (gw < NTOK) {
#pragma unroll
        for (int i = 0; i < 4; ++i) nv[i] = *GPC(f32x4)(src + (size_t)gw * DM + i * 256 + lane * 4);
    }
    for (int row = gw; row < NTOK; row += nw) {
        f32x4 v[4];
#pragma unroll
        for (int i = 0; i < 4; ++i) v[i] = nv[i];
        if (row + nw < NTOK) {
#pragma unroll
            for (int i = 0; i < 4; ++i) nv[i] = *GPC(f32x4)(src + (size_t)(row + nw) * DM + i * 256 + lane * 4);
        }
        if (ln) {
            float s = 0.f;
#pragma unroll
            for (int i = 0; i < 4; ++i) s += (v[i][0] + v[i][1]) + (v[i][2] + v[i][3]);
#pragma unroll
            for (int o = 32; o > 0; o >>= 1) s += shx(s, o, lane);
            const float mu = s * (1.0f / DM);
            float q = 0.f;
#pragma unroll
            for (int i = 0; i < 4; ++i) { v[i] = v[i] - mu; q += (v[i][0] * v[i][0] + v[i][1] * v[i][1]) + (v[i][2] * v[i][2] + v[i][3] * v[i][3]); }
#pragma unroll
            for (int o = 32; o > 0; o >>= 1) q += shx(q, o, lane);
            const float rstd = rsqrtf(q * (1.0f / DM) + 1e-5f);
#pragma unroll
            for (int i = 0; i < 4; ++i) v[i] = v[i] * rstd * gg[i] + bb[i];
        }
        if (dstf) {
#pragma unroll
            for (int i = 0; i < 4; ++i) *GP(f32x4)(dstf + (size_t)row * DM + i * 256 + lane * 4) = v[i];
        }
        if (xb) {
#pragma unroll
            for (int i = 0; i < 4; ++i) { u32x2 w; w.x = cvt_pk_bf16(v[i][0], v[i][1]); w.y = cvt_pk_bf16(v[i][2], v[i][3]);
                *GP(u32x2)(xb + (size_t)row * DM + i * 256 + lane * 4) = w; }
        }
        if (wg) {
            float d[8] = {0.f, 0.f, 0.f, 0.f, 0.f, 0.f, 0.f, 0.f};
#pragma unroll
            for (int i = 0; i < 4; ++i)
#pragma unroll
                for (int e = 0; e < 4; ++e) {
                    const float* wp = wgs + (i * 256 + lane * 4 + e) * 8;
                    const f32x4 w0 = *reinterpret_cast<const f32x4*>(wp), w1 = *reinterpret_cast<const f32x4*>(wp + 4);
                    const float xv = v[i][e];
                    d[0] += xv * w0[0]; d[1] += xv * w0[1]; d[2] += xv * w0[2]; d[3] += xv * w0[3];
                    d[4] += xv * w1[0]; d[5] += xv * w1[1]; d[6] += xv * w1[2]; d[7] += xv * w1[3];
                }
#pragma unroll
            for (int j = 0; j < 8; ++j) {
#pragma unroll
                for (int o = 32; o > 0; o >>= 1) d[j] += shx(d[j], o, lane);
            }
            if (lane == 0) {
                *GP(f32x4)(BA + (size_t)row * 8) = (f32x4){d[0], d[1], d[2], d[3]};
                *GP(f32x4)(BA + (size_t)row * 8 + 4) = (f32x4){d[4], d[5], d[6], d[7]};
            }
        }
    }
    __syncthreads();
}

constexpr int GRP_LDS = 73728;
constexpr int L_KRM = 0, L_QRM = 17408, L_KBGT = 34816, L_VBT = 53248, L_GC = 71680, L_BETA = 71936;
__device__ __forceinline__ void chunk_prep(const Params& p_, int l, int g_wave) {
    Params p = p_; p.ws = opaque_ws(p.ws);
    const bf16_t* HA = reinterpret_cast<const bf16_t*>(p.ws + OFF_HA);
    const float* BA = reinterpret_cast<const float*>(p.ws + OFF_BA);
    bf16_t* UT = reinterpret_cast<bf16_t*>(p.ws + OFF_UT);
    bf16_t* W = reinterpret_cast<bf16_t*>(p.ws + OFF_W);
    bf16_t* QD = reinterpret_cast<bf16_t*>(p.ws + OFF_QD);
    bf16_t* KDT = reinterpret_cast<bf16_t*>(p.ws + OFF_KDT);
    bf16_t* QK = reinterpret_cast<bf16_t*>(p.ws + OFF_QK);
    float* GT = reinterpret_cast<float*>(p.ws + OFF_GT);
    const float* cw = p.conv_w + (size_t)l * 4 * 1536;
#define CP_LANEVARS const int tid = opaque_tid(), grp = tid >> 8, gt = tid & 255, lane = tid & 63, wv = gt >> 6, fr = lane & 15, fq = lane >> 4; \
    unsigned char* lds = dyn_lds + grp * GRP_LDS; float* gc_s = reinterpret_cast<float*>(lds + L_GC); float* beta_s = reinterpret_cast<float*>(lds + L_BETA); \
    const int tg = gt >> 4, sg = gt & 15, t0 = tg * 4, c0 = sg * 8; (void)fr; (void)fq; (void)wv; (void)t0; (void)c0; (void)gc_s; (void)beta_s; (void)lane;
    for (int rr = 0; rr < 2; ++rr) {
        const int grp0 = opaque_tid() >> 8;
        const int xcd_ = blockIdx.x & 7, q_ = (blockIdx.x >> 3) + 32 * rr;
        const int hp = q_ & 1, n = (xcd_ & 1) * 32 + (q_ >> 1), b = xcd_ >> 1, h = hp * 2 + grp0;
        const int item = (b * 4 + h) * 64 + n, tok0 = b * SEQ + n * 64;
        u32x4 rawp[3][7];
        { CP_LANEVARS
#pragma unroll
          for (int ten = 0; ten < 3; ++ten)
#pragma unroll
            for (int r = 0; r < 7; ++r) {
                const int tt = n * 64 + t0 - 3 + r;
                rawp[ten][r] = mk4(0u, 0u, 0u, 0u);
                if (tt >= 0) rawp[ten][r] = *GPC(u32x4)(HA + (size_t)(b * SEQ + tt) * HA_LD + ten * 512 + h * 128 + c0);
            } }
        { CP_LANEVARS
        if (wv == 0) {
            const float bv = *GPC(float)(BA + (size_t)(tok0 + lane) * 8 + h), av = *GPC(float)(BA + (size_t)(tok0 + lane) * 8 + 4 + h);
            const float beta = __builtin_amdgcn_rcpf(1.0f + __expf(-bv));
            const float xx = av + p.dt_bias[l * 4 + h];
            const float sp = fmaxf(xx, 0.f) + log1pf(__expf(-fabsf(xx)));
            float gv = -__expf(p.a_log[l * 4 + h]) * sp;
#pragma unroll
            for (int o = 1; o < 64; o <<= 1) { const float t = __int_as_float(__builtin_amdgcn_ds_bpermute((lane - o) << 2, __float_as_int(gv))); if (lane >= o) gv += t; }
            gc_s[lane] = gv; beta_s[lane] = beta;
            if (lane == 63) *GP(float)(GT + item) = __expf(gv);
        } }
        __syncthreads();
        {
            CP_LANEVARS
            const float glast = gc_s[63];
            float eg[4], ek[4], be[4];
#pragma unroll
            for (int i = 0; i < 4; ++i) { const float gci = gc_s[t0 + i]; eg[i] = __expf(gci); ek[i] = __expf(glast - gci); be[i] = beta_s[t0 + i]; }
#pragma unroll
            for (int ten = 0; ten < 3; ++ten) {
                __builtin_amdgcn_sched_barrier(0);
                float raw[7][8];
#pragma unroll
                for (int r = 0; r < 7; ++r) {
                    const u32x4 u = rawp[ten][r];
                    raw[r][0] = bf_lo(u.x); raw[r][1] = bf_hi(u.x); raw[r][2] = bf_lo(u.y); raw[r][3] = bf_hi(u.y);
                    raw[r][4] = bf_lo(u.z); raw[r][5] = bf_hi(u.z); raw[r][6] = bf_lo(u.w); raw[r][7] = bf_hi(u.w);
                }
                float o[4][8];
#pragma unroll
                for (int i = 0; i < 4; ++i)
#pragma unroll
                    for (int c = 0; c < 8; ++c) o[i][c] = 0.f;
#pragma unroll
                for (int j = 0; j < 4; ++j) {
                    const float* wp = cw + (size_t)j * 1536 + ten * 512 + h * 128 + c0;
                    const f32x4 a = *GPC(f32x4)(wp), c4 = *GPC(f32x4)(wp + 4);
                    const float wj[8] = {a[0], a[1], a[2], a[3], c4[0], c4[1], c4[2], c4[3]};
#pragma unroll
                    for (int i = 0; i < 4; ++i)
#pragma unroll
                        for (int c = 0; c < 8; ++c) o[i][c] += wj[c] * raw[i + j][c];
                }
#pragma unroll
                for (int i = 0; i < 4; ++i)
#pragma unroll
                    for (int c = 0; c < 8; ++c) o[i][c] = silu_f(o[i][c]);
                if (ten < 2) {
#pragma unroll
                    for (int i = 0; i < 4; ++i) {
                        float sq = 0.f;
#pragma unroll
                        for (int c = 0; c < 8; ++c) sq += o[i][c] * o[i][c];
                        sq = row_sum16(sq);
                        const float rq = rsqrtf(sq + 1e-6f) * (ten == 0 ? 0.08838834764831845f : 1.0f);
#pragma unroll
                        for (int c = 0; c < 8; ++c) o[i][c] *= rq;
                    }
                }
                if (ten == 0) {
#pragma unroll
                    for (int i = 0; i < 4; ++i) {
                        u32x4 w;
                        w.x = cvt_pk_bf16(o[i][0] * eg[i], o[i][1] * eg[i]); w.y = cvt_pk_bf16(o[i][2] * eg[i], o[i][3] * eg[i]);
                        w.z = cvt_pk_bf16(o[i][4] * eg[i], o[i][5] * eg[i]); w.w = cvt_pk_bf16(o[i][6] * eg[i], o[i][7] * eg[i]);
                        { const int t_ = t0 + i; *GP(u32x4)(QD + ((((size_t)item * 4 + (t_ >> 4)) * 4 + (sg >> 2)) * 64 + (t_ & 15) + 16 * (sg & 3)) * 8) = w; }
                        w.x = cvt_pk_bf16(o[i][0], o[i][1]); w.y = cvt_pk_bf16(o[i][2], o[i][3]); w.z = cvt_pk_bf16(o[i][4], o[i][5]); w.w = cvt_pk_bf16(o[i][6], o[i][7]);
                        *reinterpret_cast<u32x4*>(lds + L_QRM + ((t0 + i) * 136 + c0) * 2) = w;
                    }
                } else if (ten == 1) {
#pragma unroll
                    for (int i = 0; i < 4; ++i) {
                        u32x4 w;
                        w.x = cvt_pk_bf16(o[i][0], o[i][1]); w.y = cvt_pk_bf16(o[i][2], o[i][3]); w.z = cvt_pk_bf16(o[i][4], o[i][5]); w.w = cvt_pk_bf16(o[i][6], o[i][7]);
                        *reinterpret_cast<u32x4*>(lds + L_KRM + ((t0 + i) * 136 + c0) * 2) = w;
                    }
#pragma unroll
                    for (int c = 0; c < 8; ++c) {
                        u32x2 w;
                        w.x = cvt_pk_bf16(o[0][c] * ek[0], o[1][c] * ek[1]); w.y = cvt_pk_bf16(o[2][c] * ek[2], o[3][c] * ek[3]);
                        { const int dk_ = c0 + c; *GP(u32x2)(KDT + ((((size_t)item * 8 + (dk_ >> 4)) * 2 + (t0 >> 5)) * 64 + (dk_ & 15) + 16 * ((t0 & 31) >> 3)) * 8 + ((t0 & 7) >> 2) * 4) = w; }
                        w.x = cvt_pk_bf16(o[0][c] * be[0] * eg[0], o[1][c] * be[1] * eg[1]); w.y = cvt_pk_bf16(o[2][c] * be[2] * eg[2], o[3][c] * be[3] * eg[3]);
                        *reinterpret_cast<u32x2*>(lds + L_KBGT + ((c0 + c) * 72 + t0) * 2) = w;
                    }
                } else {
#pragma unroll
                    for (int c = 0; c < 8; ++c) {
                        u32x2 w;
                        w.x = cvt_pk_bf16(o[0][c] * be[0], o[1][c] * be[1]); w.y = cvt_pk_bf16(o[2][c] * be[2], o[3][c] * be[3]);
                        *reinterpret_cast<u32x2*>(lds + L_VBT + ((c0 + c) * 72 + t0) * 2) = w;
                    }
                }
            }
        }
        __syncthreads();
        {
            CP_LANEVARS
            const int ib = wv;
            f32x4 kk[4], qk[4];
#pragma unroll
            for (int jb = 0; jb < 4; ++jb) { kk[jb] = (f32x4){0.f, 0.f, 0.f, 0.f}; qk[jb] = (f32x4){0.f, 0.f, 0.f, 0.f}; }
            bf16x8 ki[4], qi[4];
#pragma unroll
            for (int ks = 0; ks < 4; ++ks) {
                ki[ks] = lds8(lds + L_KRM + ((ib * 16 + fr) * 136 + ks * 32 + fq * 8) * 2);
                qi[ks] = lds8(lds + L_QRM + ((ib * 16 + fr) * 136 + ks * 32 + fq * 8) * 2);
            }
#pragma unroll
            for (int jb = 0; jb < 4; ++jb) {
                if (jb <= ib) {
#pragma unroll
                    for (int ks = 0; ks < 4; ++ks) {
                        const bf16x8 kj = lds8(lds + L_KRM + ((jb * 16 + fr) * 136 + ks * 32 + fq * 8) * 2);
                        kk[jb] = mfma16(ki[ks], kj, kk[jb]);
                        qk[jb] = mfma16(kj, qi[ks], qk[jb]);
                    }
                }
            }
            __syncthreads();
            float* AP = reinterpret_cast<float*>(lds + L_KRM);
#pragma unroll
            for (int jb = 0; jb < 4; ++jb) {
                if (jb <= ib) {
                    const int j = jb * 16 + fr, i0 = ib * 16 + fq * 4;
                    const float gj = gc_s[j];
#pragma unroll
                    for (int r = 0; r < 4; ++r) {
                        const int i = i0 + r;
                        const float dec = __expf(fminf(gc_s[i] - gj, 0.f));
                        float av_ = (i > j) ? kk[jb][r] * beta_s[i] * dec : 0.f;
                        AP[j * 64 + r * 16 + ib * 4 + fq] = av_;
                    }
                }
                {
                    const int i = ib * 16 + fr, j0 = jb * 16 + fq * 4;
                    const float gi = gc_s[i];
                    float o[4];
#pragma unroll
                    for (int r = 0; r < 4; ++r) {
                        const int j = j0 + r;
                        const float dec = __expf(fminf(gi - gc_s[j], 0.f));
                        o[r] = (i >= j) ? qk[jb][r] * dec : 0.f;
                    }
                    u32x2 w; w.x = cvt_pk_bf16(o[0], o[1]); w.y = cvt_pk_bf16(o[2], o[3]);
                    *GP(u32x2)(QK + ((((size_t)item * 4 + ib) * 2 + (jb >> 1)) * 64 + fr + 16 * ((jb & 1) * 2 + (fq >> 1))) * 8 + (fq & 1) * 4) = w;
                }
            }
        }
        __syncthreads();
        {
            CP_LANEVARS
            const float* AP = reinterpret_cast<const float*>(lds + L_KRM);
            const int cbk = grp ? 3 - wv : wv;
            const int cl = lane >> 2, pp = lane & 3, ccol = cbk * 16 + cl;
            float a[16];
#pragma unroll
            for (int k = 0; k < 16; ++k) a[k] = (4 * k + pp == ccol) ? 1.f : 0.f;
#define INV_STEP(SS) { const int j = jq * 4 + SS; \
                    const float tj = __int_as_float(__builtin_amdgcn_update_dpp(0, __float_as_int(a[jq]), SS * 0x55, 0xf, 0xf, false)); \
                    const float* ap = AP + j * 64 + pp * 16; \
                    _Pragma("unroll") for (int k = jq; k < 16; ++k) a[k] -= ap[k] * tj; }
#pragma unroll
            for (int jq = 0; jq < 16; ++jq) {
                __builtin_amdgcn_sched_barrier(0);
                if (jq >= cbk * 4) {
                    INV_STEP(0) INV_STEP(1) INV_STEP(2)
                    if (jq < 15) INV_STEP(3)
                }
            }
#undef INV_STEP
            bf16_t* TR = reinterpret_cast<bf16_t*>(lds + L_QRM);
#pragma unroll
            for (int k = 0; k < 16; ++k) TR[(4 * k + pp) * 72 + ccol] = (bf16_t)(cvt_pk_bf16(a[k], 0.f) & 0xffffu);
        }
        __syncthreads();
        {
            CP_LANEVARS
            bf16x8 tf[2];
#pragma unroll
            for (int ks = 0; ks < 2; ++ks) tf[ks] = lds8(lds + L_QRM + ((wv * 16 + fr) * 72 + ks * 32 + fq * 8) * 2);
#pragma unroll
            for (int db = 0; db < 8; ++db) {
                f32x4 au = (f32x4){0.f, 0.f, 0.f, 0.f}, aw = (f32x4){0.f, 0.f, 0.f, 0.f};
#pragma unroll
                for (int ks = 0; ks < 2; ++ks) {
                    const bf16x8 vb = lds8(lds + L_VBT + ((db * 16 + fr) * 72 + ks * 32 + fq * 8) * 2);
                    const bf16x8 kb = lds8(lds + L_KBGT + ((db * 16 + fr) * 72 + ks * 32 + fq * 8) * 2);
                    au = mfma16(tf[ks], vb, au);
                    aw = mfma16(kb, tf[ks], aw);
                }
                u32x2 w; w.x = cvt_pk_bf16(au[0], au[1]); w.y = cvt_pk_bf16(au[2], au[3]);
                *GP(u32x2)(UT + ((((size_t)item * 8 + db) * 2 + (wv >> 1)) * 64 + fr + 16 * ((wv & 1) * 2 + (fq >> 1))) * 8 + (fq & 1) * 4) = w;
                w.x = cvt_pk_bf16(aw[0], aw[1]); w.y = cvt_pk_bf16(aw[2], aw[3]);
                *GP(u32x2)(W + ((((size_t)item * 4 + wv) * 4 + (db >> 1)) * 64 + fr + 16 * ((db & 1) * 2 + (fq >> 1))) * 8 + (fq & 1) * 4) = w;
            }
        }
        __syncthreads();
    }
}

__device__ __forceinline__ void delta_scan(const Params& p_, int blk, int g_wave) {
    Params p = p_; p.ws = opaque_ws(p.ws);
    const int tid = opaque_tid(), lane = tid & 63, w = tid >> 6, fr = lane & 15, fq = lane >> 4;
    const int bh = ((blk & 7) >> 1) * 4 + ((blk & 7) & 1) * 2 + ((blk >> 3) & 1), sl = blk >> 4, dv0 = sl * 32;
    bf16_t* ST = reinterpret_cast<bf16_t*>(p.ws + OFF_HA);
    bf16_t* UT = reinterpret_cast<bf16_t*>(p.ws + OFF_UT);
    const bf16_t* W = reinterpret_cast<const bf16_t*>(p.ws + OFF_W);
    const bf16_t* KDT = reinterpret_cast<const bf16_t*>(p.ws + OFF_KDT);
    const float* GT = reinterpret_cast<const float*>(p.ws + OFF_GT);
    unsigned char* STL = dyn_lds;
    unsigned char* VTL = dyn_lds + 8704;
    unsigned char* DMY = dyn_lds + 13312;
    unsigned char* RING = dyn_lds + 16384;
    (void)dv0;
#define LDS_BAR() do { asm volatile("s_waitcnt lgkmcnt(0)" ::: "memory"); __builtin_amdgcn_s_barrier(); asm volatile("" ::: "memory"); } while (0)
    if (w >= 4) {
        constexpr int PD = 10;
        const int hw = w - 4, pl = hw * 64 + lane;
#define RING_LOAD(C) do { const int c_ = (C) < 64 ? (C) : 63; const int slot_ = (C) & 3; \
            const bf16_t* wsrc = W + (size_t)(bh * 64 + c_) * 8192 + (hw * 4) * 512 + lane * 8; \
            const bf16_t* ksrc = KDT + (size_t)(bh * 64 + c_) * 8192 + (hw * 4) * 512 + lane * 8; \
            _Pragma("unroll") for (int j = 0; j < 4; ++j) { \
                __builtin_amdgcn_global_load_lds((const unsigned*)(wsrc + j * 512), (unsigned*)(RING + slot_ * 32768 + (hw * 4 + j) * 1024), 16, 0, 0); \
                __builtin_amdgcn_global_load_lds((const unsigned*)(ksrc + j * 512), (unsigned*)(RING + slot_ * 32768 + 16384 + (hw * 4 + j) * 1024), 16, 0, 0); } } while (0)
#define TOUCH(C) do { const int c_ = (C) < 64 ? (C) : 63; const int item_ = bh * 64 + c_; \
            const int li = sl * 32 + (lane & 31); \
            const unsigned char* a0 = (hw == 0) ? ((lane < 32) ? reinterpret_cast<const unsigned char*>(W + (size_t)item_ * 8192) + li * 128 \
                                                               : reinterpret_cast<const unsigned char*>(KDT + (size_t)item_ * 8192) + li * 128) \
                                                : reinterpret_cast<const unsigned char*>(UT + ((size_t)item_ * 8 + sl * 2) * 1024) + (lane & 31) * 128; \
            __builtin_amdgcn_global_load_lds((const unsigned*)a0, (unsigned*)(DMY + hw * 256), 4, 0, 0); } while (0)
        for (int c = 0; c < PD; ++c) TOUCH(c);
        RING_LOAD(0); RING_LOAD(1); RING_LOAD(2);
        asm volatile("s_waitcnt vmcnt(0)" ::: "memory");
        __syncthreads();
        for (int n = 0; n < 64; ++n) {
            const int item = bh * 64 + n;
            __builtin_amdgcn_s_barrier();
            {
                const int dvb_ = pl >> 7, ks_ = (pl >> 6) & 1, l_ = pl & 63;
                const u32x4 v = *reinterpret_cast<const u32x4*>(VTL + ((dvb_ * 16 + (l_ & 15)) * 72 + ks_ * 32 + (l_ >> 4) * 8) * 2);
                *GP(u32x4)(UT + (((size_t)item * 8 + sl * 2) * 128 + pl) * 8) = v;
            }
            asm volatile("s_waitcnt vmcnt(14) lgkmcnt(0)" ::: "memory");
            __builtin_amdgcn_s_barrier();
            {
                bf16_t* dst = (n < 63) ? ST + (((size_t)(item + 1) * 8 + sl * 2) * 256) * 8 : ST + (size_t)1024 * 16384 + (size_t)blk * 4096;
#pragma unroll
                for (int j = 0; j < 2; ++j) {
                    const int q = pl + 256 * j, dvb_ = q >> 8, ks_ = (q >> 6) & 3, l_ = q & 63;
                    const u32x4 v = *reinterpret_cast<const u32x4*>(STL + ((dvb_ * 16 + (l_ & 15)) * 136 + ks_ * 32 + (l_ >> 4) * 8) * 2);
                    *GP(u32x4)(dst + (size_t)q * 8) = v;
                }
            }
            RING_LOAD(n + 3);
            TOUCH(n + PD);
            asm volatile("s_waitcnt lgkmcnt(0)" ::: "memory");
        }
        asm volatile("s_waitcnt vmcnt(0)" ::: "memory");
#undef RING_LOAD
#undef TOUCH
    } else {
        f32x4 S[2][2];
#pragma unroll
        for (int kb = 0; kb < 2; ++kb)
#pragma unroll
            for (int db = 0; db < 2; ++db) {
                S[kb][db] = (f32x4){0.f, 0.f, 0.f, 0.f};
                const u32x2 z = mk2(0u, 0u);
                *reinterpret_cast<u32x2*>(STL + ((db * 16 + fr) * 136 + (2 * w + kb) * 16 + fq * 4) * 2) = z;
                *GP(u32x2)(ST + (((size_t)(bh * 64) * 8 + sl * 2) * 256) * 8 + (size_t)(((kb * 2 + db) * 256 + w * 64 + lane)) * 4) = z;
            }
        __syncthreads();
#define SCAN_LOAD(NN, UB, GTV) do { const int item_ = bh * 64 + (NN); \
        _Pragma("unroll") for (int db = 0; db < 2; ++db) UB[db] = *GPC(u32x2)(UT + ((((size_t)item_ * 8 + sl * 2 + db) * 2 + (w >> 1)) * 64 + fr + 16 * ((w & 1) * 2 + (fq >> 1))) * 8 + (fq & 1) * 4); \
        GTV = *GPC(float)(GT + item_); } while (0)
        u32x2 ubA[2], ubB[2], ubC[2]; float gtA, gtB, gtC;
        SCAN_LOAD(0, ubA, gtA); SCAN_LOAD(1, ubB, gtB);
#define SCAN_STEP(N_, UB, GTV, NUB, NGT) do { \
        const int n = (N_); \
        { const int nn = n + 2 < 64 ? n + 2 : 63; SCAN_LOAD(nn, NUB, NGT); } \
        const unsigned char* slot = RING + (n & 3) * 32768; \
        { bf16x8 sb_[2][4], wf_[4]; \
          _Pragma("unroll") for (int ks = 0; ks < 4; ++ks) wf_[ks] = lds8(slot + ((w * 4 + ks) * 64 + lane) * 16); \
          _Pragma("unroll") for (int db = 0; db < 2; ++db) _Pragma("unroll") for (int ks = 0; ks < 4; ++ks) sb_[db][ks] = lds8(STL + ((db * 16 + fr) * 136 + ks * 32 + fq * 8) * 2); \
          f32x4 a10 = (f32x4){0.f, 0.f, 0.f, 0.f}, a11 = (f32x4){0.f, 0.f, 0.f, 0.f}; \
          _Pragma("unroll") for (int ks = 0; ks < 4; ++ks) { a10 = mfma16(wf_[ks], sb_[0][ks], a10); a11 = mfma16(wf_[ks], sb_[1][ks], a11); } \
          _Pragma("unroll") for (int db = 0; db < 2; ++db) { \
              const f32x4 a1 = db ? a11 : a10; u32x2 vw; \
              vw.x = cvt_pk_bf16(bf_lo(UB[db].x) - a1[0], bf_hi(UB[db].x) - a1[1]); vw.y = cvt_pk_bf16(bf_lo(UB[db].y) - a1[2], bf_hi(UB[db].y) - a1[3]); \
              *reinterpret_cast<u32x2*>(VTL + ((db * 16 + fr) * 72 + w * 16 + fq * 4) * 2) = vw; \
              } } \
        LDS_BAR(); \
        { bf16x8 vb_[2][2], kf_[2][2]; \
          _Pragma("unroll") for (int kb = 0; kb < 2; ++kb) _Pragma("unroll") for (int ks = 0; ks < 2; ++ks) kf_[kb][ks] = lds8(slot + 16384 + (((2 * w + kb) * 2 + ks) * 64 + lane) * 16); \
          _Pragma("unroll") for (int db = 0; db < 2; ++db) _Pragma("unroll") for (int ks = 0; ks < 2; ++ks) vb_[db][ks] = lds8(VTL + ((db * 16 + fr) * 72 + ks * 32 + fq * 8) * 2); \
          _Pragma("unroll") for (int kb = 0; kb < 2; ++kb) _Pragma("unroll") for (int db = 0; db < 2; ++db) { \
              f32x4 a2 = S[kb][db] * GTV; \
              a2 = mfma16(kf_[kb][0], vb_[db][0], a2); a2 = mfma16(kf_[kb][1], vb_[db][1], a2); \
              S[kb][db] = a2; \
              if (n < 63) { \
                  u32x2 sw; sw.x = cvt_pk_bf16(a2[0], a2[1]); sw.y = cvt_pk_bf16(a2[2], a2[3]); \
                  *reinterpret_cast<u32x2*>(STL + ((db * 16 + fr) * 136 + (2 * w + kb) * 16 + fq * 4) * 2) = sw; \
              } } } \
        LDS_BAR(); } while (0)
        for (int n3 = 0; n3 < 63; n3 += 3) {
            SCAN_STEP(n3 + 0, ubA, gtA, ubC, gtC);
            SCAN_STEP(n3 + 1, ubB, gtB, ubA, gtA);
            SCAN_STEP(n3 + 2, ubC, gtC, ubB, gtB);
        }
        SCAN_STEP(63, ubA, gtA, ubC, gtC);
#undef SCAN_STEP
#undef SCAN_LOAD
    }
#undef LDS_BAR
}

__device__ __forceinline__ void swa_phase(const Params& p_, int l, int sblk, int nsb, int g_wave) {
    Params p = p_; p.ws = opaque_ws(p.ws);
    const int tid = opaque_tid(), lane = tid & 63, w = tid >> 6, fr = lane & 15, fq = lane >> 4;
    const bf16_t* HB = reinterpret_cast<const bf16_t*>(p.ws + OFF_HB);
    bf16_t* YM = reinterpret_cast<bf16_t*>(p.ws + OFF_XB);
    unsigned char* VTS = dyn_lds;
    unsigned char* KSL = dyn_lds + 21504;
    const int sw_xcd = sblk & 7, sw_j = sblk >> 3, sw_n = nsb >> 3;
    for (int qi = sw_j; qi < 128; qi += sw_n) {
        const int b = sw_xcd >> 1, kvh = qi & 1, qt = (sw_xcd & 1) * 64 + (qi >> 1), q0 = qt * 32, kbase = q0 - 128;
        for (int idx = tid; idx < 1280; idx += 512) {
            const int key = idx >> 3, sg = idx & 7, kp = kbase + key;
            u32x4 u = mk4(0u, 0u, 0u, 0u);
            if (kp >= 0) u = *GPC(u32x4)(HB + (size_t)(b * SEQ + kp) * HB_LD + HB_KB + kvh * 64 + sg * 8);
            *reinterpret_cast<u32x4*>(KSL + (key * 72 + sg * 8) * 2) = u;
        }
        if (tid < 320) {
            const int kg = tid >> 3, sg = tid & 7;
            u32x4 u[4];
#pragma unroll
            for (int k = 0; k < 4; ++k) {
                const int kp = kbase + kg * 4 + k;
                u[k] = mk4(0u, 0u, 0u, 0u);
                if (kp >= 0) u[k] = *GPC(u32x4)(HB + (size_t)(b * SEQ + kp) * HB_LD + HB_VB + kvh * 64 + sg * 8);
            }
#pragma unroll
            for (int dp = 0; dp < 4; ++dp) {
                u32x2 lo, hi;
                lo.x = (u[0][dp] & 0xffffu) | (u[1][dp] << 16); lo.y = (u[2][dp] & 0xffffu) | (u[3][dp] << 16);
                hi.x = (u[0][dp] >> 16) | (u[1][dp] & 0xffff0000u); hi.y = (u[2][dp] >> 16) | (u[3][dp] & 0xffff0000u);
                *reinterpret_cast<u32x2*>(VTS + ((sg * 8 + dp * 2) * 168 + kg * 4) * 2) = lo;
                *reinterpret_cast<u32x2*>(VTS + ((sg * 8 + dp * 2 + 1) * 168 + kg * 4) * 2) = hi;
            }
        }
        const int g = w >> 1, sub = w & 1, qs = q0 + sub * 16, hq = kvh * 4 + g;
        const float slope = exp2f(-(float)(hq + 1)), sink = p.sinks[l * 8 + hq];
        bf16x8 qf[2];
#pragma unroll
        for (int ks = 0; ks < 2; ++ks) qf[ks] = ldg8(HB + (size_t)(b * SEQ + qs + fr) * HB_LD + HB_QB + hq * 64 + ks * 32 + fq * 8);
        __syncthreads();
        f32x4 sc[10];
#pragma unroll
        for (int kt = 0; kt < 10; ++kt) {
            const unsigned char* kr = KSL + ((kt * 16 + fr) * 72 + fq * 8) * 2;
            f32x4 a = (f32x4){0.f, 0.f, 0.f, 0.f};
            a = mfma16(lds8(kr), qf[0], a);
            a = mfma16(lds8(kr + 64), qf[1], a);
            sc[kt] = a;
        }
        const int qpos = qs + fr;
        float m = -1e30f;
#pragma unroll
        for (int kt = 0; kt < 10; ++kt)
#pragma unroll
            for (int r = 0; r < 4; ++r) {
                const int kpos = kbase + kt * 16 + fq * 4 + r, dist = qpos - kpos;
                const bool valid = (dist >= 0) && (dist < 128) && (kpos >= 0);
                const float s = valid ? sc[kt][r] * 0.125f - slope * (float)dist : -1e30f;
                sc[kt][r] = s; m = fmaxf(m, s);
            }
        m = fmaxf(m, shx(m, 16, lane)); m = fmaxf(m, shx(m, 32, lane));
        m = fmaxf(m, sink);
        float lsum = 0.f;
#pragma unroll
        for (int kt = 0; kt < 10; ++kt)
#pragma unroll
            for (int r = 0; r < 4; ++r) { const float e = __expf(sc[kt][r] - m); sc[kt][r] = e; lsum += e; }
        lsum += shx(lsum, 16, lane); lsum += shx(lsum, 32, lane);
        lsum += __expf(sink - m);
        const float inv = __builtin_amdgcn_rcpf(lsum);
        f32x4 o[4];
#pragma unroll
        for (int db = 0; db < 4; ++db) o[db] = (f32x4){0.f, 0.f, 0.f, 0.f};
#pragma unroll
        for (int j = 0; j < 5; ++j) {
            union { bf16x8 v; unsigned u[4]; } pf;
            pf.u[0] = cvt_pk_bf16(sc[2 * j][0], sc[2 * j][1]); pf.u[1] = cvt_pk_bf16(sc[2 * j][2], sc[2 * j][3]);
            pf.u[2] = cvt_pk_bf16(sc[2 * j + 1][0], sc[2 * j + 1][1]); pf.u[3] = cvt_pk_bf16(sc[2 * j + 1][2], sc[2 * j + 1][3]);
#pragma unroll
            for (int db = 0; db < 4; ++db) {
                union { bf16x8 v; u32x2 h[2]; } vf;
                const unsigned char* vr = VTS + ((db * 16 + fr) * 168 + (2 * j) * 16 + fq * 4) * 2;
                vf.h[0] = *reinterpret_cast<const u32x2*>(vr);
                vf.h[1] = *reinterpret_cast<const u32x2*>(vr + 32);
                o[db] = mfma16(vf.v, pf.v, o[db]);
            }
        }
        {
            const size_t tok = (size_t)(b * SEQ + qs + fr);
#pragma unroll
            for (int db = 0; db < 4; ++db) {
                const int col = hq * 64 + db * 16 + fq * 4;
                const u32x2 z = *GPC(u32x2)(HB + tok * HB_LD + HB_ZB + col);
                u32x2 y;
                y.x = cvt_pk_bf16(o[db][0] * inv * silu_f(bf_lo(z.x)), o[db][1] * inv * silu_f(bf_hi(z.x)));
                y.y = cvt_pk_bf16(o[db][2] * inv * silu_f(bf_lo(z.y)), o[db][3] * inv * silu_f(bf_hi(z.y)));
                *GP(u32x2)(YM + tok * DM + 512 + col) = y;
            }
        }
        __syncthreads();
    }
}

__device__ __forceinline__ void delta_out(const Params& p_, int l, int g_wave) {
    Params p = p_; p.ws = opaque_ws(p.ws);
    const int tid = opaque_tid(), grp = tid >> 8, lane = tid & 63, wv = (tid & 255) >> 6, fr = lane & 15, fq = lane >> 4;
    const bf16_t* ST = reinterpret_cast<const bf16_t*>(p.ws + OFF_HA);
    const bf16_t* VT = reinterpret_cast<const bf16_t*>(p.ws + OFF_UT);
    const bf16_t* QD = reinterpret_cast<const bf16_t*>(p.ws + OFF_QD);
    const bf16_t* QK = reinterpret_cast<const bf16_t*>(p.ws + OFF_QK);
    const bf16_t* HB = reinterpret_cast<const bf16_t*>(p.ws + OFF_HB);
    bf16_t* YM = reinterpret_cast<bf16_t*>(p.ws + OFF_XB);
    const float* nw = p.norm_w + l * 128;
    for (int rr = 0; rr < 2; ++rr) {
        const int xcd_ = blockIdx.x & 7, q_ = (blockIdx.x >> 3) + 32 * rr;
        const int b = xcd_ >> 1, n = (xcd_ & 1) * 32 + (q_ >> 1), h = (q_ & 1) * 2 + grp, item = (b * 4 + h) * 64 + n;
        const int tok = b * SEQ + n * 64 + wv * 16 + fr;
        bf16x8 qd[4], qk[2];
#pragma unroll
        for (int ks = 0; ks < 4; ++ks) qd[ks] = ldg8(QD + ((((size_t)item * 4 + wv) * 4 + ks) * 64 + lane) * 8);
#pragma unroll
        for (int ks = 0; ks < 2; ++ks) qk[ks] = ldg8(QK + ((((size_t)item * 4 + wv) * 2 + ks) * 64 + lane) * 8);
        u32x2 zz[8];
#pragma unroll
        for (int db = 0; db < 8; ++db) zz[db] = *GPC(u32x2)(HB + (size_t)tok * HB_LD + HB_ZA + h * 128 + db * 16 + fq * 4);
        f32x4 o[8];
        float ss = 0.f;
        bf16x8 sfA[4], vfA[2], sfB[4], vfB[2];
#define DO_LOAD(DB, SF, VF) do { const bf16_t* sp = ST + ((((size_t)item * 8 + (DB)) * 4) * 64 + lane) * 8; const bf16_t* vp = VT + ((((size_t)item * 8 + (DB)) * 2) * 64 + lane) * 8; \
            _Pragma("unroll") for (int ks = 0; ks < 4; ++ks) SF[ks] = ldg8(sp + ks * 512); \
            _Pragma("unroll") for (int ks = 0; ks < 2; ++ks) VF[ks] = ldg8(vp + ks * 512); } while (0)
#define DO_MMA(DB, SF, VF) do { f32x4 a = (f32x4){0.f, 0.f, 0.f, 0.f}; \
            _Pragma("unroll") for (int ks = 0; ks < 4; ++ks) a = mfma16(SF[ks], qd[ks], a); \
            _Pragma("unroll") for (int ks = 0; ks < 2; ++ks) a = mfma16(VF[ks], qk[ks], a); \
            o[DB] = a; ss += (a[0] * a[0] + a[1] * a[1]) + (a[2] * a[2] + a[3] * a[3]); } while (0)
        DO_LOAD(0, sfA, vfA); DO_LOAD(1, sfB, vfB);
#pragma unroll
        for (int db = 0; db < 8; db += 2) {
            DO_MMA(db, sfA, vfA);
            if (db + 2 < 8) DO_LOAD(db + 2, sfA, vfA);
            DO_MMA(db + 1, sfB, vfB);
            if (db + 3 < 8) DO_LOAD(db + 3, sfB, vfB);
        }
#undef DO_LOAD
#undef DO_MMA
        ss += shx(ss, 16, lane); ss += shx(ss, 32, lane);
        const float rs = rsqrtf(ss * (1.0f / 128.0f) + 1e-6f);
#pragma unroll
        for (int db = 0; db < 8; ++db) {
            const int dv = db * 16 + fq * 4;
            const f32x4 nv = *GPC(f32x4)(nw + dv);
            const u32x2 z = zz[db];
            u32x2 y;
            y.x = cvt_pk_bf16(o[db][0] * rs * nv[0] * silu_f(bf_lo(z.x)), o[db][1] * rs * nv[1] * silu_f(bf_hi(z.x)));
            y.y = cvt_pk_bf16(o[db][2] * rs * nv[2] * silu_f(bf_lo(z.y)), o[db][3] * rs * nv[3] * silu_f(bf_hi(z.y)));
            *GP(u32x2)(YM + (size_t)tok * DM + h * 128 + dv) = y;
        }
    }
}


__global__ void __launch_bounds__(512) fwd_megakernel(Params p) {
    __shared__ u32x4 xb_words;
    const int g_wave = __builtin_amdgcn_readfirstlane((int)(threadIdx.x >> 6));
    if (xb_t0(g_wave)) xb_words = mk4(0u, 0u, 0u, 0u);
    __syncthreads();
    XcdBarrier gb = xcd_barrier_post(reinterpret_cast<unsigned*>(p.ws + OFF_BAR), (volatile LAS unsigned*)&xb_words, g_wave);

    prep_weights(p, 0, blockIdx.x, gridDim.x, g_wave);
    row_pass(p.x, false, nullptr, nullptr, nullptr, reinterpret_cast<bf16_t*>(p.ws + OFF_XB), p.w_in + 2048, reinterpret_cast<float*>(p.ws + OFF_BA), g_wave);
    xcd_barrier(gb);
    for (int l = 0; l < 2; ++l) {
        unsigned char* wsl = opaque_ws(p.ws);
        bf16_t* XB = reinterpret_cast<bf16_t*>(wsl + OFF_XB);
        float* BA = reinterpret_cast<float*>(wsl + OFF_BA);
        {
            EpiH e; e.ha = reinterpret_cast<bf16_t*>(p.ws + OFF_HA); e.hb = reinterpret_cast<bf16_t*>(p.ws + OFF_HB);
            gemm_phase(XB, reinterpret_cast<const bf16_t*>(p.ws + OFF_WIN) + (size_t)l * NIN * DM, NTOK, NIN, DM, e, g_wave);
            if (l == 0 && blockIdx.x >= 64) prep_weights(p, 1, blockIdx.x - 64, gridDim.x - 64, g_wave);
        }
        xcd_barrier(gb);
        chunk_prep(p, l, g_wave);
        xcd_barrier(gb);
        if (blockIdx.x < 64) delta_scan(p, blockIdx.x, g_wave);
        else swa_phase(p, l, blockIdx.x - 64, gridDim.x - 64, g_wave);
        xcd_barrier(gb);
        if (l == 0) { const int t_ = opaque_tid(); float zf_ = 0.f; asm volatile("" : "+v"(zf_)); for (int i = blockIdx.x * 512 + t_; i < NTOK * 2; i += gridDim.x * 512) *GP(f32x4)(BA + (size_t)i * 4) = (f32x4){zf_, zf_, zf_, zf_}; }
        delta_out(p, l, g_wave);
        xcd_barrier(gb);
        {
            EpiLN e; e.xres = (l == 0) ? p.x : p.out; e.out = p.out; e.xb = (l == 0) ? XB : nullptr;
            e.g = p.ln_g + l * DM; e.b = p.ln_b + l * DM; e.wg = (l == 0) ? p.w_in + (size_t)DM * INC + 2048 : nullptr; e.BA = BA;
            e.xbuf = reinterpret_cast<float*>(wsl + OFF_XS) + (size_t)l * NTOK * 8;
            e.cnt = reinterpret_cast<unsigned*>(wsl + OFF_BAR) + 3500 + l * 64; e.tmo = reinterpret_cast<unsigned*>(wsl + OFF_BAR) + XB_TMO; e.gw = g_wave;
            gemm_phase(XB, reinterpret_cast<const bf16_t*>(p.ws + OFF_WOUT) + (size_t)l * DM * DM, NTOK, DM, DM, e, g_wave);
        }
        if (l == 0) xcd_barrier(gb);
    }
}

extern "C" void kernel_launch(void* const* d_in, const int* in_sizes, int n_in, void* d_out, int out_size, void* d_ws, size_t ws_size, hipStream_t stream) {
    static int grid_blocks = 0;
    if (!grid_blocks) {
        int dev = 0, cus = 0, per_cu = 0;
        hipGetDevice(&dev);
        hipDeviceGetAttribute(&cus, hipDeviceAttributeMultiprocessorCount, dev);
        hipFuncSetAttribute((const void*)fwd_megakernel, hipFuncAttributeMaxDynamicSharedMemorySize, LDS_BYTES);
        hipOccupancyMaxActiveBlocksPerMultiprocessor(&per_cu, fwd_megakernel, 512, LDS_BYTES);
        grid_blocks = (per_cu >= 1) ? cus : 0;
        if (grid_blocks > 256) grid_blocks = 256;
        if (ws_size < WS_NEED) { fprintf(stderr, "workspace too small: %zu < %zu\n", ws_size, (size_t)WS_NEED); }
        if (!grid_blocks) { fprintf(stderr, "occupancy query returned 0\n"); grid_blocks = 256; }
    }
    Params p{};
    p.x = (const float*)d_in[0]; p.w_in = (const float*)d_in[1]; p.conv_w = (const float*)d_in[2]; p.a_log = (const float*)d_in[3];
    p.dt_bias = (const float*)d_in[4]; p.norm_w = (const float*)d_in[5]; p.sinks = (const float*)d_in[6]; p.w_out = (const float*)d_in[7];
    p.ln_g = (const float*)d_in[8]; p.ln_b = (const float*)d_in[9]; p.out = (float*)d_out; p.ws = (unsigned char*)d_ws;
    hipMemsetAsync(d_ws, 0, 16384, stream);
    void* args[] = {&p};
    hipError_t e = hipLaunchCooperativeKernel((const void*)fwd_megakernel, dim3(grid_blocks), dim3(512), args, LDS_BYTES, stream);
    if (e != hipSuccess) fprintf(stderr, "cooperative launch failed: %s (grid %d)\n", hipGetErrorString(e), grid_blocks);
}
```

```cpp
#include <hip/hip_runtime.h>
#include <cstdio>
#include <cstdint>

#define LAS __attribute__((address_space(3)))
__device__ __forceinline__ int opaque_lane() { int lane; asm volatile("v_mbcnt_lo_u32_b32 %0, -1, 0\n\tv_mbcnt_hi_u32_b32 %0, -1, %0" : "=v"(lane)); return lane; }
typedef unsigned short bf16_t;
typedef short bf16x8 __attribute__((ext_vector_type(8)));
typedef float f32x4 __attribute__((ext_vector_type(4)));
typedef unsigned u32x4 __attribute__((ext_vector_type(4)));
typedef unsigned u32x2 __attribute__((ext_vector_type(2)));
__device__ __forceinline__ u32x4 mk4(unsigned a, unsigned b, unsigned c, unsigned d) { return (u32x4){a, b, c, d}; }
__device__ __forceinline__ u32x2 mk2(unsigned a, unsigned b) { return (u32x2){a, b}; }

constexpr int NTOK = 16384, SEQ = 4096, DM = 1024, INC = 3336, NIN = 3328;
constexpr int HA_LD = 1536, HB_LD = 1792;
constexpr int HB_ZA = 0, HB_QB = 512, HB_KB = 1024, HB_VB = 1152, HB_ZB = 1280;
constexpr float DN_ALPHA = 1.41421356237f;

constexpr size_t OFF_BAR = 0;
constexpr size_t OFF_XB = 16384;
constexpr size_t OFF_WIN = OFF_XB + (size_t)NTOK * DM * 2;
constexpr size_t OFF_WOUT = OFF_WIN + (size_t)2 * NIN * DM * 2;
constexpr size_t OFF_HA = OFF_WOUT + (size_t)2 * DM * DM * 2;
constexpr size_t OFF_HB = OFF_HA + (size_t)NTOK * HA_LD * 2;
constexpr size_t OFF_UT = OFF_HB + (size_t)NTOK * HB_LD * 2;
constexpr size_t OFF_W = OFF_UT + (size_t)NTOK * 512 * 2;
constexpr size_t OFF_QD = OFF_W + (size_t)NTOK * 512 * 2;
constexpr size_t OFF_KDT = OFF_QD + (size_t)NTOK * 512 * 2;
constexpr size_t OFF_QK = OFF_KDT + (size_t)NTOK * 512 * 2;
constexpr size_t OFF_BA = OFF_QK + (size_t)NTOK * 256 * 2;
constexpr size_t OFF_GT = OFF_BA + (size_t)NTOK * 8 * 4;
constexpr size_t OFF_XS = OFF_GT + 4096;
constexpr size_t WS_NEED = OFF_XS + (size_t)2 * NTOK * 4 * 8;

constexpr int LDS_BYTES = 147456;
extern __shared__ __attribute__((aligned(16))) unsigned char dyn_lds[];

struct Params {
    const float* x; const float* w_in; const float* conv_w; const float* a_log; const float* dt_bias;
    const float* norm_w; const float* sinks; const float* w_out; const float* ln_g; const float* ln_b;
    float* out; unsigned char* ws;
};

typedef float f32x2_t __attribute__((ext_vector_type(2)));
typedef __bf16 bf16x2_t __attribute__((ext_vector_type(2)));
__device__ __forceinline__ unsigned cvt_pk_bf16(float lo, float hi) {
    const f32x2_t v = {lo, hi};
    const bf16x2_t r = __builtin_convertvector(v, bf16x2_t);
    return __builtin_bit_cast(unsigned, r);
}
__device__ __forceinline__ float bf_lo(unsigned u) { return __uint_as_float(u << 16); }
__device__ __forceinline__ float bf_hi(unsigned u) { return __uint_as_float(u & 0xffff0000u); }
__device__ __forceinline__ float silu_f(float x) { return x * __builtin_amdgcn_rcpf(1.0f + __expf(-x)); }
__device__ __forceinline__ f32x4 mfma16(bf16x8 a, bf16x8 b, f32x4 c) { return __builtin_amdgcn_mfma_f32_16x16x32_bf16(a, b, c, 0, 0, 0); }
#define GPC(T) (const __attribute__((address_space(1))) T*)
#define GP(T) (__attribute__((address_space(1))) T*)
__device__ __forceinline__ bf16x8 ldg8(const bf16_t* p) { return *GPC(bf16x8)(p); }
__device__ __forceinline__ bf16x8 lds8(const unsigned char* p) { return *reinterpret_cast<const bf16x8*>(p); }

__device__ __forceinline__ int opaque_tid_(int g_wave) {
    int lane; asm volatile("v_mbcnt_lo_u32_b32 %0, -1, 0\n\tv_mbcnt_hi_u32_b32 %0, -1, %0" : "=v"(lane));
    return g_wave * 64 + lane; }
#define opaque_tid() opaque_tid_(g_wave)
__device__ __forceinline__ unsigned char* opaque_ws(unsigned char* w) { asm volatile("" : "+s"(w)); return w; }
__device__ __forceinline__ const bf16_t* uniform_ptr(const bf16_t* p) {
    const unsigned long long v = (unsigned long long)p;
    const unsigned lo = __builtin_amdgcn_readfirstlane((unsigned)v), hi = __builtin_amdgcn_readfirstlane((unsigned)(v >> 32));
    return (const bf16_t*)(((unsigned long long)hi << 32) | lo);
}

__device__ __forceinline__ float shx(float v, int m, int lane) { return __int_as_float(__builtin_amdgcn_ds_bpermute((lane ^ m) << 2, __float_as_int(v))); }

__device__ __forceinline__ float row_sum16(float x) {
    x += __int_as_float(__builtin_amdgcn_update_dpp(0, __float_as_int(x), 0x128, 0xf, 0xf, false));
    x += __int_as_float(__builtin_amdgcn_update_dpp(0, __float_as_int(x), 0x124, 0xf, 0xf, false));
    x += __int_as_float(__builtin_amdgcn_update_dpp(0, __float_as_int(x), 0x122, 0xf, 0xf, false));
    x += __int_as_float(__builtin_amdgcn_update_dpp(0, __float_as_int(x), 0x121, 0xf, 0xf, false));
    return x;
}

#define XB_TMO      128
#define XB_XCNT(j)  (256  + 64 * (j))
#define XB_XSUB(j)  (1280 + 64 * (j))
#define XB_XGEN(j)  (2304 + 64 * (j))
#define XB_TOP      3328
#define XB_TOPGEN   3392
#define XCD_BAR_WORDS 3456
#define XB_SPIN_CAP (1u << 20)
__device__ __forceinline__ unsigned xb_ld(unsigned* p)              { return __hip_atomic_load(p, __ATOMIC_RELAXED, __HIP_MEMORY_SCOPE_AGENT); }
__device__ __forceinline__ unsigned xb_add(unsigned* p, unsigned v) { return __hip_atomic_fetch_add(p, v, __ATOMIC_RELAXED, __HIP_MEMORY_SCOPE_AGENT); }
__device__ __forceinline__ unsigned xb_xcc_id() { return (unsigned)__builtin_amdgcn_s_getreg((3 << 11) | 20) & 0xFu; }
#define XB_SPIN(cond, bar) do { unsigned _sp = 0; while (cond) { __builtin_amdgcn_s_sleep(1); \
    if ((++_sp & 255u) == 0u) { if (xb_ld(&(bar)[XB_TMO])) break; if (_sp > XB_SPIN_CAP) { atomicAdd(&(bar)[XB_TMO], 1u); break; } } } } while (0)
struct XcdBarrier { unsigned* bar; unsigned x; volatile LAS unsigned* st; int gw; };
__device__ __forceinline__ bool xb_t0(int gw) { return gw == 0 && opaque_lane() == 0; }
__device__ __forceinline__ XcdBarrier xcd_barrier_post(unsigned* bar, volatile LAS unsigned* st, int gw) {
    XcdBarrier b; b.bar = bar; b.x = xb_xcc_id(); b.st = st; b.gw = gw;
    if (xb_t0(gw)) (void)xb_add(&bar[XB_XCNT(b.x)], 1u);
    return b;
}
__device__ __forceinline__ void xcd_barrier_complete(unsigned* bar, unsigned x, unsigned& nloc, unsigned& nx) {
    const unsigned G = gridDim.x * gridDim.y * gridDim.z;
    unsigned sum, cnt, mine, sp = 0u;
    for (;;) {
        sum = 0u; cnt = 0u; mine = 0u;
#pragma unroll
        for (unsigned j = 0; j < 16; ++j) { const unsigned c = xb_ld(&bar[XB_XCNT(j)]); sum += c; cnt += (c > 0u) ? 1u : 0u; mine = (j == x) ? c : mine; }
        if (sum == G) break;
        __builtin_amdgcn_s_sleep(1);
        if ((++sp & 255u) == 0u) { if (xb_ld(&bar[XB_TMO])) break; if (sp > XB_SPIN_CAP) { atomicAdd(&bar[XB_TMO], 1u); break; } }
    }
    nloc = mine > 0u ? mine : 1u; nx = cnt > 0u ? cnt : 1u;
}
__device__ __forceinline__ void xcd_barrier(const XcdBarrier& b_) {
    asm volatile("s_waitcnt vmcnt(0)" ::: "memory");
    __syncthreads();
    if (xb_t0(b_.gw)) {
        XcdBarrier b = b_; b.x = xb_xcc_id();
        asm volatile("" : "+s"(b.x));
        unsigned* bar = b.bar;
        __builtin_amdgcn_s_waitcnt(0);
        unsigned nloc = b.st[0], nx = b.st[1];
        if (nloc == 0u) { xcd_barrier_complete(bar, b.x, nloc, nx); b.st[0] = nloc; b.st[1] = nx; }
        const unsigned old = xb_add(&bar[XB_XSUB(b.x)], 1u);
        const unsigned gen = old / nloc;
        if (old + 1u == (gen + 1u) * nloc) {
            __builtin_amdgcn_fence(__ATOMIC_RELEASE, "agent");
            asm volatile("s_waitcnt vmcnt(0)" ::: "memory");
            const unsigned og = xb_add(&bar[XB_TOP], 1u);
            const unsigned tg = og / nx;
            if (og + 1u == (tg + 1u) * nx) xb_add(&bar[XB_TOPGEN], 1u);
            else XB_SPIN(xb_ld(&bar[XB_TOPGEN]) == tg, bar);
            __builtin_amdgcn_fence(__ATOMIC_ACQUIRE, "agent");
            xb_add(&bar[XB_XGEN(b.x)], 1u);
            asm volatile("s_waitcnt vmcnt(0)" ::: "memory");
        } else {
            XB_SPIN(xb_ld(&bar[XB_XGEN(b.x)]) == gen, bar);
            __builtin_amdgcn_fence(__ATOMIC_ACQUIRE, "agent");
            asm volatile("s_waitcnt vmcnt(0)" ::: "memory");
        }
    }
    __syncthreads();
}


constexpr int BM = 256, BK = 64, HALF = 128, NXCD = 8, WGM = 8, HT = HALF * BK;
__device__ __forceinline__ int lds_byte(int r, int c) {
    int st = (r >> 4) * 2 + (c >> 5), rr = r & 15, cc = c & 31, ob = rr * 64 + cc * 2;
    return st * 1024 + (ob ^ (((ob >> 9) & 1) << 5));
}
__device__ __forceinline__ void stage_rc(int b, int& R, int& C) {
    int st = b / 1024, sb = b % 1024, swz = sb ^ (((sb >> 9) & 1) << 5);
    R = (st >> 1) * 16 + swz / 64; C = (st & 1) * 32 + (swz % 64) / 2;
}

struct EpiH {
    bf16_t* ha; bf16_t* hb;
    __device__ __forceinline__ void operator()(const f32x4 (&acc)[2][2][4][2], int brow, int bcol, int wr, int wc, int fr, int fq) const {
        bf16_t* base; int ld, c0;
        if (bcol < HA_LD) { base = ha; ld = HA_LD; c0 = bcol; } else { base = hb; ld = HB_LD; c0 = bcol - HA_LD; }
#pragma unroll
        for (int ai = 0; ai < 2; ++ai)
#pragma unroll
            for (int m = 0; m < 4; ++m) {
                const int row = brow + ai * HALF + wr * 64 + m * 16 + fr;
                bf16_t* rp = base + (size_t)row * ld + c0 + wc * 32 + fq * 8;
#pragma unroll
                for (int bj = 0; bj < 2; ++bj) {
                    const f32x4 v0 = acc[ai][bj][m][0], v1 = acc[ai][bj][m][1];
                    u32x4 w; w.x = cvt_pk_bf16(v0[0], v0[1]); w.y = cvt_pk_bf16(v0[2], v0[3]); w.z = cvt_pk_bf16(v1[0], v1[1]); w.w = cvt_pk_bf16(v1[2], v1[3]);
                    *GP(u32x4)(rp + bj * HALF) = w;
                }
            }
    }
};
struct EpiZ {
    const float* xres; float* out;
    __device__ __forceinline__ void operator()(const f32x4 (&acc)[2][2][4][2], int brow, int bcol, int wr, int wc, int fr, int fq) const {
#pragma unroll
        for (int ai = 0; ai < 2; ++ai)
#pragma unroll
            for (int m = 0; m < 4; ++m) {
                const int row = brow + ai * HALF + wr * 64 + m * 16 + fr;
                const size_t ro = (size_t)row * DM + bcol + wc * 32 + fq * 4;
#pragma unroll
                for (int bj = 0; bj < 2; ++bj)
#pragma unroll
                    for (int n = 0; n < 2; ++n) {
                        const size_t o = ro + bj * HALF + n * 16;
                        const f32x4 r = *GPC(f32x4)(xres + o);
                        *GP(f32x4)(out + o) = r * DN_ALPHA + acc[ai][bj][m][n];
                    }
            }
    }
};


struct EpiLN {
    const float* xres; float* out; bf16_t* xb; const float* g; const float* b; const float* wg; float* BA; float* xbuf; unsigned* cnt; unsigned* tmo; int gw;
    __device__ __forceinline__ void operator()(f32x4 (&acc)[2][2][4][2], int brow, int bcol, int, int, int, int) const {
        const int tid = opaque_tid_(gw), lane = tid & 63, wr = tid >> 8, wc = (tid >> 6) & 3, fr = lane & 15, fq = lane >> 4, pm = brow >> 8, pn = bcol >> 8;
        f32x2_t* P = reinterpret_cast<f32x2_t*>(dyn_lds);
        f32x2_t* STATS = reinterpret_cast<f32x2_t*>(dyn_lds + 8192);
        float* WG = reinterpret_cast<float*>(dyn_lds + 10240);
        float* GP4 = reinterpret_cast<float*>(dyn_lds + 18432);
        if (wg) {
            for (int c = tid; c < 256; c += 512) {
                const float* wp = wg + (size_t)(bcol + c) * INC;
                *reinterpret_cast<f32x4*>(WG + c * 8) = *GPC(f32x4)(wp); *reinterpret_cast<f32x4*>(WG + c * 8 + 4) = *GPC(f32x4)(wp + 4);
            }
        }
#pragma unroll
        for (int ai = 0; ai < 2; ++ai)
#pragma unroll
            for (int m = 0; m < 4; ++m) {
                __builtin_amdgcn_sched_barrier(0);
                const int rl = ai * HALF + wr * 64 + m * 16 + fr;
                const size_t ro = (size_t)(brow + rl) * DM + bcol + wc * 32 + fq * 8;
                float s1 = 0.f, s2 = 0.f;
#pragma unroll
                for (int bj = 0; bj < 2; ++bj)
#pragma unroll
                    for (int n = 0; n < 2; ++n) {
                        const f32x4 r = *GPC(f32x4)(xres + ro + bj * HALF + n * 4);
                        const f32x4 v = r * DN_ALPHA + acc[ai][bj][m][n];
                        acc[ai][bj][m][n] = v;
                        s1 += (v[0] + v[1]) + (v[2] + v[3]);
                        s2 += (v[0] * v[0] + v[1] * v[1]) + (v[2] * v[2] + v[3] * v[3]);
                    }
                s1 += shx(s1, 16, lane); s1 += shx(s1, 32, lane);
                s2 += shx(s2, 16, lane); s2 += shx(s2, 32, lane);
                if (fq == 0) P[rl * 4 + wc] = (f32x2_t){s1, s2};
            }
        __syncthreads();
        if (tid < 256) {
            const f32x2_t a = P[tid * 4 + 0], b2 = P[tid * 4 + 1], c = P[tid * 4 + 2], d = P[tid * 4 + 3];
            *GP(f32x2_t)(xbuf + ((size_t)(brow + tid) * 4 + pn) * 2) = (f32x2_t){(a.x + b2.x) + (c.x + d.x), (a.y + b2.y) + (c.y + d.y)};
        }
        asm volatile("s_waitcnt vmcnt(0)" ::: "memory");
        __syncthreads();
        if (tid == 0) {
            __threadfence();
            xb_add(cnt + pm, 1u);
            unsigned sp = 0;
            while (xb_ld(cnt + pm) < 4u) { __builtin_amdgcn_s_sleep(1); if (++sp > (1u << 22)) { atomicAdd(tmo, 1u); break; } }
            __threadfence();
        }
        __syncthreads();
        if (tid < 256) {
            float S1 = 0.f, S2 = 0.f;
#pragma unroll
            for (int t = 0; t < 4; ++t) {
                const f32x2_t v = *GPC(f32x2_t)(xbuf + ((size_t)(brow + tid) * 4 + t) * 2);
                S1 += v.x; S2 += v.y;
            }
            const float mean = S1 * (1.0f / DM);
            const float var = fmaxf(S2 * (1.0f / DM) - mean * mean, 0.f);
            STATS[tid] = (f32x2_t){mean, rsqrtf(var + 1e-5f)};
        }
        __syncthreads();
#pragma unroll
        for (int ai = 0; ai < 2; ++ai)
#pragma unroll
            for (int m = 0; m < 4; ++m) {
                __builtin_amdgcn_sched_barrier(0);
                const int rl = ai * HALF + wr * 64 + m * 16 + fr;
                const f32x2_t st = STATS[rl];
                const size_t ro = (size_t)(brow + rl) * DM + bcol + wc * 32 + fq * 8;
                float d[8] = {0.f, 0.f, 0.f, 0.f, 0.f, 0.f, 0.f, 0.f};
#pragma unroll
                for (int bj = 0; bj < 2; ++bj) {
                    u32x4 wpk;
#pragma unroll
                    for (int n = 0; n < 2; ++n) {
                        const int cl = bj * HALF + wc * 32 + fq * 8 + n * 4;
                        const f32x4 gg = *GPC(f32x4)(g + bcol + cl), bb = *GPC(f32x4)(b + bcol + cl);
                        const f32x4 v = (acc[ai][bj][m][n] - st.x) * st.y * gg + bb;
                        *GP(f32x4)(out + ro + bj * HALF + n * 4) = v;
                        if (n == 0) { wpk.x = cvt_pk_bf16(v[0], v[1]); wpk.y = cvt_pk_bf16(v[2], v[3]); } else { wpk.z = cvt_pk_bf16(v[0], v[1]); wpk.w = cvt_pk_bf16(v[2], v[3]); }
                        if (wg) {
#pragma unroll
                            for (int j = 0; j < 4; ++j) {
                                const f32x4 w0 = *reinterpret_cast<const f32x4*>(WG + (cl + j) * 8), w1 = *reinterpret_cast<const f32x4*>(WG + (cl + j) * 8 + 4);
                                d[0] += v[j] * w0[0]; d[1] += v[j] * w0[1]; d[2] += v[j] * w0[2]; d[3] += v[j] * w0[3];
                                d[4] += v[j] * w1[0]; d[5] += v[j] * w1[1]; d[6] += v[j] * w1[2]; d[7] += v[j] * w1[3];
                            }
                        }
                    }
                    if (xb) *GP(u32x4)(xb + ro + bj * HALF) = wpk;
                }
                if (wg) {
#pragma unroll
                    for (int k = 0; k < 8; ++k) { d[k] += shx(d[k], 16, lane); d[k] += shx(d[k], 32, lane); }
                    if (fq == 0) {
                        *reinterpret_cast<f32x4*>(GP4 + (rl * 4 + wc) * 8) = (f32x4){d[0], d[1], d[2], d[3]};
                        *reinterpret_cast<f32x4*>(GP4 + (rl * 4 + wc) * 8 + 4) = (f32x4){d[4], d[5], d[6], d[7]};
                    }
                }
            }
        if (wg) {
            __syncthreads();
            for (int i = tid; i < 2048; i += 512) {
                const int rl = i >> 3, k = i & 7;
                const float sgate = (GP4[(rl * 4 + 0) * 8 + k] + GP4[(rl * 4 + 1) * 8 + k]) + (GP4[(rl * 4 + 2) * 8 + k] + GP4[(rl * 4 + 3) * 8 + k]);
                unsafeAtomicAdd(BA + (size_t)(brow + rl) * 8 + k, sgate);
            }
        }
    }
};

template <class Epi>
__device__ __forceinline__ void gemm_phase(const bf16_t* __restrict__ A, const bf16_t* __restrict__ Bt, int M, int N, int K, const Epi& epi, int g_wave) {
    bf16_t* shm = reinterpret_cast<bf16_t*>(dyn_lds);
#define SA(b,h) (shm+((b)*2+(h))*HT)
#define SB(b,h) (shm+(4+(b)*2+(h))*HT)
#define STAGE(P,BASE,br,kt) do{const bf16_t* _bp=uniform_ptr((BASE)+((long)(br)*K+(long)(kt)*BK)); \
    __builtin_amdgcn_global_load_lds((const unsigned*)((const char*)_bp+soff0),(unsigned*)((char*)(P)+tidx*16),16,0,0); \
    __builtin_amdgcn_global_load_lds((const unsigned*)((const char*)_bp+soff1),(unsigned*)((char*)(P)+tidx*16+8192),16,0,0);}while(0)
#define LDA(dst,b,h) for(int m=0;m<4;++m)for(int k=0;k<2;++k) \
    dst[m][k]=*reinterpret_cast<const bf16x8*>((char*)SA(b,h)+lds_byte(wr*64+m*16+fr,k*32+fq*8))
#define LDB(dst,b,h) for(int n=0;n<2;++n)for(int k=0;k<2;++k) \
    dst[n][k]=*reinterpret_cast<const bf16x8*>((char*)SB(b,h)+lds_byte(wc*32+n*16+fr,k*32+fq*8))
#define MMA(ai,bj,At,Bt_) do{__builtin_amdgcn_s_setprio(1); \
    for(int m=0;m<4;++m)for(int n=0;n<2;++n)for(int k=0;k<2;++k) \
      acc[ai][bj][m][n]=__builtin_amdgcn_mfma_f32_16x16x32_bf16(Bt_[n][k],At[m][k],acc[ai][bj][m][n],0,0,0); \
    __builtin_amdgcn_s_setprio(0);}while(0)
#define WAIT_V(n) asm volatile("s_waitcnt vmcnt(" #n ")":::"memory")
#define WAIT_L(n) asm volatile("s_waitcnt lgkmcnt(" #n ")":::"memory")
#define BAR __builtin_amdgcn_s_barrier()
#define SCHED __builtin_amdgcn_sched_barrier(0)
    const int nM = M / BM, nN = N / BM, nwg = nM * nN;
    const int tidx = opaque_tid();
    const int wid = tidx >> 6, lane = tidx & 63, wr = wid >> 2, wc = wid & 3, fr = lane & 15, fq = lane >> 4;
    const int nt = K / BK;
    unsigned soff0, soff1;
    { int r_, c_; stage_rc(tidx * 16, r_, c_); soff0 = (unsigned)(r_ * K + c_) * 2u; stage_rc(tidx * 16 + 8192, r_, c_); soff1 = (unsigned)(r_ * K + c_) * 2u; }
    for (int L = blockIdx.x; L < nwg; L += gridDim.x) {
        int wgid = L;
        { int q = nwg / NXCD, r = nwg % NXCD, xcd = wgid % NXCD, off = wgid / NXCD; wgid = (xcd < r ? xcd * (q + 1) : r * (q + 1) + (xcd - r) * q) + off; }
        const int nig = WGM * nN, gid = wgid / nig, fm = gid * WGM, gsz = min(nM - fm, WGM);
        const int pm = fm + ((wgid % nig) % gsz), pn = (wgid % nig) / gsz, brow = pm * BM, bcol = pn * BM;
        f32x4 acc[2][2][4][2] = {};
        bf16x8 At[4][2], B0[2][2], B1[2][2];
        STAGE(SB(0,0),Bt,bcol,0); STAGE(SA(0,0),A,brow,0);
        STAGE(SB(0,1),Bt,bcol+HALF,0); STAGE(SA(0,1),A,brow+HALF,0);
        if(wr==1)BAR;
        WAIT_V(4); BAR;
        STAGE(SB(1,0),Bt,bcol,1); STAGE(SA(1,0),A,brow,1); STAGE(SB(1,1),Bt,bcol+HALF,1);
        WAIT_V(6); BAR;
        for(int t=0;t<nt-2;t+=2){
            LDB(B0,0,0); SCHED; LDA(At,0,0); STAGE(SA(1,1),A,brow+HALF,t+1);
            WAIT_L(8); BAR; WAIT_L(0); MMA(0,0,At,B0); BAR; SCHED;
            LDB(B1,0,1); STAGE(SB(0,0),Bt,bcol,t+2);
            BAR; WAIT_L(0); MMA(0,1,At,B1); BAR;
            LDA(At,0,1); STAGE(SA(0,0),A,brow,t+2);
            BAR; WAIT_L(0); MMA(1,0,At,B0); BAR; SCHED;
            STAGE(SB(0,1),Bt,bcol+HALF,t+2);
            WAIT_V(6); BAR; MMA(1,1,At,B1); BAR;
            LDB(B0,1,0); SCHED; LDA(At,1,0); STAGE(SA(0,1),A,brow+HALF,t+2);
            WAIT_L(8); BAR; WAIT_L(0); MMA(0,0,At,B0); BAR; SCHED;
            LDB(B1,1,1); STAGE(SB(1,0),Bt,bcol,t+3);
            BAR; WAIT_L(0); MMA(0,1,At,B1); BAR;
            LDA(At,1,1); STAGE(SA(1,0),A,brow,t+3);
            BAR; WAIT_L(0); MMA(1,0,At,B0); BAR; SCHED;
            STAGE(SB(1,1),Bt,bcol+HALF,t+3);
            WAIT_V(6); BAR; MMA(1,1,At,B1); BAR;
        }
        { LDB(B0,0,0); LDA(At,0,0); STAGE(SA(1,1),A,brow+HALF,nt-1);
          BAR; WAIT_L(0); MMA(0,0,At,B0); BAR;
          LDB(B1,0,1); BAR; WAIT_L(0); MMA(0,1,At,B1); BAR;
          LDA(At,0,1); WAIT_V(4); BAR; WAIT_L(0); MMA(1,0,At,B0); MMA(1,1,At,B1); BAR; }
        { LDB(B0,1,0); LDA(At,1,0); WAIT_V(2); BAR; WAIT_L(0); MMA(0,0,At,B0); BAR;
          LDB(B1,1,1); WAIT_V(0); BAR; WAIT_L(0); MMA(0,1,At,B1); BAR;
          LDA(At,1,1); BAR; WAIT_L(0); MMA(1,0,At,B0); MMA(1,1,At,B1); BAR; }
        if(wr==0)BAR;
        epi(acc, brow, bcol, wr, wc, fr, fq);
        __syncthreads();
    }
#undef SA
#undef SB
#undef STAGE
#undef LDA
#undef LDB
#undef MMA
}

__device__ __forceinline__ void prep_weights(const Params& p, int part, int vblk, int nvblk, int g_wave) {
    bf16_t* win = reinterpret_cast<bf16_t*>(p.ws + OFF_WIN);
    bf16_t* wout = reinterpret_cast<bf16_t*>(p.ws + OFF_WOUT);
    const int gtid = vblk * 512 + opaque_tid(), gsz = nvblk * 512;
    const int n_in = 128 * NIN;
    for (int i = gtid; i < n_in; i += gsz) {
        const int n = i % NIN, kg = i / NIN, l = part;
        const int rho = n & 31, ncol = (n & ~31) + 8 * ((rho & 15) >> 2) + 4 * (rho >> 4) + (rho & 3);
        const int sc = ncol < 2048 ? ncol : ncol + 8;
        const float* s = p.w_in + (size_t)l * DM * INC + (size_t)(kg * 8) * INC + sc;
        u32x4 w;
        w.x = cvt_pk_bf16(s[0], s[INC]); w.y = cvt_pk_bf16(s[2 * INC], s[3 * INC]);
        w.z = cvt_pk_bf16(s[4 * INC], s[5 * INC]); w.w = cvt_pk_bf16(s[6 * INC], s[7 * INC]);
        *GP(u32x4)(win + ((size_t)l * NIN + n) * DM + kg * 8) = w;
    }
    if (part == 1) {
        const int n_out = 2 * 128 * DM;
        for (int i = gtid; i < n_out; i += gsz) {
            const int n = i % DM, kg = (i / DM) % 128, l = i / (DM * 128);
            const int rho = n & 31, ncol = (n & ~31) + 8 * ((rho & 15) >> 2) + 4 * (rho >> 4) + (rho & 3);
            const float* s = p.w_out + (size_t)l * DM * DM + (size_t)(kg * 8) * DM + ncol;
            u32x4 w;
            w.x = cvt_pk_bf16(s[0], s[DM]); w.y = cvt_pk_bf16(s[2 * DM], s[3 * DM]);
            w.z = cvt_pk_bf16(s[4 * DM], s[5 * DM]); w.w = cvt_pk_bf16(s[6 * DM], s[7 * DM]);
            *GP(u32x4)(wout + ((size_t)l * DM + n) * DM + kg * 8) = w;
        }
    }
}

__device__ __forceinline__ void row_pass(const float* src, bool ln, const float* g, const float* bta, float* dstf, bf16_t* xb, const float* wg  , float* BA, int g_wave) {
    const int tidx = opaque_tid();
    const int lane = tidx & 63;
    const int gw = blockIdx.x * 8 + (tidx >> 6), nw = gridDim.x * 8;
    float* wgs = reinterpret_cast<float*>(dyn_lds);
    if (wg) {
        for (int c = tidx; c < DM; c += 512) {
            const f32x4 w0 = *GPC(f32x4)(wg + (size_t)c * INC), w1 = *GPC(f32x4)(wg + (size_t)c * INC + 4);
            *reinterpret_cast<f32x4*>(wgs + c * 8) = w0; *reinterpret_cast<f32x4*>(wgs + c * 8 + 4) = w1;
        }
    }
    __syncthreads();
    f32x4 gg[4], bb[4];
#pragma unroll
    for (int i = 0; i < 4; ++i) { gg[i] = ln ? *GPC(f32x4)(g + i * 256 + lane * 4) : (f32x4){1.f, 1.f, 1.f, 1.f}; bb[i] = ln ? *GPC(f32x4)(bta + i * 256 + lane * 4) : (f32x4){0.f, 0.f, 0.f, 0.f}; }
    f32x4 nv[4];
    if (gw < NTOK) {
#pragma unroll
        for (int i = 0; i < 4; ++i) nv[i] = *GPC(f32x4)(src + (size_t)gw * DM + i * 256 + lane * 4);
    }
    for (int row = gw; row < NTOK; row += nw) {
        f32x4 v[4];
#pragma unroll
        for (int i = 0; i < 4; ++i) v[i] = nv[i];
        if (row + nw < NTOK) {
#pragma unroll
            for (int i = 0; i < 4; ++i) nv[i] = *GPC(f32x4)(src + (size_t)(row + nw) * DM + i * 256 + lane * 4);
        }
        if (ln) {
            float s = 0.f;
#pragma unroll
            for (int i = 0; i < 4; ++i) s += (v[i][0] + v[i][1]) + (v[i][2] + v[i][3]);
#pragma unroll
            for (int o = 32; o > 0; o >>= 1) s += shx(s, o, lane);
            const float mu = s * (1.0f / DM);
            float q = 0.f;
#pragma unroll
            for (int i = 0; i < 4; ++i) { v[i] = v[i] - mu; q += (v[i][0] * v[i][0] + v[i][1] * v[i][1]) + (v[i][2] * v[i][2] + v[i][3] * v[i][3]); }
#pragma unroll
            for (int o = 32; o > 0; o >>= 1) q += shx(q, o, lane);
            const float rstd = rsqrtf(q * (1.0f / DM) + 1e-5f);
#pragma unroll
            for (int i = 0; i < 4; ++i) v[i] = v[i] * rstd * gg[i] + bb[i];
        }
        if (dstf) {
#pragma unroll
            for (int i = 0; i < 4; ++i) *GP(f32x4)(dstf + (size_t)row * DM + i * 256 + lane * 4) = v[i];
        }
        if (xb) {
#pragma unroll
            for (int i = 0; i < 4; ++i) { u32x2 w; w.x = cvt_pk_bf16(v[i][0], v[i][1]); w.y = cvt_pk_bf16(v[i][2], v[i][3]);
                *GP(u32x2)(xb + (size_t)row * DM + i * 256 + lane * 4) = w; }
        }
        if (wg) {
            float d[8] = {0.f, 0.f, 0.f, 0.f, 0.f, 0.f, 0.f, 0.f};
#pragma unroll
            for (int i = 0; i < 4; ++i)
#pragma unroll
                for (int e = 0; e < 4; ++e) {
                    const float* wp = wgs + (i * 256 + lane * 4 + e) * 8;
                    const f32x4 w0 = *reinterpret_cast<const f32x4*>(wp), w1 = *reinterpret_cast<const f32x4*>(wp + 4);
                    const float xv = v[i][e];
                    d[0] += xv * w0[0]; d[1] += xv * w0[1]; d[2] += xv * w0[2]; d[3] += xv * w0[3];
                    d[4] += xv * w1[0]; d[5] += xv * w1[1]; d[6] += xv * w1[2]; d[7] += xv * w1[3];
                }
#pragma unroll
            for (int j = 0; j < 8; ++j) {
#pragma unroll
                for (int o = 32; o > 0; o >>= 1) d[j] += shx(d[j], o, lane);
            }
            if (lane == 0) {
                *GP(f32x4)(BA + (size_t)row * 8) = (f32x4){d[0], d[1], d[2], d[3]};
                *GP(f32x4)(BA + (size_t)row * 8 + 4) = (f32x4){d[4], d[5], d[6], d[7]};
            }
        }
    }
    __syncthreads();
}

constexpr int GRP_LDS = 73728;
constexpr int L_KRM = 0, L_QRM = 17408, L_KBGT = 34816, L_VBT = 53248, L_GC = 71680, L_BETA = 71936;
__device__ __forceinline__ void chunk_prep(const Params& p_, int l, int g_wave) {
    Params p = p_; p.ws = opaque_ws(p.ws);
    const bf16_t* HA = reinterpret_cast<const bf16_t*>(p.ws + OFF_HA);
    const float* BA = reinterpret_cast<const float*>(p.ws + OFF_BA);
    bf16_t* UT = reinterpret_cast<bf16_t*>(p.ws + OFF_UT);
    bf16_t* W = reinterpret_cast<bf16_t*>(p.ws + OFF_W);
    bf16_t* QD = reinterpret_cast<bf16_t*>(p.ws + OFF_QD);
    bf16_t* KDT = reinterpret_cast<bf16_t*>(p.ws + OFF_KDT);
    bf16_t* QK = reinterpret_cast<bf16_t*>(p.ws + OFF_QK);
    float* GT = reinterpret_cast<float*>(p.ws + OFF_GT);
    const float* cw = p.conv_w + (size_t)l * 4 * 1536;
#define CP_LANEVARS const int tid = opaque_tid(), grp = tid >> 8, gt = tid & 255, lane = tid & 63, wv = gt >> 6, fr = lane & 15, fq = lane >> 4; \
    unsigned char* lds = dyn_lds + grp * GRP_LDS; float* gc_s = reinterpret_cast<float*>(lds + L_GC); float* beta_s = reinterpret_cast<float*>(lds + L_BETA); \
    const int tg = gt >> 4, sg = gt & 15, t0 = tg * 4, c0 = sg * 8; (void)fr; (void)fq; (void)wv; (void)t0; (void)c0; (void)gc_s; (void)beta_s; (void)lane;
    for (int rr = 0; rr < 2; ++rr) {
        const int grp0 = opaque_tid() >> 8;
        const int xcd_ = blockIdx.x & 7, q_ = (blockIdx.x >> 3) + 32 * rr;
        const int hp = q_ & 1, n = (xcd_ & 1) * 32 + (q_ >> 1), b = xcd_ >> 1, h = hp * 2 + grp0;
        const int item = (b * 4 + h) * 64 + n, tok0 = b * SEQ + n * 64;
        u32x4 rawp[3][7];
        { CP_LANEVARS
#pragma unroll
          for (int ten = 0; ten < 3; ++ten)
#pragma unroll
            for (int r = 0; r < 7; ++r) {
                const int tt = n * 64 + t0 - 3 + r;
                rawp[ten][r] = mk4(0u, 0u, 0u, 0u);
                if (tt >= 0) rawp[ten][r] = *GPC(u32x4)(HA + (size_t)(b * SEQ + tt) * HA_LD + ten * 512 + h * 128 + c0);
            } }
        { CP_LANEVARS
        if (wv == 0) {
            const float bv = *GPC(float)(BA + (size_t)(tok0 + lane) * 8 + h), av = *GPC(float)(BA + (size_t)(tok0 + lane) * 8 + 4 + h);
            const float beta = __builtin_amdgcn_rcpf(1.0f + __expf(-bv));
            const float xx = av + p.dt_bias[l * 4 + h];
            const float sp = fmaxf(xx, 0.f) + log1pf(__expf(-fabsf(xx)));
            float gv = -__expf(p.a_log[l * 4 + h]) * sp;
#pragma unroll
            for (int o = 1; o < 64; o <<= 1) { const float t = __int_as_float(__builtin_amdgcn_ds_bpermute((lane - o) << 2, __float_as_int(gv))); if (lane >= o) gv += t; }
            gc_s[lane] = gv; beta_s[lane] = beta;
            if (lane == 63) *GP(float)(GT + item) = __expf(gv);
        } }
        __syncthreads();
        {
            CP_LANEVARS
            const float glast = gc_s[63];
            float eg[4], ek[4], be[4];
#pragma unroll
            for (int i = 0; i < 4; ++i) { const float gci = gc_s[t0 + i]; eg[i] = __expf(gci); ek[i] = __expf(glast - gci); be[i] = beta_s[t0 + i]; }
#pragma unroll
            for (int ten = 0; ten < 3; ++ten) {
                __builtin_amdgcn_sched_barrier(0);
                float raw[7][8];
#pragma unroll
                for (int r = 0; r < 7; ++r) {
                    const u32x4 u = rawp[ten][r];
                    raw[r][0] = bf_lo(u.x); raw[r][1] = bf_hi(u.x); raw[r][2] = bf_lo(u.y); raw[r][3] = bf_hi(u.y);
                    raw[r][4] = bf_lo(u.z); raw[r][5] = bf_hi(u.z); raw[r][6] = bf_lo(u.w); raw[r][7] = bf_hi(u.w);
                }
                float o[4][8];
#pragma unroll
                for (int i = 0; i < 4; ++i)
#pragma unroll
                    for (int c = 0; c < 8; ++c) o[i][c] = 0.f;
#pragma unroll
                for (int j = 0; j < 4; ++j) {
                    const float* wp = cw + (size_t)j * 1536 + ten * 512 + h * 128 + c0;
                    const f32x4 a = *GPC(f32x4)(wp), c4 = *GPC(f32x4)(wp + 4);
                    const float wj[8] = {a[0], a[1], a[2], a[3], c4[0], c4[1], c4[2], c4[3]};
#pragma unroll
                    for (int i = 0; i < 4; ++i)
#pragma unroll
                        for (int c = 0; c < 8; ++c) o[i][c] += wj[c] * raw[i + j][c];
                }
#pragma unroll
                for (int i = 0; i < 4; ++i)
#pragma unroll
                    for (int c = 0; c < 8; ++c) o[i][c] = silu_f(o[i][c]);
                if (ten < 2) {
#pragma unroll
                    for (int i = 0; i < 4; ++i) {
                        float sq = 0.f;
#pragma unroll
                        for (int c = 0; c < 8; ++c) sq += o[i][c] * o[i][c];
                        sq = row_sum16(sq);
                        const float rq = rsqrtf(sq + 1e-6f) * (ten == 0 ? 0.08838834764831845f : 1.0f);
#pragma unroll
                        for (int c = 0; c < 8; ++c) o[i][c] *= rq;
                    }
                }
                if (ten == 0) {
#pragma unroll
                    for (int i = 0; i < 4; ++i) {
                        u32x4 w;
                        w.x = cvt_pk_bf16(o[i][0], o[i][1]); w.y = cvt_pk_bf16(o[i][2], o[i][3]); w.z = cvt_pk_bf16(o[i][4], o[i][5]); w.w = cvt_pk_bf16(o[i][6], o[i][7]);
                        *reinterpret_cast<u32x4*>(lds + L_QRM + ((t0 + i) * 136 + c0) * 2) = w;
                    }
                } else if (ten == 1) {
#pragma unroll
                    for (int i = 0; i < 4; ++i) {
                        u32x4 w;
                        w.x = cvt_pk_bf16(o[i][0], o[i][1]); w.y = cvt_pk_bf16(o[i][2], o[i][3]); w.z = cvt_pk_bf16(o[i][4], o[i][5]); w.w = cvt_pk_bf16(o[i][6], o[i][7]);
                        *reinterpret_cast<u32x4*>(lds + L_KRM + ((t0 + i) * 136 + c0) * 2) = w;
                    }
#pragma unroll
                    for (int c = 0; c < 8; ++c) {
                        u32x2 w;
                        w.x = cvt_pk_bf16(o[0][c] * ek[0], o[1][c] * ek[1]); w.y = cvt_pk_bf16(o[2][c] * ek[2], o[3][c] * ek[3]);
                        { const int dk_ = c0 + c; *GP(u32x2)(KDT + ((((size_t)item * 8 + (dk_ >> 4)) * 2 + (t0 >> 5)) * 64 + (dk_ & 15) + 16 * ((t0 & 31) >> 3)) * 8 + ((t0 & 7) >> 2) * 4) = w; }
                        w.x = cvt_pk_bf16(o[0][c] * be[0] * eg[0], o[1][c] * be[1] * eg[1]); w.y = cvt_pk_bf16(o[2][c] * be[2] * eg[2], o[3][c] * be[3] * eg[3]);
                        *reinterpret_cast<u32x2*>(lds + L_KBGT + ((c0 + c) * 72 + t0) * 2) = w;
                    }
                } else {
#pragma unroll
                    for (int c = 0; c < 8; ++c) {
                        u32x2 w;
                        w.x = cvt_pk_bf16(o[0][c] * be[0], o[1][c] * be[1]); w.y = cvt_pk_bf16(o[2][c] * be[2], o[3][c] * be[3]);
                        *reinterpret_cast<u32x2*>(lds + L_VBT + ((c0 + c) * 72 + t0) * 2) = w;
                    }
                }
            }
        }
        __syncthreads();
        {
            CP_LANEVARS
            const int ib = wv;
            f32x4 kk[4], qk[4];
#pragma unroll
            for (int jb = 0; jb < 4; ++jb) { kk[jb] = (f32x4){0.f, 0.f, 0.f, 0.f}; qk[jb] = (f32x4){0.f, 0.f, 0.f, 0.f}; }
            bf16x8 ki[4], qi[4];
#pragma unroll
            for (int ks = 0; ks < 4; ++ks) {
                ki[ks] = lds8(lds + L_KRM + ((ib * 16 + fr) * 136 + ks * 32 + fq * 8) * 2);
                qi[ks] = lds8(lds + L_QRM + ((ib * 16 + fr) * 136 + ks * 32 + fq * 8) * 2);
            }
#pragma unroll
            for (int jb = 0; jb < 4; ++jb) {
                if (jb <= ib) {
#pragma unroll
                    for (int ks = 0; ks < 4; ++ks) {
                        const bf16x8 kj = lds8(lds + L_KRM + ((jb * 16 + fr) * 136 + ks * 32 + fq * 8) * 2);
                        kk[jb] = mfma16(ki[ks], kj, kk[jb]);
                        qk[jb] = mfma16(kj, qi[ks], qk[jb]);
                    }
                }
            }
            {
                const float egq = __expf(gc_s[ib * 16 + fr]);
#pragma unroll
                for (int ks = 0; ks < 4; ++ks) {
                    union { bf16x8 v; unsigned u[4]; } qq; qq.v = qi[ks];
                    u32x4 w;
                    w.x = cvt_pk_bf16(bf_lo(qq.u[0]) * egq, bf_hi(qq.u[0]) * egq); w.y = cvt_pk_bf16(bf_lo(qq.u[1]) * egq, bf_hi(qq.u[1]) * egq);
                    w.z = cvt_pk_bf16(bf_lo(qq.u[2]) * egq, bf_hi(qq.u[2]) * egq); w.w = cvt_pk_bf16(bf_lo(qq.u[3]) * egq, bf_hi(qq.u[3]) * egq);
                    *GP(u32x4)(QD + ((((size_t)item * 4 + ib) * 4 + ks) * 64 + lane) * 8) = w;
                }
            }
            __syncthreads();
            float* AP = reinterpret_cast<float*>(lds + L_KRM);
#pragma unroll
            for (int jb = 0; jb < 4; ++jb) {
                if (jb <= ib) {
                    const int j = jb * 16 + fr, i0 = ib * 16 + fq * 4;
                    const float gj = gc_s[j];
#pragma unroll
                    for (int r = 0; r < 4; ++r) {
                        const int i = i0 + r;
                        const float dec = __expf(fminf(gc_s[i] - gj, 0.f));
                        float av_ = (i > j) ? kk[jb][r] * beta_s[i] * dec : 0.f;
                        AP[j * 64 + r * 16 + ib * 4 + fq] = av_;
                    }
                }
                {
                    const int i = ib * 16 + fr, j0 = jb * 16 + fq * 4;
                    const float gi = gc_s[i];
                    float o[4];
#pragma unroll
                    for (int r = 0; r < 4; ++r) {
                        const int j = j0 + r;
                        const float dec = __expf(fminf(gi - gc_s[j], 0.f));
                        o[r] = (i >= j) ? qk[jb][r] * dec : 0.f;
                    }
                    u32x2 w; w.x = cvt_pk_bf16(o[0], o[1]); w.y = cvt_pk_bf16(o[2], o[3]);
                    *GP(u32x2)(QK + ((((size_t)item * 4 + ib) * 2 + (jb >> 1)) * 64 + fr + 16 * ((jb & 1) * 2 + (fq >> 1))) * 8 + (fq & 1) * 4) = w;
                }
            }
        }
        __syncthreads();
        {
            CP_LANEVARS
            const float* AP = reinterpret_cast<const float*>(lds + L_KRM);
            const int cbk = grp ? 3 - wv : wv;
            const int cl = lane >> 2, pp = lane & 3, ccol = cbk * 16 + cl;
            float a[16];
#pragma unroll
            for (int k = 0; k < 16; ++k) a[k] = (4 * k + pp == ccol) ? 1.f : 0.f;
#define INV_STEP(SS) { const int j = jq * 4 + SS; \
                    const float tj = __int_as_float(__builtin_amdgcn_update_dpp(0, __float_as_int(a[jq]), SS * 0x55, 0xf, 0xf, false)); \
                    const float* ap = AP + j * 64 + pp * 16; \
                    _Pragma("unroll") for (int k = jq; k < 16; ++k) a[k] -= ap[k] * tj; }
#pragma unroll
            for (int jq = 0; jq < 16; ++jq) {
                __builtin_amdgcn_sched_barrier(0);
                if (jq >= cbk * 4) {
                    INV_STEP(0) INV_STEP(1) INV_STEP(2)
                    if (jq < 15) INV_STEP(3)
                }
            }
#undef INV_STEP
            bf16_t* TR = reinterpret_cast<bf16_t*>(lds + L_QRM);
#pragma unroll
            for (int k = 0; k < 16; ++k) TR[(4 * k + pp) * 72 + ccol] = (bf16_t)(cvt_pk_bf16(a[k], 0.f) & 0xffffu);
        }
        __syncthreads();
        {
            CP_LANEVARS
            bf16x8 tf[2];
#pragma unroll
            for (int ks = 0; ks < 2; ++ks) tf[ks] = lds8(lds + L_QRM + ((wv * 16 + fr) * 72 + ks * 32 + fq * 8) * 2);
#pragma unroll
            for (int db = 0; db < 8; ++db) {
                f32x4 au = (f32x4){0.f, 0.f, 0.f, 0.f}, aw = (f32x4){0.f, 0.f, 0.f, 0.f};
#pragma unroll
                for (int ks = 0; ks < 2; ++ks) {
                    const bf16x8 vb = lds8(lds + L_VBT + ((db * 16 + fr) * 72 + ks * 32 + fq * 8) * 2);
                    const bf16x8 kb = lds8(lds + L_KBGT + ((db * 16 + fr) * 72 + ks * 32 + fq * 8) * 2);
                    au = mfma16(tf[ks], vb, au);
                    aw = mfma16(kb, tf[ks], aw);
                }
                u32x2 w; w.x = cvt_pk_bf16(au[0], au[1]); w.y = cvt_pk_bf16(au[2], au[3]);
                *GP(u32x2)(UT + ((((size_t)item * 8 + db) * 2 + (wv >> 1)) * 64 + fr + 16 * ((wv & 1) * 2 + (fq >> 1))) * 8 + (fq & 1) * 4) = w;
                w.x = cvt_pk_bf16(aw[0], aw[1]); w.y = cvt_pk_bf16(aw[2], aw[3]);
                *GP(u32x2)(W + ((((size_t)item * 4 + wv) * 4 + (db >> 1)) * 64 + fr + 16 * ((db & 1) * 2 + (fq >> 1))) * 8 + (fq & 1) * 4) = w;
            }
        }
        __syncthreads();
    }
}

__device__ __forceinline__ void delta_scan(const Params& p_, int blk, int g_wave) {
    Params p = p_; p.ws = opaque_ws(p.ws);
    const int tid = opaque_tid(), lane = tid & 63, w = tid >> 6, fr = lane & 15, fq = lane >> 4;
    const int bh = ((blk & 7) >> 1) * 4 + ((blk & 7) & 1) * 2 + ((blk >> 3) & 1), sl = blk >> 4, dv0 = sl * 32;
    bf16_t* ST = reinterpret_cast<bf16_t*>(p.ws + OFF_HA);
    bf16_t* UT = reinterpret_cast<bf16_t*>(p.ws + OFF_UT);
    const bf16_t* W = reinterpret_cast<const bf16_t*>(p.ws + OFF_W);
    const bf16_t* KDT = reinterpret_cast<const bf16_t*>(p.ws + OFF_KDT);
    const float* GT = reinterpret_cast<const float*>(p.ws + OFF_GT);
    unsigned char* STL = dyn_lds;
    unsigned char* VTL = dyn_lds + 8704;
    unsigned char* DMY = dyn_lds + 13312;
    unsigned char* RING = dyn_lds + 16384;
    (void)dv0;
#define LDS_BAR() do { asm volatile("s_waitcnt lgkmcnt(0)" ::: "memory"); __builtin_amdgcn_s_barrier(); asm volatile("" ::: "memory"); } while (0)
    if (w >= 4) {
        constexpr int PD = 10;
        const int hw = w - 4, pl = hw * 64 + lane;
#define RING_LOAD(C) do { const int c_ = (C) < 64 ? (C) : 63; const int slot_ = (C) & 3; \
            const bf16_t* wsrc = W + (size_t)(bh * 64 + c_) * 8192 + (hw * 4) * 512 + lane * 8; \
            const bf16_t* ksrc = KDT + (size_t)(bh * 64 + c_) * 8192 + (hw * 4) * 512 + lane * 8; \
            _Pragma("unroll") for (int j = 0; j < 4; ++j) { \
                __builtin_amdgcn_global_load_lds((const unsigned*)(wsrc + j * 512), (unsigned*)(RING + slot_ * 32768 + (hw * 4 + j) * 1024), 16, 0, 0); \
                __builtin_amdgcn_global_load_lds((const unsigned*)(ksrc + j * 512), (unsigned*)(RING + slot_ * 32768 + 16384 + (hw * 4 + j) * 1024), 16, 0, 0); } } while (0)
#define TOUCH(C) do { const int c_ = (C) < 64 ? (C) : 63; const int item_ = bh * 64 + c_; \
            const int li = sl * 32 + (lane & 31); \
            const unsigned char* a0 = (hw == 0) ? ((lane < 32) ? reinterpret_cast<const unsigned char*>(W + (size_t)item_ * 8192) + li * 128 \
                                                               : reinterpret_cast<const unsigned char*>(KDT + (size_t)item_ * 8192) + li * 128) \
                                                : reinterpret_cast<const unsigned char*>(UT + ((size_t)item_ * 8 + sl * 2) * 1024) + (lane & 31) * 128; \
            __builtin_amdgcn_global_load_lds((const unsigned*)a0, (unsigned*)(DMY + hw * 256), 4, 0, 0); } while (0)
        for (int c = 0; c < PD; ++c) TOUCH(c);
        RING_LOAD(0); RING_LOAD(1); RING_LOAD(2);
        asm volatile("s_waitcnt vmcnt(0)" ::: "memory");
        __syncthreads();
        for (int n = 0; n < 64; ++n) {
            const int item = bh * 64 + n;
            __builtin_amdgcn_s_barrier();
            {
                const int dvb_ = pl >> 7, ks_ = (pl >> 6) & 1, l_ = pl & 63;
                const u32x4 v = *reinterpret_cast<const u32x4*>(VTL + ((dvb_ * 16 + (l_ & 15)) * 72 + ks_ * 32 + (l_ >> 4) * 8) * 2);
                *GP(u32x4)(UT + (((size_t)item * 8 + sl * 2) * 128 + pl) * 8) = v;
            }
            asm volatile("s_waitcnt vmcnt(14) lgkmcnt(0)" ::: "memory");
            __builtin_amdgcn_s_barrier();
            {
                bf16_t* dst = (n < 63) ? ST + (((size_t)(item + 1) * 8 + sl * 2) * 256) * 8 : ST + (size_t)1024 * 16384 + (size_t)blk * 4096;
#pragma unroll
                for (int j = 0; j < 2; ++j) {
                    const int q = pl + 256 * j, dvb_ = q >> 8, ks_ = (q >> 6) & 3, l_ = q & 63;
                    const u32x4 v = *reinterpret_cast<const u32x4*>(STL + ((dvb_ * 16 + (l_ & 15)) * 136 + ks_ * 32 + (l_ >> 4) * 8) * 2);
                    *GP(u32x4)(dst + (size_t)q * 8) = v;
                }
            }
            RING_LOAD(n + 3);
            TOUCH(n + PD);
            asm volatile("s_waitcnt lgkmcnt(0)" ::: "memory");
        }
        asm volatile("s_waitcnt vmcnt(0)" ::: "memory");
#undef RING_LOAD
#undef TOUCH
    } else {
        f32x4 S[2][2];
#pragma unroll
        for (int kb = 0; kb < 2; ++kb)
#pragma unroll
            for (int db = 0; db < 2; ++db) {
                S[kb][db] = (f32x4){0.f, 0.f, 0.f, 0.f};
                const u32x2 z = mk2(0u, 0u);
                *reinterpret_cast<u32x2*>(STL + ((db * 16 + fr) * 136 + (2 * w + kb) * 16 + fq * 4) * 2) = z;
                *GP(u32x2)(ST + (((size_t)(bh * 64) * 8 + sl * 2) * 256) * 8 + (size_t)(((kb * 2 + db) * 256 + w * 64 + lane)) * 4) = z;
            }
        __syncthreads();
#define SCAN_LOAD(NN, UB, GTV) do { const int item_ = bh * 64 + (NN); \
        _Pragma("unroll") for (int db = 0; db < 2; ++db) UB[db] = *GPC(u32x2)(UT + ((((size_t)item_ * 8 + sl * 2 + db) * 2 + (w >> 1)) * 64 + fr + 16 * ((w & 1) * 2 + (fq >> 1))) * 8 + (fq & 1) * 4); \
        GTV = *GPC(float)(GT + item_); } while (0)
        u32x2 ubA[2], ubB[2], ubC[2]; float gtA, gtB, gtC;
        SCAN_LOAD(0, ubA, gtA); SCAN_LOAD(1, ubB, gtB);
#define SCAN_STEP(N_, UB, GTV, NUB, NGT) do { \
        const int n = (N_); \
        { const int nn = n + 2 < 64 ? n + 2 : 63; SCAN_LOAD(nn, NUB, NGT); } \
        const unsigned char* slot = RING + (n & 3) * 32768; \
        { bf16x8 sb_[2][4], wf_[4]; \
          _Pragma("unroll") for (int ks = 0; ks < 4; ++ks) wf_[ks] = lds8(slot + ((w * 4 + ks) * 64 + lane) * 16); \
          _Pragma("unroll") for (int db = 0; db < 2; ++db) _Pragma("unroll") for (int ks = 0; ks < 4; ++ks) sb_[db][ks] = lds8(STL + ((db * 16 + fr) * 136 + ks * 32 + fq * 8) * 2); \
          f32x4 a10 = (f32x4){0.f, 0.f, 0.f, 0.f}, a11 = (f32x4){0.f, 0.f, 0.f, 0.f}; \
          _Pragma("unroll") for (int ks = 0; ks < 4; ++ks) { a10 = mfma16(wf_[ks], sb_[0][ks], a10); a11 = mfma16(wf_[ks], sb_[1][ks], a11); } \
          _Pragma("unroll") for (int db = 0; db < 2; ++db) { \
              const f32x4 a1 = db ? a11 : a10; u32x2 vw; \
              vw.x = cvt_pk_bf16(bf_lo(UB[db].x) - a1[0], bf_hi(UB[db].x) - a1[1]); vw.y = cvt_pk_bf16(bf_lo(UB[db].y) - a1[2], bf_hi(UB[db].y) - a1[3]); \
              *reinterpret_cast<u32x2*>(VTL + ((db * 16 + fr) * 72 + w * 16 + fq * 4) * 2) = vw; \
              } } \
        LDS_BAR(); \
        { bf16x8 vb_[2][2], kf_[2][2]; \
          _Pragma("unroll") for (int kb = 0; kb < 2; ++kb) _Pragma("unroll") for (int ks = 0; ks < 2; ++ks) kf_[kb][ks] = lds8(slot + 16384 + (((2 * w + kb) * 2 + ks) * 64 + lane) * 16); \
          _Pragma("unroll") for (int db = 0; db < 2; ++db) _Pragma("unroll") for (int ks = 0; ks < 2; ++ks) vb_[db][ks] = lds8(VTL + ((db * 16 + fr) * 72 + ks * 32 + fq * 8) * 2); \
          _Pragma("unroll") for (int kb = 0; kb < 2; ++kb) _Pragma("unroll") for (int db = 0; db < 2; ++db) { \
              f32x4 a2 = S[kb][db] * GTV; \
              a2 = mfma16(kf_[kb][0], vb_[db][0], a2); a2 = mfma16(kf_[kb][1], vb_[db][1], a2); \
              S[kb][db] = a2; \
              if (n < 63) { \
                  u32x2 sw; sw.x = cvt_pk_bf16(a2[0], a2[1]); sw.y = cvt_pk_bf16(a2[2], a2[3]); \
                  *reinterpret_cast<u32x2*>(STL + ((db * 16 + fr) * 136 + (2 * w + kb) * 16 + fq * 4) * 2) = sw; \
              } } } \
        LDS_BAR(); } while (0)
        for (int n3 = 0; n3 < 63; n3 += 3) {
            SCAN_STEP(n3 + 0, ubA, gtA, ubC, gtC);
            SCAN_STEP(n3 + 1, ubB, gtB, ubA, gtA);
            SCAN_STEP(n3 + 2, ubC, gtC, ubB, gtB);
        }
        SCAN_STEP(63, ubA, gtA, ubC, gtC);
#undef SCAN_STEP
#undef SCAN_LOAD
    }
#undef LDS_BAR
}

__device__ __forceinline__ void swa_phase(const Params& p_, int l, int sblk, int nsb, int g_wave) {
    Params p = p_; p.ws = opaque_ws(p.ws);
    const int tid = opaque_tid(), lane = tid & 63, w = tid >> 6, fr = lane & 15, fq = lane >> 4;
    const bf16_t* HB = reinterpret_cast<const bf16_t*>(p.ws + OFF_HB);
    bf16_t* YM = reinterpret_cast<bf16_t*>(p.ws + OFF_XB);
    unsigned char* VTS = dyn_lds;
    unsigned char* KSL = dyn_lds + 21504;
    const int sw_xcd = sblk & 7, sw_j = sblk >> 3, sw_n = nsb >> 3;
    for (int qi = sw_j; qi < 128; qi += sw_n) {
        const int b = sw_xcd >> 1, kvh = qi & 1, qt = (sw_xcd & 1) * 64 + (qi >> 1), q0 = qt * 32, kbase = q0 - 128;
        for (int idx = tid; idx < 1280; idx += 512) {
            const int key = idx >> 3, sg = idx & 7, kp = kbase + key;
            u32x4 u = mk4(0u, 0u, 0u, 0u);
            if (kp >= 0) u = *GPC(u32x4)(HB + (size_t)(b * SEQ + kp) * HB_LD + HB_KB + kvh * 64 + sg * 8);
            *reinterpret_cast<u32x4*>(KSL + (key * 72 + sg * 8) * 2) = u;
        }
        if (tid < 320) {
            const int kg = tid >> 3, sg = tid & 7;
            u32x4 u[4];
#pragma unroll
            for (int k = 0; k < 4; ++k) {
                const int kp = kbase + kg * 4 + k;
                u[k] = mk4(0u, 0u, 0u, 0u);
                if (kp >= 0) u[k] = *GPC(u32x4)(HB + (size_t)(b * SEQ + kp) * HB_LD + HB_VB + kvh * 64 + sg * 8);
            }
#pragma unroll
            for (int dp = 0; dp < 4; ++dp) {
                u32x2 lo, hi;
                lo.x = (u[0][dp] & 0xffffu) | (u[1][dp] << 16); lo.y = (u[2][dp] & 0xffffu) | (u[3][dp] << 16);
                hi.x = (u[0][dp] >> 16) | (u[1][dp] & 0xffff0000u); hi.y = (u[2][dp] >> 16) | (u[3][dp] & 0xffff0000u);
                *reinterpret_cast<u32x2*>(VTS + ((sg * 8 + dp * 2) * 168 + kg * 4) * 2) = lo;
                *reinterpret_cast<u32x2*>(VTS + ((sg * 8 + dp * 2 + 1) * 168 + kg * 4) * 2) = hi;
            }
        }
        const int g = w >> 1, sub = w & 1, qs = q0 + sub * 16, hq = kvh * 4 + g;
        const float slope = exp2f(-(float)(hq + 1)), sink = p.sinks[l * 8 + hq];
        bf16x8 qf[2];
#pragma unroll
        for (int ks = 0; ks < 2; ++ks) qf[ks] = ldg8(HB + (size_t)(b * SEQ + qs + fr) * HB_LD + HB_QB + hq * 64 + ks * 32 + fq * 8);
        __syncthreads();
        f32x4 sc[10];
#pragma unroll
        for (int kt = 0; kt < 10; ++kt) {
            const unsigned char* kr = KSL + ((kt * 16 + fr) * 72 + fq * 8) * 2;
            f32x4 a = (f32x4){0.f, 0.f, 0.f, 0.f};
            a = mfma16(lds8(kr), qf[0], a);
            a = mfma16(lds8(kr + 64), qf[1], a);
            sc[kt] = a;
        }
        const int qpos = qs + fr;
        float m = -1e30f;
#pragma unroll
        for (int kt = 0; kt < 10; ++kt)
#pragma unroll
            for (int r = 0; r < 4; ++r) {
                const int kpos = kbase + kt * 16 + fq * 4 + r, dist = qpos - kpos;
                const bool valid = (dist >= 0) && (dist < 128) && (kpos >= 0);
                const float s = valid ? sc[kt][r] * 0.125f - slope * (float)dist : -1e30f;
                sc[kt][r] = s; m = fmaxf(m, s);
            }
        m = fmaxf(m, shx(m, 16, lane)); m = fmaxf(m, shx(m, 32, lane));
        m = fmaxf(m, sink);
        float lsum = 0.f;
#pragma unroll
        for (int kt = 0; kt < 10; ++kt)
#pragma unroll
            for (int r = 0; r < 4; ++r) { const float e = __expf(sc[kt][r] - m); sc[kt][r] = e; lsum += e; }
        lsum += shx(lsum, 16, lane); lsum += shx(lsum, 32, lane);
        lsum += __expf(sink - m);
        const float inv = __builtin_amdgcn_rcpf(lsum);
        f32x4 o[4];
#pragma unroll
        for (int db = 0; db < 4; ++db) o[db] = (f32x4){0.f, 0.f, 0.f, 0.f};
#pragma unroll
        for (int j = 0; j < 5; ++j) {
            union { bf16x8 v; unsigned u[4]; } pf;
            pf.u[0] = cvt_pk_bf16(sc[2 * j][0], sc[2 * j][1]); pf.u[1] = cvt_pk_bf16(sc[2 * j][2], sc[2 * j][3]);
            pf.u[2] = cvt_pk_bf16(sc[2 * j + 1][0], sc[2 * j + 1][1]); pf.u[3] = cvt_pk_bf16(sc[2 * j + 1][2], sc[2 * j + 1][3]);
#pragma unroll
            for (int db = 0; db < 4; ++db) {
                union { bf16x8 v; u32x2 h[2]; } vf;
                const unsigned char* vr = VTS + ((db * 16 + fr) * 168 + (2 * j) * 16 + fq * 4) * 2;
                vf.h[0] = *reinterpret_cast<const u32x2*>(vr);
                vf.h[1] = *reinterpret_cast<const u32x2*>(vr + 32);
                o[db] = mfma16(vf.v, pf.v, o[db]);
            }
        }
        {
            const size_t tok = (size_t)(b * SEQ + qs + fr);
#pragma unroll
            for (int db = 0; db < 4; ++db) {
                const int col = hq * 64 + db * 16 + fq * 4;
                const u32x2 z = *GPC(u32x2)(HB + tok * HB_LD + HB_ZB + col);
                u32x2 y;
                y.x = cvt_pk_bf16(o[db][0] * inv * silu_f(bf_lo(z.x)), o[db][1] * inv * silu_f(bf_hi(z.x)));
                y.y = cvt_pk_bf16(o[db][2] * inv * silu_f(bf_lo(z.y)), o[db][3] * inv * silu_f(bf_hi(z.y)));
                *GP(u32x2)(YM + tok * DM + 512 + col) = y;
            }
        }
        __syncthreads();
    }
}

__device__ __forceinline__ void delta_out(const Params& p_, int l, int g_wave) {
    Params p = p_; p.ws = opaque_ws(p.ws);
    const int tid = opaque_tid(), grp = tid >> 8, lane = tid & 63, wv = (tid & 255) >> 6, fr = lane & 15, fq = lane >> 4;
    const bf16_t* ST = reinterpret_cast<const bf16_t*>(p.ws + OFF_HA);
    const bf16_t* VT = reinterpret_cast<const bf16_t*>(p.ws + OFF_UT);
    const bf16_t* QD = reinterpret_cast<const bf16_t*>(p.ws + OFF_QD);
    const bf16_t* QK = reinterpret_cast<const bf16_t*>(p.ws + OFF_QK);
    const bf16_t* HB = reinterpret_cast<const bf16_t*>(p.ws + OFF_HB);
    bf16_t* YM = reinterpret_cast<bf16_t*>(p.ws + OFF_XB);
    const float* nw = p.norm_w + l * 128;
    for (int rr = 0; rr < 2; ++rr) {
        const int xcd_ = blockIdx.x & 7, q_ = (blockIdx.x >> 3) + 32 * rr;
        const int b = xcd_ >> 1, n = (xcd_ & 1) * 32 + (q_ >> 1), h = (q_ & 1) * 2 + grp, item = (b * 4 + h) * 64 + n;
        const int tok = b * SEQ + n * 64 + wv * 16 + fr;
        bf16x8 qd[4], qk[2];
#pragma unroll
        for (int ks = 0; ks < 4; ++ks) qd[ks] = ldg8(QD + ((((size_t)item * 4 + wv) * 4 + ks) * 64 + lane) * 8);
#pragma unroll
        for (int ks = 0; ks < 2; ++ks) qk[ks] = ldg8(QK + ((((size_t)item * 4 + wv) * 2 + ks) * 64 + lane) * 8);
        u32x2 zz[8];
#pragma unroll
        for (int db = 0; db < 8; ++db) zz[db] = *GPC(u32x2)(HB + (size_t)tok * HB_LD + HB_ZA + h * 128 + db * 16 + fq * 4);
        f32x4 o[8];
        float ss = 0.f;
        bf16x8 sfA[4], vfA[2], sfB[4], vfB[2];
#define DO_LOAD(DB, SF, VF) do { const bf16_t* sp = ST + ((((size_t)item * 8 + (DB)) * 4) * 64 + lane) * 8; const bf16_t* vp = VT + ((((size_t)item * 8 + (DB)) * 2) * 64 + lane) * 8; \
            _Pragma("unroll") for (int ks = 0; ks < 4; ++ks) SF[ks] = ldg8(sp + ks * 512); \
            _Pragma("unroll") for (int ks = 0; ks < 2; ++ks) VF[ks] = ldg8(vp + ks * 512); } while (0)
#define DO_MMA(DB, SF, VF) do { f32x4 a = (f32x4){0.f, 0.f, 0.f, 0.f}; \
            _Pragma("unroll") for (int ks = 0; ks < 4; ++ks) a = mfma16(SF[ks], qd[ks], a); \
            _Pragma("unroll") for (int ks = 0; ks < 2; ++ks) a = mfma16(VF[ks], qk[ks], a); \
            o[DB] = a; ss += (a[0] * a[0] + a[1] * a[1]) + (a[2] * a[2] + a[3] * a[3]); } while (0)
        DO_LOAD(0, sfA, vfA); DO_LOAD(1, sfB, vfB);
#pragma unroll
        for (int db = 0; db < 8; db += 2) {
            DO_MMA(db, sfA, vfA);
            if (db + 2 < 8) DO_LOAD(db + 2, sfA, vfA);
            DO_MMA(db + 1, sfB, vfB);
            if (db + 3 < 8) DO_LOAD(db + 3, sfB, vfB);
        }
#undef DO_LOAD
#undef DO_MMA
        ss += shx(ss, 16, lane); ss += shx(ss, 32, lane);
        const float rs = rsqrtf(ss * (1.0f / 128.0f) + 1e-6f);
#pragma unroll
        for (int db = 0; db < 8; ++db) {
            const int dv = db * 16 + fq * 4;
            const f32x4 nv = *GPC(f32x4)(nw + dv);
            const u32x2 z = zz[db];
            u32x2 y;
            y.x = cvt_pk_bf16(o[db][0] * rs * nv[0] * silu_f(bf_lo(z.x)), o[db][1] * rs * nv[1] * silu_f(bf_hi(z.x)));
            y.y = cvt_pk_bf16(o[db][2] * rs * nv[2] * silu_f(bf_lo(z.y)), o[db][3] * rs * nv[3] * silu_f(bf_hi(z.y)));
            *GP(u32x2)(YM + (size_t)tok * DM + h * 128 + dv) = y;
        }
    }
}


__global__ void __launch_bounds__(512) fwd_megakernel(Params p) {
    __shared__ u32x4 xb_words;
    const int g_wave = __builtin_amdgcn_readfirstlane((int)(threadIdx.x >> 6));
    if (xb_t0(g_wave)) xb_words = mk4(0u, 0u, 0u, 0u);
    __syncthreads();
    XcdBarrier gb = xcd_barrier_post(reinterpret_cast<unsigned*>(p.ws + OFF_BAR), (volatile LAS unsigned*)&xb_words, g_wave);

    prep_weights(p, 0, blockIdx.x, gridDim.x, g_wave);
    row_pass(p.x, false, nullptr, nullptr, nullptr, reinterpret_cast<bf16_t*>(p.ws + OFF_XB), p.w_in + 2048, reinterpret_cast<float*>(p.ws + OFF_BA), g_wave);
    xcd_barrier(gb);
    for (int l = 0; l < 2; ++l) {
        unsigned char* wsl = opaque_ws(p.ws);
        bf16_t* XB = reinterpret_cast<bf16_t*>(wsl + OFF_XB);
        float* BA = reinterpret_cast<float*>(wsl + OFF_BA);
        {
            EpiH e; e.ha = reinterpret_cast<bf16_t*>(p.ws + OFF_HA); e.hb = reinterpret_cast<bf16_t*>(p.ws + OFF_HB);
            gemm_phase(XB, reinterpret_cast<const bf16_t*>(p.ws + OFF_WIN) + (size_t)l * NIN * DM, NTOK, NIN, DM, e, g_wave);
            if (l == 0 && blockIdx.x >= 64) prep_weights(p, 1, blockIdx.x - 64, gridDim.x - 64, g_wave);
        }
        xcd_barrier(gb);
        chunk_prep(p, l, g_wave);
        xcd_barrier(gb);
        if (blockIdx.x < 64) delta_scan(p, blockIdx.x, g_wave);
        else swa_phase(p, l, blockIdx.x - 64, gridDim.x - 64, g_wave);
        xcd_barrier(gb);
        if (l == 0) { const int t_ = opaque_tid(); float zf_ = 0.f; asm volatile("" : "+v"(zf_)); for (int i = blockIdx.x * 512 + t_; i < NTOK * 2; i += gridDim.x * 512) *GP(f32x4)(BA + (size_t)i * 4) = (f32x4){zf_, zf_, zf_, zf_}; }
        delta_out(p, l, g_wave);
        xcd_barrier(gb);
        {
            EpiLN e; e.xres = (l == 0) ? p.x : p.out; e.out = p.out; e.xb = (l == 0) ? XB : nullptr;
            e.g = p.ln_g + l * DM; e.b = p.ln_b + l * DM; e.wg = (l == 0) ? p.w_in + (size_t)DM * INC + 2048 : nullptr; e.BA = BA;
            e.xbuf = reinterpret_cast<float*>(wsl + OFF_XS) + (size_t)l * NTOK * 8;
            e.cnt = reinterpret_cast<unsigned*>(wsl + OFF_BAR) + 3500 + l * 64; e.tmo = reinterpret_cast<unsigned*>(wsl + OFF_BAR) + XB_TMO; e.gw = g_wave;
            gemm_phase(XB, reinterpret_cast<const bf16_t*>(p.ws + OFF_WOUT) + (size_t)l * DM * DM, NTOK, DM, DM, e, g_wave);
        }
        if (l == 0) xcd_barrier(gb);
    }
}

extern "C" void kernel_launch(void* const* d_in, const int* in_sizes, int n_in, void* d_out, int out_size, void* d_ws, size_t ws_size, hipStream_t stream) {
    static int grid_blocks = 0;
    if (!grid_blocks) {
        int dev = 0, cus = 0, per_cu = 0;
        hipGetDevice(&dev);
        hipDeviceGetAttribute(&cus, hipDeviceAttributeMultiprocessorCount, dev);
        hipFuncSetAttribute((const void*)fwd_megakernel, hipFuncAttributeMaxDynamicSharedMemorySize, LDS_BYTES);
        hipOccupancyMaxActiveBlocksPerMultiprocessor(&per_cu, fwd_megakernel, 512, LDS_BYTES);
        grid_blocks = (per_cu >= 1) ? cus : 0;
        if (grid_blocks > 256) grid_blocks = 256;
        if (ws_size < WS_NEED) { fprintf(stderr, "workspace too small: %zu < %zu\n", ws_size, (size_t)WS_NEED); }
        if (!grid_blocks) { fprintf(stderr, "occupancy query returned 0\n"); grid_blocks = 256; }
    }
    Params p{};
    p.x = (const float*)d_in[0]; p.w_in = (const float*)d_in[1]; p.conv_w = (const float*)d_in[2]; p.a_log = (const float*)d_in[3];
    p.dt_bias = (const float*)d_in[4]; p.norm_w = (const float*)d_in[5]; p.sinks = (const float*)d_in[6]; p.w_out = (const float*)d_in[7];
    p.ln_g = (const float*)d_in[8]; p.ln_b = (const float*)d_in[9]; p.out = (float*)d_out; p.ws = (unsigned char*)d_ws;
    hipMemsetAsync(d_ws, 0, 16384, stream);
    void* args[] = {&p};
    hipError_t e = hipLaunchCooperativeKernel((const void*)fwd_megakernel, dim3(grid_blocks), dim3(512), args, LDS_BYTES, stream);
    if (e != hipSuccess) fprintf(stderr, "cooperative launch failed: %s (grid %d)\n", hipGetErrorString(e), grid_blocks);
}
```

```cpp
#include <hip/hip_runtime.h>
#include <cstdio>
#include <cstdint>

#define LAS __attribute__((address_space(3)))
__device__ __forceinline__ int opaque_lane() { int lane; asm volatile("v_mbcnt_lo_u32_b32 %0, -1, 0\n\tv_mbcnt_hi_u32_b32 %0, -1, %0" : "=v"(lane)); return lane; }
typedef unsigned short bf16_t;
typedef short bf16x8 __attribute__((ext_vector_type(8)));
typedef float f32x4 __attribute__((ext_vector_type(4)));
typedef unsigned u32x4 __attribute__((ext_vector_type(4)));
typedef unsigned u32x2 __attribute__((ext_vector_type(2)));
__device__ __forceinline__ u32x4 mk4(unsigned a, unsigned b, unsigned c, unsigned d) { return (u32x4){a, b, c, d}; }
__device__ __forceinline__ u32x2 mk2(unsigned a, unsigned b) { return (u32x2){a, b}; }

constexpr int NTOK = 16384, SEQ = 4096, DM = 1024, INC = 3336, NIN = 3328;
constexpr int HA_LD = 1536, HB_LD = 1792;
constexpr int HB_ZA = 0, HB_QB = 512, HB_KB = 1024, HB_VB = 1152, HB_ZB = 1280;
constexpr float DN_ALPHA = 1.41421356237f;

constexpr size_t OFF_BAR = 0;
constexpr size_t OFF_XB = 16384;
constexpr size_t OFF_WIN = OFF_XB + (size_t)NTOK * DM * 2;
constexpr size_t OFF_WOUT = OFF_WIN + (size_t)2 * NIN * DM * 2;
constexpr size_t OFF_HA = OFF_WOUT + (size_t)2 * DM * DM * 2;
constexpr size_t OFF_HB = OFF_HA + (size_t)NTOK * HA_LD * 2;
constexpr size_t OFF_UT = OFF_HB + (size_t)NTOK * HB_LD * 2;
constexpr size_t OFF_W = OFF_UT + (size_t)NTOK * 512 * 2;
constexpr size_t OFF_QD = OFF_W + (size_t)NTOK * 512 * 2;
constexpr size_t OFF_KDT = OFF_QD + (size_t)NTOK * 512 * 2;
constexpr size_t OFF_QK = OFF_KDT + (size_t)NTOK * 512 * 2;
constexpr size_t OFF_BA = OFF_QK + (size_t)NTOK * 256 * 2;
constexpr size_t OFF_GT = OFF_BA + (size_t)NTOK * 8 * 4;
constexpr size_t OFF_XS = OFF_GT + 4096;
constexpr size_t WS_NEED = OFF_XS + (size_t)2 * NTOK * 4 * 8;

constexpr int LDS_BYTES = 147456;
extern __shared__ __attribute__((aligned(16))) unsigned char dyn_lds[];

struct Params {
    const float* x; const float* w_in; const float* conv_w; const float* a_log; const float* dt_bias;
    const float* norm_w; const float* sinks; const float* w_out; const float* ln_g; const float* ln_b;
    float* out; unsigned char* ws;
};

typedef float f32x2_t __attribute__((ext_vector_type(2)));
typedef __bf16 bf16x2_t __attribute__((ext_vector_type(2)));
__device__ __forceinline__ unsigned cvt_pk_bf16(float lo, float hi) {
    const f32x2_t v = {lo, hi};
    const bf16x2_t r = __builtin_convertvector(v, bf16x2_t);
    return __builtin_bit_cast(unsigned, r);
}
__device__ __forceinline__ float bf_lo(unsigned u) { return __uint_as_float(u << 16); }
__device__ __forceinline__ float bf_hi(unsigned u) { return __uint_as_float(u & 0xffff0000u); }
__device__ __forceinline__ float silu_f(float x) { return x * __builtin_amdgcn_rcpf(1.0f + __expf(-x)); }
__device__ __forceinline__ f32x4 mfma16(bf16x8 a, bf16x8 b, f32x4 c) { return __builtin_amdgcn_mfma_f32_16x16x32_bf16(a, b, c, 0, 0, 0); }
#define GPC(T) (const __attribute__((address_space(1))) T*)
#define GP(T) (__attribute__((address_space(1))) T*)
__device__ __forceinline__ bf16x8 ldg8(const bf16_t* p) { return *GPC(bf16x8)(p); }
__device__ __forceinline__ bf16x8 lds8(const unsigned char* p) { return *reinterpret_cast<const bf16x8*>(p); }

__device__ __forceinline__ int opaque_tid_(int g_wave) {
    int lane; asm volatile("v_mbcnt_lo_u32_b32 %0, -1, 0\n\tv_mbcnt_hi_u32_b32 %0, -1, %0" : "=v"(lane));
    return g_wave * 64 + lane; }
#define opaque_tid() opaque_tid_(g_wave)
__device__ __forceinline__ unsigned char* opaque_ws(unsigned char* w) { asm volatile("" : "+s"(w)); return w; }
__device__ __forceinline__ const bf16_t* uniform_ptr(const bf16_t* p) {
    const unsigned long long v = (unsigned long long)p;
    const unsigned lo = __builtin_amdgcn_readfirstlane((unsigned)v), hi = __builtin_amdgcn_readfirstlane((unsigned)(v >> 32));
    return (const bf16_t*)(((unsigned long long)hi << 32) | lo);
}

__device__ __forceinline__ float shx(float v, int m, int lane) { return __int_as_float(__builtin_amdgcn_ds_bpermute((lane ^ m) << 2, __float_as_int(v))); }

__device__ __forceinline__ float row_sum16(float x) {
    x += __int_as_float(__builtin_amdgcn_update_dpp(0, __float_as_int(x), 0x128, 0xf, 0xf, false));
    x += __int_as_float(__builtin_amdgcn_update_dpp(0, __float_as_int(x), 0x124, 0xf, 0xf, false));
    x += __int_as_float(__builtin_amdgcn_update_dpp(0, __float_as_int(x), 0x122, 0xf, 0xf, false));
    x += __int_as_float(__builtin_amdgcn_update_dpp(0, __float_as_int(x), 0x121, 0xf, 0xf, false));
    return x;
}

#define XB_TMO      128
#define XB_XCNT(j)  (256  + 64 * (j))
#define XB_XSUB(j)  (1280 + 64 * (j))
#define XB_XGEN(j)  (2304 + 64 * (j))
#define XB_TOP      3328
#define XB_TOPGEN   3392
#define XCD_BAR_WORDS 3456
#define XB_SPIN_CAP (1u << 20)
__device__ __forceinline__ unsigned xb_ld(unsigned* p)              { return __hip_atomic_load(p, __ATOMIC_RELAXED, __HIP_MEMORY_SCOPE_AGENT); }
__device__ __forceinline__ unsigned xb_add(unsigned* p, unsigned v) { return __hip_atomic_fetch_add(p, v, __ATOMIC_RELAXED, __HIP_MEMORY_SCOPE_AGENT); }
__device__ __forceinline__ unsigned xb_xcc_id() { return (unsigned)__builtin_amdgcn_s_getreg((3 << 11) | 20) & 0xFu; }
#define XB_SPIN(cond, bar) do { unsigned _sp = 0; while (cond) { __builtin_amdgcn_s_sleep(1); \
    if ((++_sp & 255u) == 0u) { if (xb_ld(&(bar)[XB_TMO])) break; if (_sp > XB_SPIN_CAP) { atomicAdd(&(bar)[XB_TMO], 1u); break; } } } } while (0)
struct XcdBarrier { unsigned* bar; unsigned x; volatile LAS unsigned* st; int gw; };
__device__ __forceinline__ bool xb_t0(int gw) { return gw == 0 && opaque_lane() == 0; }
__device__ __forceinline__ XcdBarrier xcd_barrier_post(unsigned* bar, volatile LAS unsigned* st, int gw) {
    XcdBarrier b; b.bar = bar; b.x = xb_xcc_id(); b.st = st; b.gw = gw;
    if (xb_t0(gw)) (void)xb_add(&bar[XB_XCNT(b.x)], 1u);
    return b;
}
__device__ __forceinline__ void xcd_barrier_complete(unsigned* bar, unsigned x, unsigned& nloc, unsigned& nx) {
    const unsigned G = gridDim.x * gridDim.y * gridDim.z;
    unsigned sum, cnt, mine, sp = 0u;
    for (;;) {
        sum = 0u; cnt = 0u; mine = 0u;
#pragma unroll
        for (unsigned j = 0; j < 16; ++j) { const unsigned c = xb_ld(&bar[XB_XCNT(j)]); sum += c; cnt += (c > 0u) ? 1u : 0u; mine = (j == x) ? c : mine; }
        if (sum == G) break;
        __builtin_amdgcn_s_sleep(1);
        if ((++sp & 255u) == 0u) { if (xb_ld(&bar[XB_TMO])) break; if (sp > XB_SPIN_CAP) { atomicAdd(&bar[XB_TMO], 1u); break; } }
    }
    nloc = mine > 0u ? mine : 1u; nx = cnt > 0u ? cnt : 1u;
}
__device__ __forceinline__ void xcd_barrier(const XcdBarrier& b_) {
    asm volatile("s_waitcnt vmcnt(0)" ::: "memory");
    __syncthreads();
    if (xb_t0(b_.gw)) {
        XcdBarrier b = b_; b.x = xb_xcc_id();
        asm volatile("" : "+s"(b.x));
        unsigned* bar = b.bar;
        __builtin_amdgcn_s_waitcnt(0);
        unsigned nloc = b.st[0], nx = b.st[1];
        if (nloc == 0u) { xcd_barrier_complete(bar, b.x, nloc, nx); b.st[0] = nloc; b.st[1] = nx; }
        const unsigned old = xb_add(&bar[XB_XSUB(b.x)], 1u);
        const unsigned gen = old / nloc;
        if (old + 1u == (gen + 1u) * nloc) {
            __builtin_amdgcn_fence(__ATOMIC_RELEASE, "agent");
            asm volatile("s_waitcnt vmcnt(0)" ::: "memory");
            const unsigned og = xb_add(&bar[XB_TOP], 1u);
            const unsigned tg = og / nx;
            if (og + 1u == (tg + 1u) * nx) xb_add(&bar[XB_TOPGEN], 1u);
            else XB_SPIN(xb_ld(&bar[XB_TOPGEN]) == tg, bar);
            __builtin_amdgcn_fence(__ATOMIC_ACQUIRE, "agent");
            xb_add(&bar[XB_XGEN(b.x)], 1u);
            asm volatile("s_waitcnt vmcnt(0)" ::: "memory");
        } else {
            XB_SPIN(xb_ld(&bar[XB_XGEN(b.x)]) == gen, bar);
            __builtin_amdgcn_fence(__ATOMIC_ACQUIRE, "agent");
            asm volatile("s_waitcnt vmcnt(0)" ::: "memory");
        }
    }
    __syncthreads();
}


constexpr int BM = 256, BK = 64, HALF = 128, NXCD = 8, WGM = 4, HT = HALF * BK;
__device__ __forceinline__ int lds_byte(int r, int c) {
    int st = (r >> 4) * 2 + (c >> 5), rr = r & 15, cc = c & 31, ob = rr * 64 + cc * 2;
    return st * 1024 + (ob ^ (((ob >> 9) & 1) << 5));
}
__device__ __forceinline__ void stage_rc(int b, int& R, int& C) {
    int st = b / 1024, sb = b % 1024, swz = sb ^ (((sb >> 9) & 1) << 5);
    R = (st >> 1) * 16 + swz / 64; C = (st & 1) * 32 + (swz % 64) / 2;
}

struct EpiH {
    bf16_t* ha; bf16_t* hb;
    __device__ __forceinline__ void operator()(const f32x4 (&acc)[2][2][4][2], int brow, int bcol, int wr, int wc, int fr, int fq) const {
        bf16_t* base; int ld, c0;
        if (bcol < HA_LD) { base = ha; ld = HA_LD; c0 = bcol; } else { base = hb; ld = HB_LD; c0 = bcol - HA_LD; }
#pragma unroll
        for (int ai = 0; ai < 2; ++ai)
#pragma unroll
            for (int m = 0; m < 4; ++m) {
                const int row = brow + ai * HALF + wr * 64 + m * 16 + fr;
                bf16_t* rp = base + (size_t)row * ld + c0 + wc * 32 + fq * 8;
#pragma unroll
                for (int bj = 0; bj < 2; ++bj) {
                    const f32x4 v0 = acc[ai][bj][m][0], v1 = acc[ai][bj][m][1];
                    u32x4 w; w.x = cvt_pk_bf16(v0[0], v0[1]); w.y = cvt_pk_bf16(v0[2], v0[3]); w.z = cvt_pk_bf16(v1[0], v1[1]); w.w = cvt_pk_bf16(v1[2], v1[3]);
                    *GP(u32x4)(rp + bj * HALF) = w;
                }
            }
    }
};
struct EpiZ {
    const float* xres; float* out;
    __device__ __forceinline__ void operator()(const f32x4 (&acc)[2][2][4][2], int brow, int bcol, int wr, int wc, int fr, int fq) const {
#pragma unroll
        for (int ai = 0; ai < 2; ++ai)
#pragma unroll
            for (int m = 0; m < 4; ++m) {
                const int row = brow + ai * HALF + wr * 64 + m * 16 + fr;
                const size_t ro = (size_t)row * DM + bcol + wc * 32 + fq * 4;
#pragma unroll
                for (int bj = 0; bj < 2; ++bj)
#pragma unroll
                    for (int n = 0; n < 2; ++n) {
                        const size_t o = ro + bj * HALF + n * 16;
                        const f32x4 r = *GPC(f32x4)(xres + o);
                        *GP(f32x4)(out + o) = r * DN_ALPHA + acc[ai][bj][m][n];
                    }
            }
    }
};


struct EpiLN {
    const float* xres; float* out; bf16_t* xb; const float* g; const float* b; const float* wg; float* BA; float* xbuf; unsigned* cnt; unsigned* tmo; int gw;
    __device__ __forceinline__ void operator()(f32x4 (&acc)[2][2][4][2], int brow, int bcol, int, int, int, int) const {
        const int tid = opaque_tid_(gw), lane = tid & 63, wr = tid >> 8, wc = (tid >> 6) & 3, fr = lane & 15, fq = lane >> 4, pm = brow >> 8, pn = bcol >> 8;
        f32x2_t* P = reinterpret_cast<f32x2_t*>(dyn_lds);
        f32x2_t* STATS = reinterpret_cast<f32x2_t*>(dyn_lds + 8192);
        float* WG = reinterpret_cast<float*>(dyn_lds + 10240);
        float* GP4 = reinterpret_cast<float*>(dyn_lds + 18432);
        if (wg) {
            for (int c = tid; c < 256; c += 512) {
                const float* wp = wg + (size_t)(bcol + c) * INC;
                *reinterpret_cast<f32x4*>(WG + c * 8) = *GPC(f32x4)(wp); *reinterpret_cast<f32x4*>(WG + c * 8 + 4) = *GPC(f32x4)(wp + 4);
            }
        }
#pragma unroll
        for (int ai = 0; ai < 2; ++ai)
#pragma unroll
            for (int m = 0; m < 4; ++m) {
                __builtin_amdgcn_sched_barrier(0);
                const int rl = ai * HALF + wr * 64 + m * 16 + fr;
                const size_t ro = (size_t)(brow + rl) * DM + bcol + wc * 32 + fq * 8;
                float s1 = 0.f, s2 = 0.f;
#pragma unroll
                for (int bj = 0; bj < 2; ++bj)
#pragma unroll
                    for (int n = 0; n < 2; ++n) {
                        const f32x4 r = *GPC(f32x4)(xres + ro + bj * HALF + n * 4);
                        const f32x4 v = r * DN_ALPHA + acc[ai][bj][m][n];
                        acc[ai][bj][m][n] = v;
                        s1 += (v[0] + v[1]) + (v[2] + v[3]);
                        s2 += (v[0] * v[0] + v[1] * v[1]) + (v[2] * v[2] + v[3] * v[3]);
                    }
                s1 += shx(s1, 16, lane); s1 += shx(s1, 32, lane);
                s2 += shx(s2, 16, lane); s2 += shx(s2, 32, lane);
                if (fq == 0) P[rl * 4 + wc] = (f32x2_t){s1, s2};
            }
        __syncthreads();
        if (tid < 256) {
            const f32x2_t a = P[tid * 4 + 0], b2 = P[tid * 4 + 1], c = P[tid * 4 + 2], d = P[tid * 4 + 3];
            *GP(f32x2_t)(xbuf + ((size_t)(brow + tid) * 4 + pn) * 2) = (f32x2_t){(a.x + b2.x) + (c.x + d.x), (a.y + b2.y) + (c.y + d.y)};
        }
        asm volatile("s_waitcnt vmcnt(0)" ::: "memory");
        __syncthreads();
        if (tid == 0) {
            __threadfence();
            xb_add(cnt + pm, 1u);
            unsigned sp = 0;
            while (xb_ld(cnt + pm) < 4u) { __builtin_amdgcn_s_sleep(1); if (++sp > (1u << 22)) { atomicAdd(tmo, 1u); break; } }
            __threadfence();
        }
        __syncthreads();
        if (tid < 256) {
            float S1 = 0.f, S2 = 0.f;
#pragma unroll
            for (int t = 0; t < 4; ++t) {
                const f32x2_t v = *GPC(f32x2_t)(xbuf + ((size_t)(brow + tid) * 4 + t) * 2);
                S1 += v.x; S2 += v.y;
            }
            const float mean = S1 * (1.0f / DM);
            const float var = fmaxf(S2 * (1.0f / DM) - mean * mean, 0.f);
            STATS[tid] = (f32x2_t){mean, rsqrtf(var + 1e-5f)};
        }
        __syncthreads();
#pragma unroll
        for (int ai = 0; ai < 2; ++ai)
#pragma unroll
            for (int m = 0; m < 4; ++m) {
                __builtin_amdgcn_sched_barrier(0);
                const int rl = ai * HALF + wr * 64 + m * 16 + fr;
                const f32x2_t st = STATS[rl];
                const size_t ro = (size_t)(brow + rl) * DM + bcol + wc * 32 + fq * 8;
                float d[8] = {0.f, 0.f, 0.f, 0.f, 0.f, 0.f, 0.f, 0.f};
#pragma unroll
                for (int bj = 0; bj < 2; ++bj) {
                    u32x4 wpk;
#pragma unroll
                    for (int n = 0; n < 2; ++n) {
                        const int cl = bj * HALF + wc * 32 + fq * 8 + n * 4;
                        const f32x4 gg = *GPC(f32x4)(g + bcol + cl), bb = *GPC(f32x4)(b + bcol + cl);
                        const f32x4 v = (acc[ai][bj][m][n] - st.x) * st.y * gg + bb;
                        *GP(f32x4)(out + ro + bj * HALF + n * 4) = v;
                        if (n == 0) { wpk.x = cvt_pk_bf16(v[0], v[1]); wpk.y = cvt_pk_bf16(v[2], v[3]); } else { wpk.z = cvt_pk_bf16(v[0], v[1]); wpk.w = cvt_pk_bf16(v[2], v[3]); }
                        if (wg) {
#pragma unroll
                            for (int j = 0; j < 4; ++j) {
                                const f32x4 w0 = *reinterpret_cast<const f32x4*>(WG + (cl + j) * 8), w1 = *reinterpret_cast<const f32x4*>(WG + (cl + j) * 8 + 4);
                                d[0] += v[j] * w0[0]; d[1] += v[j] * w0[1]; d[2] += v[j] * w0[2]; d[3] += v[j] * w0[3];
                                d[4] += v[j] * w1[0]; d[5] += v[j] * w1[1]; d[6] += v[j] * w1[2]; d[7] += v[j] * w1[3];
                            }
                        }
                    }
                    if (xb) *GP(u32x4)(xb + ro + bj * HALF) = wpk;
                }
                if (wg) {
#pragma unroll
                    for (int k = 0; k < 8; ++k) { d[k] += shx(d[k], 16, lane); d[k] += shx(d[k], 32, lane); }
                    if (fq == 0) {
                        *reinterpret_cast<f32x4*>(GP4 + (rl * 4 + wc) * 8) = (f32x4){d[0], d[1], d[2], d[3]};
                        *reinterpret_cast<f32x4*>(GP4 + (rl * 4 + wc) * 8 + 4) = (f32x4){d[4], d[5], d[6], d[7]};
                    }
                }
            }
        if (wg) {
            __syncthreads();
            for (int i = tid; i < 2048; i += 512) {
                const int rl = i >> 3, k = i & 7;
                const float sgate = (GP4[(rl * 4 + 0) * 8 + k] + GP4[(rl * 4 + 1) * 8 + k]) + (GP4[(rl * 4 + 2) * 8 + k] + GP4[(rl * 4 + 3) * 8 + k]);
                unsafeAtomicAdd(BA + (size_t)(brow + rl) * 8 + k, sgate);
            }
        }
    }
};

template <class Epi>
__device__ __forceinline__ void gemm_phase(const bf16_t* __restrict__ A, const bf16_t* __restrict__ Bt, int M, int N, int K, const Epi& epi, int g_wave) {
    bf16_t* shm = reinterpret_cast<bf16_t*>(dyn_lds);
#define SA(b,h) (shm+((b)*2+(h))*HT)
#define SB(b,h) (shm+(4+(b)*2+(h))*HT)
#define STAGE(P,BASE,br,kt) do{const bf16_t* _bp=uniform_ptr((BASE)+((long)(br)*K+(long)(kt)*BK)); \
    __builtin_amdgcn_global_load_lds((const unsigned*)((const char*)_bp+soff0),(unsigned*)((char*)(P)+tidx*16),16,0,0); \
    __builtin_amdgcn_global_load_lds((const unsigned*)((const char*)_bp+soff1),(unsigned*)((char*)(P)+tidx*16+8192),16,0,0);}while(0)
#define LDA(dst,b,h) for(int m=0;m<4;++m)for(int k=0;k<2;++k) \
    dst[m][k]=*reinterpret_cast<const bf16x8*>((char*)SA(b,h)+lds_byte(wr*64+m*16+fr,k*32+fq*8))
#define LDB(dst,b,h) for(int n=0;n<2;++n)for(int k=0;k<2;++k) \
    dst[n][k]=*reinterpret_cast<const bf16x8*>((char*)SB(b,h)+lds_byte(wc*32+n*16+fr,k*32+fq*8))
#define MMA(ai,bj,At,Bt_) do{__builtin_amdgcn_s_setprio(1); \
    for(int m=0;m<4;++m)for(int n=0;n<2;++n)for(int k=0;k<2;++k) \
      acc[ai][bj][m][n]=__builtin_amdgcn_mfma_f32_16x16x32_bf16(Bt_[n][k],At[m][k],acc[ai][bj][m][n],0,0,0); \
    __builtin_amdgcn_s_setprio(0);}while(0)
#define WAIT_V(n) asm volatile("s_waitcnt vmcnt(" #n ")":::"memory")
#define WAIT_L(n) asm volatile("s_waitcnt lgkmcnt(" #n ")":::"memory")
#define BAR __builtin_amdgcn_s_barrier()
#define SCHED __builtin_amdgcn_sched_barrier(0)
    const int nM = M / BM, nN = N / BM, nwg = nM * nN;
    const int tidx = opaque_tid();
    const int wid = tidx >> 6, lane = tidx & 63, wr = wid >> 2, wc = wid & 3, fr = lane & 15, fq = lane >> 4;
    const int nt = K / BK;
    unsigned soff0, soff1;
    { int r_, c_; stage_rc(tidx * 16, r_, c_); soff0 = (unsigned)(r_ * K + c_) * 2u; stage_rc(tidx * 16 + 8192, r_, c_); soff1 = (unsigned)(r_ * K + c_) * 2u; }
    for (int L = blockIdx.x; L < nwg; L += gridDim.x) {
        int wgid = L;
        { int q = nwg / NXCD, r = nwg % NXCD, xcd = wgid % NXCD, off = wgid / NXCD; wgid = (xcd < r ? xcd * (q + 1) : r * (q + 1) + (xcd - r) * q) + off; }
        const int nig = WGM * nN, gid = wgid / nig, fm = gid * WGM, gsz = min(nM - fm, WGM);
        const int pm = fm + ((wgid % nig) % gsz), pn = (wgid % nig) / gsz, brow = pm * BM, bcol = pn * BM;
        f32x4 acc[2][2][4][2] = {};
        bf16x8 At[4][2], B0[2][2], B1[2][2];
        STAGE(SB(0,0),Bt,bcol,0); STAGE(SA(0,0),A,brow,0);
        STAGE(SB(0,1),Bt,bcol+HALF,0); STAGE(SA(0,1),A,brow+HALF,0);
        if(wr==1)BAR;
        WAIT_V(4); BAR;
        STAGE(SB(1,0),Bt,bcol,1); STAGE(SA(1,0),A,brow,1); STAGE(SB(1,1),Bt,bcol+HALF,1);
        WAIT_V(6); BAR;
        for(int t=0;t<nt-2;t+=2){
            LDB(B0,0,0); SCHED; LDA(At,0,0); STAGE(SA(1,1),A,brow+HALF,t+1);
            WAIT_L(8); BAR; WAIT_L(0); MMA(0,0,At,B0); BAR; SCHED;
            LDB(B1,0,1); STAGE(SB(0,0),Bt,bcol,t+2);
            BAR; WAIT_L(0); MMA(0,1,At,B1); BAR;
            LDA(At,0,1); STAGE(SA(0,0),A,brow,t+2);
            BAR; WAIT_L(0); MMA(1,0,At,B0); BAR; SCHED;
            STAGE(SB(0,1),Bt,bcol+HALF,t+2);
            WAIT_V(6); BAR; MMA(1,1,At,B1); BAR;
            LDB(B0,1,0); SCHED; LDA(At,1,0); STAGE(SA(0,1),A,brow+HALF,t+2);
            WAIT_L(8); BAR; WAIT_L(0); MMA(0,0,At,B0); BAR; SCHED;
            LDB(B1,1,1); STAGE(SB(1,0),Bt,bcol,t+3);
            BAR; WAIT_L(0); MMA(0,1,At,B1); BAR;
            LDA(At,1,1); STAGE(SA(1,0),A,brow,t+3);
            BAR; WAIT_L(0); MMA(1,0,At,B0); BAR; SCHED;
            STAGE(SB(1,1),Bt,bcol+HALF,t+3);
            WAIT_V(6); BAR; MMA(1,1,At,B1); BAR;
        }
        { LDB(B0,0,0); LDA(At,0,0); STAGE(SA(1,1),A,brow+HALF,nt-1);
          BAR; WAIT_L(0); MMA(0,0,At,B0); BAR;
          LDB(B1,0,1); BAR; WAIT_L(0); MMA(0,1,At,B1); BAR;
          LDA(At,0,1); WAIT_V(4); BAR; WAIT_L(0); MMA(1,0,At,B0); MMA(1,1,At,B1); BAR; }
        { LDB(B0,1,0); LDA(At,1,0); WAIT_V(2); BAR; WAIT_L(0); MMA(0,0,At,B0); BAR;
          LDB(B1,1,1); WAIT_V(0); BAR; WAIT_L(0); MMA(0,1,At,B1); BAR;
          LDA(At,1,1); BAR; WAIT_L(0); MMA(1,0,At,B0); MMA(1,1,At,B1); BAR; }
        if(wr==0)BAR;
        epi(acc, brow, bcol, wr, wc, fr, fq);
        __syncthreads();
    }
#undef SA
#undef SB
#undef STAGE
#undef LDA
#undef LDB
#undef MMA
}

__device__ __forceinline__ void prep_weights(const Params& p, int part, int vblk, int nvblk, int g_wave) {
    bf16_t* win = reinterpret_cast<bf16_t*>(p.ws + OFF_WIN);
    bf16_t* wout = reinterpret_cast<bf16_t*>(p.ws + OFF_WOUT);
    const int gtid = vblk * 512 + opaque_tid(), gsz = nvblk * 512;
    const int n_in = 128 * NIN;
    for (int i = gtid; i < n_in; i += gsz) {
        const int n = i % NIN, kg = i / NIN, l = part;
        const int rho = n & 31, ncol = (n & ~31) + 8 * ((rho & 15) >> 2) + 4 * (rho >> 4) + (rho & 3);
        const int sc = ncol < 2048 ? ncol : ncol + 8;
        const float* s = p.w_in + (size_t)l * DM * INC + (size_t)(kg * 8) * INC + sc;
        u32x4 w;
        w.x = cvt_pk_bf16(s[0], s[INC]); w.y = cvt_pk_bf16(s[2 * INC], s[3 * INC]);
        w.z = cvt_pk_bf16(s[4 * INC], s[5 * INC]); w.w = cvt_pk_bf16(s[6 * INC], s[7 * INC]);
        *GP(u32x4)(win + ((size_t)l * NIN + n) * DM + kg * 8) = w;
    }
    if (part == 1) {
        const int n_out = 2 * 128 * DM;
        for (int i = gtid; i < n_out; i += gsz) {
            const int n = i % DM, kg = (i / DM) % 128, l = i / (DM * 128);
            const int rho = n & 31, ncol = (n & ~31) + 8 * ((rho & 15) >> 2) + 4 * (rho >> 4) + (rho & 3);
            const float* s = p.w_out + (size_t)l * DM * DM + (size_t)(kg * 8) * DM + ncol;
            u32x4 w;
            w.x = cvt_pk_bf16(s[0], s[DM]); w.y = cvt_pk_bf16(s[2 * DM], s[3 * DM]);
            w.z = cvt_pk_bf16(s[4 * DM], s[5 * DM]); w.w = cvt_pk_bf16(s[6 * DM], s[7 * DM]);
            *GP(u32x4)(wout + ((size_t)l * DM + n) * DM + kg * 8) = w;
        }
    }
}

__device__ __forceinline__ void row_pass(const float* src, bool ln, const float* g, const float* bta, float* dstf, bf16_t* xb, const float* wg  , float* BA, int g_wave) {
    const int tidx = opaque_tid();
    const int lane = tidx & 63;
    const int gw = blockIdx.x * 8 + (tidx >> 6), nw = gridDim.x * 8;
    float* wgs = reinterpret_cast<float*>(dyn_lds);
    if (wg) {
        for (int c = tidx; c < DM; c += 512) {
            const f32x4 w0 = *GPC(f32x4)(wg + (size_t)c * INC), w1 = *GPC(f32x4)(wg + (size_t)c * INC + 4);
            *reinterpret_cast<f32x4*>(wgs + c * 8) = w0; *reinterpret_cast<f32x4*>(wgs + c * 8 + 4) = w1;
        }
    }
    __syncthreads();
    f32x4 gg[4], bb[4];
#pragma unroll
    for (int i = 0; i < 4; ++i) { gg[i] = ln ? *GPC(f32x4)(g + i * 256 + lane * 4) : (f32x4){1.f, 1.f, 1.f, 1.f}; bb[i] = ln ? *GPC(f32x4)(bta + i * 256 + lane * 4) : (f32x4){0.f, 0.f, 0.f, 0.f}; }
    f32x4 nv[4];
    if (gw < NTOK) {
#pragma unroll
        for (int i = 0; i < 4; ++i) nv[i] = *GPC(f32x4)(src + (size_t)gw * DM + i * 256 + lane * 4);
    }
    for (int row = gw; row < NTOK; row += nw) {
        f32x4 v[4];
#pragma unroll
        for (int i = 0; i < 4; ++i) v[i] = nv[i];
        if (row + nw < NTOK) {
#pragma unroll
            for (int i = 0; i < 4; ++i) nv[i] = *GPC(f32x4)(src + (size_t)(row + nw) * DM + i * 256 + lane * 4);
        }
        if (ln) {
            float s = 0.f;
#pragma unroll
            for (int i = 0; i < 4; ++i) s += (v[i][0] + v[i][1]) + (v[i][2] + v[i][3]);
#pragma unroll
            for (int o = 32; o > 0; o >>= 1) s += shx(s, o, lane);
            const float mu = s * (1.0f / DM);
            float q = 0.f;
#pragma unroll
            for (int i = 0; i < 4; ++i) { v[i] = v[i] - mu; q += (v[i][0] * v[i][0] + v[i][1] * v[i][1]) + (v[i][2] * v[i][2] + v[i][3] * v[i][3]); }
#pragma unroll
            for (int o = 32; o > 0; o >>= 1) q += shx(q, o, lane);
            const float rstd = rsqrtf(q * (1.0f / DM) + 1e-5f);
#pragma unroll
            for (int i = 0; i < 4; ++i) v[i] = v[i] * rstd * gg[i] + bb[i];
        }
        if (dstf) {
#pragma unroll
            for (int i = 0; i < 4; ++i) *GP(f32x4)(dstf + (size_t)row * DM + i * 256 + lane * 4) = v[i];
        }
        if (xb) {
#pragma unroll
            for (int i = 0; i < 4; ++i) { u32x2 w; w.x = cvt_pk_bf16(v[i][0], v[i][1]); w.y = cvt_pk_bf16(v[i][2], v[i][3]);
                *GP(u32x2)(xb + (size_t)row * DM + i * 256 + lane * 4) = w; }
        }
        if (wg) {
            float d[8] = {0.f, 0.f, 0.f, 0.f, 0.f, 0.f, 0.f, 0.f};
#pragma unroll
            for (int i = 0; i < 4; ++i)
#pragma unroll
                for (int e = 0; e < 4; ++e) {
                    const float* wp = wgs + (i * 256 + lane * 4 + e) * 8;
                    const f32x4 w0 = *reinterpret_cast<const f32x4*>(wp), w1 = *reinterpret_cast<const f32x4*>(wp + 4);
                    const float xv = v[i][e];
                    d[0] += xv * w0[0]; d[1] += xv * w0[1]; d[2] += xv * w0[2]; d[3] += xv * w0[3];
                    d[4] += xv * w1[0]; d[5] += xv * w1[1]; d[6] += xv * w1[2]; d[7] += xv * w1[3];
                }
#pragma unroll
            for (int j = 0; j < 8; ++j) {
#pragma unroll
                for (int o = 32; o > 0; o >>= 1) d[j] += shx(d[j], o, lane);
            }
            if (lane == 0) {
                *GP(f32x4)(BA + (size_t)row * 8) = (f32x4){d[0], d[1], d[2], d[3]};
                *GP(f32x4)(BA + (size_t)row * 8 + 4) = (f32x4){d[4], d[5], d[6], d[7]};
            }
        }
    }
    __syncthreads();
}

constexpr int GRP_LDS = 73728;
constexpr int L_KRM = 0, L_QRM = 17408, L_KBGT = 34816, L_VBT = 53248, L_GC = 71680, L_BETA = 71936;
__device__ __forceinline__ void chunk_prep(const Params& p_, int l, int g_wave) {
    Params p = p_; p.ws = opaque_ws(p.ws);
    const bf16_t* HA = reinterpret_cast<const bf16_t*>(p.ws + OFF_HA);
    const float* BA = reinterpret_cast<const float*>(p.ws + OFF_BA);
    bf16_t* UT = reinterpret_cast<bf16_t*>(p.ws + OFF_UT);
    bf16_t* W = reinterpret_cast<bf16_t*>(p.ws + OFF_W);
    bf16_t* QD = reinterpret_cast<bf16_t*>(p.ws + OFF_QD);
    bf16_t* KDT = reinterpret_cast<bf16_t*>(p.ws + OFF_KDT);
    bf16_t* QK = reinterpret_cast<bf16_t*>(p.ws + OFF_QK);
    float* GT = reinterpret_cast<float*>(p.ws + OFF_GT);
    const float* cw = p.conv_w + (size_t)l * 4 * 1536;
#define CP_LANEVARS const int tid = opaque_tid(), grp = tid >> 8, gt = tid & 255, lane = tid & 63, wv = gt >> 6, fr = lane & 15, fq = lane >> 4; \
    unsigned char* lds = dyn_lds + grp * GRP_LDS; float* gc_s = reinterpret_cast<float*>(lds + L_GC); float* beta_s = reinterpret_cast<float*>(lds + L_BETA); \
    const int tg = gt >> 4, sg = gt & 15, t0 = tg * 4, c0 = sg * 8; (void)fr; (void)fq; (void)wv; (void)t0; (void)c0; (void)gc_s; (void)beta_s; (void)lane;
    for (int rr = 0; rr < 2; ++rr) {
        const int grp0 = opaque_tid() >> 8;
        const int xcd_ = blockIdx.x & 7, q_ = (blockIdx.x >> 3) + 32 * rr;
        const int hp = q_ & 1, n = (xcd_ & 1) * 32 + (q_ >> 1), b = xcd_ >> 1, h = hp * 2 + grp0;
        const int item = (b * 4 + h) * 64 + n, tok0 = b * SEQ + n * 64;
        u32x4 rawp[3][7];
        { CP_LANEVARS
#pragma unroll
          for (int ten = 0; ten < 3; ++ten)
#pragma unroll
            for (int r = 0; r < 7; ++r) {
                const int tt = n * 64 + t0 - 3 + r;
                rawp[ten][r] = mk4(0u, 0u, 0u, 0u);
                if (tt >= 0) rawp[ten][r] = *GPC(u32x4)(HA + (size_t)(b * SEQ + tt) * HA_LD + ten * 512 + h * 128 + c0);
            } }
        { CP_LANEVARS
        if (wv == 0) {
            const float bv = *GPC(float)(BA + (size_t)(tok0 + lane) * 8 + h), av = *GPC(float)(BA + (size_t)(tok0 + lane) * 8 + 4 + h);
            const float beta = __builtin_amdgcn_rcpf(1.0f + __expf(-bv));
            const float xx = av + p.dt_bias[l * 4 + h];
            const float sp = fmaxf(xx, 0.f) + log1pf(__expf(-fabsf(xx)));
            float gv = -__expf(p.a_log[l * 4 + h]) * sp;
#pragma unroll
            for (int o = 1; o < 64; o <<= 1) { const float t = __int_as_float(__builtin_amdgcn_ds_bpermute((lane - o) << 2, __float_as_int(gv))); if (lane >= o) gv += t; }
            gc_s[lane] = gv; beta_s[lane] = beta;
            if (lane == 63) *GP(float)(GT + item) = __expf(gv);
        } }
        __syncthreads();
        {
            CP_LANEVARS
            const float glast = gc_s[63];
            float eg[4], ek[4], be[4];
#pragma unroll
            for (int i = 0; i < 4; ++i) { const float gci = gc_s[t0 + i]; eg[i] = __expf(gci); ek[i] = __expf(glast - gci); be[i] = beta_s[t0 + i]; }
#pragma unroll
            for (int ten = 0; ten < 3; ++ten) {
                __builtin_amdgcn_sched_barrier(0);
                float raw[7][8];
#pragma unroll
                for (int r = 0; r < 7; ++r) {
                    const u32x4 u = rawp[ten][r];
                    raw[r][0] = bf_lo(u.x); raw[r][1] = bf_hi(u.x); raw[r][2] = bf_lo(u.y); raw[r][3] = bf_hi(u.y);
                    raw[r][4] = bf_lo(u.z); raw[r][5] = bf_hi(u.z); raw[r][6] = bf_lo(u.w); raw[r][7] = bf_hi(u.w);
                }
                float o[4][8];
#pragma unroll
                for (int i = 0; i < 4; ++i)
#pragma unroll
                    for (int c = 0; c < 8; ++c) o[i][c] = 0.f;
#pragma unroll
                for (int j = 0; j < 4; ++j) {
                    const float* wp = cw + (size_t)j * 1536 + ten * 512 + h * 128 + c0;
                    const f32x4 a = *GPC(f32x4)(wp), c4 = *GPC(f32x4)(wp + 4);
                    const float wj[8] = {a[0], a[1], a[2], a[3], c4[0], c4[1], c4[2], c4[3]};
#pragma unroll
                    for (int i = 0; i < 4; ++i)
#pragma unroll
                        for (int c = 0; c < 8; ++c) o[i][c] += wj[c] * raw[i + j][c];
                }
#pragma unroll
                for (int i = 0; i < 4; ++i)
#pragma unroll
                    for (int c = 0; c < 8; ++c) o[i][c] = silu_f(o[i][c]);
                if (ten < 2) {
#pragma unroll
                    for (int i = 0; i < 4; ++i) {
                        float sq = 0.f;
#pragma unroll
                        for (int c = 0; c < 8; ++c) sq += o[i][c] * o[i][c];
                        sq = row_sum16(sq);
                        const float rq = rsqrtf(sq + 1e-6f) * (ten == 0 ? 0.08838834764831845f : 1.0f);
#pragma unroll
                        for (int c = 0; c < 8; ++c) o[i][c] *= rq;
                    }
                }
                if (ten == 0) {
#pragma unroll
                    for (int i = 0; i < 4; ++i) {
                        u32x4 w;
                        w.x = cvt_pk_bf16(o[i][0], o[i][1]); w.y = cvt_pk_bf16(o[i][2], o[i][3]); w.z = cvt_pk_bf16(o[i][4], o[i][5]); w.w = cvt_pk_bf16(o[i][6], o[i][7]);
                        *reinterpret_cast<u32x4*>(lds + L_QRM + ((t0 + i) * 136 + c0) * 2) = w;
                    }
                } else if (ten == 1) {
#pragma unroll
                    for (int i = 0; i < 4; ++i) {
                        u32x4 w;
                        w.x = cvt_pk_bf16(o[i][0], o[i][1]); w.y = cvt_pk_bf16(o[i][2], o[i][3]); w.z = cvt_pk_bf16(o[i][4], o[i][5]); w.w = cvt_pk_bf16(o[i][6], o[i][7]);
                        *reinterpret_cast<u32x4*>(lds + L_KRM + ((t0 + i) * 136 + c0) * 2) = w;
                    }
#pragma unroll
                    for (int c = 0; c < 8; ++c) {
                        u32x2 w;
                        w.x = cvt_pk_bf16(o[0][c] * ek[0], o[1][c] * ek[1]); w.y = cvt_pk_bf16(o[2][c] * ek[2], o[3][c] * ek[3]);
                        { const int dk_ = c0 + c; *GP(u32x2)(KDT + ((((size_t)item * 8 + (dk_ >> 4)) * 2 + (t0 >> 5)) * 64 + (dk_ & 15) + 16 * ((t0 & 31) >> 3)) * 8 + ((t0 & 7) >> 2) * 4) = w; }
                        w.x = cvt_pk_bf16(o[0][c] * be[0] * eg[0], o[1][c] * be[1] * eg[1]); w.y = cvt_pk_bf16(o[2][c] * be[2] * eg[2], o[3][c] * be[3] * eg[3]);
                        *reinterpret_cast<u32x2*>(lds + L_KBGT + ((c0 + c) * 72 + t0) * 2) = w;
                    }
                } else {
#pragma unroll
                    for (int c = 0; c < 8; ++c) {
                        u32x2 w;
                        w.x = cvt_pk_bf16(o[0][c] * be[0], o[1][c] * be[1]); w.y = cvt_pk_bf16(o[2][c] * be[2], o[3][c] * be[3]);
                        *reinterpret_cast<u32x2*>(lds + L_VBT + ((c0 + c) * 72 + t0) * 2) = w;
                    }
                }
            }
        }
        __syncthreads();
        {
            CP_LANEVARS
            const int ib = wv;
            f32x4 kk[4], qk[4];
#pragma unroll
            for (int jb = 0; jb < 4; ++jb) { kk[jb] = (f32x4){0.f, 0.f, 0.f, 0.f}; qk[jb] = (f32x4){0.f, 0.f, 0.f, 0.f}; }
            bf16x8 ki[4], qi[4];
#pragma unroll
            for (int ks = 0; ks < 4; ++ks) {
                ki[ks] = lds8(lds + L_KRM + ((ib * 16 + fr) * 136 + ks * 32 + fq * 8) * 2);
                qi[ks] = lds8(lds + L_QRM + ((ib * 16 + fr) * 136 + ks * 32 + fq * 8) * 2);
            }
#pragma unroll
            for (int jb = 0; jb < 4; ++jb) {
                if (jb <= ib) {
#pragma unroll
                    for (int ks = 0; ks < 4; ++ks) {
                        const bf16x8 kj = lds8(lds + L_KRM + ((jb * 16 + fr) * 136 + ks * 32 + fq * 8) * 2);
                        kk[jb] = mfma16(ki[ks], kj, kk[jb]);
                        qk[jb] = mfma16(kj, qi[ks], qk[jb]);
                    }
                }
            }
            {
                const float egq = __expf(gc_s[ib * 16 + fr]);
#pragma unroll
                for (int ks = 0; ks < 4; ++ks) {
                    union { bf16x8 v; unsigned u[4]; } qq; qq.v = qi[ks];
                    u32x4 w;
                    w.x = cvt_pk_bf16(bf_lo(qq.u[0]) * egq, bf_hi(qq.u[0]) * egq); w.y = cvt_pk_bf16(bf_lo(qq.u[1]) * egq, bf_hi(qq.u[1]) * egq);
                    w.z = cvt_pk_bf16(bf_lo(qq.u[2]) * egq, bf_hi(qq.u[2]) * egq); w.w = cvt_pk_bf16(bf_lo(qq.u[3]) * egq, bf_hi(qq.u[3]) * egq);
                    *GP(u32x4)(QD + ((((size_t)item * 4 + ib) * 4 + ks) * 64 + lane) * 8) = w;
                }
            }
            __syncthreads();
            float* AP = reinterpret_cast<float*>(lds + L_KRM);
#pragma unroll
            for (int jb = 0; jb < 4; ++jb) {
                if (jb <= ib) {
                    const int j = jb * 16 + fr, i0 = ib * 16 + fq * 4;
                    const float gj = gc_s[j];
#pragma unroll
                    for (int r = 0; r < 4; ++r) {
                        const int i = i0 + r;
                        const float dec = __expf(fminf(gc_s[i] - gj, 0.f));
                        float av_ = (i > j) ? kk[jb][r] * beta_s[i] * dec : 0.f;
                        AP[j * 64 + r * 16 + ib * 4 + fq] = av_;
                    }
                }
                {
                    const int i = ib * 16 + fr, j0 = jb * 16 + fq * 4;
                    const float gi = gc_s[i];
                    float o[4];
#pragma unroll
                    for (int r = 0; r < 4; ++r) {
                        const int j = j0 + r;
                        const float dec = __expf(fminf(gi - gc_s[j], 0.f));
                        o[r] = (i >= j) ? qk[jb][r] * dec : 0.f;
                    }
                    u32x2 w; w.x = cvt_pk_bf16(o[0], o[1]); w.y = cvt_pk_bf16(o[2], o[3]);
                    *GP(u32x2)(QK + ((((size_t)item * 4 + ib) * 2 + (jb >> 1)) * 64 + fr + 16 * ((jb & 1) * 2 + (fq >> 1))) * 8 + (fq & 1) * 4) = w;
                }
            }
        }
        __syncthreads();
        {
            CP_LANEVARS
            const float* AP = reinterpret_cast<const float*>(lds + L_KRM);
            const int cbk = grp ? 3 - wv : wv;
            const int cl = lane >> 2, pp = lane & 3, ccol = cbk * 16 + cl;
            float a[16];
#pragma unroll
            for (int k = 0; k < 16; ++k) a[k] = (4 * k + pp == ccol) ? 1.f : 0.f;
#define INV_STEP(SS) { const int j = jq * 4 + SS; \
                    const float tj = __int_as_float(__builtin_amdgcn_update_dpp(0, __float_as_int(a[jq]), SS * 0x55, 0xf, 0xf, false)); \
                    const float* ap = AP + j * 64 + pp * 16; \
                    _Pragma("unroll") for (int k = jq; k < 16; ++k) a[k] -= ap[k] * tj; }
#pragma unroll
            for (int jq = 0; jq < 16; ++jq) {
                __builtin_amdgcn_sched_barrier(0);
                if (jq >= cbk * 4) {
                    INV_STEP(0) INV_STEP(1) INV_STEP(2)
                    if (jq < 15) INV_STEP(3)
                }
            }
#undef INV_STEP
            bf16_t* TR = reinterpret_cast<bf16_t*>(lds + L_QRM);
#pragma unroll
            for (int k = 0; k < 16; ++k) TR[(4 * k + pp) * 72 + ccol] = (bf16_t)(cvt_pk_bf16(a[k], 0.f) & 0xffffu);
        }
        __syncthreads();
        {
            CP_LANEVARS
            bf16x8 tf[2];
#pragma unroll
            for (int ks = 0; ks < 2; ++ks) tf[ks] = lds8(lds + L_QRM + ((wv * 16 + fr) * 72 + ks * 32 + fq * 8) * 2);
#pragma unroll
            for (int db = 0; db < 8; ++db) {
                f32x4 au = (f32x4){0.f, 0.f, 0.f, 0.f}, aw = (f32x4){0.f, 0.f, 0.f, 0.f};
#pragma unroll
                for (int ks = 0; ks < 2; ++ks) {
                    const bf16x8 vb = lds8(lds + L_VBT + ((db * 16 + fr) * 72 + ks * 32 + fq * 8) * 2);
                    const bf16x8 kb = lds8(lds + L_KBGT + ((db * 16 + fr) * 72 + ks * 32 + fq * 8) * 2);
                    au = mfma16(tf[ks], vb, au);
                    aw = mfma16(kb, tf[ks], aw);
                }
                u32x2 w; w.x = cvt_pk_bf16(au[0], au[1]); w.y = cvt_pk_bf16(au[2], au[3]);
                *GP(u32x2)(UT + ((((size_t)item * 8 + db) * 2 + (wv >> 1)) * 64 + fr + 16 * ((wv & 1) * 2 + (fq >> 1))) * 8 + (fq & 1) * 4) = w;
                w.x = cvt_pk_bf16(aw[0], aw[1]); w.y = cvt_pk_bf16(aw[2], aw[3]);
                *GP(u32x2)(W + ((((size_t)item * 4 + wv) * 4 + (db >> 1)) * 64 + fr + 16 * ((db & 1) * 2 + (fq >> 1))) * 8 + (fq & 1) * 4) = w;
            }
        }
        __syncthreads();
    }
}

__device__ __forceinline__ void delta_scan(const Params& p_, int blk, int g_wave) {
    Params p = p_; p.ws = opaque_ws(p.ws);
    const int tid = opaque_tid(), lane = tid & 63, w = tid >> 6, fr = lane & 15, fq = lane >> 4;
    const int bh = ((blk & 7) >> 1) * 4 + ((blk & 7) & 1) * 2 + ((blk >> 3) & 1), sl = blk >> 4, dv0 = sl * 32;
    bf16_t* ST = reinterpret_cast<bf16_t*>(p.ws + OFF_HA);
    bf16_t* UT = reinterpret_cast<bf16_t*>(p.ws + OFF_UT);
    const bf16_t* W = reinterpret_cast<const bf16_t*>(p.ws + OFF_W);
    const bf16_t* KDT = reinterpret_cast<const bf16_t*>(p.ws + OFF_KDT);
    const float* GT = reinterpret_cast<const float*>(p.ws + OFF_GT);
    unsigned char* STL = dyn_lds;
    unsigned char* VTL = dyn_lds + 8704;
    unsigned char* DMY = dyn_lds + 13312;
    unsigned char* RING = dyn_lds + 16384;
    (void)dv0;
#define LDS_BAR() do { asm volatile("s_waitcnt lgkmcnt(0)" ::: "memory"); __builtin_amdgcn_s_barrier(); asm volatile("" ::: "memory"); } while (0)
    if (w >= 4) {
        constexpr int PD = 10;
        const int hw = w - 4, pl = hw * 64 + lane;
#define RING_LOAD(C) do { const int c_ = (C) < 64 ? (C) : 63; const int slot_ = (C) & 3; \
            const bf16_t* wsrc = W + (size_t)(bh * 64 + c_) * 8192 + (hw * 4) * 512 + lane * 8; \
            const bf16_t* ksrc = KDT + (size_t)(bh * 64 + c_) * 8192 + (hw * 4) * 512 + lane * 8; \
            _Pragma("unroll") for (int j = 0; j < 4; ++j) { \
                __builtin_amdgcn_global_load_lds((const unsigned*)(wsrc + j * 512), (unsigned*)(RING + slot_ * 32768 + (hw * 4 + j) * 1024), 16, 0, 0); \
                __builtin_amdgcn_global_load_lds((const unsigned*)(ksrc + j * 512), (unsigned*)(RING + slot_ * 32768 + 16384 + (hw * 4 + j) * 1024), 16, 0, 0); } } while (0)
#define TOUCH(C) do { const int c_ = (C) < 64 ? (C) : 63; const int item_ = bh * 64 + c_; \
            const int li = sl * 32 + (lane & 31); \
            const unsigned char* a0 = (hw == 0) ? ((lane < 32) ? reinterpret_cast<const unsigned char*>(W + (size_t)item_ * 8192) + li * 128 \
                                                               : reinterpret_cast<const unsigned char*>(KDT + (size_t)item_ * 8192) + li * 128) \
                                                : reinterpret_cast<const unsigned char*>(UT + ((size_t)item_ * 8 + sl * 2) * 1024) + (lane & 31) * 128; \
            __builtin_amdgcn_global_load_lds((const unsigned*)a0, (unsigned*)(DMY + hw * 256), 4, 0, 0); } while (0)
        for (int c = 0; c < PD; ++c) TOUCH(c);
        RING_LOAD(0); RING_LOAD(1); RING_LOAD(2);
        asm volatile("s_waitcnt vmcnt(0)" ::: "memory");
        __syncthreads();
        for (int n = 0; n < 64; ++n) {
            const int item = bh * 64 + n;
            __builtin_amdgcn_s_barrier();
            {
                const int dvb_ = pl >> 7, ks_ = (pl >> 6) & 1, l_ = pl & 63;
                const u32x4 v = *reinterpret_cast<const u32x4*>(VTL + ((dvb_ * 16 + (l_ & 15)) * 72 + ks_ * 32 + (l_ >> 4) * 8) * 2);
                *GP(u32x4)(UT + (((size_t)item * 8 + sl * 2) * 128 + pl) * 8) = v;
            }
            asm volatile("s_waitcnt vmcnt(14) lgkmcnt(0)" ::: "memory");
            __builtin_amdgcn_s_barrier();
            {
                bf16_t* dst = (n < 63) ? ST + (((size_t)(item + 1) * 8 + sl * 2) * 256) * 8 : ST + (size_t)1024 * 16384 + (size_t)blk * 4096;
#pragma unroll
                for (int j = 0; j < 2; ++j) {
                    const int q = pl + 256 * j, dvb_ = q >> 8, ks_ = (q >> 6) & 3, l_ = q & 63;
                    const u32x4 v = *reinterpret_cast<const u32x4*>(STL + ((dvb_ * 16 + (l_ & 15)) * 136 + ks_ * 32 + (l_ >> 4) * 8) * 2);
                    *GP(u32x4)(dst + (size_t)q * 8) = v;
                }
            }
            RING_LOAD(n + 3);
            TOUCH(n + PD);
            asm volatile("s_waitcnt lgkmcnt(0)" ::: "memory");
        }
        asm volatile("s_waitcnt vmcnt(0)" ::: "memory");
#undef RING_LOAD
#undef TOUCH
    } else {
        f32x4 S[2][2];
#pragma unroll
        for (int kb = 0; kb < 2; ++kb)
#pragma unroll
            for (int db = 0; db < 2; ++db) {
                S[kb][db] = (f32x4){0.f, 0.f, 0.f, 0.f};
                const u32x2 z = mk2(0u, 0u);
                *reinterpret_cast<u32x2*>(STL + ((db * 16 + fr) * 136 + (2 * w + kb) * 16 + fq * 4) * 2) = z;
                *GP(u32x2)(ST + (((size_t)(bh * 64) * 8 + sl * 2) * 256) * 8 + (size_t)(((kb * 2 + db) * 256 + w * 64 + lane)) * 4) = z;
            }
        __syncthreads();
#define SCAN_LOAD(NN, UB, GTV) do { const int item_ = bh * 64 + (NN); \
        _Pragma("unroll") for (int db = 0; db < 2; ++db) UB[db] = *GPC(u32x2)(UT + ((((size_t)item_ * 8 + sl * 2 + db) * 2 + (w >> 1)) * 64 + fr + 16 * ((w & 1) * 2 + (fq >> 1))) * 8 + (fq & 1) * 4); \
        GTV = *GPC(float)(GT + item_); } while (0)
        u32x2 ubA[2], ubB[2], ubC[2]; float gtA, gtB, gtC;
        SCAN_LOAD(0, ubA, gtA); SCAN_LOAD(1, ubB, gtB);
#define SCAN_STEP(N_, UB, GTV, NUB, NGT) do { \
        const int n = (N_); \
        { const int nn = n + 2 < 64 ? n + 2 : 63; SCAN_LOAD(nn, NUB, NGT); } \
        const unsigned char* slot = RING + (n & 3) * 32768; \
        { bf16x8 sb_[2][4], wf_[4]; \
          _Pragma("unroll") for (int ks = 0; ks < 4; ++ks) wf_[ks] = lds8(slot + ((w * 4 + ks) * 64 + lane) * 16); \
          _Pragma("unroll") for (int db = 0; db < 2; ++db) _Pragma("unroll") for (int ks = 0; ks < 4; ++ks) sb_[db][ks] = lds8(STL + ((db * 16 + fr) * 136 + ks * 32 + fq * 8) * 2); \
          f32x4 a10 = (f32x4){0.f, 0.f, 0.f, 0.f}, a11 = (f32x4){0.f, 0.f, 0.f, 0.f}; \
          _Pragma("unroll") for (int ks = 0; ks < 4; ++ks) { a10 = mfma16(wf_[ks], sb_[0][ks], a10); a11 = mfma16(wf_[ks], sb_[1][ks], a11); } \
          _Pragma("unroll") for (int db = 0; db < 2; ++db) { \
              const f32x4 a1 = db ? a11 : a10; u32x2 vw; \
              vw.x = cvt_pk_bf16(bf_lo(UB[db].x) - a1[0], bf_hi(UB[db].x) - a1[1]); vw.y = cvt_pk_bf16(bf_lo(UB[db].y) - a1[2], bf_hi(UB[db].y) - a1[3]); \
              *reinterpret_cast<u32x2*>(VTL + ((db * 16 + fr) * 72 + w * 16 + fq * 4) * 2) = vw; \
              } } \
        LDS_BAR(); \
        { bf16x8 vb_[2][2], kf_[2][2]; \
          _Pragma("unroll") for (int kb = 0; kb < 2; ++kb) _Pragma("unroll") for (int ks = 0; ks < 2; ++ks) kf_[kb][ks] = lds8(slot + 16384 + (((2 * w + kb) * 2 + ks) * 64 + lane) * 16); \
          _Pragma("unroll") for (int db = 0; db < 2; ++db) _Pragma("unroll") for (int ks = 0; ks < 2; ++ks) vb_[db][ks] = lds8(VTL + ((db * 16 + fr) * 72 + ks * 32 + fq * 8) * 2); \
          _Pragma("unroll") for (int kb = 0; kb < 2; ++kb) _Pragma("unroll") for (int db = 0; db < 2; ++db) { \
              f32x4 a2 = S[kb][db] * GTV; \
              a2 = mfma16(kf_[kb][0], vb_[db][0], a2); a2 = mfma16(kf_[kb][1], vb_[db][1], a2); \
              S[kb][db] = a2; \
              if (n < 63) { \
                  u32x2 sw; sw.x = cvt_pk_bf16(a2[0], a2[1]); sw.y = cvt_pk_bf16(a2[2], a2[3]); \
                  *reinterpret_cast<u32x2*>(STL + ((db * 16 + fr) * 136 + (2 * w + kb) * 16 + fq * 4) * 2) = sw; \
              } } } \
        LDS_BAR(); } while (0)
        for (int n3 = 0; n3 < 63; n3 += 3) {
            SCAN_STEP(n3 + 0, ubA, gtA, ubC, gtC);
            SCAN_STEP(n3 + 1, ubB, gtB, ubA, gtA);
            SCAN_STEP(n3 + 2, ubC, gtC, ubB, gtB);
        }
        SCAN_STEP(63, ubA, gtA, ubC, gtC);
#undef SCAN_STEP
#undef SCAN_LOAD
    }
#undef LDS_BAR
}

__device__ __forceinline__ void swa_phase(const Params& p_, int l, int sblk, int nsb, int g_wave) {
    Params p = p_; p.ws = opaque_ws(p.ws);
    const int tid = opaque_tid(), lane = tid & 63, w = tid >> 6, fr = lane & 15, fq = lane >> 4;
    const bf16_t* HB = reinterpret_cast<const bf16_t*>(p.ws + OFF_HB);
    bf16_t* YM = reinterpret_cast<bf16_t*>(p.ws + OFF_XB);
    unsigned char* VTS = dyn_lds;
    unsigned char* KSL = dyn_lds + 21504;
    const int sw_xcd = sblk & 7, sw_j = sblk >> 3, sw_n = nsb >> 3;
    for (int qi = sw_j; qi < 128; qi += sw_n) {
        const int b = sw_xcd >> 1, kvh = qi & 1, qt = (sw_xcd & 1) * 64 + (qi >> 1), q0 = qt * 32, kbase = q0 - 128;
        for (int idx = tid; idx < 1280; idx += 512) {
            const int key = idx >> 3, sg = idx & 7, kp = kbase + key;
            u32x4 u = mk4(0u, 0u, 0u, 0u);
            if (kp >= 0) u = *GPC(u32x4)(HB + (size_t)(b * SEQ + kp) * HB_LD + HB_KB + kvh * 64 + sg * 8);
            *reinterpret_cast<u32x4*>(KSL + (key * 72 + sg * 8) * 2) = u;
        }
        if (tid < 320) {
            const int kg = tid >> 3, sg = tid & 7;
            u32x4 u[4];
#pragma unroll
            for (int k = 0; k < 4; ++k) {
                const int kp = kbase + kg * 4 + k;
                u[k] = mk4(0u, 0u, 0u, 0u);
                if (kp >= 0) u[k] = *GPC(u32x4)(HB + (size_t)(b * SEQ + kp) * HB_LD + HB_VB + kvh * 64 + sg * 8);
            }
#pragma unroll
            for (int dp = 0; dp < 4; ++dp) {
                u32x2 lo, hi;
                lo.x = (u[0][dp] & 0xffffu) | (u[1][dp] << 16); lo.y = (u[2][dp] & 0xffffu) | (u[3][dp] << 16);
                hi.x = (u[0][dp] >> 16) | (u[1][dp] & 0xffff0000u); hi.y = (u[2][dp] >> 16) | (u[3][dp] & 0xffff0000u);
                *reinterpret_cast<u32x2*>(VTS + ((sg * 8 + dp * 2) * 168 + kg * 4) * 2) = lo;
                *reinterpret_cast<u32x2*>(VTS + ((sg * 8 + dp * 2 + 1) * 168 + kg * 4) * 2) = hi;
            }
        }
        const int g = w >> 1, sub = w & 1, qs = q0 + sub * 16, hq = kvh * 4 + g;
        const float slope = exp2f(-(float)(hq + 1)), sink = p.sinks[l * 8 + hq];
        bf16x8 qf[2];
#pragma unroll
        for (int ks = 0; ks < 2; ++ks) qf[ks] = ldg8(HB + (size_t)(b * SEQ + qs + fr) * HB_LD + HB_QB + hq * 64 + ks * 32 + fq * 8);
        __syncthreads();
        f32x4 sc[10];
#pragma unroll
        for (int kt = 0; kt < 10; ++kt) {
            const unsigned char* kr = KSL + ((kt * 16 + fr) * 72 + fq * 8) * 2;
            f32x4 a = (f32x4){0.f, 0.f, 0.f, 0.f};
            a = mfma16(lds8(kr), qf[0], a);
            a = mfma16(lds8(kr + 64), qf[1], a);
            sc[kt] = a;
        }
        const int qpos = qs + fr;
        float m = -1e30f;
#pragma unroll
        for (int kt = 0; kt < 10; ++kt)
#pragma unroll
            for (int r = 0; r < 4; ++r) {
                const int kpos = kbase + kt * 16 + fq * 4 + r, dist = qpos - kpos;
                const bool valid = (dist >= 0) && (dist < 128) && (kpos >= 0);
                const float s = valid ? sc[kt][r] * 0.125f - slope * (float)dist : -1e30f;
                sc[kt][r] = s; m = fmaxf(m, s);
            }
        m = fmaxf(m, shx(m, 16, lane)); m = fmaxf(m, shx(m, 32, lane));
        m = fmaxf(m, sink);
        float lsum = 0.f;
#pragma unroll
        for (int kt = 0; kt < 10; ++kt)
#pragma unroll
            for (int r = 0; r < 4; ++r) { const float e = __expf(sc[kt][r] - m); sc[kt][r] = e; lsum += e; }
        lsum += shx(lsum, 16, lane); lsum += shx(lsum, 32, lane);
        lsum += __expf(sink - m);
        const float inv = __builtin_amdgcn_rcpf(lsum);
        f32x4 o[4];
#pragma unroll
        for (int db = 0; db < 4; ++db) o[db] = (f32x4){0.f, 0.f, 0.f, 0.f};
#pragma unroll
        for (int j = 0; j < 5; ++j) {
            union { bf16x8 v; unsigned u[4]; } pf;
            pf.u[0] = cvt_pk_bf16(sc[2 * j][0], sc[2 * j][1]); pf.u[1] = cvt_pk_bf16(sc[2 * j][2], sc[2 * j][3]);
            pf.u[2] = cvt_pk_bf16(sc[2 * j + 1][0], sc[2 * j + 1][1]); pf.u[3] = cvt_pk_bf16(sc[2 * j + 1][2], sc[2 * j + 1][3]);
#pragma unroll
            for (int db = 0; db < 4; ++db) {
                union { bf16x8 v; u32x2 h[2]; } vf;
                const unsigned char* vr = VTS + ((db * 16 + fr) * 168 + (2 * j) * 16 + fq * 4) * 2;
                vf.h[0] = *reinterpret_cast<const u32x2*>(vr);
                vf.h[1] = *reinterpret_cast<const u32x2*>(vr + 32);
                o[db] = mfma16(vf.v, pf.v, o[db]);
            }
        }
        {
            const size_t tok = (size_t)(b * SEQ + qs + fr);
#pragma unroll
            for (int db = 0; db < 4; ++db) {
                const int col = hq * 64 + db * 16 + fq * 4;
                const u32x2 z = *GPC(u32x2)(HB + tok * HB_LD + HB_ZB + col);
                u32x2 y;
                y.x = cvt_pk_bf16(o[db][0] * inv * silu_f(bf_lo(z.x)), o[db][1] * inv * silu_f(bf_hi(z.x)));
                y.y = cvt_pk_bf16(o[db][2] * inv * silu_f(bf_lo(z.y)), o[db][3] * inv * silu_f(bf_hi(z.y)));
                *GP(u32x2)(YM + tok * DM + 512 + col) = y;
            }
        }
        __syncthreads();
    }
}

__device__ __forceinline__ void delta_out(const Params& p_, int l, int g_wave) {
    Params p = p_; p.ws = opaque_ws(p.ws);
    const int tid = opaque_tid(), grp = tid >> 8, lane = tid & 63, wv = (tid & 255) >> 6, fr = lane & 15, fq = lane >> 4;
    const bf16_t* ST = reinterpret_cast<const bf16_t*>(p.ws + OFF_HA);
    const bf16_t* VT = reinterpret_cast<const bf16_t*>(p.ws + OFF_UT);
    const bf16_t* QD = reinterpret_cast<const bf16_t*>(p.ws + OFF_QD);
    const bf16_t* QK = reinterpret_cast<const bf16_t*>(p.ws + OFF_QK);
    const bf16_t* HB = reinterpret_cast<const bf16_t*>(p.ws + OFF_HB);
    bf16_t* YM = reinterpret_cast<bf16_t*>(p.ws + OFF_XB);
    const float* nw = p.norm_w + l * 128;
    for (int rr = 0; rr < 2; ++rr) {
        const int xcd_ = blockIdx.x & 7, q_ = (blockIdx.x >> 3) + 32 * rr;
        const int b = xcd_ >> 1, n = (xcd_ & 1) * 32 + (q_ >> 1), h = (q_ & 1) * 2 + grp, item = (b * 4 + h) * 64 + n;
        const int tok = b * SEQ + n * 64 + wv * 16 + fr;
        bf16x8 qd[4], qk[2];
#pragma unroll
        for (int ks = 0; ks < 4; ++ks) qd[ks] = ldg8(QD + ((((size_t)item * 4 + wv) * 4 + ks) * 64 + lane) * 8);
#pragma unroll
        for (int ks = 0; ks < 2; ++ks) qk[ks] = ldg8(QK + ((((size_t)item * 4 + wv) * 2 + ks) * 64 + lane) * 8);
        u32x2 zz[8];
#pragma unroll
        for (int db = 0; db < 8; ++db) zz[db] = *GPC(u32x2)(HB + (size_t)tok * HB_LD + HB_ZA + h * 128 + db * 16 + fq * 4);
        f32x4 o[8];
        float ss = 0.f;
        bf16x8 sfA[4], vfA[2], sfB[4], vfB[2];
#define DO_LOAD(DB, SF, VF) do { const bf16_t* sp = ST + ((((size_t)item * 8 + (DB)) * 4) * 64 + lane) * 8; const bf16_t* vp = VT + ((((size_t)item * 8 + (DB)) * 2) * 64 + lane) * 8; \
            _Pragma("unroll") for (int ks = 0; ks < 4; ++ks) SF[ks] = ldg8(sp + ks * 512); \
            _Pragma("unroll") for (int ks = 0; ks < 2; ++ks) VF[ks] = ldg8(vp + ks * 512); } while (0)
#define DO_MMA(DB, SF, VF) do { f32x4 a = (f32x4){0.f, 0.f, 0.f, 0.f}; \
            _Pragma("unroll") for (int ks = 0; ks < 4; ++ks) a = mfma16(SF[ks], qd[ks], a); \
            _Pragma("unroll") for (int ks = 0; ks < 2; ++ks) a = mfma16(VF[ks], qk[ks], a); \
            o[DB] = a; ss += (a[0] * a[0] + a[1] * a[1]) + (a[2] * a[2] + a[3] * a[3]); } while (0)
        DO_LOAD(0, sfA, vfA); DO_LOAD(1, sfB, vfB);
#pragma unroll
        for (int db = 0; db < 8; db += 2) {
            DO_MMA(db, sfA, vfA);
            if (db + 2 < 8) DO_LOAD(db + 2, sfA, vfA);
            DO_MMA(db + 1, sfB, vfB);
            if (db + 3 < 8) DO_LOAD(db + 3, sfB, vfB);
        }
#undef DO_LOAD
#undef DO_MMA
        ss += shx(ss, 16, lane); ss += shx(ss, 32, lane);
        const float rs = rsqrtf(ss * (1.0f / 128.0f) + 1e-6f);
#pragma unroll
        for (int db = 0; db < 8; ++db) {
            const int dv = db * 16 + fq * 4;
            const f32x4 nv = *GPC(f32x4)(nw + dv);
            const u32x2 z = zz[db];
            u32x2 y;
            y.x = cvt_pk_bf16(o[db][0] * rs * nv[0] * silu_f(bf_lo(z.x)), o[db][1] * rs * nv[1] * silu_f(bf_hi(z.x)));
            y.y = cvt_pk_bf16(o[db][2] * rs * nv[2] * silu_f(bf_lo(z.y)), o[db][3] * rs * nv[3] * silu_f(bf_hi(z.y)));
            *GP(u32x2)(YM + (size_t)tok * DM + h * 128 + dv) = y;
        }
    }
}


__global__ void __launch_bounds__(512) fwd_megakernel(Params p) {
    __shared__ u32x4 xb_words;
    const int g_wave = __builtin_amdgcn_readfirstlane((int)(threadIdx.x >> 6));
    if (xb_t0(g_wave)) xb_words = mk4(0u, 0u, 0u, 0u);
    __syncthreads();
    XcdBarrier gb = xcd_barrier_post(reinterpret_cast<unsigned*>(p.ws + OFF_BAR), (volatile LAS unsigned*)&xb_words, g_wave);

    prep_weights(p, 0, blockIdx.x, gridDim.x, g_wave);
    row_pass(p.x, false, nullptr, nullptr, nullptr, reinterpret_cast<bf16_t*>(p.ws + OFF_XB), p.w_in + 2048, reinterpret_cast<float*>(p.ws + OFF_BA), g_wave);
    xcd_barrier(gb);
    for (int l = 0; l < 2; ++l) {
        unsigned char* wsl = opaque_ws(p.ws);
        bf16_t* XB = reinterpret_cast<bf16_t*>(wsl + OFF_XB);
        float* BA = reinterpret_cast<float*>(wsl + OFF_BA);
        {
            EpiH e; e.ha = reinterpret_cast<bf16_t*>(p.ws + OFF_HA); e.hb = reinterpret_cast<bf16_t*>(p.ws + OFF_HB);
            gemm_phase(XB, reinterpret_cast<const bf16_t*>(p.ws + OFF_WIN) + (size_t)l * NIN * DM, NTOK, NIN, DM, e, g_wave);
            if (l == 0 && blockIdx.x >= 64) prep_weights(p, 1, blockIdx.x - 64, gridDim.x - 64, g_wave);
        }
        xcd_barrier(gb);
        chunk_prep(p, l, g_wave);
        xcd_barrier(gb);
        if (blockIdx.x < 64) delta_scan(p, blockIdx.x, g_wave);
        else swa_phase(p, l, blockIdx.x - 64, gridDim.x - 64, g_wave);
        xcd_barrier(gb);
        if (l == 0) { const int t_ = opaque_tid(); float zf_ = 0.f; asm volatile("" : "+v"(zf_)); for (int i = blockIdx.x * 512 + t_; i < NTOK * 2; i += gridDim.x * 512) *GP(f32x4)(BA + (size_t)i * 4) = (f32x4){zf_, zf_, zf_, zf_}; }
        delta_out(p, l, g_wave);
        xcd_barrier(gb);
        {
            EpiLN e; e.xres = (l == 0) ? p.x : p.out; e.out = p.out; e.xb = (l == 0) ? XB : nullptr;
            e.g = p.ln_g + l * DM; e.b = p.ln_b + l * DM; e.wg = (l == 0) ? p.w_in + (size_t)DM * INC + 2048 : nullptr; e.BA = BA;
            e.xbuf = reinterpret_cast<float*>(wsl + OFF_XS) + (size_t)l * NTOK * 8;
            e.cnt = reinterpret_cast<unsigned*>(wsl + OFF_BAR) + 3500 + l * 64; e.tmo = reinterpret_cast<unsigned*>(wsl + OFF_BAR) + XB_TMO; e.gw = g_wave;
            gemm_phase(XB, reinterpret_cast<const bf16_t*>(p.ws + OFF_WOUT) + (size_t)l * DM * DM, NTOK, DM, DM, e, g_wave);
        }
        if (l == 0) xcd_barrier(gb);
    }
}

extern "C" void kernel_launch(void* const* d_in, const int* in_sizes, int n_in, void* d_out, int out_size, void* d_ws, size_t ws_size, hipStream_t stream) {
    static int grid_blocks = 0;
    if (!grid_blocks) {
        int dev = 0, cus = 0, per_cu = 0;
        hipGetDevice(&dev);
        hipDeviceGetAttribute(&cus, hipDeviceAttributeMultiprocessorCount, dev);
        hipFuncSetAttribute((const void*)fwd_megakernel, hipFuncAttributeMaxDynamicSharedMemorySize, LDS_BYTES);
        hipOccupancyMaxActiveBlocksPerMultiprocessor(&per_cu, fwd_megakernel, 512, LDS_BYTES);
        grid_blocks = (per_cu >= 1) ? cus : 0;
        if (grid_blocks > 256) grid_blocks = 256;
        if (ws_size < WS_NEED) { fprintf(stderr, "workspace too small: %zu < %zu\n", ws_size, (size_t)WS_NEED); }
        if (!grid_blocks) { fprintf(stderr, "occupancy query returned 0\n"); grid_blocks = 256; }
    }
    Params p{};
    p.x = (const float*)d_in[0]; p.w_in = (const float*)d_in[1]; p.conv_w = (const float*)d_in[2]; p.a_log = (const float*)d_in[3];
    p.dt_bias = (const float*)d_in[4]; p.norm_w = (const float*)d_in[5]; p.sinks = (const float*)d_in[6]; p.w_out = (const float*)d_in[7];
    p.ln_g = (const float*)d_in[8]; p.ln_b = (const float*)d_in[9]; p.out = (float*)d_out; p.ws = (unsigned char*)d_ws;
    hipMemsetAsync(d_ws, 0, 16384, stream);
    void* args[] = {&p};
    hipError_t e = hipLaunchCooperativeKernel((const void*)fwd_megakernel, dim3(grid_blocks), dim3(512), args, LDS_BYTES, stream);
    if (e != hipSuccess) fprintf(stderr, "cooperative launch failed: %s (grid %d)\n", hipGetErrorString(e), grid_blocks);
}
```

```cpp
#include <hip/hip_runtime.h>
#include <cstdio>
#include <cstdint>

#define LAS __attribute__((address_space(3)))
__device__ __forceinline__ int opaque_lane() { int lane; asm volatile("v_mbcnt_lo_u32_b32 %0, -1, 0\n\tv_mbcnt_hi_u32_b32 %0, -1, %0" : "=v"(lane)); return lane; }
typedef unsigned short bf16_t;
typedef short bf16x8 __attribute__((ext_vector_type(8)));
typedef float f32x4 __attribute__((ext_vector_type(4)));
typedef unsigned u32x4 __attribute__((ext_vector_type(4)));
typedef unsigned u32x2 __attribute__((ext_vector_type(2)));
__device__ __forceinline__ u32x4 mk4(unsigned a, unsigned b, unsigned c, unsigned d) { return (u32x4){a, b, c, d}; }
__device__ __forceinline__ u32x2 mk2(unsigned a, unsigned b) { return (u32x2){a, b}; }

constexpr int NTOK = 16384, SEQ = 4096, DM = 1024, INC = 3336, NIN = 3328;
constexpr int HA_LD = 1536, HB_LD = 1792;
constexpr int HB_ZA = 0, HB_QB = 512, HB_KB = 1024, HB_VB = 1152, HB_ZB = 1280;
constexpr float DN_ALPHA = 1.41421356237f;

constexpr size_t OFF_BAR = 0;
constexpr size_t OFF_XB = 16384;
constexpr size_t OFF_WIN = OFF_XB + (size_t)NTOK * DM * 2;
constexpr size_t OFF_WOUT = OFF_WIN + (size_t)2 * NIN * DM * 2;
constexpr size_t OFF_HA = OFF_WOUT + (size_t)2 * DM * DM * 2;
constexpr size_t OFF_HB = OFF_HA + (size_t)NTOK * HA_LD * 2;
constexpr size_t OFF_UT = OFF_HB + (size_t)NTOK * HB_LD * 2;
constexpr size_t OFF_W = OFF_UT + (size_t)NTOK * 512 * 2;
constexpr size_t OFF_QD = OFF_W + (size_t)NTOK * 512 * 2;
constexpr size_t OFF_KDT = OFF_QD + (size_t)NTOK * 512 * 2;
constexpr size_t OFF_QK = OFF_KDT + (size_t)NTOK * 512 * 2;
constexpr size_t OFF_BA = OFF_QK + (size_t)NTOK * 256 * 2;
constexpr size_t OFF_GT = OFF_BA + (size_t)NTOK * 8 * 4;
constexpr size_t OFF_XS = OFF_GT + 4096;
constexpr size_t WS_NEED = OFF_XS + (size_t)2 * NTOK * 4 * 8;

constexpr int LDS_BYTES = 147456;
extern __shared__ __attribute__((aligned(16))) unsigned char dyn_lds[];

struct Params {
    const float* x; const float* w_in; const float* conv_w; const float* a_log; const float* dt_bias;
    const float* norm_w; const float* sinks; const float* w_out; const float* ln_g; const float* ln_b;
    float* out; unsigned char* ws;
};

typedef float f32x2_t __attribute__((ext_vector_type(2)));
typedef __bf16 bf16x2_t __attribute__((ext_vector_type(2)));
__device__ __forceinline__ unsigned cvt_pk_bf16(float lo, float hi) {
    const f32x2_t v = {lo, hi};
    const bf16x2_t r = __builtin_convertvector(v, bf16x2_t);
    return __builtin_bit_cast(unsigned, r);
}
__device__ __forceinline__ float bf_lo(unsigned u) { return __uint_as_float(u << 16); }
__device__ __forceinline__ float bf_hi(unsigned u) { return __uint_as_float(u & 0xffff0000u); }
__device__ __forceinline__ float silu_f(float x) { return x * __builtin_amdgcn_rcpf(1.0f + __expf(-x)); }
__device__ __forceinline__ f32x4 mfma16(bf16x8 a, bf16x8 b, f32x4 c) { return __builtin_amdgcn_mfma_f32_16x16x32_bf16(a, b, c, 0, 0, 0); }
#define GPC(T) (const __attribute__((address_space(1))) T*)
#define GP(T) (__attribute__((address_space(1))) T*)
__device__ __forceinline__ bf16x8 ldg8(const bf16_t* p) { return *GPC(bf16x8)(p); }
__device__ __forceinline__ bf16x8 lds8(const unsigned char* p) { return *reinterpret_cast<const bf16x8*>(p); }

__device__ __forceinline__ int opaque_tid_(int g_wave) {
    int lane; asm volatile("v_mbcnt_lo_u32_b32 %0, -1, 0\n\tv_mbcnt_hi_u32_b32 %0, -1, %0" : "=v"(lane));
    return g_wave * 64 + lane; }
#define opaque_tid() opaque_tid_(g_wave)
__device__ __forceinline__ unsigned char* opaque_ws(unsigned char* w) { asm volatile("" : "+s"(w)); return w; }
__device__ __forceinline__ const bf16_t* uniform_ptr(const bf16_t* p) {
    const unsigned long long v = (unsigned long long)p;
    const unsigned lo = __builtin_amdgcn_readfirstlane((unsigned)v), hi = __builtin_amdgcn_readfirstlane((unsigned)(v >> 32));
    return (const bf16_t*)(((unsigned long long)hi << 32) | lo);
}

__device__ __forceinline__ float shx(float v, int m, int lane) { return __int_as_float(__builtin_amdgcn_ds_bpermute((lane ^ m) << 2, __float_as_int(v))); }

__device__ __forceinline__ float row_sum16(float x) {
    x += __int_as_float(__builtin_amdgcn_update_dpp(0, __float_as_int(x), 0x128, 0xf, 0xf, false));
    x += __int_as_float(__builtin_amdgcn_update_dpp(0, __float_as_int(x), 0x124, 0xf, 0xf, false));
    x += __int_as_float(__builtin_amdgcn_update_dpp(0, __float_as_int(x), 0x122, 0xf, 0xf, false));
    x += __int_as_float(__builtin_amdgcn_update_dpp(0, __float_as_int(x), 0x121, 0xf, 0xf, false));
    return x;
}

#define XB_TMO      128
#define XB_XCNT(j)  (256  + 64 * (j))
#define XB_XSUB(j)  (1280 + 64 * (j))
#define XB_XGEN(j)  (2304 + 64 * (j))
#define XB_TOP      3328
#define XB_TOPGEN   3392
#define XCD_BAR_WORDS 3456
#define XB_SPIN_CAP (1u << 20)
__device__ __forceinline__ unsigned xb_ld(unsigned* p)              { return __hip_atomic_load(p, __ATOMIC_RELAXED, __HIP_MEMORY_SCOPE_AGENT); }
__device__ __forceinline__ unsigned xb_add(unsigned* p, unsigned v) { return __hip_atomic_fetch_add(p, v, __ATOMIC_RELAXED, __HIP_MEMORY_SCOPE_AGENT); }
__device__ __forceinline__ unsigned xb_xcc_id() { return (unsigned)__builtin_amdgcn_s_getreg((3 << 11) | 20) & 0xFu; }
#define XB_SPIN(cond, bar) do { unsigned _sp = 0; while (cond) { __builtin_amdgcn_s_sleep(1); \
    if ((++_sp & 255u) == 0u) { if (xb_ld(&(bar)[XB_TMO])) break; if (_sp > XB_SPIN_CAP) { atomicAdd(&(bar)[XB_TMO], 1u); break; } } } } while (0)
struct XcdBarrier { unsigned* bar; unsigned x; volatile LAS unsigned* st; int gw; };
__device__ __forceinline__ bool xb_t0(int gw) { return gw == 0 && opaque_lane() == 0; }
__device__ __forceinline__ XcdBarrier xcd_barrier_post(unsigned* bar, volatile LAS unsigned* st, int gw) {
    XcdBarrier b; b.bar = bar; b.x = xb_xcc_id(); b.st = st; b.gw = gw;
    if (xb_t0(gw)) (void)xb_add(&bar[XB_XCNT(b.x)], 1u);
    return b;
}
__device__ __forceinline__ void xcd_barrier_complete(unsigned* bar, unsigned x, unsigned& nloc, unsigned& nx) {
    const unsigned G = gridDim.x * gridDim.y * gridDim.z;
    unsigned sum, cnt, mine, sp = 0u;
    for (;;) {
        sum = 0u; cnt = 0u; mine = 0u;
#pragma unroll
        for (unsigned j = 0; j < 16; ++j) { const unsigned c = xb_ld(&bar[XB_XCNT(j)]); sum += c; cnt += (c > 0u) ? 1u : 0u; mine = (j == x) ? c : mine; }
        if (sum == G) break;
        __builtin_amdgcn_s_sleep(1);
        if ((++sp & 255u) == 0u) { if (xb_ld(&bar[XB_TMO])) break; if (sp > XB_SPIN_CAP) { atomicAdd(&bar[XB_TMO], 1u); break; } }
    }
    nloc = mine > 0u ? mine : 1u; nx = cnt > 0u ? cnt : 1u;
}
__device__ __forceinline__ void xcd_barrier(const XcdBarrier& b_) {
    asm volatile("s_waitcnt vmcnt(0)" ::: "memory");
    __syncthreads();
    if (xb_t0(b_.gw)) {
        XcdBarrier b = b_; b.x = xb_xcc_id();
        asm volatile("" : "+s"(b.x));
        unsigned* bar = b.bar;
        __builtin_amdgcn_s_waitcnt(0);
        unsigned nloc = b.st[0], nx = b.st[1];
        if (nloc == 0u) { xcd_barrier_complete(bar, b.x, nloc, nx); b.st[0] = nloc; b.st[1] = nx; }
        const unsigned old = xb_add(&bar[XB_XSUB(b.x)], 1u);
        const unsigned gen = old / nloc;
        if (old + 1u == (gen + 1u) * nloc) {
            __builtin_amdgcn_fence(__ATOMIC_RELEASE, "agent");
            asm volatile("s_waitcnt vmcnt(0)" ::: "memory");
            const unsigned og = xb_add(&bar[XB_TOP], 1u);
            const unsigned tg = og / nx;
            if (og + 1u == (tg + 1u) * nx) xb_add(&bar[XB_TOPGEN], 1u);
            else XB_SPIN(xb_ld(&bar[XB_TOPGEN]) == tg, bar);
            __builtin_amdgcn_fence(__ATOMIC_ACQUIRE, "agent");
            xb_add(&bar[XB_XGEN(b.x)], 1u);
            asm volatile("s_waitcnt vmcnt(0)" ::: "memory");
        } else {
            XB_SPIN(xb_ld(&bar[XB_XGEN(b.x)]) == gen, bar);
            __builtin_amdgcn_fence(__ATOMIC_ACQUIRE, "agent");
            asm volatile("s_waitcnt vmcnt(0)" ::: "memory");
        }
    }
    __syncthreads();
}


constexpr int BM = 256, BK = 64, HALF = 128, NXCD = 8, WGM = 4, HT = HALF * BK;
__device__ __forceinline__ int lds_byte(int r, int c) {
    int st = (r >> 4) * 2 + (c >> 5), rr = r & 15, cc = c & 31, ob = rr * 64 + cc * 2;
    return st * 1024 + (ob ^ (((ob >> 9) & 1) << 5));
}
__device__ __forceinline__ void stage_rc(int b, int& R, int& C) {
    int st = b / 1024, sb = b % 1024, swz = sb ^ (((sb >> 9) & 1) << 5);
    R = (st >> 1) * 16 + swz / 64; C = (st & 1) * 32 + (swz % 64) / 2;
}

struct EpiH {
    bf16_t* ha; bf16_t* hb;
    __device__ __forceinline__ void operator()(const f32x4 (&acc)[2][2][4][2], int brow, int bcol, int wr, int wc, int fr, int fq) const {
        bf16_t* base; int ld, c0;
        if (bcol < HA_LD) { base = ha; ld = HA_LD; c0 = bcol; } else { base = hb; ld = HB_LD; c0 = bcol - HA_LD; }
#pragma unroll
        for (int ai = 0; ai < 2; ++ai)
#pragma unroll
            for (int m = 0; m < 4; ++m) {
                const int row = brow + ai * HALF + wr * 64 + m * 16 + fr;
                bf16_t* rp = base + (size_t)row * ld + c0 + wc * 32 + fq * 8;
#pragma unroll
                for (int bj = 0; bj < 2; ++bj) {
                    const f32x4 v0 = acc[ai][bj][m][0], v1 = acc[ai][bj][m][1];
                    u32x4 w; w.x = cvt_pk_bf16(v0[0], v0[1]); w.y = cvt_pk_bf16(v0[2], v0[3]); w.z = cvt_pk_bf16(v1[0], v1[1]); w.w = cvt_pk_bf16(v1[2], v1[3]);
                    *GP(u32x4)(rp + bj * HALF) = w;
                }
            }
    }
};
struct EpiZ {
    const float* xres; float* out;
    __device__ __forceinline__ void operator()(const f32x4 (&acc)[2][2][4][2], int brow, int bcol, int wr, int wc, int fr, int fq) const {
#pragma unroll
        for (int ai = 0; ai < 2; ++ai)
#pragma unroll
            for (int m = 0; m < 4; ++m) {
                const int row = brow + ai * HALF + wr * 64 + m * 16 + fr;
                const size_t ro = (size_t)row * DM + bcol + wc * 32 + fq * 4;
#pragma unroll
                for (int bj = 0; bj < 2; ++bj)
#pragma unroll
                    for (int n = 0; n < 2; ++n) {
                        const size_t o = ro + bj * HALF + n * 16;
                        const f32x4 r = *GPC(f32x4)(xres + o);
                        *GP(f32x4)(out + o) = r * DN_ALPHA + acc[ai][bj][m][n];
                    }
            }
    }
};


struct EpiLN {
    const float* xres; float* out; bf16_t* xb; const float* g; const float* b; const float* wg; float* BA; float* xbuf; unsigned* cnt; unsigned* tmo; int gw;
    __device__ __forceinline__ void operator()(f32x4 (&acc)[2][2][4][2], int brow, int bcol, int, int, int, int) const {
        const int tid = opaque_tid_(gw), lane = tid & 63, wr = tid >> 8, wc = (tid >> 6) & 3, fr = lane & 15, fq = lane >> 4, pm = brow >> 8, pn = bcol >> 8;
        f32x2_t* P = reinterpret_cast<f32x2_t*>(dyn_lds);
        f32x2_t* STATS = reinterpret_cast<f32x2_t*>(dyn_lds + 8192);
        float* WG = reinterpret_cast<float*>(dyn_lds + 10240);
        float* GP4 = reinterpret_cast<float*>(dyn_lds + 18432);
        if (wg) {
            for (int c = tid; c < 256; c += 512) {
                const float* wp = wg + (size_t)(bcol + c) * INC;
                *reinterpret_cast<f32x4*>(WG + c * 8) = *GPC(f32x4)(wp); *reinterpret_cast<f32x4*>(WG + c * 8 + 4) = *GPC(f32x4)(wp + 4);
            }
        }
#pragma unroll
        for (int ai = 0; ai < 2; ++ai)
#pragma unroll
            for (int m = 0; m < 4; ++m) {
                __builtin_amdgcn_sched_barrier(0);
                const int rl = ai * HALF + wr * 64 + m * 16 + fr;
                const size_t ro = (size_t)(brow + rl) * DM + bcol + wc * 32 + fq * 8;
                float s1 = 0.f, s2 = 0.f;
#pragma unroll
                for (int bj = 0; bj < 2; ++bj)
#pragma unroll
                    for (int n = 0; n < 2; ++n) {
                        const f32x4 r = *GPC(f32x4)(xres + ro + bj * HALF + n * 4);
                        const f32x4 v = r * DN_ALPHA + acc[ai][bj][m][n];
                        acc[ai][bj][m][n] = v;
                        s1 += (v[0] + v[1]) + (v[2] + v[3]);
                        s2 += (v[0] * v[0] + v[1] * v[1]) + (v[2] * v[2] + v[3] * v[3]);
                    }
                s1 += shx(s1, 16, lane); s1 += shx(s1, 32, lane);
                s2 += shx(s2, 16, lane); s2 += shx(s2, 32, lane);
                if (fq == 0) P[rl * 4 + wc] = (f32x2_t){s1, s2};
            }
        __syncthreads();
        if (tid < 256) {
            const f32x2_t a = P[tid * 4 + 0], b2 = P[tid * 4 + 1], c = P[tid * 4 + 2], d = P[tid * 4 + 3];
            *GP(f32x2_t)(xbuf + ((size_t)(brow + tid) * 4 + pn) * 2) = (f32x2_t){(a.x + b2.x) + (c.x + d.x), (a.y + b2.y) + (c.y + d.y)};
        }
        asm volatile("s_waitcnt vmcnt(0)" ::: "memory");
        __syncthreads();
        if (tid == 0) {
            __threadfence();
            xb_add(cnt + pm, 1u);
            unsigned sp = 0;
            while (xb_ld(cnt + pm) < 4u) { __builtin_amdgcn_s_sleep(1); if (++sp > (1u << 22)) { atomicAdd(tmo, 1u); break; } }
            __threadfence();
        }
        __syncthreads();
        if (tid < 256) {
            float S1 = 0.f, S2 = 0.f;
#pragma unroll
            for (int t = 0; t < 4; ++t) {
                const f32x2_t v = *GPC(f32x2_t)(xbuf + ((size_t)(brow + tid) * 4 + t) * 2);
                S1 += v.x; S2 += v.y;
            }
            const float mean = S1 * (1.0f / DM);
            const float var = fmaxf(S2 * (1.0f / DM) - mean * mean, 0.f);
            STATS[tid] = (f32x2_t){mean, rsqrtf(var + 1e-5f)};
        }
        __syncthreads();
#pragma unroll
        for (int ai = 0; ai < 2; ++ai)
#pragma unroll
            for (int m = 0; m < 4; ++m) {
                __builtin_amdgcn_sched_barrier(0);
                const int rl = ai * HALF + wr * 64 + m * 16 + fr;
                const f32x2_t st = STATS[rl];
                const size_t ro = (size_t)(brow + rl) * DM + bcol + wc * 32 + fq * 8;
                float d[8] = {0.f, 0.f, 0.f, 0.f, 0.f, 0.f, 0.f, 0.f};
#pragma unroll
                for (int bj = 0; bj < 2; ++bj) {
                    u32x4 wpk;
#pragma unroll
                    for (int n = 0; n < 2; ++n) {
                        const int cl = bj * HALF + wc * 32 + fq * 8 + n * 4;
                        const f32x4 gg = *GPC(f32x4)(g + bcol + cl), bb = *GPC(f32x4)(b + bcol + cl);
                        const f32x4 v = (acc[ai][bj][m][n] - st.x) * st.y * gg + bb;
                        *GP(f32x4)(out + ro + bj * HALF + n * 4) = v;
                        if (n == 0) { wpk.x = cvt_pk_bf16(v[0], v[1]); wpk.y = cvt_pk_bf16(v[2], v[3]); } else { wpk.z = cvt_pk_bf16(v[0], v[1]); wpk.w = cvt_pk_bf16(v[2], v[3]); }
                        if (wg) {
#pragma unroll
                            for (int j = 0; j < 4; ++j) {
                                const f32x4 w0 = *reinterpret_cast<const f32x4*>(WG + (cl + j) * 8), w1 = *reinterpret_cast<const f32x4*>(WG + (cl + j) * 8 + 4);
                                d[0] += v[j] * w0[0]; d[1] += v[j] * w0[1]; d[2] += v[j] * w0[2]; d[3] += v[j] * w0[3];
                                d[4] += v[j] * w1[0]; d[5] += v[j] * w1[1]; d[6] += v[j] * w1[2]; d[7] += v[j] * w1[3];
                            }
                        }
                    }
                    if (xb) *GP(u32x4)(xb + ro + bj * HALF) = wpk;
                }
                if (wg) {
#pragma unroll
                    for (int k = 0; k < 8; ++k) { d[k] += shx(d[k], 16, lane); d[k] += shx(d[k], 32, lane); }
                    if (fq == 0) {
                        *reinterpret_cast<f32x4*>(GP4 + (rl * 4 + wc) * 8) = (f32x4){d[0], d[1], d[2], d[3]};
                        *reinterpret_cast<f32x4*>(GP4 + (rl * 4 + wc) * 8 + 4) = (f32x4){d[4], d[5], d[6], d[7]};
                    }
                }
            }
        if (wg) {
            __syncthreads();
            for (int i = tid; i < 2048; i += 512) {
                const int rl = i >> 3, k = i & 7;
                const float sgate = (GP4[(rl * 4 + 0) * 8 + k] + GP4[(rl * 4 + 1) * 8 + k]) + (GP4[(rl * 4 + 2) * 8 + k] + GP4[(rl * 4 + 3) * 8 + k]);
                unsafeAtomicAdd(BA + (size_t)(brow + rl) * 8 + k, sgate);
            }
        }
    }
};

template <class Epi>
__device__ __forceinline__ void gemm_phase(const bf16_t* __restrict__ A, const bf16_t* __restrict__ Bt, int M, int N, int K, const Epi& epi, int g_wave) {
    bf16_t* shm = reinterpret_cast<bf16_t*>(dyn_lds);
#define SA(b,h) (shm+((b)*2+(h))*HT)
#define SB(b,h) (shm+(4+(b)*2+(h))*HT)
#define STAGE(P,BASE,br,kt) do{const bf16_t* _bp=uniform_ptr((BASE)+((long)(br)*K+(long)(kt)*BK)); \
    __builtin_amdgcn_global_load_lds((const unsigned*)((const char*)_bp+soff0),(unsigned*)((char*)(P)+tidx*16),16,0,0); \
    __builtin_amdgcn_global_load_lds((const unsigned*)((const char*)_bp+soff1),(unsigned*)((char*)(P)+tidx*16+8192),16,0,0);}while(0)
#define LDA(dst,b,h) for(int m=0;m<4;++m)for(int k=0;k<2;++k) \
    dst[m][k]=*reinterpret_cast<const bf16x8*>((char*)SA(b,h)+lds_byte(wr*64+m*16+fr,k*32+fq*8))
#define LDB(dst,b,h) for(int n=0;n<2;++n)for(int k=0;k<2;++k) \
    dst[n][k]=*reinterpret_cast<const bf16x8*>((char*)SB(b,h)+lds_byte(wc*32+n*16+fr,k*32+fq*8))
#define MMA(ai,bj,At,Bt_) do{__builtin_amdgcn_s_setprio(1); \
    for(int m=0;m<4;++m)for(int n=0;n<2;++n)for(int k=0;k<2;++k) \
      acc[ai][bj][m][n]=__builtin_amdgcn_mfma_f32_16x16x32_bf16(Bt_[n][k],At[m][k],acc[ai][bj][m][n],0,0,0); \
    __builtin_amdgcn_s_setprio(0);}while(0)
#define WAIT_V(n) asm volatile("s_waitcnt vmcnt(" #n ")":::"memory")
#define WAIT_L(n) asm volatile("s_waitcnt lgkmcnt(" #n ")":::"memory")
#define BAR __builtin_amdgcn_s_barrier()
#define SCHED __builtin_amdgcn_sched_barrier(0)
    const int nM = M / BM, nN = N / BM, nwg = nM * nN;
    const int tidx = opaque_tid();
    const int wid = tidx >> 6, lane = tidx & 63, wr = wid >> 2, wc = wid & 3, fr = lane & 15, fq = lane >> 4;
    const int nt = K / BK;
    unsigned soff0, soff1;
    { int r_, c_; stage_rc(tidx * 16, r_, c_); soff0 = (unsigned)(r_ * K + c_) * 2u; stage_rc(tidx * 16 + 8192, r_, c_); soff1 = (unsigned)(r_ * K + c_) * 2u; }
    for (int L = blockIdx.x; L < nwg; L += gridDim.x) {
        int wgid = L;
        { int q = nwg / NXCD, r = nwg % NXCD, xcd = wgid % NXCD, off = wgid / NXCD; wgid = (xcd < r ? xcd * (q + 1) : r * (q + 1) + (xcd - r) * q) + off; }
        const int nig = WGM * nN, gid = wgid / nig, fm = gid * WGM, gsz = min(nM - fm, WGM);
        const int pm = fm + ((wgid % nig) % gsz), pn = (wgid % nig) / gsz, brow = pm * BM, bcol = pn * BM;
        f32x4 acc[2][2][4][2] = {};
        bf16x8 At[4][2], B0[2][2], B1[2][2];
        STAGE(SB(0,0),Bt,bcol,0); STAGE(SA(0,0),A,brow,0);
        STAGE(SB(0,1),Bt,bcol+HALF,0); STAGE(SA(0,1),A,brow+HALF,0);
        if(wr==1)BAR;
        WAIT_V(4); BAR;
        STAGE(SB(1,0),Bt,bcol,1); STAGE(SA(1,0),A,brow,1); STAGE(SB(1,1),Bt,bcol+HALF,1);
        WAIT_V(6); BAR;
        for(int t=0;t<nt-2;t+=2){
            LDB(B0,0,0); SCHED; LDA(At,0,0); STAGE(SA(1,1),A,brow+HALF,t+1);
            WAIT_L(8); BAR; WAIT_L(0); MMA(0,0,At,B0); BAR; SCHED;
            LDB(B1,0,1); STAGE(SB(0,0),Bt,bcol,t+2);
            BAR; WAIT_L(0); MMA(0,1,At,B1); BAR;
            LDA(At,0,1); STAGE(SA(0,0),A,brow,t+2);
            BAR; WAIT_L(0); MMA(1,0,At,B0); BAR; SCHED;
            STAGE(SB(0,1),Bt,bcol+HALF,t+2);
            WAIT_V(6); BAR; MMA(1,1,At,B1); BAR;
            LDB(B0,1,0); SCHED; LDA(At,1,0); STAGE(SA(0,1),A,brow+HALF,t+2);
            WAIT_L(8); BAR; WAIT_L(0); MMA(0,0,At,B0); BAR; SCHED;
            LDB(B1,1,1); STAGE(SB(1,0),Bt,bcol,t+3);
            BAR; WAIT_L(0); MMA(0,1,At,B1); BAR;
            LDA(At,1,1); STAGE(SA(1,0),A,brow,t+3);
            BAR; WAIT_L(0); MMA(1,0,At,B0); BAR; SCHED;
            STAGE(SB(1,1),Bt,bcol+HALF,t+3);
            WAIT_V(6); BAR; MMA(1,1,At,B1); BAR;
        }
        { LDB(B0,0,0); LDA(At,0,0); STAGE(SA(1,1),A,brow+HALF,nt-1);
          BAR; WAIT_L(0); MMA(0,0,At,B0); BAR;
          LDB(B1,0,1); BAR; WAIT_L(0); MMA(0,1,At,B1); BAR;
          LDA(At,0,1); WAIT_V(4); BAR; WAIT_L(0); MMA(1,0,At,B0); MMA(1,1,At,B1); BAR; }
        { LDB(B0,1,0); LDA(At,1,0); WAIT_V(2); BAR; WAIT_L(0); MMA(0,0,At,B0); BAR;
          LDB(B1,1,1); WAIT_V(0); BAR; WAIT_L(0); MMA(0,1,At,B1); BAR;
          LDA(At,1,1); BAR; WAIT_L(0); MMA(1,0,At,B0); MMA(1,1,At,B1); BAR; }
        if(wr==0)BAR;
        epi(acc, brow, bcol, wr, wc, fr, fq);
        __syncthreads();
    }
#undef SA
#undef SB
#undef STAGE
#undef LDA
#undef LDB
#undef MMA
}

__device__ __forceinline__ void prep_weights(const Params& p, int part, int vblk, int nvblk, int g_wave) {
    bf16_t* win = reinterpret_cast<bf16_t*>(p.ws + OFF_WIN);
    bf16_t* wout = reinterpret_cast<bf16_t*>(p.ws + OFF_WOUT);
    const int gtid = vblk * 512 + opaque_tid(), gsz = nvblk * 512;
    const int n_in = 128 * NIN;
    for (int i = gtid; i < n_in; i += gsz) {
        const int n = i % NIN, kg = i / NIN, l = part;
        const int rho = n & 31, ncol = (n & ~31) + 8 * ((rho & 15) >> 2) + 4 * (rho >> 4) + (rho & 3);
        const int sc = ncol < 2048 ? ncol : ncol + 8;
        const float* s = p.w_in + (size_t)l * DM * INC + (size_t)(kg * 8) * INC + sc;
        u32x4 w;
        w.x = cvt_pk_bf16(s[0], s[INC]); w.y = cvt_pk_bf16(s[2 * INC], s[3 * INC]);
        w.z = cvt_pk_bf16(s[4 * INC], s[5 * INC]); w.w = cvt_pk_bf16(s[6 * INC], s[7 * INC]);
        *GP(u32x4)(win + ((size_t)l * NIN + n) * DM + kg * 8) = w;
    }
    if (part == 1) {
        const int n_out = 2 * 128 * DM;
        for (int i = gtid; i < n_out; i += gsz) {
            const int n = i % DM, kg = (i / DM) % 128, l = i / (DM * 128);
            const int rho = n & 31, ncol = (n & ~31) + 8 * ((rho & 15) >> 2) + 4 * (rho >> 4) + (rho & 3);
            const float* s = p.w_out + (size_t)l * DM * DM + (size_t)(kg * 8) * DM + ncol;
            u32x4 w;
            w.x = cvt_pk_bf16(s[0], s[DM]); w.y = cvt_pk_bf16(s[2 * DM], s[3 * DM]);
            w.z = cvt_pk_bf16(s[4 * DM], s[5 * DM]); w.w = cvt_pk_bf16(s[6 * DM], s[7 * DM]);
            *GP(u32x4)(wout + ((size_t)l * DM + n) * DM + kg * 8) = w;
        }
    }
}

__device__ __forceinline__ void row_pass(const float* src, bool ln, const float* g, const float* bta, float* dstf, bf16_t* xb, const float* wg  , float* BA, int g_wave) {
    const int tidx = opaque_tid();
    const int lane = tidx & 63;
    const int gw = blockIdx.x * 8 + (tidx >> 6), nw = gridDim.x * 8;
    float* wgs = reinterpret_cast<float*>(dyn_lds);
    if (wg) {
        for (int c = tidx; c < DM; c += 512) {
            const f32x4 w0 = *GPC(f32x4)(wg + (size_t)c * INC), w1 = *GPC(f32x4)(wg + (size_t)c * INC + 4);
            *reinterpret_cast<f32x4*>(wgs + c * 8) = w0; *reinterpret_cast<f32x4*>(wgs + c * 8 + 4) = w1;
        }
    }
    __syncthreads();
    f32x4 gg[4], bb[4];
#pragma unroll
    for (int i = 0; i < 4; ++i) { gg[i] = ln ? *GPC(f32x4)(g + i * 256 + lane * 4) : (f32x4){1.f, 1.f, 1.f, 1.f}; bb[i] = ln ? *GPC(f32x4)(bta + i * 256 + lane * 4) : (f32x4){0.f, 0.f, 0.f, 0.f}; }
    f32x4 nv[4];
    if (gw < NTOK) {
#pragma unroll
        for (int i = 0; i < 4; ++i) nv[i] = *GPC(f32x4)(src + (size_t)gw * DM + i * 256 + lane * 4);
    }
    for (int row = gw; row < NTOK; row += nw) {
        f32x4 v[4];
#pragma unroll
        for (int i = 0; i < 4; ++i) v[i] = nv[i];
        if (row + nw < NTOK) {
#pragma unroll
            for (int i = 0; i < 4; ++i) nv[i] = *GPC(f32x4)(src + (size_t)(row + nw) * DM + i * 256 + lane * 4);
        }
        if (ln) {
            float s = 0.f;
#pragma unroll
            for (int i = 0; i < 4; ++i) s += (v[i][0] + v[i][1]) + (v[i][2] + v[i][3]);
#pragma unroll
            for (int o = 32; o > 0; o >>= 1) s += shx(s, o, lane);
            const float mu = s * (1.0f / DM);
            float q = 0.f;
#pragma unroll
            for (int i = 0; i < 4; ++i) { v[i] = v[i] - mu; q += (v[i][0] * v[i][0] + v[i][1] * v[i][1]) + (v[i][2] * v[i][2] + v[i][3] * v[i][3]); }
#pragma unroll
            for (int o = 32; o > 0; o >>= 1) q += shx(q, o, lane);
            const float rstd = rsqrtf(q * (1.0f / DM) + 1e-5f);
#pragma unroll
            for (int i = 0; i < 4; ++i) v[i] = v[i] * rstd * gg[i] + bb[i];
        }
        if (dstf) {
#pragma unroll
            for (int i = 0; i < 4; ++i) *GP(f32x4)(dstf + (size_t)row * DM + i * 256 + lane * 4) = v[i];
        }
        if (xb) {
#pragma unroll
            for (int i = 0; i < 4; ++i) { u32x2 w; w.x = cvt_pk_bf16(v[i][0], v[i][1]); w.y = cvt_pk_bf16(v[i][2], v[i][3]);
                *GP(u32x2)(xb + (size_t)row * DM + i * 256 + lane * 4) = w; }
        }
        if (wg) {
            float d[8] = {0.f, 0.f, 0.f, 0.f, 0.f, 0.f, 0.f, 0.f};
#pragma unroll
            for (int i = 0; i < 4; ++i)
#pragma unroll
                for (int e = 0; e < 4; ++e) {
                    const float* wp = wgs + (i * 256 + lane * 4 + e) * 8;
                    const f32x4 w0 = *reinterpret_cast<const f32x4*>(wp), w1 = *reinterpret_cast<const f32x4*>(wp + 4);
                    const float xv = v[i][e];
                    d[0] += xv * w0[0]; d[1] += xv * w0[1]; d[2] += xv * w0[2]; d[3] += xv * w0[3];
                    d[4] += xv * w1[0]; d[5] += xv * w1[1]; d[6] += xv * w1[2]; d[7] += xv * w1[3];
                }
#pragma unroll
            for (int j = 0; j < 8; ++j) {
#pragma unroll
                for (int o = 32; o > 0; o >>= 1) d[j] += shx(d[j], o, lane);
            }
            if (lane == 0) {
                *GP(f32x4)(BA + (size_t)row * 8) = (f32x4){d[0], d[1], d[2], d[3]};
                *GP(f32x4)(BA + (size_t)row * 8 + 4) = (f32x4){d[4], d[5], d[6], d[7]};
            }
        }
    }
    __syncthreads();
}

constexpr int GRP_LDS = 73728;
constexpr int L_KRM = 0, L_QRM = 17408, L_KBGT = 34816, L_VBT = 53248, L_GC = 71680, L_BETA = 71936;
__device__ __forceinline__ void chunk_prep(const Params& p_, int l, int g_wave) {
    Params p = p_; p.ws = opaque_ws(p.ws);
    const bf16_t* HA = reinterpret_cast<const bf16_t*>(p.ws + OFF_HA);
    const float* BA = reinterpret_cast<const float*>(p.ws + OFF_BA);
    bf16_t* UT = reinterpret_cast<bf16_t*>(p.ws + OFF_UT);
    bf16_t* W = reinterpret_cast<bf16_t*>(p.ws + OFF_W);
    bf16_t* QD = reinterpret_cast<bf16_t*>(p.ws + OFF_QD);
    bf16_t* KDT = reinterpret_cast<bf16_t*>(p.ws + OFF_KDT);
    bf16_t* QK = reinterpret_cast<bf16_t*>(p.ws + OFF_QK);
    float* GT = reinterpret_cast<float*>(p.ws + OFF_GT);
    const float* cw = p.conv_w + (size_t)l * 4 * 1536;
#define CP_LANEVARS const int tid = opaque_tid(), grp = tid >> 8, gt = tid & 255, lane = tid & 63, wv = gt >> 6, fr = lane & 15, fq = lane >> 4; \
    unsigned char* lds = dyn_lds + grp * GRP_LDS; float* gc_s = reinterpret_cast<float*>(lds + L_GC); float* beta_s = reinterpret_cast<float*>(lds + L_BETA); \
    const int tg = gt >> 4, sg = gt & 15, t0 = tg * 4, c0 = sg * 8; (void)fr; (void)fq; (void)wv; (void)t0; (void)c0; (void)gc_s; (void)beta_s; (void)lane;
    for (int rr = 0; rr < 2; ++rr) {
        const int grp0 = opaque_tid() >> 8;
        const int xcd_ = blockIdx.x & 7, q_ = (blockIdx.x >> 3) + 32 * rr;
        const int hp = q_ & 1, n = (xcd_ & 1) * 32 + (q_ >> 1), b = xcd_ >> 1, h = hp * 2 + grp0;
        const int item = (b * 4 + h) * 64 + n, tok0 = b * SEQ + n * 64;
        u32x4 rawp[3][7];
        { CP_LANEVARS
#pragma unroll
          for (int ten = 0; ten < 3; ++ten)
#pragma unroll
            for (int r = 0; r < 7; ++r) {
                const int tt = n * 64 + t0 - 3 + r;
                rawp[ten][r] = mk4(0u, 0u, 0u, 0u);
                if (tt >= 0) rawp[ten][r] = *GPC(u32x4)(HA + (size_t)(b * SEQ + tt) * HA_LD + ten * 512 + h * 128 + c0);
            } }
        { CP_LANEVARS
        if (wv == 0) {
            const float bv = *GPC(float)(BA + (size_t)(tok0 + lane) * 8 + h), av = *GPC(float)(BA + (size_t)(tok0 + lane) * 8 + 4 + h);
            const float beta = __builtin_amdgcn_rcpf(1.0f + __expf(-bv));
            const float xx = av + p.dt_bias[l * 4 + h];
            const float sp = fmaxf(xx, 0.f) + log1pf(__expf(-fabsf(xx)));
            float gv = -__expf(p.a_log[l * 4 + h]) * sp;
#pragma unroll
            for (int o = 1; o < 64; o <<= 1) { const float t = __int_as_float(__builtin_amdgcn_ds_bpermute((lane - o) << 2, __float_as_int(gv))); if (lane >= o) gv += t; }
            gc_s[lane] = gv; beta_s[lane] = beta;
            if (lane == 63) *GP(float)(GT + item) = __expf(gv);
        } }
        __syncthreads();
        {
            CP_LANEVARS
            const float glast = gc_s[63];
            float eg[4], ek[4], be[4];
#pragma unroll
            for (int i = 0; i < 4; ++i) { const float gci = gc_s[t0 + i]; eg[i] = __expf(gci); ek[i] = __expf(glast - gci); be[i] = beta_s[t0 + i]; }
#pragma unroll
            for (int ten = 0; ten < 3; ++ten) {
                __builtin_amdgcn_sched_barrier(0);
                float raw[7][8];
#pragma unroll
                for (int r = 0; r < 7; ++r) {
                    const u32x4 u = rawp[ten][r];
                    raw[r][0] = bf_lo(u.x); raw[r][1] = bf_hi(u.x); raw[r][2] = bf_lo(u.y); raw[r][3] = bf_hi(u.y);
                    raw[r][4] = bf_lo(u.z); raw[r][5] = bf_hi(u.z); raw[r][6] = bf_lo(u.w); raw[r][7] = bf_hi(u.w);
                }
                float o[4][8];
#pragma unroll
                for (int i = 0; i < 4; ++i)
#pragma unroll
                    for (int c = 0; c < 8; ++c) o[i][c] = 0.f;
#pragma unroll
                for (int j = 0; j < 4; ++j) {
                    const float* wp = cw + (size_t)j * 1536 + ten * 512 + h * 128 + c0;
                    const f32x4 a = *GPC(f32x4)(wp), c4 = *GPC(f32x4)(wp + 4);
                    const float wj[8] = {a[0], a[1], a[2], a[3], c4[0], c4[1], c4[2], c4[3]};
#pragma unroll
                    for (int i = 0; i < 4; ++i)
#pragma unroll
                        for (int c = 0; c < 8; ++c) o[i][c] += wj[c] * raw[i + j][c];
                }
#pragma unroll
                for (int i = 0; i < 4; ++i)
#pragma unroll
                    for (int c = 0; c < 8; ++c) o[i][c] = silu_f(o[i][c]);
                if (ten < 2) {
#pragma unroll
                    for (int i = 0; i < 4; ++i) {
                        float sq = 0.f;
#pragma unroll
                        for (int c = 0; c < 8; ++c) sq += o[i][c] * o[i][c];
                        sq = row_sum16(sq);
                        const float rq = rsqrtf(sq + 1e-6f) * (ten == 0 ? 0.08838834764831845f : 1.0f);
#pragma unroll
                        for (int c = 0; c < 8; ++c) o[i][c] *= rq;
                    }
                }
                if (ten == 0) {
#pragma unroll
                    for (int i = 0; i < 4; ++i) {
                        u32x4 w;
                        w.x = cvt_pk_bf16(o[i][0], o[i][1]); w.y = cvt_pk_bf16(o[i][2], o[i][3]); w.z = cvt_pk_bf16(o[i][4], o[i][5]); w.w = cvt_pk_bf16(o[i][6], o[i][7]);
                        *reinterpret_cast<u32x4*>(lds + L_QRM + ((t0 + i) * 136 + c0) * 2) = w;
                    }
                } else if (ten == 1) {
#pragma unroll
                    for (int i = 0; i < 4; ++i) {
                        u32x4 w;
                        w.x = cvt_pk_bf16(o[i][0], o[i][1]); w.y = cvt_pk_bf16(o[i][2], o[i][3]); w.z = cvt_pk_bf16(o[i][4], o[i][5]); w.w = cvt_pk_bf16(o[i][6], o[i][7]);
                        *reinterpret_cast<u32x4*>(lds + L_KRM + ((t0 + i) * 136 + c0) * 2) = w;
                    }
#pragma unroll
                    for (int c = 0; c < 8; ++c) {
                        u32x2 w;
                        w.x = cvt_pk_bf16(o[0][c] * ek[0], o[1][c] * ek[1]); w.y = cvt_pk_bf16(o[2][c] * ek[2], o[3][c] * ek[3]);
                        { const int dk_ = c0 + c; *GP(u32x2)(KDT + ((((size_t)item * 8 + (dk_ >> 4)) * 2 + (t0 >> 5)) * 64 + (dk_ & 15) + 16 * ((t0 & 31) >> 3)) * 8 + ((t0 & 7) >> 2) * 4) = w; }
                        w.x = cvt_pk_bf16(o[0][c] * be[0] * eg[0], o[1][c] * be[1] * eg[1]); w.y = cvt_pk_bf16(o[2][c] * be[2] * eg[2], o[3][c] * be[3] * eg[3]);
                        *reinterpret_cast<u32x2*>(lds + L_KBGT + ((c0 + c) * 72 + t0) * 2) = w;
                    }
                } else {
#pragma unroll
                    for (int c = 0; c < 8; ++c) {
                        u32x2 w;
                        w.x = cvt_pk_bf16(o[0][c] * be[0], o[1][c] * be[1]); w.y = cvt_pk_bf16(o[2][c] * be[2], o[3][c] * be[3]);
                        *reinterpret_cast<u32x2*>(lds + L_VBT + ((c0 + c) * 72 + t0) * 2) = w;
                    }
                }
            }
        }
        __syncthreads();
        {
            CP_LANEVARS
            const int ib = wv;
            f32x4 kk[4], qk[4];
#pragma unroll
            for (int jb = 0; jb < 4; ++jb) { kk[jb] = (f32x4){0.f, 0.f, 0.f, 0.f}; qk[jb] = (f32x4){0.f, 0.f, 0.f, 0.f}; }
            bf16x8 ki[4], qi[4];
#pragma unroll
            for (int ks = 0; ks < 4; ++ks) {
                ki[ks] = lds8(lds + L_KRM + ((ib * 16 + fr) * 136 + ks * 32 + fq * 8) * 2);
                qi[ks] = lds8(lds + L_QRM + ((ib * 16 + fr) * 136 + ks * 32 + fq * 8) * 2);
            }
#pragma unroll
            for (int jb = 0; jb < 4; ++jb) {
                if (jb <= ib) {
#pragma unroll
                    for (int ks = 0; ks < 4; ++ks) {
                        const bf16x8 kj = lds8(lds + L_KRM + ((jb * 16 + fr) * 136 + ks * 32 + fq * 8) * 2);
                        kk[jb] = mfma16(ki[ks], kj, kk[jb]);
                        qk[jb] = mfma16(kj, qi[ks], qk[jb]);
                    }
                }
            }
            {
                const float egq = __expf(gc_s[ib * 16 + fr]);
#pragma unroll
                for (int ks = 0; ks < 4; ++ks) {
                    union { bf16x8 v; unsigned u[4]; } qq; qq.v = qi[ks];
                    u32x4 w;
                    w.x = cvt_pk_bf16(bf_lo(qq.u[0]) * egq, bf_hi(qq.u[0]) * egq); w.y = cvt_pk_bf16(bf_lo(qq.u[1]) * egq, bf_hi(qq.u[1]) * egq);
                    w.z = cvt_pk_bf16(bf_lo(qq.u[2]) * egq, bf_hi(qq.u[2]) * egq); w.w = cvt_pk_bf16(bf_lo(qq.u[3]) * egq, bf_hi(qq.u[3]) * egq);
                    *GP(u32x4)(QD + ((((size_t)item * 4 + ib) * 4 + ks) * 64 + lane) * 8) = w;
                }
            }
            __syncthreads();
            float* AP = reinterpret_cast<float*>(lds + L_KRM);
#pragma unroll
            for (int jb = 0; jb < 4; ++jb) {
                if (jb <= ib) {
                    const int j = jb * 16 + fr, i0 = ib * 16 + fq * 4;
                    const float gj = gc_s[j];
#pragma unroll
                    for (int r = 0; r < 4; ++r) {
                        const int i = i0 + r;
                        const float dec = __expf(fminf(gc_s[i] - gj, 0.f));
                        float av_ = (i > j) ? kk[jb][r] * beta_s[i] * dec : 0.f;
                        AP[j * 64 + r * 16 + ib * 4 + fq] = av_;
                    }
                }
                {
                    const int i = ib * 16 + fr, j0 = jb * 16 + fq * 4;
                    const float gi = gc_s[i];
                    float o[4];
#pragma unroll
                    for (int r = 0; r < 4; ++r) {
                        const int j = j0 + r;
                        const float dec = __expf(fminf(gi - gc_s[j], 0.f));
                        o[r] = (i >= j) ? qk[jb][r] * dec : 0.f;
                    }
                    u32x2 w; w.x = cvt_pk_bf16(o[0], o[1]); w.y = cvt_pk_bf16(o[2], o[3]);
                    *GP(u32x2)(QK + ((((size_t)item * 4 + ib) * 2 + (jb >> 1)) * 64 + fr + 16 * ((jb & 1) * 2 + (fq >> 1))) * 8 + (fq & 1) * 4) = w;
                }
            }
        }
        __syncthreads();
        {
            CP_LANEVARS
            const float* AP = reinterpret_cast<const float*>(lds + L_KRM);
            const int cbk = grp ? 3 - wv : wv;
            const int cl = lane >> 2, pp = lane & 3, ccol = cbk * 16 + cl;
            float a[16];
#pragma unroll
            for (int k = 0; k < 16; ++k) a[k] = (4 * k + pp == ccol) ? 1.f : 0.f;
#define INV_STEP(SS) { const int j = jq * 4 + SS; \
                    const float tj = __int_as_float(__builtin_amdgcn_update_dpp(0, __float_as_int(a[jq]), SS * 0x55, 0xf, 0xf, false)); \
                    const float* ap = AP + j * 64 + pp * 16; \
                    _Pragma("unroll") for (int k = jq; k < 16; ++k) a[k] -= ap[k] * tj; }
#pragma unroll
            for (int jq = 0; jq < 16; ++jq) {
                __builtin_amdgcn_sched_barrier(0);
                if (jq >= cbk * 4) {
                    INV_STEP(0) INV_STEP(1) INV_STEP(2)
                    if (jq < 15) INV_STEP(3)
                }
            }
#undef INV_STEP
            bf16_t* TR = reinterpret_cast<bf16_t*>(lds + L_QRM);
#pragma unroll
            for (int k = 0; k < 16; ++k) TR[(4 * k + pp) * 72 + ccol] = (bf16_t)(cvt_pk_bf16(a[k], 0.f) & 0xffffu);
        }
        __syncthreads();
        {
            CP_LANEVARS
            bf16x8 tf[2];
#pragma unroll
            for (int ks = 0; ks < 2; ++ks) tf[ks] = lds8(lds + L_QRM + ((wv * 16 + fr) * 72 + ks * 32 + fq * 8) * 2);
#pragma unroll
            for (int db = 0; db < 8; ++db) {
                f32x4 au = (f32x4){0.f, 0.f, 0.f, 0.f}, aw = (f32x4){0.f, 0.f, 0.f, 0.f};
#pragma unroll
                for (int ks = 0; ks < 2; ++ks) {
                    const bf16x8 vb = lds8(lds + L_VBT + ((db * 16 + fr) * 72 + ks * 32 + fq * 8) * 2);
                    const bf16x8 kb = lds8(lds + L_KBGT + ((db * 16 + fr) * 72 + ks * 32 + fq * 8) * 2);
                    au = mfma16(tf[ks], vb, au);
                    aw = mfma16(kb, tf[ks], aw);
                }
                u32x2 w; w.x = cvt_pk_bf16(au[0], au[1]); w.y = cvt_pk_bf16(au[2], au[3]);
                *GP(u32x2)(UT + ((((size_t)item * 8 + db) * 2 + (wv >> 1)) * 64 + fr + 16 * ((wv & 1) * 2 + (fq >> 1))) * 8 + (fq & 1) * 4) = w;
                w.x = cvt_pk_bf16(aw[0], aw[1]); w.y = cvt_pk_bf16(aw[2], aw[3]);
                *GP(u32x2)(W + ((((size_t)item * 4 + wv) * 4 + (db >> 1)) * 64 + fr + 16 * ((db & 1) * 2 + (fq >> 1))) * 8 + (fq & 1) * 4) = w;
            }
        }
        __syncthreads();
    }
}

__device__ __forceinline__ void delta_scan(const Params& p_, int blk, int g_wave) {
    Params p = p_; p.ws = opaque_ws(p.ws);
    const int tid = opaque_tid(), lane = tid & 63, w = tid >> 6, fr = lane & 15, fq = lane >> 4;
    const int bh = ((blk & 7) >> 1) * 4 + ((blk & 7) & 1) * 2 + ((blk >> 3) & 1), sl = blk >> 4, dv0 = sl * 32;
    bf16_t* ST = reinterpret_cast<bf16_t*>(p.ws + OFF_HA);
    bf16_t* UT = reinterpret_cast<bf16_t*>(p.ws + OFF_UT);
    const bf16_t* W = reinterpret_cast<const bf16_t*>(p.ws + OFF_W);
    const bf16_t* KDT = reinterpret_cast<const bf16_t*>(p.ws + OFF_KDT);
    const float* GT = reinterpret_cast<const float*>(p.ws + OFF_GT);
    unsigned char* STL = dyn_lds;
    unsigned char* VTL = dyn_lds + 8704;
    unsigned char* DMY = dyn_lds + 13312;
    unsigned char* RING = dyn_lds + 16384;
    (void)dv0;
#define LDS_BAR() do { asm volatile("s_waitcnt lgkmcnt(0)" ::: "memory"); __builtin_amdgcn_s_barrier(); asm volatile("" ::: "memory"); } while (0)
    if (w >= 4) {
        constexpr int PD = 10;
        const int hw = w - 4, pl = hw * 64 + lane;
#define RING_LOAD(C) do { const int c_ = (C) < 64 ? (C) : 63; const int slot_ = (C) & 3; \
            const bf16_t* wsrc = W + (size_t)(bh * 64 + c_) * 8192 + (hw * 4) * 512 + lane * 8; \
            const bf16_t* ksrc = KDT + (size_t)(bh * 64 + c_) * 8192 + (hw * 4) * 512 + lane * 8; \
            _Pragma("unroll") for (int j = 0; j < 4; ++j) { \
                __builtin_amdgcn_global_load_lds((const unsigned*)(wsrc + j * 512), (unsigned*)(RING + slot_ * 32768 + (hw * 4 + j) * 1024), 16, 0, 0); \
                __builtin_amdgcn_global_load_lds((const unsigned*)(ksrc + j * 512), (unsigned*)(RING + slot_ * 32768 + 16384 + (hw * 4 + j) * 1024), 16, 0, 0); } } while (0)
#define TOUCH(C) do { const int c_ = (C) < 64 ? (C) : 63; const int item_ = bh * 64 + c_; \
            const int li = sl * 32 + (lane & 31); \
            const unsigned char* a0 = (hw == 0) ? ((lane < 32) ? reinterpret_cast<const unsigned char*>(W + (size_t)item_ * 8192) + li * 128 \
                                                               : reinterpret_cast<const unsigned char*>(KDT + (size_t)item_ * 8192) + li * 128) \
                                                : reinterpret_cast<const unsigned char*>(UT + ((size_t)item_ * 8 + sl * 2) * 1024) + (lane & 31) * 128; \
            __builtin_amdgcn_global_load_lds((const unsigned*)a0, (unsigned*)(DMY + hw * 256), 4, 0, 0); } while (0)
        RING_LOAD(0); RING_LOAD(1); RING_LOAD(2);
        asm volatile("s_waitcnt vmcnt(0)" ::: "memory");
        __syncthreads();
        for (int n = 0; n < 64; ++n) {
            const int item = bh * 64 + n;
            __builtin_amdgcn_s_barrier();
            {
                const int dvb_ = pl >> 7, ks_ = (pl >> 6) & 1, l_ = pl & 63;
                const u32x4 v = *reinterpret_cast<const u32x4*>(VTL + ((dvb_ * 16 + (l_ & 15)) * 72 + ks_ * 32 + (l_ >> 4) * 8) * 2);
                *GP(u32x4)(UT + (((size_t)item * 8 + sl * 2) * 128 + pl) * 8) = v;
            }
            asm volatile("s_waitcnt vmcnt(12) lgkmcnt(0)" ::: "memory");
            __builtin_amdgcn_s_barrier();
            {
                bf16_t* dst = (n < 63) ? ST + (((size_t)(item + 1) * 8 + sl * 2) * 256) * 8 : ST + (size_t)1024 * 16384 + (size_t)blk * 4096;
#pragma unroll
                for (int j = 0; j < 2; ++j) {
                    const int q = pl + 256 * j, dvb_ = q >> 8, ks_ = (q >> 6) & 3, l_ = q & 63;
                    const u32x4 v = *reinterpret_cast<const u32x4*>(STL + ((dvb_ * 16 + (l_ & 15)) * 136 + ks_ * 32 + (l_ >> 4) * 8) * 2);
                    *GP(u32x4)(dst + (size_t)q * 8) = v;
                }
            }
            RING_LOAD(n + 3);
            asm volatile("s_waitcnt lgkmcnt(0)" ::: "memory");
        }
        asm volatile("s_waitcnt vmcnt(0)" ::: "memory");
#undef RING_LOAD
#undef TOUCH
    } else {
        f32x4 S[2][2];
#pragma unroll
        for (int kb = 0; kb < 2; ++kb)
#pragma unroll
            for (int db = 0; db < 2; ++db) {
                S[kb][db] = (f32x4){0.f, 0.f, 0.f, 0.f};
                const u32x2 z = mk2(0u, 0u);
                *reinterpret_cast<u32x2*>(STL + ((db * 16 + fr) * 136 + (2 * w + kb) * 16 + fq * 4) * 2) = z;
                *GP(u32x2)(ST + (((size_t)(bh * 64) * 8 + sl * 2) * 256) * 8 + (size_t)(((kb * 2 + db) * 256 + w * 64 + lane)) * 4) = z;
            }
        __syncthreads();
#define SCAN_LOAD(NN, UB, GTV) do { const int item_ = bh * 64 + (NN); \
        _Pragma("unroll") for (int db = 0; db < 2; ++db) UB[db] = *GPC(u32x2)(UT + ((((size_t)item_ * 8 + sl * 2 + db) * 2 + (w >> 1)) * 64 + fr + 16 * ((w & 1) * 2 + (fq >> 1))) * 8 + (fq & 1) * 4); \
        GTV = *GPC(float)(GT + item_); } while (0)
        u32x2 ubA[2], ubB[2], ubC[2]; float gtA, gtB, gtC;
        SCAN_LOAD(0, ubA, gtA); SCAN_LOAD(1, ubB, gtB);
#define SCAN_STEP(N_, UB, GTV, NUB, NGT) do { \
        const int n = (N_); \
        { const int nn = n + 2 < 64 ? n + 2 : 63; SCAN_LOAD(nn, NUB, NGT); } \
        const unsigned char* slot = RING + (n & 3) * 32768; \
        { bf16x8 sb_[2][4], wf_[4]; \
          _Pragma("unroll") for (int ks = 0; ks < 4; ++ks) wf_[ks] = lds8(slot + ((w * 4 + ks) * 64 + lane) * 16); \
          _Pragma("unroll") for (int db = 0; db < 2; ++db) _Pragma("unroll") for (int ks = 0; ks < 4; ++ks) sb_[db][ks] = lds8(STL + ((db * 16 + fr) * 136 + ks * 32 + fq * 8) * 2); \
          f32x4 a10 = (f32x4){0.f, 0.f, 0.f, 0.f}, a11 = (f32x4){0.f, 0.f, 0.f, 0.f}; \
          _Pragma("unroll") for (int ks = 0; ks < 4; ++ks) { a10 = mfma16(wf_[ks], sb_[0][ks], a10); a11 = mfma16(wf_[ks], sb_[1][ks], a11); } \
          _Pragma("unroll") for (int db = 0; db < 2; ++db) { \
              const f32x4 a1 = db ? a11 : a10; u32x2 vw; \
              vw.x = cvt_pk_bf16(bf_lo(UB[db].x) - a1[0], bf_hi(UB[db].x) - a1[1]); vw.y = cvt_pk_bf16(bf_lo(UB[db].y) - a1[2], bf_hi(UB[db].y) - a1[3]); \
              *reinterpret_cast<u32x2*>(VTL + ((db * 16 + fr) * 72 + w * 16 + fq * 4) * 2) = vw; \
              } } \
        LDS_BAR(); \
        { bf16x8 vb_[2][2], kf_[2][2]; \
          _Pragma("unroll") for (int kb = 0; kb < 2; ++kb) _Pragma("unroll") for (int ks = 0; ks < 2; ++ks) kf_[kb][ks] = lds8(slot + 16384 + (((2 * w + kb) * 2 + ks) * 64 + lane) * 16); \
          _Pragma("unroll") for (int db = 0; db < 2; ++db) _Pragma("unroll") for (int ks = 0; ks < 2; ++ks) vb_[db][ks] = lds8(VTL + ((db * 16 + fr) * 72 + ks * 32 + fq * 8) * 2); \
          _Pragma("unroll") for (int kb = 0; kb < 2; ++kb) _Pragma("unroll") for (int db = 0; db < 2; ++db) { \
              f32x4 a2 = S[kb][db] * GTV; \
              a2 = mfma16(kf_[kb][0], vb_[db][0], a2); a2 = mfma16(kf_[kb][1], vb_[db][1], a2); \
              S[kb][db] = a2; \
              if (n < 63) { \
                  u32x2 sw; sw.x = cvt_pk_bf16(a2[0], a2[1]); sw.y = cvt_pk_bf16(a2[2], a2[3]); \
                  *reinterpret_cast<u32x2*>(STL + ((db * 16 + fr) * 136 + (2 * w + kb) * 16 + fq * 4) * 2) = sw; \
              } } } \
        LDS_BAR(); } while (0)
        for (int n3 = 0; n3 < 63; n3 += 3) {
            SCAN_STEP(n3 + 0, ubA, gtA, ubC, gtC);
            SCAN_STEP(n3 + 1, ubB, gtB, ubA, gtA);
            SCAN_STEP(n3 + 2, ubC, gtC, ubB, gtB);
        }
        SCAN_STEP(63, ubA, gtA, ubC, gtC);
#undef SCAN_STEP
#undef SCAN_LOAD
    }
#undef LDS_BAR
}

__device__ __forceinline__ void swa_phase(const Params& p_, int l, int sblk, int nsb, int g_wave) {
    Params p = p_; p.ws = opaque_ws(p.ws);
    const int tid = opaque_tid(), lane = tid & 63, w = tid >> 6, fr = lane & 15, fq = lane >> 4;
    const bf16_t* HB = reinterpret_cast<const bf16_t*>(p.ws + OFF_HB);
    bf16_t* YM = reinterpret_cast<bf16_t*>(p.ws + OFF_XB);
    unsigned char* VTS = dyn_lds;
    unsigned char* KSL = dyn_lds + 21504;
    const int sw_xcd = sblk & 7, sw_j = sblk >> 3, sw_n = nsb >> 3;
    for (int qi = sw_j; qi < 128; qi += sw_n) {
        const int b = sw_xcd >> 1, kvh = qi & 1, qt = (sw_xcd & 1) * 64 + (qi >> 1), q0 = qt * 32, kbase = q0 - 128;
        for (int idx = tid; idx < 1280; idx += 512) {
            const int key = idx >> 3, sg = idx & 7, kp = kbase + key;
            u32x4 u = mk4(0u, 0u, 0u, 0u);
            if (kp >= 0) u = *GPC(u32x4)(HB + (size_t)(b * SEQ + kp) * HB_LD + HB_KB + kvh * 64 + sg * 8);
            *reinterpret_cast<u32x4*>(KSL + (key * 72 + sg * 8) * 2) = u;
        }
        if (tid < 320) {
            const int kg = tid >> 3, sg = tid & 7;
            u32x4 u[4];
#pragma unroll
            for (int k = 0; k < 4; ++k) {
                const int kp = kbase + kg * 4 + k;
                u[k] = mk4(0u, 0u, 0u, 0u);
                if (kp >= 0) u[k] = *GPC(u32x4)(HB + (size_t)(b * SEQ + kp) * HB_LD + HB_VB + kvh * 64 + sg * 8);
            }
#pragma unroll
            for (int dp = 0; dp < 4; ++dp) {
                u32x2 lo, hi;
                lo.x = (u[0][dp] & 0xffffu) | (u[1][dp] << 16); lo.y = (u[2][dp] & 0xffffu) | (u[3][dp] << 16);
                hi.x = (u[0][dp] >> 16) | (u[1][dp] & 0xffff0000u); hi.y = (u[2][dp] >> 16) | (u[3][dp] & 0xffff0000u);
                *reinterpret_cast<u32x2*>(VTS + ((sg * 8 + dp * 2) * 168 + kg * 4) * 2) = lo;
                *reinterpret_cast<u32x2*>(VTS + ((sg * 8 + dp * 2 + 1) * 168 + kg * 4) * 2) = hi;
            }
        }
        const int g = w >> 1, sub = w & 1, qs = q0 + sub * 16, hq = kvh * 4 + g;
        const float slope = exp2f(-(float)(hq + 1)), sink = p.sinks[l * 8 + hq];
        bf16x8 qf[2];
#pragma unroll
        for (int ks = 0; ks < 2; ++ks) qf[ks] = ldg8(HB + (size_t)(b * SEQ + qs + fr) * HB_LD + HB_QB + hq * 64 + ks * 32 + fq * 8);
        __syncthreads();
        f32x4 sc[10];
#pragma unroll
        for (int kt = 0; kt < 10; ++kt) {
            const unsigned char* kr = KSL + ((kt * 16 + fr) * 72 + fq * 8) * 2;
            f32x4 a = (f32x4){0.f, 0.f, 0.f, 0.f};
            a = mfma16(lds8(kr), qf[0], a);
            a = mfma16(lds8(kr + 64), qf[1], a);
            sc[kt] = a;
        }
        const int qpos = qs + fr;
        float m = -1e30f;
#pragma unroll
        for (int kt = 0; kt < 10; ++kt)
#pragma unroll
            for (int r = 0; r < 4; ++r) {
                const int kpos = kbase + kt * 16 + fq * 4 + r, dist = qpos - kpos;
                const bool valid = (dist >= 0) && (dist < 128) && (kpos >= 0);
                const float s = valid ? sc[kt][r] * 0.125f - slope * (float)dist : -1e30f;
                sc[kt][r] = s; m = fmaxf(m, s);
            }
        m = fmaxf(m, shx(m, 16, lane)); m = fmaxf(m, shx(m, 32, lane));
        m = fmaxf(m, sink);
        float lsum = 0.f;
#pragma unroll
        for (int kt = 0; kt < 10; ++kt)
#pragma unroll
            for (int r = 0; r < 4; ++r) { const float e = __expf(sc[kt][r] - m); sc[kt][r] = e; lsum += e; }
        lsum += shx(lsum, 16, lane); lsum += shx(lsum, 32, lane);
        lsum += __expf(sink - m);
        const float inv = __builtin_amdgcn_rcpf(lsum);
        f32x4 o[4];
#pragma unroll
        for (int db = 0; db < 4; ++db) o[db] = (f32x4){0.f, 0.f, 0.f, 0.f};
#pragma unroll
        for (int j = 0; j < 5; ++j) {
            union { bf16x8 v; unsigned u[4]; } pf;
            pf.u[0] = cvt_pk_bf16(sc[2 * j][0], sc[2 * j][1]); pf.u[1] = cvt_pk_bf16(sc[2 * j][2], sc[2 * j][3]);
            pf.u[2] = cvt_pk_bf16(sc[2 * j + 1][0], sc[2 * j + 1][1]); pf.u[3] = cvt_pk_bf16(sc[2 * j + 1][2], sc[2 * j + 1][3]);
#pragma unroll
            for (int db = 0; db < 4; ++db) {
                union { bf16x8 v; u32x2 h[2]; } vf;
                const unsigned char* vr = VTS + ((db * 16 + fr) * 168 + (2 * j) * 16 + fq * 4) * 2;
                vf.h[0] = *reinterpret_cast<const u32x2*>(vr);
                vf.h[1] = *reinterpret_cast<const u32x2*>(vr + 32);
                o[db] = mfma16(vf.v, pf.v, o[db]);
            }
        }
        {
            const size_t tok = (size_t)(b * SEQ + qs + fr);
#pragma unroll
            for (int db = 0; db < 4; ++db) {
                const int col = hq * 64 + db * 16 + fq * 4;
                const u32x2 z = *GPC(u32x2)(HB + tok * HB_LD + HB_ZB + col);
                u32x2 y;
                y.x = cvt_pk_bf16(o[db][0] * inv * silu_f(bf_lo(z.x)), o[db][1] * inv * silu_f(bf_hi(z.x)));
                y.y = cvt_pk_bf16(o[db][2] * inv * silu_f(bf_lo(z.y)), o[db][3] * inv * silu_f(bf_hi(z.y)));
                *GP(u32x2)(YM + tok * DM + 512 + col) = y;
            }
        }
        __syncthreads();
    }
}

__device__ __forceinline__ void delta_out(const Params& p_, int l, int g_wave) {
    Params p = p_; p.ws = opaque_ws(p.ws);
    const int tid = opaque_tid(), grp = tid >> 8, lane = tid & 63, wv = (tid & 255) >> 6, fr = lane & 15, fq = lane >> 4;
    const bf16_t* ST = reinterpret_cast<const bf16_t*>(p.ws + OFF_HA);
    const bf16_t* VT = reinterpret_cast<const bf16_t*>(p.ws + OFF_UT);
    const bf16_t* QD = reinterpret_cast<const bf16_t*>(p.ws + OFF_QD);
    const bf16_t* QK = reinterpret_cast<const bf16_t*>(p.ws + OFF_QK);
    const bf16_t* HB = reinterpret_cast<const bf16_t*>(p.ws + OFF_HB);
    bf16_t* YM = reinterpret_cast<bf16_t*>(p.ws + OFF_XB);
    const float* nw = p.norm_w + l * 128;
    for (int rr = 0; rr < 2; ++rr) {
        const int xcd_ = blockIdx.x & 7, q_ = (blockIdx.x >> 3) + 32 * rr;
        const int b = xcd_ >> 1, n = (xcd_ & 1) * 32 + (q_ >> 1), h = (q_ & 1) * 2 + grp, item = (b * 4 + h) * 64 + n;
        const int tok = b * SEQ + n * 64 + wv * 16 + fr;
        bf16x8 qd[4], qk[2];
#pragma unroll
        for (int ks = 0; ks < 4; ++ks) qd[ks] = ldg8(QD + ((((size_t)item * 4 + wv) * 4 + ks) * 64 + lane) * 8);
#pragma unroll
        for (int ks = 0; ks < 2; ++ks) qk[ks] = ldg8(QK + ((((size_t)item * 4 + wv) * 2 + ks) * 64 + lane) * 8);
        u32x2 zz[8];
#pragma unroll
        for (int db = 0; db < 8; ++db) zz[db] = *GPC(u32x2)(HB + (size_t)tok * HB_LD + HB_ZA + h * 128 + db * 16 + fq * 4);
        f32x4 o[8];
        float ss = 0.f;
        bf16x8 sfA[4], vfA[2], sfB[4], vfB[2];
#define DO_LOAD(DB, SF, VF) do { const bf16_t* sp = ST + ((((size_t)item * 8 + (DB)) * 4) * 64 + lane) * 8; const bf16_t* vp = VT + ((((size_t)item * 8 + (DB)) * 2) * 64 + lane) * 8; \
            _Pragma("unroll") for (int ks = 0; ks < 4; ++ks) SF[ks] = ldg8(sp + ks * 512); \
            _Pragma("unroll") for (int ks = 0; ks < 2; ++ks) VF[ks] = ldg8(vp + ks * 512); } while (0)
#define DO_MMA(DB, SF, VF) do { f32x4 a = (f32x4){0.f, 0.f, 0.f, 0.f}; \
            _Pragma("unroll") for (int ks = 0; ks < 4; ++ks) a = mfma16(SF[ks], qd[ks], a); \
            _Pragma("unroll") for (int ks = 0; ks < 2; ++ks) a = mfma16(VF[ks], qk[ks], a); \
            o[DB] = a; ss += (a[0] * a[0] + a[1] * a[1]) + (a[2] * a[2] + a[3] * a[3]); } while (0)
        DO_LOAD(0, sfA, vfA); DO_LOAD(1, sfB, vfB);
#pragma unroll
        for (int db = 0; db < 8; db += 2) {
            DO_MMA(db, sfA, vfA);
            if (db + 2 < 8) DO_LOAD(db + 2, sfA, vfA);
            DO_MMA(db + 1, sfB, vfB);
            if (db + 3 < 8) DO_LOAD(db + 3, sfB, vfB);
        }
#undef DO_LOAD
#undef DO_MMA
        ss += shx(ss, 16, lane); ss += shx(ss, 32, lane);
        const float rs = rsqrtf(ss * (1.0f / 128.0f) + 1e-6f);
#pragma unroll
        for (int db = 0; db < 8; ++db) {
            const int dv = db * 16 + fq * 4;
            const f32x4 nv = *GPC(f32x4)(nw + dv);
            const u32x2 z = zz[db];
            u32x2 y;
            y.x = cvt_pk_bf16(o[db][0] * rs * nv[0] * silu_f(bf_lo(z.x)), o[db][1] * rs * nv[1] * silu_f(bf_hi(z.x)));
            y.y = cvt_pk_bf16(o[db][2] * rs * nv[2] * silu_f(bf_lo(z.y)), o[db][3] * rs * nv[3] * silu_f(bf_hi(z.y)));
            *GP(u32x2)(YM + (size_t)tok * DM + h * 128 + dv) = y;
        }
    }
}


__global__ void __launch_bounds__(512) fwd_megakernel(Params p) {
    __shared__ u32x4 xb_words;
    const int g_wave = __builtin_amdgcn_readfirstlane((int)(threadIdx.x >> 6));
    if (xb_t0(g_wave)) xb_words = mk4(0u, 0u, 0u, 0u);
    __syncthreads();
    XcdBarrier gb = xcd_barrier_post(reinterpret_cast<unsigned*>(p.ws + OFF_BAR), (volatile LAS unsigned*)&xb_words, g_wave);

    prep_weights(p, 0, blockIdx.x, gridDim.x, g_wave);
    row_pass(p.x, false, nullptr, nullptr, nullptr, reinterpret_cast<bf16_t*>(p.ws + OFF_XB), p.w_in + 2048, reinterpret_cast<float*>(p.ws + OFF_BA), g_wave);
    xcd_barrier(gb);
    for (int l = 0; l < 2; ++l) {
        unsigned char* wsl = opaque_ws(p.ws);
        bf16_t* XB = reinterpret_cast<bf16_t*>(wsl + OFF_XB);
        float* BA = reinterpret_cast<float*>(wsl + OFF_BA);
        {
            EpiH e; e.ha = reinterpret_cast<bf16_t*>(p.ws + OFF_HA); e.hb = reinterpret_cast<bf16_t*>(p.ws + OFF_HB);
            gemm_phase(XB, reinterpret_cast<const bf16_t*>(p.ws + OFF_WIN) + (size_t)l * NIN * DM, NTOK, NIN, DM, e, g_wave);
            if (l == 0 && blockIdx.x >= 64) prep_weights(p, 1, blockIdx.x - 64, gridDim.x - 64, g_wave);
        }
        xcd_barrier(gb);
        chunk_prep(p, l, g_wave);
        xcd_barrier(gb);
        if (blockIdx.x < 64) delta_scan(p, blockIdx.x, g_wave);
        else swa_phase(p, l, blockIdx.x - 64, gridDim.x - 64, g_wave);
        xcd_barrier(gb);
        if (l == 0) { const int t_ = opaque_tid(); float zf_ = 0.f; asm volatile("" : "+v"(zf_)); for (int i = blockIdx.x * 512 + t_; i < NTOK * 2; i += gridDim.x * 512) *GP(f32x4)(BA + (size_t)i * 4) = (f32x4){zf_, zf_, zf_, zf_}; }
        delta_out(p, l, g_wave);
        xcd_barrier(gb);
        {
            EpiLN e; e.xres = (l == 0) ? p.x : p.out; e.out = p.out; e.xb = (l == 0) ? XB : nullptr;
            e.g = p.ln_g + l * DM; e.b = p.ln_b + l * DM; e.wg = (l == 0) ? p.w_in + (size_t)DM * INC + 2048 : nullptr; e.BA = BA;
            e.xbuf = reinterpret_cast<float*>(wsl + OFF_XS) + (size_t)l * NTOK * 8;
            e.cnt = reinterpret_cast<unsigned*>(wsl + OFF_BAR) + 3500 + l * 64; e.tmo = reinterpret_cast<unsigned*>(wsl + OFF_BAR) + XB_TMO; e.gw = g_wave;
            gemm_phase(XB, reinterpret_cast<const bf16_t*>(p.ws + OFF_WOUT) + (size_t)l * DM * DM, NTOK, DM, DM, e, g_wave);
        }
        if (l == 0) xcd_barrier(gb);
    }
}

extern "C" void kernel_launch(void* const* d_in, const int* in_sizes, int n_in, void* d_out, int out_size, void* d_ws, size_t ws_size, hipStream_t stream) {
    static int grid_blocks = 0;
    if (!grid_blocks) {
        int dev = 0, cus = 0, per_cu = 0;
        hipGetDevice(&dev);
        hipDeviceGetAttribute(&cus, hipDeviceAttributeMultiprocessorCount, dev);
        hipFuncSetAttribute((const void*)fwd_megakernel, hipFuncAttributeMaxDynamicSharedMemorySize, LDS_BYTES);
        hipOccupancyMaxActiveBlocksPerMultiprocessor(&per_cu, fwd_megakernel, 512, LDS_BYTES);
        grid_blocks = (per_cu >= 1) ? cus : 0;
        if (grid_blocks > 256) grid_blocks = 256;
        if (ws_size < WS_NEED) { fprintf(stderr, "workspace too small: %zu < %zu\n", ws_size, (size_t)WS_NEED); }
        if (!grid_blocks) { fprintf(stderr, "occupancy query returned 0\n"); grid_blocks = 256; }
    }
    Params p{};
    p.x = (const float*)d_in[0]; p.w_in = (const float*)d_in[1]; p.conv_w = (const float*)d_in[2]; p.a_log = (const float*)d_in[3];
    p.dt_bias = (const float*)d_in[4]; p.norm_w = (const float*)d_in[5]; p.sinks = (const float*)d_in[6]; p.w_out = (const float*)d_in[7];
    p.ln_g = (const float*)d_in[8]; p.ln_b = (const float*)d_in[9]; p.out = (float*)d_out; p.ws = (unsigned char*)d_ws;
    hipMemsetAsync(d_ws, 0, 16384, stream);
    void* args[] = {&p};
    hipError_t e = hipLaunchCooperativeKernel((const void*)fwd_megakernel, dim3(grid_blocks), dim3(512), args, LDS_BYTES, stream);
    if (e != hipSuccess) fprintf(stderr, "cooperative launch failed: %s (grid %d)\n", hipGetErrorString(e), grid_blocks);
}
```
